# Optimizing an MI355X kernel written in HIP

```python
import math
import jax, jax.numpy as jnp
from jax import lax
import numpy as np

D_MODEL = 2048
BATCH = 2
SEQ = 8192
DEPTH = 1
DEC_BATCH = 32
DEC_SEQ = 8
PAST_LEN = 16384
PAGE_SIZE = 128

RET_HEADS = 8
RET_DK = 128
RET_DV = 128
RET_WIDTH = RET_HEADS * RET_DV
RET_CHUNK = 128
ATT_GROUPS = ((128, 1), (512, 4), (2048, 16))
N_GROUPS = 3
ATT_HG = 4
ATT_HD = 128
ATT_GW = ATT_HG * ATT_HD
ATT_SPAN = 128
ATT_BLK = 128
ALIBI_MAX = 8.0
D_FF = 5632
CONV_W = 3
EPS = 1e-6
NEG = -1e30
IN_COLS = 4 * RET_WIDTH + 3 * N_GROUPS * ATT_GW + 2 * D_MODEL

kernel_name = 'retention_dilated_swa_convffn_step'


def _rmsnorm(x, g):
    xf = x.astype(jnp.float32)
    xf = xf * lax.rsqrt(jnp.mean(xf * xf, axis=-1, keepdims=True) + EPS)
    return xf.astype(x.dtype) * g


def _split_offsets():
    sizes = [RET_WIDTH] * 4 + [ATT_GW] * (3 * N_GROUPS) + [D_MODEL] * 2
    offs, acc = [], 0
    for s in sizes[:-1]:
        acc += s
        offs.append(acc)
    return offs


def _log_gamma():
    return jnp.log(1.0 - jnp.exp2(-5.0 - jnp.arange(RET_HEADS, dtype=jnp.float32)))


def _alibi_slopes():
    n = N_GROUPS * ATT_HG
    h = jnp.arange(1, n + 1, dtype=jnp.float32)
    return jnp.exp2(-ALIBI_MAX * h / n).reshape(N_GROUPS, ATT_HG)


def _retention_chunk(state, q, k, v):
    L = q.shape[1]
    lg = _log_gamma()
    pos = jnp.arange(L, dtype=jnp.float32)
    diff = pos[:, None] - pos[None, :]
    dmask = jnp.where(diff >= 0, jnp.exp(jnp.maximum(diff, 0.0)[None] * lg[:, None, None]), 0.0)
    scores = jnp.einsum('bihd,bjhd->bhij', q, k) * dmask
    inner = jnp.einsum('bhij,bjhe->bihe', scores, v)
    q_decay = jnp.exp((pos[:, None] + 1.0) * lg[None])
    cross = jnp.einsum('bihd,bhde->bihe', q, state) * q_decay[None, :, :, None]
    k_decay = jnp.exp((L - 1.0 - pos)[:, None] * lg[None])
    new_state = (state * jnp.exp(L * lg)[None, :, None, None]
                 + jnp.einsum('bjhd,bjhe->bhde', k * k_decay[None, :, :, None], v))
    return new_state, inner + cross


def _retention_prompt(q, k, v):
    B, S, H, _ = q.shape
    nc = S // RET_CHUNK
    def to_chunks(t):
        return t.reshape(B, nc, RET_CHUNK, H, t.shape[-1]).swapaxes(0, 1)
    state0 = jnp.zeros((B, H, RET_DK, RET_DV), jnp.float32)
    def step(st, qkv):
        return _retention_chunk(st, qkv[0], qkv[1], qkv[2])
    st, out = lax.scan(step, state0, (to_chunks(q), to_chunks(k), to_chunks(v)))
    return st, out.swapaxes(0, 1).reshape(B, S, H, RET_DV)


def _retention_branch(rq, rk, rv, rg, gn_ret, w_ret_o, state):
    B, L, _ = rq.shape
    q = rq.reshape(B, L, RET_HEADS, RET_DK).astype(jnp.float32)
    k = rk.reshape(B, L, RET_HEADS, RET_DK).astype(jnp.float32) * (RET_DK ** -0.5)
    v = rv.reshape(B, L, RET_HEADS, RET_DV).astype(jnp.float32)
    if state is None:
        new_state, y = _retention_prompt(q, k, v)
    else:
        new_state, y = _retention_chunk(state.astype(jnp.float32), q, k, v)
    mu = jnp.mean(y, axis=-1, keepdims=True)
    yc = y - mu
    yn = yc * lax.rsqrt(jnp.mean(yc * yc, axis=-1, keepdims=True) + EPS)
    yn = yn.reshape(B, L, RET_WIDTH).astype(rq.dtype) * gn_ret
    return (jax.nn.silu(rg) * yn) @ w_ret_o, new_state


def _dilated_prompt(q, k, v, dil, slopes):
    B, S, H, hd = q.shape
    L = S // dil
    nb = -(-L // ATT_BLK)
    Lp = nb * ATT_BLK
    N = B * dil
    def sub(t):
        t = t.reshape(B, L, dil, H, hd).swapaxes(1, 2).reshape(N, L, H, hd)
        return jnp.pad(t, ((0, 0), (0, Lp - L), (0, 0), (0, 0)))
    def band(t):
        t = jnp.pad(t, ((0, 0), (ATT_BLK, 0), (0, 0), (0, 0))).reshape(N, nb + 1, ATT_BLK, H, hd)
        return jnp.concatenate([t[:, :-1], t[:, 1:]], axis=2)
    qb = sub(q).reshape(N, nb, ATT_BLK, H, hd)
    kb = band(sub(k))
    vb = band(sub(v))
    r = jnp.arange(ATT_BLK)[:, None]
    c = jnp.arange(2 * ATT_BLK)[None, :]
    dist = ATT_BLK + r - c
    key_idx = jnp.arange(nb)[:, None, None] * ATT_BLK - ATT_BLK + c[None]
    valid = (dist >= 0)[None] & (dist <= ATT_SPAN)[None] & (key_idx >= 0)
    bias = -slopes[:, None, None] * (dil * dist).astype(jnp.float32)[None]
    s = jnp.einsum('nbqhd,nbkhd->nbhqk', qb, kb).astype(jnp.float32) * (hd ** -0.5) + bias[None, None]
    s = jnp.where(valid[None, :, None], s, NEG)
    lse = jax.nn.logsumexp(s, axis=-1)
    p = jnp.exp(s - lse[..., None])
    o = jnp.einsum('nbhqk,nbkhd->nbqhd', p.astype(v.dtype), vb)
    o = o.reshape(N, Lp, H, hd)[:, :L].reshape(B, dil, L, H, hd).swapaxes(1, 2).reshape(B, S, H, hd)
    lse = lse.transpose(0, 1, 3, 2).reshape(N, Lp, H)[:, :L]
    lse = lse.reshape(B, dil, L, H).swapaxes(1, 2).reshape(B, S, H)
    return o, lse


def _dilated_sample(q, k, v, buf, dil, slopes):
    B, T, H, hd = q.shape
    Wb = buf.shape[1]
    buf = buf.astype(k.dtype)
    kall = jnp.concatenate([buf[:, :, 0], k], axis=1)
    vall = jnp.concatenate([buf[:, :, 1], v], axis=1)
    j = jnp.arange(ATT_SPAN + 1)
    idx = Wb + jnp.arange(T)[:, None] - dil * j[None]
    valid = idx >= 0
    idx = jnp.maximum(idx, 0)
    kg = kall[:, idx]
    vg = vall[:, idx]
    bias = -slopes[:, None, None] * (dil * j).astype(jnp.float32)[None, None]
    s = jnp.einsum('bthd,btjhd->bhtj', q, kg).astype(jnp.float32) * (hd ** -0.5) + bias[None]
    s = jnp.where(valid[None, None], s, NEG)
    lse = jax.nn.logsumexp(s, axis=-1)
    p = jnp.exp(s - lse[..., None])
    o = jnp.einsum('bhtj,btjhd->bthd', p.astype(v.dtype), vg)
    new_buf = jnp.concatenate([buf, jnp.stack([k, v], axis=2)], axis=1)[:, T:]
    return o, lse.swapaxes(1, 2), new_buf


def _dilated_branch(att_cols, kv_bufs, w_att_o):
    B, L, _ = att_cols[0].shape
    slopes = _alibi_slopes()
    outs, lses, new_bufs = [], [], []
    for g, (win, dil) in enumerate(ATT_GROUPS):
        q, k, v = (t.reshape(B, L, ATT_HG, ATT_HD) for t in att_cols[3 * g:3 * g + 3])
        if kv_bufs is None:
            o, lse = _dilated_prompt(q, k, v, dil, slopes[g])
            nbuf = jnp.stack([k, v], axis=2)[:, -min(win, L):]
        else:
            o, lse, nbuf = _dilated_sample(q, k, v, kv_bufs[g], dil, slopes[g])
        outs.append(o)
        lses.append(lse)
        new_bufs.append(nbuf)
    wts = jax.nn.softmax(jnp.stack(lses, axis=0), axis=0)
    o = jnp.einsum('gblh,gblhd->blhd', wts.astype(outs[0].dtype), jnp.stack(outs, axis=0))
    return o.reshape(B, L, ATT_GW) @ w_att_o, new_bufs


def _conv_ffn(h, w_up, conv_w, conv_b, w_down, prev):
    L = h.shape[1]
    u = h @ w_up
    ext = jnp.concatenate([prev.astype(u.dtype), u], axis=1)
    c = conv_b + sum(ext[:, t:t + L] * conv_w[t] for t in range(CONV_W))
    a, b = jnp.split(c, 2, axis=-1)
    return (jax.nn.gelu(a, approximate=False) * b) @ w_down, ext[:, -(CONV_W - 1):]


def _layer(x, ret_state, kv_bufs, conv_state, g_mix, w_in, gn_ret, w_ret_o, w_att_o, w_o,
           g_ffn, w_up, conv_w, conv_b, w_down):
    h = _rmsnorm(x, g_mix)
    parts = jnp.split(h @ w_in, _split_offsets(), axis=-1)
    rq, rk, rv, rg = parts[0:4]
    att_cols = parts[4:4 + 3 * N_GROUPS]
    gate_ret, gate_att = parts[4 + 3 * N_GROUPS:]
    ret_out, new_ret = _retention_branch(rq, rk, rv, rg, gn_ret, w_ret_o, ret_state)
    att_out, new_bufs = _dilated_branch(att_cols, kv_bufs, w_att_o)
    merged = jax.nn.sigmoid(gate_ret) * ret_out + jax.nn.sigmoid(gate_att) * att_out
    x = x + merged @ w_o
    if conv_state is None:
        conv_state = jnp.zeros((x.shape[0], CONV_W - 1, 2 * D_FF), x.dtype)
    ffn_out, new_conv = _conv_ffn(_rmsnorm(x, g_ffn), w_up, conv_w, conv_b, w_down, conv_state)
    return x + ffn_out, new_ret, new_bufs, new_conv


def setup_inputs(seed: int = 0) -> dict:
    key = jax.random.key(seed)
    ks = jax.random.split(key, 20)
    f32 = jnp.float32
    def nrm(k, shape, scale=1.0):
        return jax.random.normal(k, shape, f32) * scale
    F2 = 2 * D_FF
    return {
        'x_prompt': nrm(ks[0], (BATCH, SEQ, D_MODEL)),
        'x_sample': nrm(ks[1], (DEC_BATCH, DEC_SEQ, D_MODEL)),
        'state_ret': nrm(ks[2], (DEPTH, DEC_BATCH, RET_HEADS, RET_DK, RET_DV), 0.5),
        'cache_kv_w128': nrm(ks[3], (DEPTH, DEC_BATCH, min(ATT_GROUPS[0][0], PAST_LEN), 2, ATT_HG, ATT_HD)),
        'cache_kv_w512': nrm(ks[4], (DEPTH, DEC_BATCH, min(ATT_GROUPS[1][0], PAST_LEN), 2, ATT_HG, ATT_HD)),
        'cache_kv_w2048': nrm(ks[5], (DEPTH, DEC_BATCH, min(ATT_GROUPS[2][0], PAST_LEN), 2, ATT_HG, ATT_HD)),
        'state_conv': nrm(ks[6], (DEPTH, DEC_BATCH, CONV_W - 1, F2)),
        'g_mix': 1.0 + nrm(ks[7], (DEPTH, D_MODEL), 0.01),
        'w_in': nrm(ks[8], (DEPTH, D_MODEL, IN_COLS), D_MODEL ** -0.5),
        'gn_ret': 1.0 + nrm(ks[9], (DEPTH, RET_WIDTH), 0.01),
        'w_ret_o': nrm(ks[10], (DEPTH, RET_WIDTH, D_MODEL), RET_WIDTH ** -0.5),
        'w_att_o': nrm(ks[11], (DEPTH, ATT_GW, D_MODEL), ATT_GW ** -0.5),
        'w_o': nrm(ks[12], (DEPTH, D_MODEL, D_MODEL), D_MODEL ** -0.5),
        'g_ffn': 1.0 + nrm(ks[13], (DEPTH, D_MODEL), 0.01),
        'w_up': nrm(ks[14], (DEPTH, D_MODEL, F2), D_MODEL ** -0.5),
        'conv_w': nrm(ks[15], (DEPTH, CONV_W, F2), CONV_W ** -0.5),
        'conv_b': nrm(ks[16], (DEPTH, F2), 0.01),
        'w_down': nrm(ks[17], (DEPTH, D_FF, D_MODEL), D_FF ** -0.5),
        'g_final': 1.0 + nrm(ks[18], (D_MODEL,), 0.01),
    }


def reference(x_prompt, x_sample, state_ret, cache_kv_w128, cache_kv_w512, cache_kv_w2048, state_conv,
              g_mix, w_in, gn_ret, w_ret_o, w_att_o, w_o, g_ffn, w_up, conv_w, conv_b, w_down, g_final):
    xp, xs = x_prompt, x_sample
    ret_p, ret_s, conv_p, conv_s = [], [], [], []
    kv_p = [[] for _ in range(N_GROUPS)]
    kv_s = [[] for _ in range(N_GROUPS)]
    for l in range(DEPTH):
        wts = (g_mix[l], w_in[l], gn_ret[l], w_ret_o[l], w_att_o[l], w_o[l],
               g_ffn[l], w_up[l], conv_w[l], conv_b[l], w_down[l])
        xp, r, bufs, cv = _layer(xp, None, None, None, *wts)
        ret_p.append(r)
        conv_p.append(cv)
        for g in range(N_GROUPS):
            kv_p[g].append(bufs[g])
        xs, r, bufs, cv = _layer(xs, state_ret[l], (cache_kv_w128[l], cache_kv_w512[l], cache_kv_w2048[l]),
                                 state_conv[l], *wts)
        ret_s.append(r)
        conv_s.append(cv)
        for g in range(N_GROUPS):
            kv_s[g].append(bufs[g])
    y_prompt = _rmsnorm(xp, g_final)
    y_sample = _rmsnorm(xs, g_final)
    return (y_prompt, y_sample,
            jnp.stack(ret_p), jnp.stack(ret_s),
            jnp.stack(kv_p[0]), jnp.stack(kv_s[0]),
            jnp.stack(kv_p[1]), jnp.stack(kv_s[1]),
            jnp.stack(kv_p[2]), jnp.stack(kv_s[2]),
            jnp.stack(conv_p), jnp.stack(conv_s))
```

```cpp
#include <hip/hip_runtime.h>
#include <hip/hip_cooperative_groups.h>
#include <cstdio>
#include <cstdint>
namespace cg = cooperative_groups;

#define LAS __attribute__((address_space(3)))
typedef unsigned short bf16_t;
typedef short bf16x8 __attribute__((ext_vector_type(8)));
typedef float f32x4 __attribute__((ext_vector_type(4)));
typedef float f32x2 __attribute__((ext_vector_type(2)));
typedef unsigned u32x4 __attribute__((ext_vector_type(4)));
typedef unsigned u32x2 __attribute__((ext_vector_type(2)));

constexpr int DM = 2048, SEQ = 8192, MP = 16384, MS = 256, MT = MP + MS;
constexpr int INC = 12800, FF = 5632, F2 = 11264;
constexpr int C_RQ = 0, C_RK = 1024, C_RV = 2048, C_RG = 3072, C_ATT = 4096, C_GR = 8704, C_GA = 10752;
constexpr float EPS = 1e-6f;
constexpr float QK_SCALE = 0.08838834764831845f;
constexpr size_t O_Y = 0;
constexpr size_t O_RETP = 34078720, O_RETS = 34340864;
constexpr size_t O_KV128P = 38535168, O_KV128S = 38797312, O_KV512P = 42991616, O_KV512S = 44040192, O_KV2048P = 60817408, O_KV2048S = 65011712;
constexpr size_t O_CONVP = 132120576, O_CONVS = 132165632, O_END = 132886528;
constexpr size_t MiB = 1u << 20;
constexpr size_t WS_CTL = 0;
constexpr size_t WS_WIN = 1 * MiB, WS_WRETO = 51 * MiB, WS_WATTO = 55 * MiB, WS_WO = 57 * MiB, WS_WUP = 65 * MiB, WS_WDOWN = 109 * MiB;
constexpr size_t WS_XB = 131 * MiB;
constexpr size_t WS_PROJ = 196 * MiB;
constexpr size_t WS_KVC = 603 * MiB;
constexpr size_t WS_G = 699 * MiB;
constexpr size_t WS_OATT = 782 * MiB;
constexpr size_t WS_MERGED = 799 * MiB;
constexpr size_t WS_ACT = 603 * MiB;
constexpr size_t WS_END = 864 * MiB;

struct Params {
    const float* in[19];
    float* out;
    unsigned char* ws;
    int ph_lo, ph_hi;
};

__device__ __forceinline__ float bflo(unsigned w) { return __uint_as_float(w << 16); }
__device__ __forceinline__ float bfhi(unsigned w) { return __uint_as_float(w & 0xffff0000u); }
__device__ __forceinline__ float bf2f(bf16_t b) { return __uint_as_float((unsigned)b << 16); }
__device__ __forceinline__ unsigned f2bf(float f) { unsigned u = __float_as_uint(f); return (u + 0x7fffu + ((u >> 16) & 1u)) >> 16; }
__device__ __forceinline__ unsigned pk2(float lo, float hi) { return f2bf(lo) | (f2bf(hi) << 16); }
__device__ __forceinline__ float wave_sum(float v) {
#pragma unroll
    for (int o = 1; o < 64; o <<= 1) v += __shfl_xor(v, o);
    return v;
}
__device__ __forceinline__ float wave_max(float v) {
#pragma unroll
    for (int o = 1; o < 64; o <<= 1) v = fmaxf(v, __shfl_xor(v, o));
    return v;
}
__device__ __forceinline__ float sigmoidf_(float v) { return 1.0f / (1.0f + __expf(-v)); }
#define LDS_WAIT() asm volatile("s_waitcnt lgkmcnt(0)" ::: "memory")

namespace pg8 {
#define PG8_LAS __attribute__((address_space(3)))
constexpr int BM = 256, BK = 64, HALF = 128, HTB = HALF * BK * 2, STAGE_BYTES = 8 * HTB, NXCD = 8, WGM = 8;
__host__ __device__ __forceinline__ int lds_byte(int r, int c) { const int st = (r >> 4) * 2 + (c >> 5), rr = r & 15, cc = c & 31, ob = rr * 64 + cc * 2; return st * 1024 + (ob ^ (((ob >> 9) & 1) << 5)); }
__host__ __device__ __forceinline__ void stage_rc(int b, int& R, int& C) { const int st = b / 1024, sb = b % 1024, swz = sb ^ (((sb >> 9) & 1) << 5); R = (st >> 1) * 16 + swz / 64; C = (st & 1) * 32 + (swz % 64) / 2; }
__host__ __device__ __forceinline__ int perm32(int rho) { const int n = rho >> 4, i = rho & 15; return 8 * (i >> 2) + 4 * n + (i & 3); }
struct Unit { int pm, pn; };
struct Gemm { const bf16_t* A; const bf16_t* Bt; int M, N, K; };
struct StaticOrder {
    int nM, nN, nwg, G, c;
    __host__ __device__ void init(int M, int N, int G_, int c_) { nM = M / BM; nN = N / BM; nwg = nM * nN; G = G_; c = c_; }
    __host__ __device__ bool next(int i, Unit& u) const {
        const long L = (long)i * G + c; if (L >= nwg) return false;
        int wgid = (int)L; { const int q = nwg / NXCD, r = nwg % NXCD, xcd = wgid % NXCD, off = wgid / NXCD; wgid = (xcd < r ? xcd * (q + 1) : r * (q + 1) + (xcd - r) * q) + off; }
        const int nig = WGM * nN, gid = wgid / nig, fm = gid * WGM, gsz = (nM - fm) < WGM ? (nM - fm) : WGM;
        u.pm = fm + ((wgid % nig) % gsz); u.pn = (wgid % nig) / gsz; return true;
    }
    __device__ __forceinline__ void a_ready(const Unit&) const {}
    __device__ __forceinline__ void done(const Unit&) const {}
};

template <class Epi, class Sched, bool ALIGN_EPI = false, bool SP2 = false>
__device__ __forceinline__ void gemm_phase(PG8_LAS unsigned char* lds, const Gemm g, const Sched& S, const Epi& E) {
    const int tid = threadIdx.x, wid = __builtin_amdgcn_readfirstlane(tid >> 6), lane = tid & 63, wr = wid >> 2, wc = wid & 3, fr = lane & 15, fq = lane >> 4;
    const int K = g.K, nt = K / BK;
    unsigned voffA[2], voffB[2];
#pragma unroll
    for (int i = 0; i < 2; ++i) { int R, C; stage_rc(tid * 16 + i * 8192, R, C); const int Rb = Epi::PERM ? ((R & ~31) + perm32(R & 31)) : R;
        voffA[i] = (unsigned)(R * K + C) * 2u; voffB[i] = (unsigned)(Rb * K + C) * 2u; }
    const size_t kstep = (size_t)(BK * 2);
    const size_t hstep = (size_t)HALF * K * 2;
    const size_t tstep = 2 * hstep;
    const unsigned ldsw = (unsigned)wid * 1024u;
    const int aoff = lds_byte(wr * 64 + fr, fq * 8), boff = lds_byte(wc * 32 + fr, fq * 8);
#define PG8_SA(b, h) (((b) * 2 + (h)) * HTB)
#define PG8_SB(b, h) ((4 + (b) * 2 + (h)) * HTB)
#define PG8_STAGE(bufoff, gbase, voff) do { _Pragma("unroll") for (int _i = 0; _i < 2; ++_i) \
        __builtin_amdgcn_global_load_lds((const unsigned*)((const char*)(gbase) + (voff)[_i]), (PG8_LAS unsigned*)(lds + (bufoff) + ldsw + _i * 8192), 16, 0, 0); } while (0)
#define PG8_LDA(dst, b, h) do { _Pragma("unroll") for (int m = 0; m < 4; ++m) _Pragma("unroll") for (int k = 0; k < 2; ++k) dst[m][k] = *(const PG8_LAS bf16x8*)(lds + PG8_SA(b, h) + aoff + m * 2048 + k * 1024); } while (0)
#define PG8_LDB(dst, b, h) do { _Pragma("unroll") for (int n = 0; n < 2; ++n) _Pragma("unroll") for (int k = 0; k < 2; ++k) dst[n][k] = *(const PG8_LAS bf16x8*)(lds + PG8_SB(b, h) + boff + n * 2048 + k * 1024); } while (0)
#define PG8_MMA(ai, bj, At, Bt) do { __builtin_amdgcn_s_setprio(1); _Pragma("unroll") for (int m = 0; m < 4; ++m) _Pragma("unroll") for (int n = 0; n < 2; ++n) _Pragma("unroll") for (int k = 0; k < 2; ++k) \
        acc[ai][bj][m][n] = __builtin_amdgcn_mfma_f32_16x16x32_bf16(Bt[n][k], At[m][k], acc[ai][bj][m][n], 0, 0, 0); __builtin_amdgcn_s_setprio(0); } while (0)
#define PG8_WAIT_V(n) asm volatile("s_waitcnt vmcnt(" #n ")" ::: "memory")
#define PG8_WAIT_L(n) asm volatile("s_waitcnt lgkmcnt(" #n ")" ::: "memory")
#define PG8_BAR __builtin_amdgcn_s_barrier()
#define PG8_SCHED __builtin_amdgcn_sched_barrier(0)
    Unit cur, nxt; int ui = 0;
    if (!S.next(0, cur)) return;
    f32x4 acc[2][2][4][2];
#pragma unroll
    for (int a = 0; a < 2; ++a)
#pragma unroll
        for (int b = 0; b < 2; ++b)
#pragma unroll
            for (int m = 0; m < 4; ++m)
#pragma unroll
                for (int n = 0; n < 2; ++n) acc[a][b][m][n] = (f32x4){0.f, 0.f, 0.f, 0.f};
    bf16x8 At[4][2], B0[2][2], B1[2][2];
    const char* cA = (const char*)g.A + (size_t)cur.pm * tstep; const char* cB = (const char*)g.Bt + (size_t)cur.pn * tstep;
    S.a_ready(cur);
    if constexpr (SP2) {
        PG8_STAGE(PG8_SB(0, 0), cB, voffB); PG8_STAGE(PG8_SB(0, 1), cB + hstep, voffB); PG8_STAGE(PG8_SA(0, 0), cA, voffA); PG8_STAGE(PG8_SA(0, 1), cA + hstep, voffA);
        if (wr == 1) PG8_BAR;
        PG8_WAIT_V(2); PG8_BAR;
        PG8_STAGE(PG8_SB(1, 0), cB + kstep, voffB); PG8_STAGE(PG8_SA(1, 0), cA + kstep, voffA); PG8_STAGE(PG8_SB(1, 1), cB + hstep + kstep, voffB);
        PG8_WAIT_V(6); PG8_BAR;
    } else {
        PG8_STAGE(PG8_SB(0, 0), cB, voffB); PG8_STAGE(PG8_SA(0, 0), cA, voffA); PG8_STAGE(PG8_SB(0, 1), cB + hstep, voffB); PG8_STAGE(PG8_SA(0, 1), cA + hstep, voffA);
        if (wr == 1) PG8_BAR;
        PG8_WAIT_V(4); PG8_BAR;
        PG8_STAGE(PG8_SB(1, 0), cB + kstep, voffB); PG8_STAGE(PG8_SA(1, 0), cA + kstep, voffA); PG8_STAGE(PG8_SB(1, 1), cB + hstep + kstep, voffB);
        PG8_WAIT_V(6); PG8_BAR;
    }
    for (;;) {
        const bool has_next = S.next(ui + 1, nxt);
        const char* nA = has_next ? (const char*)g.A + (size_t)nxt.pm * tstep : cA; const char* nB = has_next ? (const char*)g.Bt + (size_t)nxt.pn * tstep : cB;
        for (int t = 0; t < nt; t += 2) {
            const bool last = (t == nt - 2);
            const char* a1 = cA + (size_t)(t + 1) * kstep;
            const char* a2 = last ? nA : cA + (size_t)(t + 2) * kstep; const char* b2 = last ? nB : cB + (size_t)(t + 2) * kstep;
            const char* a3 = a2 + kstep; const char* b3 = b2 + kstep;
            if (last && has_next) S.a_ready(nxt);
            if constexpr (SP2) {
            PG8_LDB(B0, 0, 0); PG8_LDB(B1, 0, 1); PG8_SCHED; PG8_LDA(At, 0, 0); PG8_STAGE(PG8_SA(1, 1), a1 + hstep, voffA);
            PG8_WAIT_V(8); PG8_WAIT_L(0); PG8_BAR; PG8_MMA(0, 0, At, B0); PG8_MMA(0, 1, At, B1); PG8_BAR; PG8_SCHED;
            PG8_LDA(At, 0, 1); PG8_STAGE(PG8_SB(0, 0), b2, voffB); PG8_STAGE(PG8_SB(0, 1), b2 + hstep, voffB); PG8_STAGE(PG8_SA(0, 0), a2, voffA);
            PG8_WAIT_V(8); PG8_WAIT_L(0); PG8_BAR; PG8_MMA(1, 0, At, B0); PG8_MMA(1, 1, At, B1); PG8_BAR; PG8_SCHED;
            PG8_LDB(B0, 1, 0); PG8_LDB(B1, 1, 1); PG8_SCHED; PG8_LDA(At, 1, 0); PG8_STAGE(PG8_SA(0, 1), a2 + hstep, voffA);
            PG8_WAIT_V(8); PG8_WAIT_L(0); PG8_BAR; PG8_MMA(0, 0, At, B0); PG8_MMA(0, 1, At, B1); PG8_BAR; PG8_SCHED;
            PG8_LDA(At, 1, 1); PG8_STAGE(PG8_SB(1, 0), b3, voffB); PG8_STAGE(PG8_SB(1, 1), b3 + hstep, voffB); PG8_STAGE(PG8_SA(1, 0), a3, voffA);
            PG8_WAIT_V(8); PG8_WAIT_L(0); PG8_BAR; PG8_MMA(1, 0, At, B0); PG8_MMA(1, 1, At, B1); PG8_BAR; PG8_SCHED;
            } else {
            PG8_LDB(B0, 0, 0); PG8_SCHED; PG8_LDA(At, 0, 0); PG8_STAGE(PG8_SA(1, 1), a1 + hstep, voffA);
            PG8_WAIT_L(8); PG8_BAR; PG8_WAIT_L(0); PG8_MMA(0, 0, At, B0); PG8_BAR; PG8_SCHED;
            PG8_LDB(B1, 0, 1); PG8_STAGE(PG8_SB(0, 0), b2, voffB);
            PG8_BAR; PG8_WAIT_L(0); PG8_MMA(0, 1, At, B1); PG8_BAR;
            PG8_LDA(At, 0, 1); PG8_STAGE(PG8_SA(0, 0), a2, voffA);
            PG8_BAR; PG8_WAIT_L(0); PG8_MMA(1, 0, At, B0); PG8_BAR; PG8_SCHED;
            PG8_STAGE(PG8_SB(0, 1), b2 + hstep, voffB);
            PG8_WAIT_V(6); PG8_BAR; PG8_MMA(1, 1, At, B1); PG8_BAR;
            PG8_LDB(B0, 1, 0); PG8_SCHED; PG8_LDA(At, 1, 0); PG8_STAGE(PG8_SA(0, 1), a2 + hstep, voffA);
            PG8_WAIT_L(8); PG8_BAR; PG8_WAIT_L(0); PG8_MMA(0, 0, At, B0); PG8_BAR; PG8_SCHED;
            PG8_LDB(B1, 1, 1); PG8_STAGE(PG8_SB(1, 0), b3, voffB);
            PG8_BAR; PG8_WAIT_L(0); PG8_MMA(0, 1, At, B1); PG8_BAR;
            PG8_LDA(At, 1, 1); PG8_STAGE(PG8_SA(1, 0), a3, voffA);
            PG8_BAR; PG8_WAIT_L(0); PG8_MMA(1, 0, At, B0); PG8_BAR; PG8_SCHED;
            PG8_STAGE(PG8_SB(1, 1), b3 + hstep, voffB);
            PG8_WAIT_V(6); PG8_BAR; PG8_MMA(1, 1, At, B1); PG8_BAR;
            }
        }
        if constexpr (ALIGN_EPI) { if (wr == 0) PG8_BAR; }
        E(acc, cur, wr, wc, fr, fq); S.done(cur);
        if (!has_next) break;
#pragma unroll
        for (int a = 0; a < 2; ++a)
#pragma unroll
            for (int b = 0; b < 2; ++b)
#pragma unroll
                for (int m = 0; m < 4; ++m)
#pragma unroll
                    for (int n = 0; n < 2; ++n) acc[a][b][m][n] = (f32x4){0.f, 0.f, 0.f, 0.f};
        cur = nxt; cA = nA; cB = nB; ++ui;
        if constexpr (ALIGN_EPI) { if (wr == 1) PG8_BAR; }
    }
    PG8_WAIT_V(0);
    if constexpr (!ALIGN_EPI) { if (wr == 0) PG8_BAR; }
    PG8_BAR;
#undef PG8_SA
#undef PG8_SB
#undef PG8_STAGE
#undef PG8_LDA
#undef PG8_LDB
#undef PG8_MMA
#undef PG8_WAIT_V
#undef PG8_WAIT_L
#undef PG8_BAR
#undef PG8_SCHED
}
}

struct Ws {
    float *rstd1, *sumsq2, *sumsq3;
    bf16_t *Wt_in, *Wt_reto, *Wt_atto, *Wt_o, *Wt_up, *Wt_down;
    bf16_t *xb, *proj, *G, *Oatt, *merged, *act, *ub;
    float* kvc;
};
__device__ __forceinline__ Ws make_ws(unsigned char* ws) {
    Ws w;
    w.rstd1 = (float*)(ws + WS_CTL); w.sumsq2 = w.rstd1 + MT; w.sumsq3 = w.sumsq2 + MT;
    w.Wt_in = (bf16_t*)(ws + WS_WIN); w.Wt_reto = (bf16_t*)(ws + WS_WRETO); w.Wt_atto = (bf16_t*)(ws + WS_WATTO); w.Wt_o = (bf16_t*)(ws + WS_WO);
    w.Wt_up = (bf16_t*)(ws + WS_WUP); w.Wt_down = (bf16_t*)(ws + WS_WDOWN);
    w.xb = (bf16_t*)(ws + WS_XB); w.proj = (bf16_t*)(ws + WS_PROJ); w.ub = (bf16_t*)(ws + WS_PROJ); w.G = (bf16_t*)(ws + WS_G); w.Oatt = (bf16_t*)(ws + WS_OATT);
    w.merged = (bf16_t*)(ws + WS_MERGED); w.act = (bf16_t*)(ws + WS_ACT); w.kvc = (float*)(ws + WS_KVC);
    return w;
}

template <int MODE> struct Epi {
    static constexpr bool PERM = true;
    Ws w; float* out; const float* xp; const float* xs;
    __device__ __forceinline__ void operator()(const f32x4 (&acc)[2][2][4][2], const pg8::Unit& u, int wr, int wc, int fr, int fq) const {
        const int row0 = u.pm * 256 + wr * 64 + fr;
        const int col0 = u.pn * 256 + wc * 32 + 8 * fq;
        int cls = 0, grp = 0, kv = 0;
        if (MODE == 1) {
            const int pn = u.pn;
            if (pn >= 12 && pn < 16) cls = 1;
            else if (pn >= 34) cls = 2;
            else if (pn >= 16 && pn < 34) { const int q = (pn - 16) % 6; grp = (pn - 16) / 6; if (q >= 2) { cls = 3; kv = (q >= 4) ? 1 : 0; } }
        }
#pragma unroll
        for (int ai = 0; ai < 2; ++ai)
#pragma unroll
            for (int m = 0; m < 4; ++m) {
                const int row = row0 + ai * 128 + m * 16;
                float rs = 1.f;
                if (MODE == 1) rs = w.rstd1[row];
                if (MODE == 5) rs = rsqrtf(w.sumsq2[row] * (1.0f / DM) + EPS);
                float ssq = 0.f;
#pragma unroll
                for (int bj = 0; bj < 2; ++bj) {
                    const int col = col0 + bj * 128;
                    f32x4 v0 = acc[ai][bj][m][0] * rs, v1 = acc[ai][bj][m][1] * rs;
                    if (MODE == 1) {
                        if (cls == 1) {
#pragma unroll
                            for (int i = 0; i < 4; ++i) { v0[i] = v0[i] * sigmoidf_(v0[i]); v1[i] = v1[i] * sigmoidf_(v1[i]); }
                        } else if (cls == 2) {
#pragma unroll
                            for (int i = 0; i < 4; ++i) { v0[i] = sigmoidf_(v0[i]); v1[i] = sigmoidf_(v1[i]); }
                        }
                        u32x4 o; o.x = pk2(v0[0], v0[1]); o.y = pk2(v0[2], v0[3]); o.z = pk2(v1[0], v1[1]); o.w = pk2(v1[2], v1[3]);
                        *(u32x4*)(w.proj + (size_t)row * INC + col) = o;
                        if (cls == 3) {
                            const int win = 128 << (2 * grp);
                            const size_t obase_p = grp == 0 ? O_KV128P : (grp == 1 ? O_KV512P : O_KV2048P);
                            const size_t obase_s = grp == 0 ? O_KV128S : (grp == 1 ? O_KV512S : O_KV2048S);
                            const int c512 = (col & 511);
                            float* dst = nullptr;
                            if (row < MP) { const int b = row >> 13, t = row & 8191; if (t >= SEQ - win) dst = out + obase_p + ((size_t)(b * win + (t - (SEQ - win))) * 2 + kv) * 512 + c512; }
                            else { const int b = (row - MP) >> 3, t = (row - MP) & 7; dst = out + obase_s + ((size_t)(b * win + (win - 8 + t)) * 2 + kv) * 512 + c512; }
                            if (dst) { *(f32x4*)dst = v0; *(f32x4*)(dst + 4) = v1; }
                        }
                    } else if (MODE == 2) {
                        const u32x4 gt = *(const u32x4*)(w.proj + (size_t)row * INC + C_GR + col);
                        v0[0] *= bflo(gt.x); v0[1] *= bfhi(gt.x); v0[2] *= bflo(gt.y); v0[3] *= bfhi(gt.y);
                        v1[0] *= bflo(gt.z); v1[1] *= bfhi(gt.z); v1[2] *= bflo(gt.w); v1[3] *= bfhi(gt.w);
                        float* dst = out + O_Y + (size_t)row * DM + col;
                        *(f32x4*)dst = v0; *(f32x4*)(dst + 4) = v1;
                    } else if (MODE == 3) {
                        const u32x4 gt = *(const u32x4*)(w.proj + (size_t)row * INC + C_GA + col);
                        const float* src = out + O_Y + (size_t)row * DM + col;
                        const f32x4 t0 = *(const f32x4*)src, t1 = *(const f32x4*)(src + 4);
                        v0[0] = t0[0] + v0[0] * bflo(gt.x); v0[1] = t0[1] + v0[1] * bfhi(gt.x); v0[2] = t0[2] + v0[2] * bflo(gt.y); v0[3] = t0[3] + v0[3] * bfhi(gt.y);
                        v1[0] = t1[0] + v1[0] * bflo(gt.z); v1[1] = t1[1] + v1[1] * bfhi(gt.z); v1[2] = t1[2] + v1[2] * bflo(gt.w); v1[3] = t1[3] + v1[3] * bfhi(gt.w);
                        u32x4 o; o.x = pk2(v0[0], v0[1]); o.y = pk2(v0[2], v0[3]); o.z = pk2(v1[0], v1[1]); o.w = pk2(v1[2], v1[3]);
                        *(u32x4*)(w.merged + (size_t)row * DM + col) = o;
                    } else if (MODE == 4) {
                        const float* xr = (row < MP) ? xp + (size_t)row * DM + col : xs + (size_t)(row - MP) * DM + col;
                        v0 += *(const f32x4*)xr; v1 += *(const f32x4*)(xr + 4);
                        float* dst = out + O_Y + (size_t)row * DM + col;
                        *(f32x4*)dst = v0; *(f32x4*)(dst + 4) = v1;
                        u32x4 o; o.x = pk2(v0[0], v0[1]); o.y = pk2(v0[2], v0[3]); o.z = pk2(v1[0], v1[1]); o.w = pk2(v1[2], v1[3]);
                        *(u32x4*)(w.xb + (size_t)row * DM + col) = o;
#pragma unroll
                        for (int i = 0; i < 4; ++i) ssq += v0[i] * v0[i] + v1[i] * v1[i];
                    } else if (MODE == 5) {
                        u32x4 o; o.x = pk2(v0[0], v0[1]); o.y = pk2(v0[2], v0[3]); o.z = pk2(v1[0], v1[1]); o.w = pk2(v1[2], v1[3]);
                        *(u32x4*)(w.ub + (size_t)row * F2 + col) = o;
                    } else if (MODE == 6) {
                        float* dst = out + O_Y + (size_t)row * DM + col;
                        v0 += *(const f32x4*)dst; v1 += *(const f32x4*)(dst + 4);
                        *(f32x4*)dst = v0; *(f32x4*)(dst + 4) = v1;
#pragma unroll
                        for (int i = 0; i < 4; ++i) ssq += v0[i] * v0[i] + v1[i] * v1[i];
                    }
                }
                if (MODE == 4 || MODE == 6) {
                    ssq += __shfl_xor(ssq, 16); ssq += __shfl_xor(ssq, 32);
                    if (fq == 0) atomicAdd((MODE == 4 ? w.sumsq2 : w.sumsq3) + row, ssq);
                }
            }
    }
};

__device__ __forceinline__ int up_rowmap(int n) { return n < FF ? ((n >> 7) * 256 + (n & 127)) : (((n - FF) >> 7) * 256 + 128 + ((n - FF) & 127)); }
__device__ __forceinline__ void p0_transpose_item(const float* W, int K, int N, bf16_t* WT, const float* g, bool upmap, LAS float* scr, int item, int lane) {
    const int nblk = N / 32, kb = item / nblk, nb = item % nblk, k0 = 64 * kb, n0 = 32 * nb;
#pragma unroll 8
    for (int i = 0; i < 32; ++i) { const int kk = 2 * i + (lane >> 5); float v = W[(size_t)(k0 + kk) * N + n0 + (lane & 31)]; if (g) v *= g[k0 + kk]; scr[kk * 33 + (lane & 31)] = v; }
    LDS_WAIT();
    const int c = lane & 7;
    const int nbase = upmap ? up_rowmap(n0) : n0;
#pragma unroll
    for (int j = 0; j < 4; ++j) { const int n = (lane >> 3) + 8 * j; const LAS float* s = scr + (8 * c) * 33 + n;
        u32x4 o; o.x = pk2(s[0 * 33], s[1 * 33]); o.y = pk2(s[2 * 33], s[3 * 33]); o.z = pk2(s[4 * 33], s[5 * 33]); o.w = pk2(s[6 * 33], s[7 * 33]);
        *(u32x4*)(WT + (size_t)(nbase + n) * K + k0 + 8 * c) = o; }
    LDS_WAIT();
}
__device__ __forceinline__ void p0_prologue(const Params& p, const Ws& w, LAS unsigned char* lds, int vcu, int G) {
    const int tid = threadIdx.x, lane = tid & 63, wave = tid >> 6;
    LAS float* scr = (LAS float*)(lds + wave * 16384);
    const int gw = vcu * 8 + wave, NGW = G * 8;
    constexpr int I_IN = (DM / 64) * (INC / 32), I_RO = (1024 / 64) * (DM / 32), I_AO = (512 / 64) * (DM / 32), I_O = (DM / 64) * (DM / 32), I_UP = (DM / 64) * (F2 / 32), I_DN = (FF / 64) * (DM / 32);
    constexpr int NITEMS = I_IN + I_RO + I_AO + I_O + I_UP + I_DN;
    for (int it = gw; it < NITEMS; it += NGW) {
        int r = it;
        if (r < I_IN) { p0_transpose_item(p.in[8], DM, INC, w.Wt_in, p.in[7], false, scr, r, lane); continue; } r -= I_IN;
        if (r < I_RO) { p0_transpose_item(p.in[10], 1024, DM, w.Wt_reto, nullptr, false, scr, r, lane); continue; } r -= I_RO;
        if (r < I_AO) { p0_transpose_item(p.in[11], 512, DM, w.Wt_atto, nullptr, false, scr, r, lane); continue; } r -= I_AO;
        if (r < I_O) { p0_transpose_item(p.in[12], DM, DM, w.Wt_o, nullptr, false, scr, r, lane); continue; } r -= I_O;
        if (r < I_UP) { p0_transpose_item(p.in[14], DM, F2, w.Wt_up, p.in[13], true, scr, r, lane); continue; } r -= I_UP;
        p0_transpose_item(p.in[17], FF, DM, w.Wt_down, nullptr, false, scr, r, lane);
    }
    for (int m = gw; m < MT; m += NGW) {
        const float* xr = (m < MP) ? p.in[0] + (size_t)m * DM : p.in[1] + (size_t)(m - MP) * DM;
        const f32x4* x4 = (const f32x4*)xr + lane;
        f32x4 v[8]; float s = 0.f;
#pragma unroll
        for (int j = 0; j < 8; ++j) { v[j] = x4[64 * j]; s += (v[j].x * v[j].x + v[j].y * v[j].y) + (v[j].z * v[j].z + v[j].w * v[j].w); }
        s = wave_sum(s);
        if (lane == 0) w.rstd1[m] = rsqrtf(s * (1.0f / DM) + EPS);
        u32x2* o8 = (u32x2*)(w.xb + (size_t)m * DM) + lane;
#pragma unroll
        for (int j = 0; j < 8; ++j) { u32x2 o; o.x = pk2(v[j].x, v[j].y); o.y = pk2(v[j].z, v[j].w); o8[64 * j] = o; }
    }
    for (int i = vcu * 512 + tid; i < 2 * MT; i += G * 512) w.sumsq2[i] = 0.f;
    {
        const size_t gt = (size_t)vcu * 512 + tid, GT = (size_t)G * 512;
#pragma unroll
        for (int g = 0; g < 3; ++g) {
            const int Wb = 128 << (2 * g);
            const f32x4* src = (const f32x4*)p.in[3 + g];
            f32x4* dst = (f32x4*)(p.out + (g == 0 ? O_KV128S : (g == 1 ? O_KV512S : O_KV2048S)));
            const size_t per_b = (size_t)(Wb - 8) * 256, stride_b = (size_t)Wb * 256;
            const size_t total = 32 * per_b;
            for (size_t i = gt; i < total; i += GT) { const size_t b = i / per_b, r = i - b * per_b; dst[b * stride_b + r] = __builtin_nontemporal_load(src + b * stride_b + 2048 + r); }
        }
    }
}

__device__ __forceinline__ float lgamma_h(int h) { return logf(1.0f - exp2f(-5.0f - (float)h)); }

__device__ __forceinline__ float dot_bf16_lds(const bf16_t* kr, const LAS float* q) {
    float s = 0.f;
#pragma unroll 4
    for (int i = 0; i < 16; ++i) { const u32x4 k = *((const u32x4*)kr + i); const LAS float* qq = q + 8 * i;
        s += bflo(k.x) * qq[0] + bfhi(k.x) * qq[1] + bflo(k.y) * qq[2] + bfhi(k.y) * qq[3] + bflo(k.z) * qq[4] + bfhi(k.z) * qq[5] + bflo(k.w) * qq[6] + bfhi(k.w) * qq[7]; }
    return s;
}
__device__ __forceinline__ float dot_f32_lds(const float* kr, const LAS float* q) {
    float s = 0.f;
#pragma unroll 4
    for (int i = 0; i < 32; ++i) { const f32x4 k = *((const f32x4*)kr + i); const LAS float* qq = q + 4 * i; s += k.x * qq[0] + k.y * qq[1] + k.z * qq[2] + k.w * qq[3]; }
    return s;
}
__device__ __forceinline__ void attn_naive(const Params& p, const Ws& w, LAS unsigned char* lds, int vcu, int G) {
    const int tid = threadIdx.x, lane = tid & 63, wave = tid >> 6;
    LAS float* q = (LAS float*)(lds + wave * 4096);
    LAS float* pb = q + 384;
    const int gw = vcu * 8 + wave, NGW = G * 8;
    for (int it = gw; it < MT * 4; it += NGW) {
        const int m = it >> 2, h = it & 3;
        const bf16_t* prow = w.proj + (size_t)m * INC;
#pragma unroll
        for (int g = 0; g < 3; ++g) { const unsigned v = *(const unsigned*)(prow + C_ATT + g * 1536 + h * 128 + 2 * lane); q[g * 128 + 2 * lane] = bflo(v); q[g * 128 + 2 * lane + 1] = bfhi(v); }
        LDS_WAIT();
        const bool samp = m >= MP;
        int b, t; if (!samp) { b = m >> 13; t = m & 8191; } else { b = (m - MP) >> 3; t = (m - MP) & 7; }
        float mx = -1e30f;
        for (int g = 0; g < 3; ++g) {
            const int dil = 1 << (2 * g), Wb = 128 << (2 * g);
            const float slope = exp2f(-8.0f * (float)(g * 4 + h + 1) / 12.0f) * (float)dil;
            const int kcol = C_ATT + g * 1536 + 512 + h * 128;
            for (int jj = lane; jj < 129; jj += 64) {
                float s = -1e30f;
                if (!samp) { const int tk = t - dil * jj; if (tk >= 0) s = dot_bf16_lds(w.proj + (size_t)(b * SEQ + tk) * INC + kcol, q + g * 128) * QK_SCALE - slope * (float)jj; }
                else { const int idx = Wb + t - dil * jj;
                    if (idx >= Wb) s = dot_bf16_lds(w.proj + (size_t)(MP + b * 8 + idx - Wb) * INC + kcol, q + g * 128) * QK_SCALE - slope * (float)jj;
                    else s = dot_f32_lds(p.in[3 + g] + ((size_t)(b * Wb + idx) * 2 + 0) * 512 + h * 128, q + g * 128) * QK_SCALE - slope * (float)jj; }
                pb[g * 129 + jj] = s; mx = fmaxf(mx, s);
            }
        }
        mx = wave_max(mx);
        LDS_WAIT();
        float sum = 0.f;
        for (int k = lane; k < 387; k += 64) { const float e = __expf(pb[k] - mx); pb[k] = e; sum += e; }
        sum = wave_sum(sum);
        LDS_WAIT();
        float o0 = 0.f, o1 = 0.f;
        for (int g = 0; g < 3; ++g) {
            const int dil = 1 << (2 * g), Wb = 128 << (2 * g);
            const int vcol = C_ATT + g * 1536 + 1024 + h * 128;
            for (int jj = 0; jj < 129; ++jj) {
                const float pj = pb[g * 129 + jj];
                if (!samp) { const int tk = t - dil * jj; if (tk < 0) break;
                    const unsigned v = *(const unsigned*)(w.proj + (size_t)(b * SEQ + tk) * INC + vcol + 2 * lane); o0 += pj * bflo(v); o1 += pj * bfhi(v); }
                else { const int idx = Wb + t - dil * jj;
                    if (idx >= Wb) { const unsigned v = *(const unsigned*)(w.proj + (size_t)(MP + b * 8 + idx - Wb) * INC + vcol + 2 * lane); o0 += pj * bflo(v); o1 += pj * bfhi(v); }
                    else { const f32x2 v = *(const f32x2*)(p.in[3 + g] + ((size_t)(b * Wb + idx) * 2 + 1) * 512 + h * 128 + 2 * lane); o0 += pj * v.x; o1 += pj * v.y; } }
            }
        }
        const float inv = 1.0f / sum;
        *(unsigned*)(w.Oatt + (size_t)m * 512 + h * 128 + 2 * lane) = pk2(o0 * inv, o1 * inv);
        LDS_WAIT();
    }
}

__device__ __forceinline__ void load_tile_bf16(const bf16_t* src  , size_t pitch, LAS bf16_t* dst, int dst_pitch  , int tid) {
#pragma unroll
    for (int i = 0; i < 4; ++i) { const int c = tid + i * 512, r = c >> 4, ch = c & 15; *(LAS u32x4*)(dst + r * dst_pitch + ch * 8) = *(const u32x4*)(src + (size_t)r * pitch + ch * 8); }
}
__device__ __forceinline__ void retA_naive(const Ws& w, LAS unsigned char* lds, int vcu, int G) {
    const int tid = threadIdx.x;
    LAS bf16_t* Kt = (LAS bf16_t*)lds; LAS bf16_t* Vt = Kt + 128 * 128;
    for (int item = vcu; item < 1024; item += G) {
        const int c = item & 63, bh = item >> 6, h = bh & 7, b = bh >> 3;
        const size_t m0 = (size_t)b * SEQ + c * 128;
        __syncthreads();
        load_tile_bf16(w.proj + m0 * INC + C_RK + h * 128, INC, Kt, 128, tid);
        load_tile_bf16(w.proj + m0 * INC + C_RV + h * 128, INC, Vt, 128, tid);
        __syncthreads();
        const int e = tid & 127, dq = tid >> 7;
        const float lg = lgamma_h(h);
        float acc[32];
#pragma unroll
        for (int i = 0; i < 32; ++i) acc[i] = 0.f;
        for (int j = 0; j < 128; ++j) {
            const float kd = __expf((float)(127 - j) * lg) * QK_SCALE;
            const float v = bf2f(Vt[j * 128 + e]) * kd;
            const LAS u32x4* kk = (const LAS u32x4*)(Kt + j * 128 + dq * 32);
#pragma unroll
            for (int i4 = 0; i4 < 4; ++i4) { const u32x4 k = kk[i4];
                acc[i4 * 8 + 0] += bflo(k.x) * v; acc[i4 * 8 + 1] += bfhi(k.x) * v; acc[i4 * 8 + 2] += bflo(k.y) * v; acc[i4 * 8 + 3] += bfhi(k.y) * v;
                acc[i4 * 8 + 4] += bflo(k.z) * v; acc[i4 * 8 + 5] += bfhi(k.z) * v; acc[i4 * 8 + 6] += bflo(k.w) * v; acc[i4 * 8 + 7] += bfhi(k.w) * v; }
        }
        float* dst = w.kvc + (size_t)item * 16384;
#pragma unroll
        for (int i = 0; i < 32; ++i) dst[(dq * 32 + i) * 128 + e] = acc[i];
    }
}
__device__ __forceinline__ void ret_scan(const Params& p, const Ws& w, int vcu, int G) {
    for (int i = vcu * 512 + threadIdx.x; i < 16 * 16384; i += G * 512) {
        const int bh = i >> 14, idx = i & 16383, h = bh & 7;
        const float g128 = __expf(128.0f * lgamma_h(h));
        float* base = w.kvc + (size_t)bh * 64 * 16384 + idx;
        float s = 0.f;
#pragma unroll 8
        for (int c = 0; c < 64; ++c) { const float kv = base[(size_t)c * 16384]; base[(size_t)c * 16384] = s; s = s * g128 + kv; }
        p.out[O_RETP + (size_t)bh * 16384 + idx] = s;
    }
}
__device__ __forceinline__ void retC_naive(const Params& p, const Ws& w, LAS unsigned char* lds, int vcu, int G) {
    const int tid = threadIdx.x, lane = tid & 63, wave = tid >> 6;
    constexpr int KP = 136;
    LAS bf16_t* Kt = (LAS bf16_t*)lds;
    LAS bf16_t* Vt = (LAS bf16_t*)(lds + 34816);
    LAS float* sc = (LAS float*)(lds + 34816 + 32768);
    LAS float* yb = sc + 64 * 128;
    const float* gn = p.in[9];
    for (int item = vcu; item < 1024; item += G) {
        const int c = item & 63, bh = item >> 6, h = bh & 7, b = bh >> 3;
        const size_t m0 = (size_t)b * SEQ + c * 128;
        const float lg = lgamma_h(h);
        const float* S = w.kvc + (size_t)item * 16384;
        __syncthreads();
        load_tile_bf16(w.proj + m0 * INC + C_RK + h * 128, INC, Kt, KP, tid);
        load_tile_bf16(w.proj + m0 * INC + C_RV + h * 128, INC, Vt, 128, tid);
        __syncthreads();
        for (int half = 0; half < 2; ++half) {
            const int i0 = half * 64;
            {
                const int j = tid & 127, iq = tid >> 7;
                float s[16];
#pragma unroll
                for (int ii = 0; ii < 16; ++ii) s[ii] = 0.f;
                for (int d8 = 0; d8 < 16; ++d8) {
                    const u32x4 k = *(const LAS u32x4*)(Kt + j * KP + d8 * 8);
                    const float k0 = bflo(k.x), k1 = bfhi(k.x), k2 = bflo(k.y), k3 = bfhi(k.y), k4 = bflo(k.z), k5 = bfhi(k.z), k6 = bflo(k.w), k7 = bfhi(k.w);
#pragma unroll
                    for (int ii = 0; ii < 16; ++ii) {
                        const u32x4 qv = *(const u32x4*)(w.proj + (m0 + i0 + iq * 16 + ii) * INC + C_RQ + h * 128 + d8 * 8);
                        s[ii] += bflo(qv.x) * k0 + bfhi(qv.x) * k1 + bflo(qv.y) * k2 + bfhi(qv.y) * k3 + bflo(qv.z) * k4 + bfhi(qv.z) * k5 + bflo(qv.w) * k6 + bfhi(qv.w) * k7;
                    }
                }
#pragma unroll
                for (int ii = 0; ii < 16; ++ii) { const int i = i0 + iq * 16 + ii; sc[(iq * 16 + ii) * 128 + j] = (i >= j) ? s[ii] * __expf((float)(i - j) * lg) * QK_SCALE : 0.f; }
            }
            __syncthreads();
            {
                const int e = tid & 127, iq = tid >> 7;
                float y[16], cr[16];
#pragma unroll
                for (int ii = 0; ii < 16; ++ii) { y[ii] = 0.f; cr[ii] = 0.f; }
                for (int j = 0; j < 128; ++j) { const float v = bf2f(Vt[j * 128 + e]);
#pragma unroll
                    for (int ii = 0; ii < 16; ++ii) y[ii] += sc[(iq * 16 + ii) * 128 + j] * v; }
                for (int d2 = 0; d2 < 64; ++d2) { const float s0 = S[(2 * d2) * 128 + e], s1 = S[(2 * d2 + 1) * 128 + e];
#pragma unroll
                    for (int ii = 0; ii < 16; ++ii) { const unsigned qv = *(const unsigned*)(w.proj + (m0 + i0 + iq * 16 + ii) * INC + C_RQ + h * 128 + 2 * d2); cr[ii] += bflo(qv) * s0 + bfhi(qv) * s1; } }
#pragma unroll
                for (int ii = 0; ii < 16; ++ii) { const int i = i0 + iq * 16 + ii; yb[(iq * 16 + ii) * 128 + e] = y[ii] + cr[ii] * __expf((float)(i + 1) * lg); }
            }
            __syncthreads();
            for (int rr = 0; rr < 8; ++rr) {
                const int il = wave * 8 + rr; const size_t m = m0 + i0 + il;
                const float a0 = yb[il * 128 + lane], a1 = yb[il * 128 + 64 + lane];
                const float mean = wave_sum(a0 + a1) * (1.0f / 128.0f);
                const float d0 = a0 - mean, d1 = a1 - mean;
                const float var = wave_sum(d0 * d0 + d1 * d1) * (1.0f / 128.0f);
                const float rstd = rsqrtf(var + EPS);
                const float g0 = bf2f(w.proj[m * INC + C_RG + h * 128 + lane]), g1 = bf2f(w.proj[m * INC + C_RG + h * 128 + 64 + lane]);
                w.G[m * 1024 + h * 128 + lane] = (bf16_t)f2bf(d0 * rstd * gn[h * 128 + lane] * g0);
                w.G[m * 1024 + h * 128 + 64 + lane] = (bf16_t)f2bf(d1 * rstd * gn[h * 128 + 64 + lane] * g1);
            }
            __syncthreads();
        }
    }
}
__device__ __forceinline__ void ret_sample(const Params& p, const Ws& w, LAS unsigned char* lds, int vcu, int G) {
    const int tid = threadIdx.x, lane = tid & 63, wave = tid >> 6;
    LAS float* qf = (LAS float*)lds;
    LAS float* kf = qf + 1024;
    LAS float* vf = kf + 1024;
    LAS float* part = vf + 1024;
    LAS float* sc = part + 4096;
    LAS float* yb = sc + 64;
    const float* gn = p.in[9];
    for (int item = vcu; item < 256; item += G) {
        const int bs = item >> 3, h = item & 7;
        const size_t m0 = MP + (size_t)bs * 8;
        const float lg = lgamma_h(h);
        __syncthreads();
        for (int i = tid; i < 1024; i += 512) { const int r = i >> 7, d = i & 127; const bf16_t* row = w.proj + (m0 + r) * INC + h * 128 + d;
            qf[i] = bf2f(row[C_RQ]); kf[i] = bf2f(row[C_RK]) * QK_SCALE; vf[i] = bf2f(row[C_RV]); }
        __syncthreads();
        if (tid < 64) { const int i = tid >> 3, j = tid & 7; float s = 0.f; for (int d = 0; d < 128; ++d) s += qf[i * 128 + d] * kf[j * 128 + d]; sc[tid] = (i >= j) ? s * __expf((float)(i - j) * lg) : 0.f; }
        const int e = tid & 127, dq = tid >> 7;
        const float* st = p.in[2] + (size_t)item * 16384;
        float* nst = p.out + O_RETS + (size_t)item * 16384;
        const float g8 = __expf(8.0f * lg);
        float kdec[8];
#pragma unroll
        for (int j = 0; j < 8; ++j) kdec[j] = __expf((float)(7 - j) * lg);
        float cr[8];
#pragma unroll
        for (int i = 0; i < 8; ++i) cr[i] = 0.f;
        for (int dd = 0; dd < 32; ++dd) {
            const int d = dq * 32 + dd;
            const float s = st[d * 128 + e];
            float ns = s * g8;
#pragma unroll
            for (int j = 0; j < 8; ++j) ns += kf[j * 128 + d] * kdec[j] * vf[j * 128 + e];
            nst[d * 128 + e] = ns;
#pragma unroll
            for (int i = 0; i < 8; ++i) cr[i] += qf[i * 128 + d] * s;
        }
#pragma unroll
        for (int i = 0; i < 8; ++i) part[(dq * 8 + i) * 128 + e] = cr[i];
        __syncthreads();
        for (int idx = tid; idx < 1024; idx += 512) { const int i = idx >> 7, ee = idx & 127;
            float y = (part[(0 * 8 + i) * 128 + ee] + part[(1 * 8 + i) * 128 + ee] + part[(2 * 8 + i) * 128 + ee] + part[(3 * 8 + i) * 128 + ee]) * __expf((float)(i + 1) * lg);
            for (int j = 0; j <= i; ++j) y += sc[i * 8 + j] * vf[j * 128 + ee];
            yb[idx] = y; }
        __syncthreads();
        {
            const int il = wave; const size_t m = m0 + il;
            const float a0 = yb[il * 128 + lane], a1 = yb[il * 128 + 64 + lane];
            const float mean = wave_sum(a0 + a1) * (1.0f / 128.0f);
            const float d0 = a0 - mean, d1 = a1 - mean;
            const float var = wave_sum(d0 * d0 + d1 * d1) * (1.0f / 128.0f);
            const float rstd = rsqrtf(var + EPS);
            const float g0 = bf2f(w.proj[m * INC + C_RG + h * 128 + lane]), g1 = bf2f(w.proj[m * INC + C_RG + h * 128 + 64 + lane]);
            w.G[m * 1024 + h * 128 + lane] = (bf16_t)f2bf(d0 * rstd * gn[h * 128 + lane] * g0);
            w.G[m * 1024 + h * 128 + 64 + lane] = (bf16_t)f2bf(d1 * rstd * gn[h * 128 + 64 + lane] * g1);
        }
    }
}
__device__ __forceinline__ void conv_naive(const Params& p, const Ws& w, int vcu, int G) {
    const float* cw = p.in[15]; const float* cb = p.in[16]; const float* sconv = p.in[6];
    const size_t total = (size_t)MT * (FF / 2);
    for (size_t i = (size_t)vcu * 512 + threadIdx.x; i < total; i += (size_t)G * 512) {
        const int m = (int)(i / (FF / 2)), f = (int)(i % (FF / 2)) * 2;
        const int ca = (f >> 7) * 256 + (f & 127), cbb = ca + 128;
        int t; bool samp = m >= MP; int bs = 0;
        if (!samp) t = m & 8191; else { bs = (m - MP) >> 3; t = (m - MP) & 7; }
        float ua[3][2], ub2[3][2];
#pragma unroll
        for (int k = 0; k < 3; ++k) {
            const int tt = t - (2 - k);
            if (tt >= 0) { const unsigned va = *(const unsigned*)(w.ub + (size_t)(m - (2 - k)) * F2 + ca), vb = *(const unsigned*)(w.ub + (size_t)(m - (2 - k)) * F2 + cbb);
                ua[k][0] = bflo(va); ua[k][1] = bfhi(va); ub2[k][0] = bflo(vb); ub2[k][1] = bfhi(vb); }
            else if (samp) { const float* sr = sconv + ((size_t)bs * 2 + (2 + tt)) * F2; ua[k][0] = sr[f]; ua[k][1] = sr[f + 1]; ub2[k][0] = sr[FF + f]; ub2[k][1] = sr[FF + f + 1]; }
            else { ua[k][0] = ua[k][1] = ub2[k][0] = ub2[k][1] = 0.f; }
        }
        float o[2];
#pragma unroll
        for (int e = 0; e < 2; ++e) {
            const float a = cb[f + e] + ua[0][e] * cw[f + e] + ua[1][e] * cw[F2 + f + e] + ua[2][e] * cw[2 * F2 + f + e];
            const float bb = cb[FF + f + e] + ub2[0][e] * cw[FF + f + e] + ub2[1][e] * cw[F2 + FF + f + e] + ub2[2][e] * cw[2 * F2 + FF + f + e];
            o[e] = 0.5f * a * (1.0f + erff(a * 0.70710678118654752f)) * bb;
        }
        *(unsigned*)(w.act + (size_t)m * FF + f) = pk2(o[0], o[1]);
        if (!samp) { if (t >= SEQ - 2) { const int b = m >> 13; float* d = p.out + O_CONVP + ((size_t)b * 2 + (t - (SEQ - 2))) * F2; d[f] = ua[2][0]; d[f + 1] = ua[2][1]; d[FF + f] = ub2[2][0]; d[FF + f + 1] = ub2[2][1]; } }
        else if (t >= 6) { float* d = p.out + O_CONVS + ((size_t)bs * 2 + (t - 6)) * F2; d[f] = ua[2][0]; d[f + 1] = ua[2][1]; d[FF + f] = ub2[2][0]; d[FF + f + 1] = ub2[2][1]; }
    }
}
__device__ __forceinline__ void final_norm(const Params& p, const Ws& w, int vcu, int G) {
    const int lane = threadIdx.x & 63, wave = threadIdx.x >> 6;
    const float* gf = p.in[18];
    for (int m = vcu * 8 + wave; m < MT; m += G * 8) {
        const float rs = rsqrtf(w.sumsq3[m] * (1.0f / DM) + EPS);
        f32x4* y4 = (f32x4*)(p.out + O_Y + (size_t)m * DM) + lane;
        const f32x4* g4 = (const f32x4*)gf + lane;
#pragma unroll
        for (int j = 0; j < 8; ++j) { f32x4 v = y4[64 * j]; const f32x4 g = g4[64 * j]; v = v * rs * g; y4[64 * j] = v; }
    }
}

constexpr int LDS_BYTES = 147456;
constexpr int NPHASE = 12;
template <bool COOP>
__global__ void __launch_bounds__(512, 2) fwd_kernel(Params p) {
    extern __shared__ __attribute__((aligned(16))) unsigned char lds_raw[];
    LAS unsigned char* lds = (LAS unsigned char*)lds_raw;
    const Ws w = make_ws(p.ws);
    const int G = gridDim.x; const int bx = blockIdx.x;
    const int vcu = (G % 8 == 0) ? (bx % 8) * (G / 8) + bx / 8 : bx;
    const int lo = p.ph_lo, hi = p.ph_hi;
#define IN(k) (lo <= (k) && (k) < hi)
#define SEAM(k) do { if (COOP) { if (IN(k) && IN((k) + 1)) cg::this_grid().sync(); } } while (0)
    if (IN(0)) { p0_prologue(p, w, lds, vcu, G); } SEAM(0);
    if (IN(1)) { pg8::Gemm g{w.xb, w.Wt_in, MT, INC, DM}; pg8::StaticOrder S; S.init(MT, INC, G, bx); Epi<1> E{w, p.out, p.in[0], p.in[1]};
        pg8::gemm_phase<Epi<1>, pg8::StaticOrder, true, true>(lds, g, S, E); } SEAM(1);
    if (IN(2)) { retA_naive(w, lds, vcu, G); __syncthreads(); ret_sample(p, w, lds, vcu, G); __syncthreads(); attn_naive(p, w, lds, vcu, G); } SEAM(2);
    if (IN(3)) { ret_scan(p, w, vcu, G); } SEAM(3);
    if (IN(4)) { retC_naive(p, w, lds, vcu, G); } SEAM(4);
    if (IN(5)) { pg8::Gemm g{w.G, w.Wt_reto, MT, DM, 1024}; pg8::StaticOrder S; S.init(MT, DM, G, bx); Epi<2> E{w, p.out, p.in[0], p.in[1]};
        pg8::gemm_phase<Epi<2>, pg8::StaticOrder, true, true>(lds, g, S, E); } SEAM(5);
    if (IN(6)) { pg8::Gemm g{w.Oatt, w.Wt_atto, MT, DM, 512}; pg8::StaticOrder S; S.init(MT, DM, G, bx); Epi<3> E{w, p.out, p.in[0], p.in[1]};
        pg8::gemm_phase<Epi<3>, pg8::StaticOrder, true, true>(lds, g, S, E); } SEAM(6);
    if (IN(7)) { pg8::Gemm g{w.merged, w.Wt_o, MT, DM, DM}; pg8::StaticOrder S; S.init(MT, DM, G, bx); Epi<4> E{w, p.out, p.in[0], p.in[1]};
        pg8::gemm_phase<Epi<4>, pg8::StaticOrder, true, true>(lds, g, S, E); } SEAM(7);
    if (IN(8)) { pg8::Gemm g{w.xb, w.Wt_up, MT, F2, DM}; pg8::StaticOrder S; S.init(MT, F2, G, bx); Epi<5> E{w, p.out, p.in[0], p.in[1]};
        pg8::gemm_phase<Epi<5>, pg8::StaticOrder, true, true>(lds, g, S, E); } SEAM(8);
    if (IN(9)) { conv_naive(p, w, vcu, G); } SEAM(9);
    if (IN(10)) { pg8::Gemm g{w.act, w.Wt_down, MT, DM, FF}; pg8::StaticOrder S; S.init(MT, DM, G, bx); Epi<6> E{w, p.out, p.in[0], p.in[1]};
        pg8::gemm_phase<Epi<6>, pg8::StaticOrder, true, true>(lds, g, S, E); } SEAM(10);
    if (IN(11)) { final_norm(p, w, vcu, G); }
#undef IN
#undef SEAM
}

#ifndef N_LAUNCHES
#define N_LAUNCHES 12
#endif
extern "C" void kernel_launch(void* const* d_in, const int* in_sizes, int n_in, void* d_out, int out_size, void* d_ws, size_t ws_size, hipStream_t stream) {
    static int grid = 0;
    if (grid == 0) {
        if (n_in != 19 || (size_t)out_size != O_END || ws_size < WS_END) { fprintf(stderr, "kernel_launch: unexpected shapes: n_in %d out %d ws %zu\n", n_in, out_size, ws_size); grid = -1; return; }
        int dev = 0, cus = 0;
        hipGetDevice(&dev); hipDeviceGetAttribute(&cus, hipDeviceAttributeMultiprocessorCount, dev);
        hipFuncSetAttribute((const void*)fwd_kernel<false>, hipFuncAttributeMaxDynamicSharedMemorySize, LDS_BYTES);
        hipFuncSetAttribute((const void*)fwd_kernel<true>, hipFuncAttributeMaxDynamicSharedMemorySize, LDS_BYTES);
        int per_cu = 0;
        hipOccupancyMaxActiveBlocksPerMultiprocessor(&per_cu, (const void*)fwd_kernel<true>, 512, LDS_BYTES);
        if (per_cu < 1) fprintf(stderr, "kernel_launch: occupancy query says %d blocks/CU\n", per_cu);
        (void)hipGetLastError();
        grid = cus;
    }
    if (grid < 0) return;
    Params p{};
    for (int i = 0; i < 19; ++i) p.in[i] = (const float*)d_in[i];
    p.out = (float*)d_out; p.ws = (unsigned char*)d_ws;
    if (N_LAUNCHES == 1) {
        p.ph_lo = 0; p.ph_hi = NPHASE;
        void* args[] = {&p};
        hipError_t e = hipLaunchCooperativeKernel((const void*)fwd_kernel<true>, dim3(grid), dim3(512), args, LDS_BYTES, stream);
        if (e != hipSuccess) fprintf(stderr, "cooperative launch failed: %s (grid %d)\n", hipGetErrorString(e), grid);
    } else {
        for (int k = 0; k < NPHASE; ++k) { p.ph_lo = k; p.ph_hi = k + 1; hipLaunchKernelGGL(fwd_kernel<false>, dim3(grid), dim3(512), LDS_BYTES, stream, p); }
    }
}
```

```cpp
#include <hip/hip_runtime.h>
#include <hip/hip_cooperative_groups.h>
#include <cstdio>
#include <cstdint>
namespace cg = cooperative_groups;

#define LAS __attribute__((address_space(3)))
typedef unsigned short bf16_t;
typedef short bf16x8 __attribute__((ext_vector_type(8)));
typedef float f32x4 __attribute__((ext_vector_type(4)));
typedef float f32x2 __attribute__((ext_vector_type(2)));
typedef unsigned u32x4 __attribute__((ext_vector_type(4)));
typedef unsigned u32x2 __attribute__((ext_vector_type(2)));

constexpr int DM = 2048, SEQ = 8192, MP = 16384, MS = 256, MT = MP + MS;
constexpr int INC = 12800, FF = 5632, F2 = 11264;
constexpr int C_RQ = 0, C_RK = 1024, C_RV = 2048, C_RG = 3072, C_ATT = 4096, C_GR = 8704, C_GA = 10752;
constexpr float EPS = 1e-6f;
constexpr float QK_SCALE = 0.08838834764831845f;
constexpr size_t O_Y = 0;
constexpr size_t O_RETP = 34078720, O_RETS = 34340864;
constexpr size_t O_KV128P = 38535168, O_KV128S = 38797312, O_KV512P = 42991616, O_KV512S = 44040192, O_KV2048P = 60817408, O_KV2048S = 65011712;
constexpr size_t O_CONVP = 132120576, O_CONVS = 132165632, O_END = 132886528;
constexpr size_t MiB = 1u << 20;
constexpr size_t WS_CTL = 0;
constexpr size_t WS_WIN = 1 * MiB, WS_WRETO = 51 * MiB, WS_WATTO = 55 * MiB, WS_WO = 57 * MiB, WS_WUP = 65 * MiB, WS_WDOWN = 109 * MiB;
constexpr size_t WS_XB = 131 * MiB;
constexpr size_t WS_PROJ = 196 * MiB;
constexpr size_t WS_KVC = 603 * MiB;
constexpr size_t WS_SB = 667 * MiB;
constexpr size_t WS_G = 699 * MiB;
constexpr size_t WS_OG = 732 * MiB;
constexpr size_t WS_LSE = 781 * MiB;
constexpr size_t WS_OATT = 930 * MiB;
constexpr size_t WS_MERGED = 799 * MiB;
constexpr size_t WS_ACT = 603 * MiB;
constexpr size_t WS_G8 = 864 * MiB;
constexpr size_t WS_WATTO_P = 964 * MiB;
constexpr size_t WS_END = 968 * MiB;
constexpr size_t WS_BAR = 512 * 1024;
constexpr size_t WS_PCNT = WS_BAR + 16384;

struct Params {
    const float* in[19];
    float* out;
    unsigned char* ws;
    int ph_lo, ph_hi, dummy, pad;
};

constexpr size_t PSLAB = (size_t)MT * 128;
__device__ __forceinline__ size_t pofs(size_t row, int col) { return ((size_t)(col >> 7) * MT + row) * 128 + (col & 127); }
__device__ __forceinline__ float bflo(unsigned w) { return __uint_as_float(w << 16); }
__device__ __forceinline__ float bfhi(unsigned w) { return __uint_as_float(w & 0xffff0000u); }
__device__ __forceinline__ float bf2f(bf16_t b) { return __uint_as_float((unsigned)b << 16); }
__device__ __forceinline__ unsigned f2bf(float f) { unsigned u = __float_as_uint(f); return (u + 0x7fffu + ((u >> 16) & 1u)) >> 16; }
typedef __bf16 bf16x2_t __attribute__((ext_vector_type(2)));
__device__ __forceinline__ unsigned pk2(float lo, float hi) { f32x2 v = {lo, hi}; bf16x2_t b = __builtin_convertvector(v, bf16x2_t); return __builtin_bit_cast(unsigned, b); }
__device__ __forceinline__ unsigned enc8(float s) { const unsigned c = (unsigned)(s * 256.0f); return c > 255u ? 255u : c; }
__device__ __forceinline__ unsigned enc8x4(f32x4 s) {
    return enc8(s[0]) | (enc8(s[1]) << 8) | (enc8(s[2]) << 16) | (enc8(s[3]) << 24);
}
__device__ __forceinline__ f32x4 dec8x4(unsigned c) { return ((f32x4){(float)(c & 255u), (float)((c >> 8) & 255u), (float)((c >> 16) & 255u), (float)(c >> 24)} + 0.5f) * (1.0f / 256.0f); }
__device__ __forceinline__ float wave_sum(float v) {
#pragma unroll
    for (int o = 1; o < 64; o <<= 1) v += __shfl_xor(v, o);
    return v;
}
__device__ __forceinline__ float wave_max(float v) {
#pragma unroll
    for (int o = 1; o < 64; o <<= 1) v = fmaxf(v, __shfl_xor(v, o));
    return v;
}
__device__ __forceinline__ unsigned sigcode(float v) { return (unsigned)__builtin_amdgcn_rcpf(__builtin_amdgcn_exp2f(fmaf(v, -1.4426950408889634f, -7.99994364f)) + (1.0f / 255.99f)); }
__device__ __forceinline__ unsigned sigcode4(f32x4 s) { return sigcode(s[0]) | (sigcode(s[1]) << 8) | (sigcode(s[2]) << 16) | (sigcode(s[3]) << 24); }
__device__ __forceinline__ float sigmoidf_(float v) { return __builtin_amdgcn_rcpf(1.0f + __builtin_amdgcn_exp2f(v * -1.4426950408889634f)); }
#define LDS_WAIT() asm volatile("s_waitcnt lgkmcnt(0)" ::: "memory")
__device__ __forceinline__ int opaque_tid() { int t = threadIdx.x; asm volatile("" : "+v"(t)); return t; }

namespace pg8 {
#define PG8_LAS __attribute__((address_space(3)))
constexpr int BM = 256, BK = 64, HALF = 128, HTB = HALF * BK * 2, STAGE_BYTES = 8 * HTB, NXCD = 8, WGM = 4;
__host__ __device__ __forceinline__ int lds_byte(int r, int c) { const int st = (r >> 4) * 2 + (c >> 5), rr = r & 15, cc = c & 31, ob = rr * 64 + cc * 2; return st * 1024 + (ob ^ (((ob >> 9) & 1) << 5)); }
__host__ __device__ __forceinline__ void stage_rc(int b, int& R, int& C) { const int st = b / 1024, sb = b % 1024, swz = sb ^ (((sb >> 9) & 1) << 5); R = (st >> 1) * 16 + swz / 64; C = (st & 1) * 32 + (swz % 64) / 2; }
__host__ __device__ __forceinline__ int perm32(int rho) { const int n = rho >> 4, i = rho & 15; return 8 * (i >> 2) + 4 * n + (i & 3); }
struct Unit { int pm, pn, seg; };
struct Gemm { const bf16_t* A; const bf16_t* Bt; int M, N, K; };
struct StaticOrder {
    int nM, nN, nwg, G, c;
    __host__ __device__ void init(int M, int N, int G_, int c_) { nM = M / BM; nN = N / BM; nwg = nM * nN; G = G_; c = c_; }
    __host__ __device__ bool next(int i, Unit& u) const {
        const long L = (long)i * G + c; if (L >= nwg) return false;
        int wgid = (int)L; { const int q = nwg / NXCD, r = nwg % NXCD, xcd = wgid % NXCD, off = wgid / NXCD; wgid = (xcd < r ? xcd * (q + 1) : r * (q + 1) + (xcd - r) * q) + off; }
        const int nig = WGM * nN, gid = wgid / nig, fm = gid * WGM, gsz = (nM - fm) < WGM ? (nM - fm) : WGM;
        u.pm = fm + ((wgid % nig) % gsz); u.pn = (wgid % nig) / gsz; u.seg = 0; return true;
    }
    __device__ __forceinline__ void a_ready(const Unit&) const {}
    __device__ __forceinline__ void done(const Unit&) const {}
    __device__ __forceinline__ long a_off(const Unit& u, int K) const { return (long)u.pm * 256 * K * 2; }
    __device__ __forceinline__ const char* a_ptr(const Gemm& g, const Unit& u) const { return (const char*)g.A + a_off(u, g.K); }
    __device__ __forceinline__ const char* b_ptr(const Gemm& g, const Unit& u) const { return (const char*)g.Bt + (size_t)u.pn * 256 * g.K * 2; }
    __device__ __forceinline__ int nt(const Gemm& g, const Unit&) const { return g.K / BK; }
    __device__ __forceinline__ bool keep(const Unit&) const { return false; }
};
struct SegOrder {
    StaticOrder base; const bf16_t* A1; const bf16_t* B1t; int nt0, nt1;
    __device__ __forceinline__ bool next(int i, Unit& u) const { if (!base.next(i >> 1, u)) return false; u.seg = i & 1; return true; }
    __device__ __forceinline__ void a_ready(const Unit&) const {}
    __device__ __forceinline__ void done(const Unit&) const {}
    __device__ __forceinline__ const char* a_ptr(const Gemm& g, const Unit& u) const { return (const char*)(u.seg ? A1 : g.A) + (size_t)u.pm * 256 * g.K * 2; }
    __device__ __forceinline__ const char* b_ptr(const Gemm& g, const Unit& u) const { return (const char*)(u.seg ? B1t : g.Bt) + (size_t)u.pn * 256 * g.K * 2; }
    __device__ __forceinline__ int nt(const Gemm&, const Unit& u) const { return u.seg ? nt1 : nt0; }
    __device__ __forceinline__ bool keep(const Unit& u) const { return u.seg == 0; }
};
struct PanelOrder {
    int v;
    __device__ __forceinline__ bool next(int i, Unit& u) const { if (i >= 2) return false; u.pm = i * 32 + (v >> 3); u.pn = v & 7; u.seg = 0; return true; }
    __device__ __forceinline__ void a_ready(const Unit&) const {}
    __device__ __forceinline__ void done(const Unit&) const {}
    __device__ __forceinline__ const char* a_ptr(const Gemm& g, const Unit& u) const { return (const char*)g.A + (size_t)u.pm * 256 * g.K * 2; }
    __device__ __forceinline__ const char* b_ptr(const Gemm& g, const Unit& u) const { return (const char*)g.Bt + (size_t)u.pn * 256 * g.K * 2; }
    __device__ __forceinline__ int nt(const Gemm& g, const Unit&) const { return g.K / BK; }
    __device__ __forceinline__ bool keep(const Unit&) const { return false; }
};
struct UpOrder : StaticOrder {
    __host__ __device__ void init_up(int G_, int c_) { nM = 67; nN = 44; nwg = nM * nN; G = G_; c = c_; }
    __device__ __forceinline__ long a_off(const Unit& u, int K) const { const int row0 = (u.pm < 66) ? (u.pm / 33) * 8192 + 254 * (u.pm % 33) - 2 : 16384; return (long)row0 * K * 2; }
    __device__ __forceinline__ const char* a_ptr(const Gemm& g, const Unit& u) const { return (const char*)g.A + a_off(u, g.K); }
};

template <class Epi, class Sched, bool ALIGN_EPI = false, bool SP2 = false>
__device__ __forceinline__ void gemm_phase(PG8_LAS unsigned char* lds, const Gemm g, const Sched& S, const Epi& E) {
    const int tid = opaque_tid(), wid = __builtin_amdgcn_readfirstlane(tid >> 6), lane = tid & 63, wr = wid >> 2, wc = wid & 3, fr = lane & 15, fq = lane >> 4;
    const int K = g.K;
    unsigned voffA[2], voffB[2];
#pragma unroll
    for (int i = 0; i < 2; ++i) { int R, C; stage_rc(tid * 16 + i * 8192, R, C); const int Rb = Epi::PERM ? ((R & ~31) + perm32(R & 31)) : R;
        const int Ra = Epi::APERM ? ((R & ~63) + 4 * (R & 15) + ((R >> 4) & 3)) : R;
        voffA[i] = (unsigned)(Ra * K + C) * 2u; voffB[i] = (unsigned)(Rb * K + C) * 2u; }
    const size_t kstep = (size_t)(BK * 2);
    const size_t hstep = (size_t)HALF * K * 2;
    const unsigned ldsw = (unsigned)wid * 1024u;
    const int aoff = lds_byte(wr * 64 + fr, fq * 8), boff = lds_byte(wc * 32 + fr, fq * 8);
#define PG8_SA(b, h) (((b) * 2 + (h)) * HTB)
#define PG8_SB(b, h) ((4 + (b) * 2 + (h)) * HTB)
#define PG8_STAGE(bufoff, gbase, voff) do { _Pragma("unroll") for (int _i = 0; _i < 2; ++_i) \
        __builtin_amdgcn_global_load_lds((const unsigned*)((const char*)(gbase) + (voff)[_i]), (PG8_LAS unsigned*)(lds + (bufoff) + ldsw + _i * 8192), 16, 0, 0); } while (0)
#define PG8_LDA(dst, b, h) do { _Pragma("unroll") for (int m = 0; m < 4; ++m) _Pragma("unroll") for (int k = 0; k < 2; ++k) dst[m][k] = *(const PG8_LAS bf16x8*)(lds + PG8_SA(b, h) + aoff + m * 2048 + k * 1024); } while (0)
#define PG8_LDB(dst, b, h) do { _Pragma("unroll") for (int n = 0; n < 2; ++n) _Pragma("unroll") for (int k = 0; k < 2; ++k) dst[n][k] = *(const PG8_LAS bf16x8*)(lds + PG8_SB(b, h) + boff + n * 2048 + k * 1024); } while (0)
#define PG8_MMA(ai, bj, At, Bt) do { __builtin_amdgcn_s_setprio(1); _Pragma("unroll") for (int m = 0; m < 4; ++m) _Pragma("unroll") for (int n = 0; n < 2; ++n) _Pragma("unroll") for (int k = 0; k < 2; ++k) \
        acc[ai][bj][m][n] = __builtin_amdgcn_mfma_f32_16x16x32_bf16(Bt[n][k], At[m][k], acc[ai][bj][m][n], 0, 0, 0); __builtin_amdgcn_s_setprio(0); } while (0)
#define PG8_WAIT_V(n) asm volatile("s_waitcnt vmcnt(" #n ")" ::: "memory")
#define PG8_WAIT_L(n) asm volatile("s_waitcnt lgkmcnt(" #n ")" ::: "memory")
#define PG8_BAR __builtin_amdgcn_s_barrier()
#define PG8_SCHED __builtin_amdgcn_sched_barrier(0)
    Unit cur, nxt; int ui = 0;
    if (!S.next(0, cur)) return;
    f32x4 acc[2][2][4][2];
#pragma unroll
    for (int a = 0; a < 2; ++a)
#pragma unroll
        for (int b = 0; b < 2; ++b)
#pragma unroll
            for (int m = 0; m < 4; ++m)
#pragma unroll
                for (int n = 0; n < 2; ++n) acc[a][b][m][n] = (f32x4){0.f, 0.f, 0.f, 0.f};
    bf16x8 At[4][2], B0[2][2], B1[2][2];
    const char* cA = S.a_ptr(g, cur); const char* cB = S.b_ptr(g, cur);
    S.a_ready(cur);
    if constexpr (SP2) {
        PG8_STAGE(PG8_SB(0, 0), cB, voffB); PG8_STAGE(PG8_SB(0, 1), cB + hstep, voffB); PG8_STAGE(PG8_SA(0, 0), cA, voffA); PG8_STAGE(PG8_SA(0, 1), cA + hstep, voffA);
        if (wr == 1) PG8_BAR;
        PG8_WAIT_V(2); PG8_BAR;
        PG8_STAGE(PG8_SB(1, 0), cB + kstep, voffB); PG8_STAGE(PG8_SA(1, 0), cA + kstep, voffA); PG8_STAGE(PG8_SB(1, 1), cB + hstep + kstep, voffB);
        PG8_WAIT_V(6); PG8_BAR;
    } else {
        PG8_STAGE(PG8_SB(0, 0), cB, voffB); PG8_STAGE(PG8_SA(0, 0), cA, voffA); PG8_STAGE(PG8_SB(0, 1), cB + hstep, voffB); PG8_STAGE(PG8_SA(0, 1), cA + hstep, voffA);
        if (wr == 1) PG8_BAR;
        PG8_WAIT_V(4); PG8_BAR;
        PG8_STAGE(PG8_SB(1, 0), cB + kstep, voffB); PG8_STAGE(PG8_SA(1, 0), cA + kstep, voffA); PG8_STAGE(PG8_SB(1, 1), cB + hstep + kstep, voffB);
        PG8_WAIT_V(6); PG8_BAR;
    }
    for (;;) {
        const bool has_next = S.next(ui + 1, nxt);
        const char* nA = has_next ? S.a_ptr(g, nxt) : cA; const char* nB = has_next ? S.b_ptr(g, nxt) : cB;
        const int nt = S.nt(g, cur);
        for (int t = 0; t < nt; t += 2) {
            const bool last = (t == nt - 2);
            const char* a1 = cA + (size_t)(t + 1) * kstep;
            const char* a2 = last ? nA : cA + (size_t)(t + 2) * kstep; const char* b2 = last ? nB : cB + (size_t)(t + 2) * kstep;
            const char* a3 = a2 + kstep; const char* b3 = b2 + kstep;
            if (last && has_next) S.a_ready(nxt);
            if constexpr (Epi::DMA_PRE) { if (last) E.dma_prefetch(cur, lds, wid, lane); }
            if constexpr (SP2) {
            PG8_LDB(B0, 0, 0); PG8_LDB(B1, 0, 1); PG8_SCHED; PG8_LDA(At, 0, 0); PG8_STAGE(PG8_SA(1, 1), a1 + hstep, voffA);
            PG8_WAIT_V(8); PG8_WAIT_L(0); PG8_BAR; PG8_MMA(0, 0, At, B0); PG8_MMA(0, 1, At, B1); PG8_BAR; PG8_SCHED;
            PG8_LDA(At, 0, 1); PG8_STAGE(PG8_SB(0, 0), b2, voffB); PG8_STAGE(PG8_SB(0, 1), b2 + hstep, voffB); PG8_STAGE(PG8_SA(0, 0), a2, voffA);
            PG8_WAIT_V(8); PG8_WAIT_L(0); PG8_BAR; PG8_MMA(1, 0, At, B0); PG8_MMA(1, 1, At, B1); PG8_BAR; PG8_SCHED;
            PG8_LDB(B0, 1, 0); PG8_LDB(B1, 1, 1); PG8_SCHED; PG8_LDA(At, 1, 0); PG8_STAGE(PG8_SA(0, 1), a2 + hstep, voffA);
            PG8_WAIT_V(8); PG8_WAIT_L(0); PG8_BAR; PG8_MMA(0, 0, At, B0); PG8_MMA(0, 1, At, B1); PG8_BAR; PG8_SCHED;
            PG8_LDA(At, 1, 1); PG8_STAGE(PG8_SB(1, 0), b3, voffB); PG8_STAGE(PG8_SB(1, 1), b3 + hstep, voffB); PG8_STAGE(PG8_SA(1, 0), a3, voffA);
            PG8_WAIT_V(8); PG8_WAIT_L(0); PG8_BAR; PG8_MMA(1, 0, At, B0); PG8_MMA(1, 1, At, B1); PG8_BAR; PG8_SCHED;
            } else {
            PG8_LDB(B0, 0, 0); PG8_SCHED; PG8_LDA(At, 0, 0); PG8_STAGE(PG8_SA(1, 1), a1 + hstep, voffA);
            PG8_WAIT_L(8); PG8_BAR; PG8_WAIT_L(0); PG8_MMA(0, 0, At, B0); PG8_BAR; PG8_SCHED;
            PG8_LDB(B1, 0, 1); PG8_STAGE(PG8_SB(0, 0), b2, voffB);
            PG8_BAR; PG8_WAIT_L(0); PG8_MMA(0, 1, At, B1); PG8_BAR;
            PG8_LDA(At, 0, 1); PG8_STAGE(PG8_SA(0, 0), a2, voffA);
            PG8_BAR; PG8_WAIT_L(0); PG8_MMA(1, 0, At, B0); PG8_BAR; PG8_SCHED;
            PG8_STAGE(PG8_SB(0, 1), b2 + hstep, voffB);
            PG8_WAIT_V(6); PG8_BAR; PG8_MMA(1, 1, At, B1); PG8_BAR;
            PG8_LDB(B0, 1, 0); PG8_SCHED; PG8_LDA(At, 1, 0); PG8_STAGE(PG8_SA(0, 1), a2 + hstep, voffA);
            PG8_WAIT_L(8); PG8_BAR; PG8_WAIT_L(0); PG8_MMA(0, 0, At, B0); PG8_BAR; PG8_SCHED;
            PG8_LDB(B1, 1, 1); PG8_STAGE(PG8_SB(1, 0), b3, voffB);
            PG8_BAR; PG8_WAIT_L(0); PG8_MMA(0, 1, At, B1); PG8_BAR;
            PG8_LDA(At, 1, 1); PG8_STAGE(PG8_SA(1, 0), a3, voffA);
            PG8_BAR; PG8_WAIT_L(0); PG8_MMA(1, 0, At, B0); PG8_BAR; PG8_SCHED;
            PG8_STAGE(PG8_SB(1, 1), b3 + hstep, voffB);
            PG8_WAIT_V(6); PG8_BAR; PG8_MMA(1, 1, At, B1); PG8_BAR;
            }
        }
        if constexpr (ALIGN_EPI) { if (wr == 0) PG8_BAR; }
        E(acc, cur, wr, wc, fr, fq, lds); S.done(cur);
        if (!has_next) break;
        if (!S.keep(cur)) {
#pragma unroll
        for (int a = 0; a < 2; ++a)
#pragma unroll
            for (int b = 0; b < 2; ++b)
#pragma unroll
                for (int m = 0; m < 4; ++m)
#pragma unroll
                    for (int n = 0; n < 2; ++n) acc[a][b][m][n] = (f32x4){0.f, 0.f, 0.f, 0.f};
        }
        cur = nxt; cA = nA; cB = nB; ++ui;
        if constexpr (ALIGN_EPI) { if (wr == 1) PG8_BAR; }
    }
    PG8_WAIT_V(0);
    if constexpr (!ALIGN_EPI) { if (wr == 0) PG8_BAR; }
    PG8_BAR;
#undef PG8_SA
#undef PG8_SB
#undef PG8_STAGE
#undef PG8_LDA
#undef PG8_LDB
#undef PG8_MMA
#undef PG8_WAIT_V
#undef PG8_WAIT_L
#undef PG8_BAR
#undef PG8_SCHED
}
}

struct Ws {
    float *rstd1, *sumsq2, *sumsq3;
    bf16_t *Wt_in, *Wt_reto, *Wt_atto, *Wt_o, *Wt_up, *Wt_down;
    bf16_t *xb, *proj, *G, *Oatt, *merged, *act, *ub;
    float* kvc; bf16_t* sb; bf16_t* og; float* lse; unsigned char* g8; bf16_t* tmp;
};
__device__ __forceinline__ Ws make_ws(unsigned char* ws) {
    Ws w;
    w.rstd1 = (float*)(ws + WS_CTL); w.sumsq2 = w.rstd1 + MT; w.sumsq3 = w.sumsq2 + MT;
    w.Wt_in = (bf16_t*)(ws + WS_WIN); w.Wt_reto = (bf16_t*)(ws + WS_WRETO); w.Wt_atto = (bf16_t*)(ws + WS_WATTO_P); w.Wt_o = (bf16_t*)(ws + WS_WO);
    w.Wt_up = (bf16_t*)(ws + WS_WUP); w.Wt_down = (bf16_t*)(ws + WS_WDOWN);
    w.xb = (bf16_t*)(ws + WS_XB); w.proj = (bf16_t*)(ws + WS_PROJ); w.ub = (bf16_t*)(ws + WS_PROJ); w.G = (bf16_t*)(ws + WS_G); w.Oatt = (bf16_t*)(ws + WS_OATT);
    w.merged = (bf16_t*)(ws + WS_MERGED); w.act = (bf16_t*)(ws + WS_ACT); w.kvc = (float*)(ws + WS_KVC);
    w.g8 = ws + WS_G8; w.tmp = (bf16_t*)(ws + WS_KVC);
    w.sb = (bf16_t*)(ws + WS_SB); w.og = (bf16_t*)(ws + WS_OG); w.lse = (float*)(ws + WS_LSE);
    return w;
}

struct EpiIn {
    static constexpr bool PERM = true, DMA_PRE = false, APERM = false;
    Ws w; float* out;
    template <int CLS> __device__ __forceinline__ void body(f32x4 (&acc)[2][2][4][2], int row0, int col0, int grp, int kv) const {
#pragma unroll
        for (int ai = 0; ai < 2; ++ai)
#pragma unroll
            for (int m = 0; m < 4; ++m) {
                const int row = row0 + ai * 128 + m * 16;
#pragma unroll
                for (int bj = 0; bj < 2; ++bj) {
                    const int col = col0 + bj * 128;
                    f32x4 v0 = acc[ai][bj][m][0], v1 = acc[ai][bj][m][1];
                    if (CLS == 1) {
#pragma unroll
                        for (int i = 0; i < 4; ++i) { v0[i] = v0[i] * sigmoidf_(v0[i]); v1[i] = v1[i] * sigmoidf_(v1[i]); }
                    }
                    if (CLS == 2) { u32x2 o8; o8.x = sigcode4(v0); o8.y = sigcode4(v1); __builtin_nontemporal_store(o8, (u32x2*)(w.g8 + (unsigned)(row * 4096) + (col - C_GR))); }
                    else { u32x4 o; o.x = pk2(v0[0], v0[1]); o.y = pk2(v0[2], v0[3]); o.z = pk2(v1[0], v1[1]); o.w = pk2(v1[2], v1[3]);
                        *(u32x4*)(w.proj + (unsigned)(((col >> 7) * MT + row) * 128 + (col & 127))) = o; }
                    if (CLS == 3) {
                        const int win = 128 << (2 * grp);
                        const size_t obase_p = grp == 0 ? O_KV128P : (grp == 1 ? O_KV512P : O_KV2048P);
                        const size_t obase_s = grp == 0 ? O_KV128S : (grp == 1 ? O_KV512S : O_KV2048S);
                        const int c512 = (col & 511);
                        float* dst = nullptr;
                        if (row < MP) { const int b = row >> 13, t = row & 8191; if (t >= SEQ - win) dst = out + obase_p + ((size_t)(b * win + (t - (SEQ - win))) * 2 + kv) * 512 + c512; }
                        else { const int b = (row - MP) >> 3, t = (row - MP) & 7; dst = out + obase_s + ((size_t)(b * win + (win - 8 + t)) * 2 + kv) * 512 + c512; }
                        if (dst) { __builtin_nontemporal_store(v0, (f32x4*)dst); __builtin_nontemporal_store(v1, (f32x4*)(dst + 4)); }
                    }
                }
            }
    }
    __device__ __forceinline__ void operator()(f32x4 (&acc)[2][2][4][2], const pg8::Unit& u, int wr, int wc, int fr_, int fq_, LAS unsigned char*) const {
        int fr = fr_, fq = fq_; asm volatile("" : "+v"(fr), "+v"(fq));
        const int row0 = u.pm * 256 + wr * 64 + fr, col0 = u.pn * 256 + wc * 32 + 8 * fq;
        const int pn = u.pn;
        if (pn >= 34) body<2>(acc, row0, col0, 0, 0);
        else if (pn >= 12 && pn < 16) body<1>(acc, row0, col0, 0, 0);
        else if (pn >= 16) { const int q = (pn - 16) % 6, grp = (pn - 16) / 6;
            const int win = 128 << (2 * grp); const int t_hi = ((u.pm & 31) + 1) * 256;
            if (q >= 2 && (u.pm >= 64 || t_hi > SEQ - win)) body<3>(acc, row0, col0, grp, q >= 4 ? 1 : 0); else body<0>(acc, row0, col0, 0, 0); }
        else body<0>(acc, row0, col0, 0, 0);
    }
};
struct EpiWo {
    static constexpr bool PERM = true, DMA_PRE = false, APERM = false;
    Ws w;
    __device__ __forceinline__ void operator()(f32x4 (&acc)[2][2][4][2], const pg8::Unit& u, int wr, int wc, int fr_, int fq_, LAS unsigned char*) const {
        int fr = fr_, fq = fq_; asm volatile("" : "+v"(fr), "+v"(fq));
        const int row0 = u.pm * 256 + wr * 64 + fr;
        const int col0 = u.pn * 256 + wc * 32 + 8 * fq;
        float ssv[8];
#pragma unroll
        for (int ai = 0; ai < 2; ++ai)
#pragma unroll
            for (int m = 0; m < 4; ++m) {
                const int row = row0 + ai * 128 + m * 16;
                const float rs = w.rstd1[row];
                float ssq = 0.f;
#pragma unroll
                for (int bj = 0; bj < 2; ++bj) {
                    const int col = col0 + bj * 128;
                    f32x4 v0 = acc[ai][bj][m][0], v1 = acc[ai][bj][m][1];
                    { const u32x4 xv = *(const u32x4*)(w.xb + (unsigned)(row * DM) + col);
                      v0[0] += bflo(xv.x) * rs; v0[1] += bfhi(xv.x) * rs; v0[2] += bflo(xv.y) * rs; v0[3] += bfhi(xv.y) * rs;
                      v1[0] += bflo(xv.z) * rs; v1[1] += bfhi(xv.z) * rs; v1[2] += bflo(xv.w) * rs; v1[3] += bfhi(xv.w) * rs; }
                    u32x4 o; o.x = pk2(v0[0], v0[1]); o.y = pk2(v0[2], v0[3]); o.z = pk2(v1[0], v1[1]); o.w = pk2(v1[2], v1[3]);
                    *(u32x4*)(w.xb + (unsigned)(row * DM) + col) = o;
#pragma unroll
                    for (int i = 0; i < 4; ++i) ssq += v0[i] * v0[i] + v1[i] * v1[i];
                }
                ssq += __shfl_xor(ssq, 16); ssq += __shfl_xor(ssq, 32);
                ssv[ai * 4 + m] = ssq;
            }
        if (fq == 0) {
#pragma unroll
            for (int k = 0; k < 8; ++k) atomicAdd(w.sumsq2 + row0 + (k >> 2) * 128 + (k & 3) * 16, ssv[k]);
        }
    }
};

struct EpiP5 {
    static constexpr bool PERM = true, DMA_PRE = false, APERM = false;
    Ws w;
    __device__ __forceinline__ void operator()(f32x4 (&acc)[2][2][4][2], const pg8::Unit& u, int wr, int wc, int fr_, int fq_, LAS unsigned char*) const {
        int fr = fr_, fq = fq_; asm volatile("" : "+v"(fr), "+v"(fq));
        const int row0 = u.pm * 256 + wr * 64 + fr, col0 = u.pn * 256 + wc * 32 + 8 * fq;
        if (u.seg == 0) {
#pragma unroll
            for (int ai = 0; ai < 2; ++ai)
#pragma unroll
                for (int m = 0; m < 4; ++m) {
                    const int row = row0 + ai * 128 + m * 16;
#pragma unroll
                    for (int bj = 0; bj < 2; ++bj) { const unsigned char* gp = w.g8 + (unsigned)(row * 4096) + col0 + bj * 128;
                        const u32x2 gr = *(const u32x2*)gp, ga = *(const u32x2*)(gp + 2048);
                        const f32x4 a0 = dec8x4(ga.x), a1 = dec8x4(ga.y);
                        f32x4 q0 = dec8x4(gr.x), q1 = dec8x4(gr.y);
#pragma unroll
                        for (int i = 0; i < 4; ++i) { q0[i] *= __builtin_amdgcn_rcpf(a0[i]); q1[i] *= __builtin_amdgcn_rcpf(a1[i]); }
                        acc[ai][bj][m][0] *= q0; acc[ai][bj][m][1] *= q1; }
                }
        } else {
#pragma unroll
            for (int ai = 0; ai < 2; ++ai)
#pragma unroll
                for (int m = 0; m < 4; ++m) {
                    const int row = row0 + ai * 128 + m * 16;
#pragma unroll
                    for (int bj = 0; bj < 2; ++bj) { const int col = col0 + bj * 128;
                        const u32x2 ga = *(const u32x2*)(w.g8 + (unsigned)(row * 4096) + 2048 + col);
                        const f32x4 v0 = acc[ai][bj][m][0] * dec8x4(ga.x), v1 = acc[ai][bj][m][1] * dec8x4(ga.y);
                        u32x4 o; o.x = pk2(v0[0], v0[1]); o.y = pk2(v0[2], v0[3]); o.z = pk2(v1[0], v1[1]); o.w = pk2(v1[2], v1[3]);
                        *(u32x4*)(w.merged + (unsigned)(row * DM) + col) = o; }
                }
        }
    }
};

__device__ __forceinline__ float dpp_ror1(float v) { return __int_as_float(__builtin_amdgcn_mov_dpp(__float_as_int(v), 0x121, 0xf, 0xf, false)); }
__device__ __forceinline__ float dpp_keep(float v) { float d = dpp_ror1(v); asm volatile("" : "+v"(d)); return d; }
__device__ __forceinline__ float dpp_ror2(float v) { return __int_as_float(__builtin_amdgcn_mov_dpp(__float_as_int(v), 0x122, 0xf, 0xf, false)); }
typedef float f32x2 __attribute__((ext_vector_type(2)));
__device__ __forceinline__ f32x2 gelu_gate2(f32x2 v, f32x2 b) {
    f32x2 a; a.x = __builtin_amdgcn_fmed3f(fabsf(v.x), 0.f, 6.5f); a.y = __builtin_amdgcn_fmed3f(fabsf(v.y), 0.f, 6.5f);
    const f32x2 c9 = {3.819134520e-07f, 3.819134520e-07f}, c8 = {-7.616652965e-06f, -7.616652965e-06f}, c7 = {6.311968900e-05f, 6.311968900e-05f}, c6 = {-2.457886876e-04f, -2.457886876e-04f},
                c5 = {-5.764040543e-05f, -5.764040543e-05f}, c4 = {7.011611480e-03f, 7.011611480e-03f}, c3 = {-5.248568207e-02f, -5.248568207e-02f}, c2 = {-4.592045844e-01f, -4.592045844e-01f},
                c1 = {-1.151106715e+00f, -1.151106715e+00f}, c0 = {-9.999999404e-01f, -9.999999404e-01f};
    f32x2 p = c9 * a + c8; p = p * a + c7; p = p * a + c6; p = p * a + c5; p = p * a + c4; p = p * a + c3; p = p * a + c2; p = p * a + c1; p = p * a + c0;
    f32x2 e; e.x = __builtin_amdgcn_exp2f(p.x); e.y = __builtin_amdgcn_exp2f(p.y);
    f32x2 r; asm("v_max_f32 %0, 0, %1" : "=v"(r.x) : "v"(v.x)); asm("v_max_f32 %0, 0, %1" : "=v"(r.y) : "v"(v.y));
    return (r - a * e) * b;
}
#define CONV_SHR1(v, c, w) asm("v_fmac_f32_dpp %0, %1, %2 row_shr:1 row_mask:0xf bank_mask:0xf" : "+v"(v) : "v"(c), "v"(w))
constexpr int HALO_OFF = 131072;
constexpr int PRE_SS = HALO_OFF + 6144, PRE_CW = HALO_OFF + 7168;
struct EpiUp {
    static constexpr bool PERM = true, DMA_PRE = true, APERM = true;
    Ws w; float* out; const float* cw; const float* cb; const float* sconv;
    __device__ __forceinline__ void dma_prefetch(const pg8::Unit& u, LAS unsigned char* lds, int wid, int lane) const {
        if (wid == 0) {
            const bool samp = u.pm >= 66;
            const int rowbase = samp ? MP : (u.pm / 33) * SEQ + 254 * (u.pm % 33) - 2;
#pragma unroll
            for (int i = 0; i < 4; ++i) __builtin_amdgcn_global_load_lds((const unsigned*)(w.sumsq2 + rowbase + 64 * i + lane), (LAS unsigned*)(lds + PRE_SS + 256 * i), 4, 0, 0);
        } else if (wid == 1) {
            const int f0 = u.pn * 128 + 4 * (lane & 31), hb = (lane >> 5) * FF;
#pragma unroll
            for (int k = 0; k < 3; ++k) __builtin_amdgcn_global_load_lds((const unsigned*)(cw + (size_t)k * F2 + hb + f0), (LAS unsigned*)(lds + PRE_CW + 1024 * k), 16, 0, 0);
            __builtin_amdgcn_global_load_lds((const unsigned*)(cb + hb + f0), (LAS unsigned*)(lds + PRE_CW + 3072), 16, 0, 0);
        }
    }
    __device__ __forceinline__ void operator()(f32x4 (&acc)[2][2][4][2], const pg8::Unit& u, int wr, int wc, int fr_, int fq_, LAS unsigned char* lds) const {
        int fr = fr_, fq = fq_; asm volatile("" : "+v"(fr), "+v"(fq));
        const bool samp = u.pm >= 66;
        const int bb = samp ? 0 : u.pm / 33, jj = samp ? 0 : u.pm % 33;
        const int t0 = samp ? 0 : 254 * jj - 2;
        const int rowbase = samp ? MP : bb * SEQ + t0;
#pragma unroll
        for (int ai = 0; ai < 2; ++ai)
#pragma unroll
            for (int m = 0; m < 4; ++m) {
                const int rl = ai * 128 + wr * 64 + 4 * fr + m, t = t0 + rl;
                const bool ok = samp || (t >= 0 && t < SEQ);
                const float ss = *(const LAS float*)(lds + PRE_SS + 4 * rl);
                const float rs = ok ? __builtin_amdgcn_rsqf(ss * (1.0f / DM) + EPS) : 0.f;
#pragma unroll
                for (int bj = 0; bj < 2; ++bj) { acc[ai][bj][m][0] *= rs; acc[ai][bj][m][1] *= rs; }
            }
        asm volatile("" ::: "memory");
        LAS float* halo = (LAS float*)(lds + HALO_OFF);
        const int fcol = u.pn * 128 + wc * 32 + 8 * fq;
        if (!samp) {
            if (fr == 15) {
#pragma unroll
                for (int ai = 0; ai < 2; ++ai) { const int bd = 2 * ai + wr;
                    if (bd < 3) {
#pragma unroll
                        for (int m = 2; m < 4; ++m) { LAS f32x4* hp = (LAS f32x4*)(halo + (((bd * 4 + wc) * 8 + (m - 2) * 4 + fq) * 16));
                            hp[0] = acc[ai][0][m][0]; hp[1] = acc[ai][0][m][1]; hp[2] = acc[ai][1][m][0]; hp[3] = acc[ai][1][m][1]; } } }
            }
            asm volatile("s_waitcnt lgkmcnt(0)" ::: "memory"); __builtin_amdgcn_s_barrier(); asm volatile("" ::: "memory");
            u32x2 olo[2][4];
            const float zm = fr == 0 ? 1.0f : 0.0f;
            bf16_t* const dump = w.merged;
#pragma unroll
            for (int n = 0; n < 2; ++n) {
                const int f0 = fcol + 4 * n;
                f32x4 wa[3], wb[3];
                const LAS unsigned char* wl = lds + PRE_CW + 4 * (f0 - u.pn * 128);
#pragma unroll
                for (int k = 0; k < 3; ++k) { wa[k] = *(const LAS f32x4*)(wl + 1024 * k); wb[k] = *(const LAS f32x4*)(wl + 1024 * k + 512); }
                const f32x4 ba = *(const LAS f32x4*)(wl + 3072), bbv = *(const LAS f32x4*)(wl + 3072 + 512);
#pragma unroll
                for (int ai = 0; ai < 2; ++ai) {
                    const int gi = 2 * ai + wr;
                    const LAS f32x4* hp = (const LAS f32x4*)(halo + ((((gi > 0 ? gi - 1 : 0) * 4 + wc) * 8 + fq) * 16));
                    const f32x4 h62a = hp[n] * zm, h62b = hp[2 + n] * zm, h63a = hp[16 + n] * zm, h63b = hp[16 + 2 + n] * zm;
#pragma unroll
                    for (int m = 0; m < 4; ++m) {
                        const int rl = ai * 128 + wr * 64 + 4 * fr + m, t = t0 + rl;
                        const f32x4 ca = acc[ai][0][m][n], cbv = acc[ai][1][m][n];
                        f32x4 va = ba + wa[2] * ca, vb = bbv + wb[2] * cbv;
                        if (m >= 1) { va += wa[1] * acc[ai][0][m - 1][n]; vb += wb[1] * acc[ai][1][m - 1][n]; }
                        else { va += wa[1] * h63a; vb += wb[1] * h63b; }
                        if (m >= 2) { va += wa[0] * acc[ai][0][m - 2][n]; vb += wb[0] * acc[ai][1][m - 2][n]; }
                        else if (m == 1) { va += wa[0] * h63a; vb += wb[0] * h63b; }
                        else { va += wa[0] * h62a; vb += wb[0] * h62b; }
                        if (m < 2) {
#pragma unroll
                            for (int i = 0; i < 4; ++i) {
                                float ta = va[i], tb = vb[i];
                                if (m == 0) { CONV_SHR1(ta, acc[ai][0][3][n][i], wa[1][i]); CONV_SHR1(tb, acc[ai][1][3][n][i], wb[1][i]);
                                              CONV_SHR1(ta, acc[ai][0][2][n][i], wa[0][i]); CONV_SHR1(tb, acc[ai][1][2][n][i], wb[0][i]); }
                                else { CONV_SHR1(ta, acc[ai][0][3][n][i], wa[0][i]); CONV_SHR1(tb, acc[ai][1][3][n][i], wb[0][i]); }
                                va[i] = ta; vb[i] = tb;
                            }
                        }
                        const f32x2 g01 = gelu_gate2((f32x2){va[0], va[1]}, (f32x2){vb[0], vb[1]}), g23 = gelu_gate2((f32x2){va[2], va[3]}, (f32x2){vb[2], vb[3]});
                        u32x2 o; o.x = pk2(g01.x, g01.y); o.y = pk2(g23.x, g23.y);
                        if (n == 0) olo[ai][m] = o;
                        else { u32x4 o4; o4.x = olo[ai][m].x; o4.y = olo[ai][m].y; o4.z = o.x; o4.w = o.y;
                            const bool ok = rl >= 2 && t < SEQ;
                            bf16_t* dst = ok ? w.act + (unsigned)((rowbase + rl) * FF + fcol) : dump + (unsigned)(threadIdx.x * 8);
                            *(u32x4*)dst = o4; }
                        asm volatile("" ::: "memory");
                    }
                }
            }
            if (jj == 32) {
#pragma unroll
                for (int ai = 0; ai < 2; ++ai)
#pragma unroll
                    for (int m = 0; m < 4; ++m) { const int rl = ai * 128 + wr * 64 + 4 * fr + m, t = t0 + rl;
                        if (t >= SEQ - 2 && t < SEQ) {
#pragma unroll
                            for (int n = 0; n < 2; ++n) { float* d = out + O_CONVP + ((size_t)bb * 2 + (t - (SEQ - 2))) * F2 + fcol + 4 * n; *(f32x4*)d = acc[ai][0][m][n]; *(f32x4*)(d + FF) = acc[ai][1][m][n]; } } }
            }
        } else {
            const bool ev = !(fr & 1);
#pragma unroll
            for (int n = 0; n < 2; ++n) {
                const int f0 = fcol + 4 * n;
                f32x4 wa[3], wb[3];
                const LAS unsigned char* wl = lds + PRE_CW + 4 * (f0 - u.pn * 128);
#pragma unroll
                for (int k = 0; k < 3; ++k) { wa[k] = *(const LAS f32x4*)(wl + 1024 * k); wb[k] = *(const LAS f32x4*)(wl + 1024 * k + 512); }
                const f32x4 ba = *(const LAS f32x4*)(wl + 3072), bbv = *(const LAS f32x4*)(wl + 3072 + 512);
#pragma unroll
                for (int ai = 0; ai < 2; ++ai) {
                    const int bs = ai * 16 + wr * 8 + (fr >> 1);
                    f32x4 s1a = ba, s1b = ba, s0a = ba, s0b = ba;
                    if (ev) { const float* s1 = sconv + ((size_t)bs * 2 + 1) * F2 + f0; const float* s0 = sconv + ((size_t)bs * 2) * F2 + f0;
                        s1a = *(const f32x4*)s1; s1b = *(const f32x4*)(s1 + FF); s0a = *(const f32x4*)s0; s0b = *(const f32x4*)(s0 + FF); }
#pragma unroll
                    for (int m = 0; m < 4; ++m) {
                        const int rl = ai * 128 + wr * 64 + 4 * fr + m, ts = 4 * (fr & 1) + m;
                        const f32x4 ca = acc[ai][0][m][n], cbv = acc[ai][1][m][n];
                        f32x4 a1, a2, b1, b2;
                        if (m >= 1) { a1 = acc[ai][0][m - 1][n]; b1 = acc[ai][1][m - 1][n]; }
                        else {
#pragma unroll
                            for (int i = 0; i < 4; ++i) { const float da = dpp_keep(acc[ai][0][3][n][i]), db = dpp_keep(acc[ai][1][3][n][i]); a1[i] = ev ? s1a[i] : da; b1[i] = ev ? s1b[i] : db; } }
                        if (m >= 2) { a2 = acc[ai][0][m - 2][n]; b2 = acc[ai][1][m - 2][n]; }
                        else if (m == 1) {
#pragma unroll
                            for (int i = 0; i < 4; ++i) { const float da = dpp_keep(acc[ai][0][3][n][i]), db = dpp_keep(acc[ai][1][3][n][i]); a2[i] = ev ? s1a[i] : da; b2[i] = ev ? s1b[i] : db; } }
                        else {
#pragma unroll
                            for (int i = 0; i < 4; ++i) { const float da = dpp_keep(acc[ai][0][2][n][i]), db = dpp_keep(acc[ai][1][2][n][i]); a2[i] = ev ? s0a[i] : da; b2[i] = ev ? s0b[i] : db; } }
                        const f32x4 va = ba + wa[0] * a2 + wa[1] * a1 + wa[2] * ca;
                        const f32x4 vb = bbv + wb[0] * b2 + wb[1] * b1 + wb[2] * cbv;
                        const f32x2 g01 = gelu_gate2((f32x2){va[0], va[1]}, (f32x2){vb[0], vb[1]}), g23 = gelu_gate2((f32x2){va[2], va[3]}, (f32x2){vb[2], vb[3]});
                        u32x2 o; o.x = pk2(g01.x, g01.y); o.y = pk2(g23.x, g23.y);
                        *(u32x2*)(w.act + (unsigned)((MP + rl) * FF + f0)) = o;
                        if (ts >= 6) { float* d = out + O_CONVS + ((size_t)bs * 2 + (ts - 6)) * F2 + f0; *(f32x4*)d = ca; *(f32x4*)(d + FF) = cbv; }
                        asm volatile("" ::: "memory");
                    }
                }
            }
        }
    }
};


__device__ __forceinline__ void panel_arrive_wait(unsigned* cnt, unsigned want) {
    asm volatile("s_waitcnt vmcnt(0)" ::: "memory");
    __hip_atomic_fetch_add(cnt, 1u, __ATOMIC_RELAXED, __HIP_MEMORY_SCOPE_AGENT);
    unsigned sp = 0;
    while (__hip_atomic_load(cnt, __ATOMIC_RELAXED, __HIP_MEMORY_SCOPE_AGENT) < want) { __builtin_amdgcn_s_sleep(2); if (++sp > (1u << 22)) break; }
    asm volatile("s_waitcnt vmcnt(0)" ::: "memory");
}
struct EpiFin {
    static constexpr bool PERM = true, DMA_PRE = false, APERM = false;
    Ws w; float* out; const float* gfin; unsigned* pcnt;
    __device__ __forceinline__ void operator()(f32x4 (&acc)[2][2][4][2], const pg8::Unit& u, int wr, int wc, int fr_, int fq_, LAS unsigned char*) const {
        int fr = fr_, fq = fq_; asm volatile("" : "+v"(fr), "+v"(fq));
        const int row0 = u.pm * 256 + wr * 64 + fr;
        const int col0 = u.pn * 256 + wc * 32 + 8 * fq;
        float ssv[8];
#pragma unroll
        for (int ai = 0; ai < 2; ++ai)
#pragma unroll
            for (int m = 0; m < 4; ++m) {
                const int row = row0 + ai * 128 + m * 16;
                float ssq = 0.f;
#pragma unroll
                for (int bj = 0; bj < 2; ++bj) {
                    const int col = col0 + bj * 128;
                    const u32x4 xv = __builtin_nontemporal_load((const u32x4*)(w.xb + (unsigned)(row * DM) + col));
                    f32x4 v0 = acc[ai][bj][m][0], v1 = acc[ai][bj][m][1];
                    v0[0] += bflo(xv.x); v0[1] += bfhi(xv.x); v0[2] += bflo(xv.y); v0[3] += bfhi(xv.y);
                    v1[0] += bflo(xv.z); v1[1] += bfhi(xv.z); v1[2] += bflo(xv.w); v1[3] += bfhi(xv.w);
                    acc[ai][bj][m][0] = v0; acc[ai][bj][m][1] = v1;
#pragma unroll
                    for (int i = 0; i < 4; ++i) ssq += v0[i] * v0[i] + v1[i] * v1[i];
                }
                ssq += __shfl_xor(ssq, 16); ssq += __shfl_xor(ssq, 32);
                ssv[ai * 4 + m] = ssq;
            }
        if (fq == 0) {
#pragma unroll
            for (int k = 0; k < 8; ++k) atomicAdd(w.sumsq3 + row0 + (k >> 2) * 128 + (k & 3) * 16, ssv[k]);
        }
        asm volatile("s_waitcnt vmcnt(0)" ::: "memory"); __builtin_amdgcn_s_barrier(); asm volatile("" ::: "memory");
        if (threadIdx.x == 0) panel_arrive_wait(pcnt + 16 * u.pm, 8u);
        asm volatile("s_waitcnt vmcnt(0) lgkmcnt(0)" ::: "memory"); __builtin_amdgcn_s_barrier(); asm volatile("" ::: "memory");
        f32x4 g[2][2];
#pragma unroll
        for (int bj = 0; bj < 2; ++bj) { g[bj][0] = *(const f32x4*)(gfin + col0 + bj * 128); g[bj][1] = *(const f32x4*)(gfin + col0 + bj * 128 + 4); }
#pragma unroll
        for (int ai = 0; ai < 2; ++ai)
#pragma unroll
            for (int m = 0; m < 4; ++m) {
                const int row = row0 + ai * 128 + m * 16;
                const float rs = rsqrtf(__hip_atomic_load(w.sumsq3 + row, __ATOMIC_RELAXED, __HIP_MEMORY_SCOPE_AGENT) * (1.0f / DM) + EPS);
#pragma unroll
                for (int bj = 0; bj < 2; ++bj) { float* dst = out + O_Y + (unsigned)(row * DM) + col0 + bj * 128;
                    __builtin_nontemporal_store(acc[ai][bj][m][0] * rs * g[bj][0], (f32x4*)dst); __builtin_nontemporal_store(acc[ai][bj][m][1] * rs * g[bj][1], (f32x4*)(dst + 4)); }
            }
    }
};

__device__ __forceinline__ int up_rowmap(int n) { return n < FF ? ((n >> 7) * 256 + (n & 127)) : (((n - FF) >> 7) * 256 + 128 + ((n - FF) & 127)); }
__device__ __forceinline__ void p0_transpose_item(const float* W, int K, int N, bf16_t* WT, const float* g, bool upmap, LAS float* scr, int item, int lane, int ldt = 0) {
    if (ldt == 0) ldt = K;
    const int nblk = N / 32, kb = item / nblk, nb = item % nblk, k0 = 64 * kb, n0 = 32 * nb;
    float tv[32];
#pragma unroll
    for (int i = 0; i < 32; ++i) { const int kk = 2 * i + (lane >> 5); tv[i] = __builtin_nontemporal_load(W + (size_t)(k0 + kk) * N + n0 + (lane & 31)); }
    if (g) {
#pragma unroll
        for (int i = 0; i < 32; ++i) tv[i] *= g[k0 + 2 * i + (lane >> 5)];
    }
#pragma unroll
    for (int i = 0; i < 32; ++i) { const int kk = 2 * i + (lane >> 5); scr[kk * 33 + (lane & 31)] = tv[i]; }
    LDS_WAIT();
    const int c = lane & 7;
    const int nbase = upmap ? up_rowmap(n0) : n0;
#pragma unroll
    for (int j = 0; j < 4; ++j) { const int n = (lane >> 3) + 8 * j; const LAS float* s = scr + (8 * c) * 33 + n;
        u32x4 o; o.x = pk2(s[0 * 33], s[1 * 33]); o.y = pk2(s[2 * 33], s[3 * 33]); o.z = pk2(s[4 * 33], s[5 * 33]); o.w = pk2(s[6 * 33], s[7 * 33]);
        *(u32x4*)(WT + (size_t)(nbase + n) * ldt + k0 + 8 * c) = o; }
    LDS_WAIT();
}
#ifndef KVSLACK
#define KVSLACK 100
#endif
#define KV_SPLIT ((KVSLACK) >= 100 ? KV_TOTAL : KV_TOTAL / 100 * (KVSLACK))
template <int SET> __device__ __forceinline__ void weight_transposes(const Params& p, const Ws& w, LAS unsigned char* lds, int rk, int n) {
    const int tid = opaque_tid(), lane = tid & 63, wave = tid >> 6;
    LAS float* scr = (LAS float*)(lds + wave * 16384);
    const int gw = rk * 8 + wave, NGW = n * 8;
    constexpr int I_IN = (DM / 64) * (INC / 32), I_RO = (1024 / 64) * (DM / 32), I_AO = (512 / 64) * (DM / 32), I_O = (DM / 64) * (DM / 32), I_UP = (DM / 64) * (F2 / 32), I_DN = (FF / 64) * (DM / 32);
    constexpr int NITEMS = SET == 0 ? I_IN + I_UP : (SET == 1 ? I_RO + I_AO + I_O : I_DN);
    for (int it = gw; it < NITEMS; it += NGW) {
        int r = it;
        if (SET == 0) {
            if (r < I_IN) { p0_transpose_item(p.in[8], DM, INC, w.Wt_in, p.in[7], false, scr, r, lane); continue; } r -= I_IN;
            p0_transpose_item(p.in[14], DM, F2, w.Wt_up, p.in[13], true, scr, r, lane);
        } else if (SET == 1) {
            if (r < I_RO) { p0_transpose_item(p.in[10], 1024, DM, w.Wt_reto, nullptr, false, scr, r, lane); continue; } r -= I_RO;
            if (r < I_AO) { p0_transpose_item(p.in[11], 512, DM, w.Wt_atto, nullptr, false, scr, r, lane, 1024); continue; } r -= I_AO;
            p0_transpose_item(p.in[12], DM, DM, w.Wt_o, nullptr, false, scr, r, lane);
        } else p0_transpose_item(p.in[17], FF, DM, w.Wt_down, nullptr, false, scr, r, lane);
    }
}
__device__ __forceinline__ void p0_xconv(const Params& p, const Ws& w, LAS unsigned char* lds, int vcu, int G) {
    const int tid = opaque_tid(), lane = tid & 63, wave = tid >> 6;
    const int gw = vcu * 8 + wave, NGW = G * 8;
    for (int m = gw; m < MT; m += NGW) {
        const float* xr = (m < MP) ? p.in[0] + (size_t)m * DM : p.in[1] + (size_t)(m - MP) * DM;
        const f32x4* x4 = (const f32x4*)xr + lane;
        f32x4 v[8]; float s = 0.f;
#pragma unroll
        for (int j = 0; j < 8; ++j) { v[j] = __builtin_nontemporal_load(x4 + 64 * j); s += (v[j].x * v[j].x + v[j].y * v[j].y) + (v[j].z * v[j].z + v[j].w * v[j].w); }
        s = wave_sum(s);
        const float rs = rsqrtf(s * (1.0f / DM) + EPS);
        if (lane == 0) w.rstd1[m] = sqrtf(s * (1.0f / DM) + EPS);
        u32x2* o8 = (u32x2*)(w.xb + (size_t)m * DM) + lane;
#pragma unroll
        for (int j = 0; j < 8; ++j) { u32x2 o; o.x = pk2(v[j].x * rs, v[j].y * rs); o.y = pk2(v[j].z * rs, v[j].w * rs); o8[64 * j] = o; }
    }
    for (int i = vcu * 512 + tid; i < 2 * MT; i += G * 512) w.sumsq2[i] = 0.f;
}
constexpr size_t KV_TOTAL = (size_t)32 * 1024 * 256;
__device__ __forceinline__ void kv_resolve(const Params& p, size_t i, const f32x4*& src, f32x4*& dst) {
    const unsigned li = (unsigned)i, b = li >> 18, rr = (li >> 8) & 1023u, c4 = li & 255u, row = (rr >> 3) * 16 + 8 + (rr & 7);
    const size_t o = ((size_t)b * 2048 + row) * 256 + c4;
    src = (const f32x4*)p.in[5] + o; dst = (f32x4*)(p.out + O_KV2048S) + o - 2048;
}
__device__ __forceinline__ void kv_copy_range(const Params& p, size_t c0, size_t c1, int rk, int ncu) {
    const size_t step = (size_t)ncu * 512;
    for (size_t i0 = c0 + (size_t)rk * 512 + opaque_tid(); i0 < c1; i0 += 16 * step) {
        f32x4 v[16]; f32x4* dp[16];
#pragma unroll
        for (int k = 0; k < 16; ++k) { const size_t i = i0 + k * step; if (i < c1) { const f32x4* sp; kv_resolve(p, i, sp, dp[k]); v[k] = __builtin_nontemporal_load(sp); } }
#pragma unroll
        for (int k = 0; k < 16; ++k) { const size_t i = i0 + k * step; if (i < c1) __builtin_nontemporal_store(v[k], dp[k]); }
    }
}

__device__ __forceinline__ float lgamma_h(int h) { return logf(1.0f - exp2f(-5.0f - (float)h)); }
__device__ __forceinline__ void ret_sample(const Params& p, const Ws& w, LAS unsigned char* lds, int vcu, int G) {
    const int tid = opaque_tid(), lane = tid & 63, wave = tid >> 6;
    LAS float* qf = (LAS float*)lds;
    LAS float* kf = qf + 1024;
    LAS float* vf = kf + 1024;
    LAS float* part = vf + 1024;
    LAS float* sc = part + 4096;
    LAS float* yb = sc + 64;
    const float* gn = p.in[9];
    for (int item = vcu; item < 256; item += G) {
        const int bs = item >> 3, h = item & 7;
        const size_t m0 = MP + (size_t)bs * 8;
        const float lg = lgamma_h(h);
        __syncthreads();
        for (int i = tid; i < 1024; i += 512) { const int r = i >> 7, d = i & 127; const bf16_t* row = w.proj + pofs(m0 + r, h * 128 + d);
            qf[i] = bf2f(row[(C_RQ / 128) * PSLAB]); kf[i] = bf2f(row[(C_RK / 128) * PSLAB]) * QK_SCALE; vf[i] = bf2f(row[(C_RV / 128) * PSLAB]); }
        __syncthreads();
        if (tid < 64) { const int i = tid >> 3, j = tid & 7; float s = 0.f; for (int d = 0; d < 128; ++d) s += qf[i * 128 + d] * kf[j * 128 + d]; sc[tid] = (i >= j) ? s * __expf((float)(i - j) * lg) : 0.f; }
        const int e = tid & 127, dq = tid >> 7;
        const float* st = p.in[2] + (size_t)item * 16384;
        float* nst = p.out + O_RETS + (size_t)item * 16384;
        const float g8 = __expf(8.0f * lg);
        float kdec[8];
#pragma unroll
        for (int j = 0; j < 8; ++j) kdec[j] = __expf((float)(7 - j) * lg);
        float cr[8];
#pragma unroll
        for (int i = 0; i < 8; ++i) cr[i] = 0.f;
        float sv[32];
#pragma unroll
        for (int dd = 0; dd < 32; ++dd) sv[dd] = __builtin_nontemporal_load(st + (dq * 32 + dd) * 128 + e);
#pragma unroll
        for (int dd = 0; dd < 32; ++dd) {
            const int d = dq * 32 + dd;
            const float s = sv[dd];
            float ns = s * g8;
#pragma unroll
            for (int j = 0; j < 8; ++j) ns += kf[j * 128 + d] * kdec[j] * vf[j * 128 + e];
            __builtin_nontemporal_store(ns, nst + d * 128 + e);
#pragma unroll
            for (int i = 0; i < 8; ++i) cr[i] += qf[i * 128 + d] * s;
        }
#pragma unroll
        for (int i = 0; i < 8; ++i) part[(dq * 8 + i) * 128 + e] = cr[i];
        __syncthreads();
        for (int idx = tid; idx < 1024; idx += 512) { const int i = idx >> 7, ee = idx & 127;
            float y = (part[(0 * 8 + i) * 128 + ee] + part[(1 * 8 + i) * 128 + ee] + part[(2 * 8 + i) * 128 + ee] + part[(3 * 8 + i) * 128 + ee]) * __expf((float)(i + 1) * lg);
            for (int j = 0; j <= i; ++j) y += sc[i * 8 + j] * vf[j * 128 + ee];
            yb[idx] = y; }
        __syncthreads();
        {
            const int il = wave; const size_t m = m0 + il;
            const float a0 = yb[il * 128 + lane], a1 = yb[il * 128 + 64 + lane];
            const float mean = wave_sum(a0 + a1) * (1.0f / 128.0f);
            const float d0 = a0 - mean, d1 = a1 - mean;
            const float var = wave_sum(d0 * d0 + d1 * d1) * (1.0f / 128.0f);
            const float rstd = rsqrtf(var + EPS);
            const float g0 = bf2f(w.proj[pofs(m, C_RG + h * 128 + lane)]), g1 = bf2f(w.proj[pofs(m, C_RG + h * 128 + 64 + lane)]);
            w.G[m * 1024 + h * 128 + lane] = (bf16_t)f2bf(d0 * rstd * gn[h * 128 + lane] * g0);
            w.G[m * 1024 + h * 128 + 64 + lane] = (bf16_t)f2bf(d1 * rstd * gn[h * 128 + 64 + lane] * g1);
        }
    }
}
typedef short v4s __attribute__((ext_vector_type(4)));
__device__ __forceinline__ v4s tr16(const LAS unsigned char* p) { return __builtin_amdgcn_ds_read_tr16_b64_v4i16((LAS v4s*)p); }
__device__ __forceinline__ bf16x8 cat8(v4s a, v4s b) { return (bf16x8){a[0], a[1], a[2], a[3], b[0], b[1], b[2], b[3]}; }
#define MFMA16(a, b, c) __builtin_amdgcn_mfma_f32_16x16x32_bf16(a, b, c, 0, 0, 0)
constexpr float LOG2E = 1.4426950408889634f, LN2 = 0.6931471805599453f;
__device__ __forceinline__ float lg2gamma(int h) { return log2f(1.0f - exp2f(-5.0f - (float)h)); }
__device__ __forceinline__ bf16x8 pack8(const f32x4 a, const f32x4 b) {
    u32x4 o; o.x = pk2(a[0], a[1]); o.y = pk2(a[2], a[3]); o.z = pk2(b[0], b[1]); o.w = pk2(b[2], b[3]);
    return __builtin_bit_cast(bf16x8, o);
}
constexpr int KP = 272, VP = 288;

struct AttnDesc { int g, h, dil, qb, qcol; size_t rowbase; };
__device__ __forceinline__ AttnDesc attn_desc(int item) {
    AttnDesc d; const int rq = item & 63; d.h = (item >> 6) & 3; const int b = (item >> 8) & 1; d.g = item >> 9;
    d.dil = 1 << (2 * d.g); const int sh = 6 - 2 * d.g, r = rq >> sh; d.qb = rq & ((1 << sh) - 1);
    d.qcol = C_ATT + d.g * 1536 + d.h * 128; d.rowbase = (size_t)b * SEQ + r; return d;
}
__device__ __forceinline__ void attn_load(const Ws& w, const AttnDesc& d, int tid, bool fresh, u32x4 (&kreg)[8], u32x4 (&vreg)[8]) {
    const int s0 = 128 * (d.qb - 1);
#pragma unroll
    for (int i = 0; i < 4; ++i) { const int cidx = tid + 512 * i, c = 128 + (cidx >> 4), ch = cidx & 15, s = s0 + c;
        const bf16_t* rp = w.proj + pofs(d.rowbase + (size_t)d.dil * s, d.qcol + ch * 8); kreg[i] = __builtin_nontemporal_load((const u32x4*)(rp + 4 * PSLAB)); vreg[i] = __builtin_nontemporal_load((const u32x4*)(rp + 8 * PSLAB)); }
    if (fresh) {
#pragma unroll
        for (int i = 4; i < 8; ++i) { const int cidx = tid + 512 * (i - 4), c = cidx >> 4, ch = cidx & 15, s = max(s0 + c, 0);
            const bf16_t* rp = w.proj + pofs(d.rowbase + (size_t)d.dil * s, d.qcol + ch * 8); kreg[i] = __builtin_nontemporal_load((const u32x4*)(rp + 4 * PSLAB)); vreg[i] = __builtin_nontemporal_load((const u32x4*)(rp + 8 * PSLAB)); }
    }
}
__device__ __forceinline__ void attn_loadq(const Ws& w, const AttnDesc& d, int wave, int fr, int fg, bf16x8 (&qf)[4]) {
    const size_t mq = d.rowbase + (size_t)d.dil * (128 * d.qb + 16 * wave + fr);
#pragma unroll
    for (int ds = 0; ds < 4; ++ds) qf[ds] = __builtin_nontemporal_load((const bf16x8*)(w.proj + pofs(mq, d.qcol + 32 * ds + 8 * fg)));
}
__device__ __forceinline__ void attn_compute(const Ws& w, LAS unsigned char* lds, const AttnDesc& d, int off, bf16x8 (&qf)[4], int wave, int fr, int fg, bool has_next, const AttnDesc& dn, int tid, u32x4 (&kreg)[8], u32x4 (&vreg)[8]) {
    LAS unsigned char* Kt = lds; LAS unsigned char* Vt = lds + 256 * KP;
    const int g = d.g, h = d.h, qb = d.qb;
    asm volatile("" : "+v"(fr), "+v"(fg));
    const int iq = 16 * wave + fr;
    const size_t mq = d.rowbase + (size_t)d.dil * (128 * qb + iq);
    const int kbmin = (qb == 0) ? 8 : 0;
    const float c1 = QK_SCALE * LOG2E, c2 = exp2f(-8.0f * (float)(g * 4 + h + 1) / 12.0f) * (float)d.dil * LOG2E;
    f32x4 sc[9];
    float mx = -1e30f;
#pragma unroll
    for (int kk = 0; kk < 9; ++kk) {
        const int kb = wave + kk;
        if (kb >= kbmin) {
            f32x4 a = (f32x4){0.f, 0.f, 0.f, 0.f};
#pragma unroll
            for (int ds = 0; ds < 4; ++ds) { const bf16x8 kf = *(const LAS bf16x8*)(Kt + (((16 * kb + off) & 255) + fr) * KP + (32 * ds + 8 * fg) * 2); a = MFMA16(kf, qf[ds], a); }
#pragma unroll
            for (int r_ = 0; r_ < 4; ++r_) { const int dist = 128 + iq - (16 * kb + 4 * fg + r_); const float s = a[r_] * c1 - c2 * (float)dist; a[r_] = (dist >= 0 && dist <= 128) ? s : -1e30f; mx = fmaxf(mx, a[r_]); }
            sc[kk] = a;
        } else sc[kk] = (f32x4){-1e30f, -1e30f, -1e30f, -1e30f};
    }
    mx = fmaxf(mx, __shfl_xor(mx, 16)); mx = fmaxf(mx, __shfl_xor(mx, 32));
    float sum = 0.f;
#pragma unroll
    for (int kk = 0; kk < 9; ++kk)
#pragma unroll
        for (int r_ = 0; r_ < 4; ++r_) { const float e = __builtin_amdgcn_exp2f(sc[kk][r_] - mx); sc[kk][r_] = e; sum += e; }
    sum += __shfl_xor(sum, 16); sum += __shfl_xor(sum, 32);
    if (has_next) { attn_load(w, dn, tid, dn.qb == 0, kreg, vreg); attn_loadq(w, dn, wave, fr, fg, qf); }
    f32x4 o[8];
#pragma unroll
    for (int eb = 0; eb < 8; ++eb) o[eb] = (f32x4){0.f, 0.f, 0.f, 0.f};
    const int q4 = fr >> 2, p4 = fr & 3;
#pragma unroll
    for (int st = 0; st < 5; ++st) {
        const int kb0 = wave + 2 * st;
        const bf16x8 pf = (st < 4) ? pack8(sc[2 * st], sc[2 * st + 1]) : pack8(sc[8], (f32x4){0.f, 0.f, 0.f, 0.f});
        const LAS unsigned char* v0 = Vt + (((16 * kb0 + off) & 255) + 4 * fg + q4) * VP + 8 * p4;
        const LAS unsigned char* v1 = Vt + (((16 * kb0 + 16 + off) & 255) + 4 * fg + q4) * VP + 8 * p4;
#pragma unroll
        for (int eb = 0; eb < 8; ++eb) {
            const v4s a0 = tr16(v0 + 32 * eb);
            const v4s a1 = (st < 4) ? tr16(v1 + 32 * eb) : (v4s){0, 0, 0, 0};
            o[eb] = MFMA16(cat8(a0, a1), pf, o[eb]);
        }
    }
    const float inv = 1.0f / sum;
    bf16_t* orow = w.og + ((size_t)g * MT + mq) * 512 + h * 128 + 4 * fg;
#pragma unroll
    for (int eb = 0; eb < 8; ++eb) { u32x2 ov; ov.x = pk2(o[eb][0] * inv, o[eb][1] * inv); ov.y = pk2(o[eb][2] * inv, o[eb][3] * inv); *(u32x2*)(orow + 16 * eb) = ov; }
    if (fg == 0) w.lse[((size_t)g * MT + mq) * 4 + h] = mx * LN2 + __logf(sum);
}
__device__ __forceinline__ void attn_phase(const Ws& w, LAS unsigned char* lds, int first, int count) {
    const int tid = opaque_tid(), lane = tid & 63, wave = __builtin_amdgcn_readfirstlane(tid >> 6), fr = lane & 15, fg = lane >> 4;
    if (count <= 0) return;
    LAS unsigned char* Kt = lds; LAS unsigned char* Vt = lds + 256 * KP;
    u32x4 kreg[8], vreg[8]; bf16x8 qf[4];
    AttnDesc d = attn_desc(first);
    attn_load(w, d, tid, true, kreg, vreg); attn_loadq(w, d, wave, fr, fg, qf);
    int off = 0; bool fresh = true;
    for (int n = 0; n < count; ++n) {
        __syncthreads();
        if (fresh) off = 0; else off = (off + 128) & 255;
#pragma unroll
        for (int i = 0; i < 4; ++i) { const int cidx = tid + 512 * i, c = (128 + (cidx >> 4) + off) & 255, ch = cidx & 15;
            *(LAS u32x4*)(Kt + c * KP + ch * 16) = kreg[i]; *(LAS u32x4*)(Vt + c * VP + ch * 16) = vreg[i]; }
        if (fresh) {
#pragma unroll
            for (int i = 4; i < 8; ++i) { const int cidx = tid + 512 * (i - 4), c = ((cidx >> 4) + off) & 255, ch = cidx & 15;
                *(LAS u32x4*)(Kt + c * KP + ch * 16) = kreg[i]; *(LAS u32x4*)(Vt + c * VP + ch * 16) = vreg[i]; }
        }
        __syncthreads();
        const AttnDesc dc = d;
        const bool has_next = n + 1 < count;
        if (has_next) { d = attn_desc(first + n + 1); fresh = (d.qb == 0); }
        attn_compute(w, lds, dc, off, qf, wave, fr, fg, has_next, d, tid, kreg, vreg);
    }
    __syncthreads();
}

__device__ __forceinline__ float half_sum(float v) {
#pragma unroll
    for (int o = 1; o < 32; o <<= 1) v += __shfl_xor(v, o);
    return v;
}
__device__ __forceinline__ void attn_sample(const Params& p, const Ws& w, LAS unsigned char* lds, int vcu, int G) {
    const int tid = opaque_tid(), lane = tid & 63, wave = tid >> 6, half = lane >> 5, c = lane & 31;
    const int gw = vcu * 8 + wave, NGW = G * 8;
    for (int it = gw; it < MS * 12; it += NGW) {
        const int g = it % 3, mh = it / 3, ms = mh >> 2, h = mh & 3, m = MP + ms, b = ms >> 3, t = ms & 7;
        const int dil = 1 << (2 * g), Wb = 128 << (2 * g);
        const int qcol = C_ATT + g * 1536 + h * 128, kcol = qcol + 512, vcol = qcol + 1024;
        f32x4 q; { const u32x2 v = *(const u32x2*)(w.proj + pofs(m, qcol + 4 * c)); q = (f32x4){bflo(v.x), bfhi(v.x), bflo(v.y), bfhi(v.y)}; }
        const float slope = exp2f(-8.0f * (float)(g * 4 + h + 1) / 12.0f) * (float)dil;
        const float* cache = p.in[3 + g];
        const int jn = t >> (2 * g);
        const int ncache = 128 - jn, npair = (ncache + 1) >> 1;
        const float* kb0 = cache + ((size_t)(b * Wb + Wb + t) * 2 + 0) * 512 + h * 128 + 4 * c;
        float* kvout = p.out + (g == 0 ? O_KV128S : (g == 1 ? O_KV512S : O_KV2048S));
        const bool owner = (g == 0) ? (t == 0) : (g == 1 ? (t < 4) : true);
        float mrun = -1e30f, sum = 0.f; f32x4 o = (f32x4){0.f, 0.f, 0.f, 0.f};
#pragma unroll
        for (int j = 0; j < 8; ++j) if (j <= jn) {
            const u32x2 kk2 = *(const u32x2*)(w.proj + pofs(m - dil * j, kcol + 4 * c)), vv = *(const u32x2*)(w.proj + pofs(m - dil * j, vcol + 4 * c));
            const float s = half_sum((bflo(kk2.x) * q[0] + bfhi(kk2.x) * q[1]) + (bflo(kk2.y) * q[2] + bfhi(kk2.y) * q[3])) * QK_SCALE - slope * (float)j;
            if (half == 0) { const float mn = fmaxf(mrun, s), al = __expf(mrun - mn), e = __expf(s - mn); mrun = mn; sum = sum * al + e;
                o = o * al; o[0] += e * bflo(vv.x); o[1] += e * bfhi(vv.x); o[2] += e * bflo(vv.y); o[3] += e * bfhi(vv.y); }
        }
        for (int k0 = 0; k0 < npair; k0 += 16) {
            f32x4 kv[16], vv[16];
#pragma unroll
            for (int u = 0; u < 16; ++u) { const int j = jn + 1 + 2 * (k0 + u) + half;
                if (k0 + u < npair && j <= 128) { const float* rp = kb0 - (size_t)(dil * j) * 1024; kv[u] = __builtin_nontemporal_load((const f32x4*)rp); vv[u] = __builtin_nontemporal_load((const f32x4*)(rp + 512));
                    const int idx = Wb + t - dil * j;
                    if (owner && idx >= 8) { float* wp = kvout + ((size_t)(b * Wb + idx - 8) * 2) * 512 + h * 128 + 4 * c; __builtin_nontemporal_store(kv[u], (f32x4*)wp); __builtin_nontemporal_store(vv[u], (f32x4*)(wp + 512)); } }
                else { kv[u] = (f32x4){0.f, 0.f, 0.f, 0.f}; vv[u] = kv[u]; } }
            float s[16]; float bm = -1e30f;
#pragma unroll
            for (int u = 0; u < 16; ++u) { const int j = jn + 1 + 2 * (k0 + u) + half;
                const float d = half_sum((kv[u][0] * q[0] + kv[u][1] * q[1]) + (kv[u][2] * q[2] + kv[u][3] * q[3]));
                s[u] = (k0 + u < npair && j <= 128) ? d * QK_SCALE - slope * (float)j : -1e30f; bm = fmaxf(bm, s[u]); }
            const float mn = fmaxf(mrun, bm), al = __expf(mrun - mn); mrun = mn; sum *= al; o = o * al;
#pragma unroll
            for (int u = 0; u < 16; ++u) { const float e = __expf(s[u] - mn); sum += e; o += vv[u] * e; }
        }
        const float mo = __shfl_xor(mrun, 32), so = __shfl_xor(sum, 32);
        const float mt = fmaxf(mrun, mo), a0 = __expf(mrun - mt), a1 = __expf(mo - mt);
        const float st = sum * a0 + so * a1;
#pragma unroll
        for (int i = 0; i < 4; ++i) o[i] = o[i] * a0 + __shfl_xor(o[i], 32) * a1;
        const float inv = 1.0f / st;
        if (half == 0) { u32x2 ov; ov.x = pk2(o[0] * inv, o[1] * inv); ov.y = pk2(o[2] * inv, o[3] * inv); *(u32x2*)(w.og + ((size_t)g * MT + m) * 512 + h * 128 + 4 * c) = ov; }
        if (lane == 0) w.lse[((size_t)g * MT + m) * 4 + h] = mt + __logf(st);
    }
}

__device__ __forceinline__ void retA_item(const Ws& w, LAS unsigned char* lds, int item) {
    const int tid = opaque_tid(), lane = tid & 63, wave = __builtin_amdgcn_readfirstlane(tid >> 6), fr = lane & 15, fg = lane >> 4;
    const int c = item & 63, bh = item >> 6, h = bh & 7, b = bh >> 3;
    const size_t m0 = (size_t)b * SEQ + c * 128;
    const float lg2 = lg2gamma(h);
    LAS unsigned char* Kt = lds; LAS unsigned char* Vt = lds + 128 * VP;
#pragma unroll
    for (int i = 0; i < 4; ++i) { const int cidx = tid + 512 * i, j = cidx >> 4, ch = cidx & 15;
        const bf16_t* rp = w.proj + pofs(m0 + j, h * 128 + ch * 8);
        const u32x4 kr = *(const u32x4*)(rp + (C_RK / 128) * PSLAB), vr = *(const u32x4*)(rp + (C_RV / 128) * PSLAB);
        const float kd = exp2f((float)(127 - j) * lg2) * QK_SCALE;
        u32x4 ks; ks.x = pk2(bflo(kr.x) * kd, bfhi(kr.x) * kd); ks.y = pk2(bflo(kr.y) * kd, bfhi(kr.y) * kd); ks.z = pk2(bflo(kr.z) * kd, bfhi(kr.z) * kd); ks.w = pk2(bflo(kr.w) * kd, bfhi(kr.w) * kd);
        *(LAS u32x4*)(Kt + j * VP + ch * 16) = ks; *(LAS u32x4*)(Vt + j * VP + ch * 16) = vr; }
    __syncthreads();
    f32x4 acc[8];
#pragma unroll
    for (int db = 0; db < 8; ++db) acc[db] = (f32x4){0.f, 0.f, 0.f, 0.f};
    const int q4 = fr >> 2, p4 = fr & 3;
#pragma unroll
    for (int st = 0; st < 4; ++st) {
        const int rowoff = (32 * st + 4 * fg + q4) * VP + 8 * p4;
        const bf16x8 af = cat8(tr16(Vt + rowoff + 32 * wave), tr16(Vt + rowoff + 16 * VP + 32 * wave));
#pragma unroll
        for (int db = 0; db < 8; ++db) { const bf16x8 bfr = cat8(tr16(Kt + rowoff + 32 * db), tr16(Kt + rowoff + 16 * VP + 32 * db)); acc[db] = MFMA16(af, bfr, acc[db]); }
    }
    __syncthreads();
    {
        LAS bf16_t* stg = (LAS bf16_t*)(lds + wave * 4096);
#pragma unroll
        for (int db = 0; db < 8; ++db)
#pragma unroll
            for (int r_ = 0; r_ < 4; ++r_) stg[(4 * fg + r_) * 128 + 16 * db + fr] = (bf16_t)f2bf(acc[db][r_]);
        LDS_WAIT();
        bf16_t* dst = (bf16_t*)w.kvc + (size_t)item * 16384 + (size_t)(16 * wave) * 128;
#pragma unroll
        for (int i = 0; i < 4; ++i) { const int row = 4 * i + (lane >> 4), ch = lane & 15; *(u32x4*)(dst + row * 128 + ch * 8) = *(const LAS u32x4*)(stg + row * 128 + ch * 8); }
    }
    __syncthreads();
}
__device__ __forceinline__ void ret_scan2(const Params& p, const Ws& w, int vcu, int G) {
    for (int i = vcu * 512 + opaque_tid(); i < 16 * 8192; i += G * 512) {
        const int bh = i >> 13, idx = (i & 8191) * 2, h = bh & 7;
        const float g128 = exp2f(128.0f * lg2gamma(h));
        const bf16_t* base = (const bf16_t*)w.kvc + (size_t)bh * 64 * 16384 + idx;
        bf16_t* sbase = w.sb + (size_t)bh * 64 * 16384 + idx;
        float s0 = 0.f, s1 = 0.f;
        for (int c0 = 0; c0 < 64; c0 += 16) {
            unsigned kv[16];
#pragma unroll
            for (int k = 0; k < 16; ++k) kv[k] = __builtin_nontemporal_load((const unsigned*)(base + (size_t)(c0 + k) * 16384));
#pragma unroll
            for (int k = 0; k < 16; ++k) { *(unsigned*)(sbase + (size_t)(c0 + k) * 16384) = pk2(s0, s1); s0 = s0 * g128 + bflo(kv[k]); s1 = s1 * g128 + bfhi(kv[k]); }
        }
        const int e = idx >> 7, d = idx & 127;
        __builtin_nontemporal_store(s0, p.out + O_RETP + (size_t)bh * 16384 + d * 128 + e); __builtin_nontemporal_store(s1, p.out + O_RETP + (size_t)bh * 16384 + (d + 1) * 128 + e);
    }
}
struct MergeIn { float l0, l1, l2; u32x4 a, b, c; };
__device__ __forceinline__ MergeIn merge_load(const Ws& w, int i) {
    const int m = i >> 6, c8 = (i & 63) * 8, h = c8 >> 7; MergeIn r;
    r.l0 = w.lse[((size_t)0 * MT + m) * 4 + h]; r.l1 = w.lse[((size_t)1 * MT + m) * 4 + h]; r.l2 = w.lse[((size_t)2 * MT + m) * 4 + h];
    r.a = __builtin_nontemporal_load((const u32x4*)(w.og + ((size_t)0 * MT + m) * 512 + c8)); r.b = __builtin_nontemporal_load((const u32x4*)(w.og + ((size_t)1 * MT + m) * 512 + c8));
    r.c = __builtin_nontemporal_load((const u32x4*)(w.og + ((size_t)2 * MT + m) * 512 + c8));
    return r;
}
__device__ __forceinline__ void merge_store(const Ws& w, int i, const MergeIn& r) {
    const int m = i >> 6, c8 = (i & 63) * 8;
    const float mx = fmaxf(r.l0, fmaxf(r.l1, r.l2));
    float w0 = __expf(r.l0 - mx), w1 = __expf(r.l1 - mx), w2 = __expf(r.l2 - mx);
    const float inv = 1.0f / (w0 + w1 + w2); w0 *= inv; w1 *= inv; w2 *= inv;
    const u32x4 a = r.a, b = r.b, c = r.c;
    u32x4 o;
    o.x = pk2(w0 * bflo(a.x) + w1 * bflo(b.x) + w2 * bflo(c.x), w0 * bfhi(a.x) + w1 * bfhi(b.x) + w2 * bfhi(c.x));
    o.y = pk2(w0 * bflo(a.y) + w1 * bflo(b.y) + w2 * bflo(c.y), w0 * bfhi(a.y) + w1 * bfhi(b.y) + w2 * bfhi(c.y));
    o.z = pk2(w0 * bflo(a.z) + w1 * bflo(b.z) + w2 * bflo(c.z), w0 * bfhi(a.z) + w1 * bfhi(b.z) + w2 * bfhi(c.z));
    o.w = pk2(w0 * bflo(a.w) + w1 * bflo(b.w) + w2 * bflo(c.w), w0 * bfhi(a.w) + w1 * bfhi(b.w) + w2 * bfhi(c.w));
    *(u32x4*)(w.Oatt + (size_t)m * 1024 + c8) = o;
}
__device__ __forceinline__ void attn_merge(const Ws& w, int vcu, int G) {
    const int step = G * 512, N = MT * 64;
    for (int i = vcu * 512 + opaque_tid(); i < N; i += 3 * step) {
        const int i2 = i + step, i3 = i + 2 * step; const bool t2 = i2 < N, t3 = i3 < N;
        const MergeIn r0 = merge_load(w, i), r1 = merge_load(w, t2 ? i2 : i), r2 = merge_load(w, t3 ? i3 : i);
        merge_store(w, i, r0);
        if (t2) merge_store(w, i2, r1);
        if (t3) merge_store(w, i3, r2);
    }
}
__device__ __forceinline__ void retC_load(const Ws& w, int item, int tid, u32x4 (&kr)[4], u32x4 (&vr)[4], u32x4 (&sr)[4]) {
    const int c = item & 63, bh = item >> 6, h = bh & 7, b = bh >> 3;
    const size_t m0 = (size_t)b * SEQ + c * 128;
    const bf16_t* sbp = w.sb + (size_t)item * 16384;
#pragma unroll
    for (int i = 0; i < 4; ++i) { const int cidx = tid + 512 * i, j = cidx >> 4, ch = cidx & 15;
        const bf16_t* rp = w.proj + pofs(m0 + j, h * 128 + ch * 8);
        kr[i] = __builtin_nontemporal_load((const u32x4*)(rp + (C_RK / 128) * PSLAB)); vr[i] = __builtin_nontemporal_load((const u32x4*)(rp + (C_RV / 128) * PSLAB)); sr[i] = __builtin_nontemporal_load((const u32x4*)(sbp + j * 128 + ch * 8)); }
}
__device__ __forceinline__ void retC_loadq(const Ws& w, int item, int wave, int fr, int fg, bf16x8 (&qf)[4]) {
    const int c = item & 63, bh = item >> 6, h = bh & 7, b = bh >> 3;
    const size_t mq = (size_t)b * SEQ + c * 128 + 16 * wave + fr;
#pragma unroll
    for (int ds = 0; ds < 4; ++ds) qf[ds] = __builtin_nontemporal_load((const bf16x8*)(w.proj + pofs(mq, C_RQ + h * 128 + 32 * ds + 8 * fg)));
}
__device__ __forceinline__ void retC_compute(const Params& p, const Ws& w, LAS unsigned char* lds, int item, bf16x8 (&qf)[4], int wave, int fr, int fg, int next_item, int tid, u32x4 (&kr)[4], u32x4 (&vr)[4], u32x4 (&sr)[4]) {
    const int c = item & 63, bh = item >> 6, h = bh & 7, b = bh >> 3;
    const size_t m0 = (size_t)b * SEQ + c * 128;
    const float lg2 = lg2gamma(h);
    LAS unsigned char* Kt = lds; LAS unsigned char* Vt = lds + 128 * KP; LAS unsigned char* St = Vt + 128 * VP;
    asm volatile("" : "+v"(fr), "+v"(fg));
    const int iq = 16 * wave + fr;
    const size_t mq = m0 + iq;
    f32x4 sc[8];
#pragma unroll
    for (int kb = 0; kb < 8; ++kb) {
        if (kb <= wave) {
            f32x4 a = (f32x4){0.f, 0.f, 0.f, 0.f};
#pragma unroll
            for (int ds = 0; ds < 4; ++ds) { const bf16x8 kf = *(const LAS bf16x8*)(Kt + (16 * kb + fr) * KP + (32 * ds + 8 * fg) * 2); a = MFMA16(kf, qf[ds], a); }
#pragma unroll
            for (int r_ = 0; r_ < 4; ++r_) { const int dj = iq - (16 * kb + 4 * fg + r_); a[r_] = (dj >= 0) ? a[r_] * QK_SCALE * exp2f((float)dj * lg2) : 0.f; }
            sc[kb] = a;
        } else sc[kb] = (f32x4){0.f, 0.f, 0.f, 0.f};
    }
    f32x4 y[8], cr[8];
#pragma unroll
    for (int eb = 0; eb < 8; ++eb) { y[eb] = (f32x4){0.f, 0.f, 0.f, 0.f}; cr[eb] = (f32x4){0.f, 0.f, 0.f, 0.f}; }
    const int q4 = fr >> 2, p4 = fr & 3;
#pragma unroll
    for (int st = 0; st < 4; ++st) {
        if (2 * st <= wave) {
            const bf16x8 pf = pack8(sc[2 * st], sc[2 * st + 1]);
            const LAS unsigned char* v0 = Vt + (32 * st + 4 * fg + q4) * VP + 8 * p4;
#pragma unroll
            for (int eb = 0; eb < 8; ++eb) y[eb] = MFMA16(cat8(tr16(v0 + 32 * eb), tr16(v0 + 16 * VP + 32 * eb)), pf, y[eb]);
        }
    }
#pragma unroll
    for (int eb = 0; eb < 8; ++eb)
#pragma unroll
        for (int ds = 0; ds < 4; ++ds) { const bf16x8 sf = *(const LAS bf16x8*)(St + (16 * eb + fr) * KP + (32 * ds + 8 * fg) * 2); cr[eb] = MFMA16(sf, qf[ds], cr[eb]); }
    if (next_item >= 0) { retC_load(w, next_item, tid, kr, vr, sr); retC_loadq(w, next_item, wave, fr, fg, qf); }
    const float qd = exp2f((float)(iq + 1) * lg2);
    float s = 0.f;
#pragma unroll
    for (int eb = 0; eb < 8; ++eb) { y[eb] = y[eb] + cr[eb] * qd; s += (y[eb][0] + y[eb][1]) + (y[eb][2] + y[eb][3]); }
    s += __shfl_xor(s, 16); s += __shfl_xor(s, 32);
    const float mean = s * (1.0f / 128.0f);
    float v = 0.f;
#pragma unroll
    for (int eb = 0; eb < 8; ++eb) { y[eb] = y[eb] - mean; v += (y[eb][0] * y[eb][0] + y[eb][1] * y[eb][1]) + (y[eb][2] * y[eb][2] + y[eb][3] * y[eb][3]); }
    v += __shfl_xor(v, 16); v += __shfl_xor(v, 32);
    const float rstd = rsqrtf(v * (1.0f / 128.0f) + EPS);
    const float* gn = p.in[9] + h * 128 + 4 * fg;
    const bf16_t* grow = w.proj + pofs(mq, C_RG + h * 128 + 4 * fg);
    bf16_t* orow = w.G + mq * 1024 + h * 128 + 4 * fg;
#pragma unroll
    for (int eb = 0; eb < 8; ++eb) { const f32x4 gv = *(const f32x4*)(gn + 16 * eb); const u32x2 sg = __builtin_nontemporal_load((const u32x2*)(grow + 16 * eb));
        u32x2 ov; ov.x = pk2(y[eb][0] * rstd * gv[0] * bflo(sg.x), y[eb][1] * rstd * gv[1] * bfhi(sg.x)); ov.y = pk2(y[eb][2] * rstd * gv[2] * bflo(sg.y), y[eb][3] * rstd * gv[3] * bfhi(sg.y));
        *(u32x2*)(orow + 16 * eb) = ov; }
}
__device__ __forceinline__ void retC_phase(const Params& p, const Ws& w, LAS unsigned char* lds, int vcu, int G) {
    const int tid = opaque_tid(), lane = tid & 63, wave = __builtin_amdgcn_readfirstlane(tid >> 6), fr = lane & 15, fg = lane >> 4;
    if (vcu >= 1024) return;
    LAS unsigned char* Kt = lds; LAS unsigned char* Vt = lds + 128 * KP; LAS unsigned char* St = Vt + 128 * VP;
    u32x4 kr[4], vr[4], sr[4]; bf16x8 qf[4];
    retC_load(w, vcu, tid, kr, vr, sr); retC_loadq(w, vcu, wave, fr, fg, qf);
    for (int item = vcu; item < 1024; item += G) {
        __syncthreads();
#pragma unroll
        for (int i = 0; i < 4; ++i) { const int cidx = tid + 512 * i, j = cidx >> 4, ch = cidx & 15;
            *(LAS u32x4*)(Kt + j * KP + ch * 16) = kr[i]; *(LAS u32x4*)(Vt + j * VP + ch * 16) = vr[i]; *(LAS u32x4*)(St + j * KP + ch * 16) = sr[i]; }
        __syncthreads();
        retC_compute(p, w, lds, item, qf, wave, fr, fg, (item + G < 1024) ? item + G : -1, tid, kr, vr, sr);
    }
    __syncthreads();
}

__device__ __forceinline__ void panel_arrive_wait(unsigned* cnt, unsigned want);
__device__ __forceinline__ void sg_accum(f32x4 (&acc)[2][4], const bf16_t* A, int lda, const bf16_t* Bt, int K, int r0, int n0, int wave, int fr, int fq, int ldb = 0) {
    if (ldb == 0) ldb = K;
    const int kw = K / 8, k0 = wave * kw;
    const bf16_t* ap = A + (size_t)(r0 + fr) * lda + k0 + 8 * fq;
    const bf16_t* bp = Bt + (size_t)(n0 + fr) * ldb + k0 + 8 * fq;
    int ks = 0;
    for (; ks + 128 <= kw; ks += 128) {
        bf16x8 a[4][2], b[4][4];
#pragma unroll
        for (int s = 0; s < 4; ++s) {
#pragma unroll
            for (int i = 0; i < 2; ++i) a[s][i] = *(const bf16x8*)(ap + (size_t)(16 * i) * lda + ks + 32 * s);
#pragma unroll
            for (int j = 0; j < 4; ++j) b[s][j] = *(const bf16x8*)(bp + (size_t)(16 * j) * ldb + ks + 32 * s);
        }
#pragma unroll
        for (int s = 0; s < 4; ++s)
#pragma unroll
            for (int i = 0; i < 2; ++i)
#pragma unroll
                for (int j = 0; j < 4; ++j) acc[i][j] = MFMA16(b[s][j], a[s][i], acc[i][j]);
    }
    for (; ks < kw; ks += 64) {
        bf16x8 a[2][2], b[2][4];
#pragma unroll
        for (int s = 0; s < 2; ++s) {
#pragma unroll
            for (int i = 0; i < 2; ++i) a[s][i] = *(const bf16x8*)(ap + (size_t)(16 * i) * lda + ks + 32 * s);
#pragma unroll
            for (int j = 0; j < 4; ++j) b[s][j] = *(const bf16x8*)(bp + (size_t)(16 * j) * ldb + ks + 32 * s);
        }
#pragma unroll
        for (int s = 0; s < 2; ++s)
#pragma unroll
            for (int i = 0; i < 2; ++i)
#pragma unroll
                for (int j = 0; j < 4; ++j) acc[i][j] = MFMA16(b[s][j], a[s][i], acc[i][j]);
    }
}
template <int MODE>
__device__ __forceinline__ void sample_gemm(const Params& p, const Ws& w, LAS unsigned char* lds, int vcu, int G) {
    const int tid = opaque_tid(), lane = tid & 63, wave = __builtin_amdgcn_readfirstlane(tid >> 6), fr = lane & 15, fq = lane >> 4;
    LAS f32x4* red = (LAS f32x4*)lds;
    for (int unit = vcu; unit < 256; unit += G) {
        const int rg = (unit & 31) >> 2, r0 = rg * 32, n0 = ((unit >> 5) * 4 + (unit & 3)) * 64;
        f32x4 acc[2][4];
#pragma unroll
        for (int i = 0; i < 2; ++i)
#pragma unroll
            for (int j = 0; j < 4; ++j) acc[i][j] = (f32x4){0.f, 0.f, 0.f, 0.f};
        if (MODE == 5) {
            sg_accum(acc, w.G + (size_t)MP * 1024, 1024, w.Wt_reto, 1024, r0, n0, wave, fr, fq);
            f32x4 acc2[2][4];
#pragma unroll
            for (int i = 0; i < 2; ++i)
#pragma unroll
                for (int j = 0; j < 4; ++j) acc2[i][j] = (f32x4){0.f, 0.f, 0.f, 0.f};
            sg_accum(acc2, w.Oatt + (size_t)MP * 1024, 1024, w.Wt_atto, 512, r0, n0, wave, fr, fq, 1024);
#pragma unroll
            for (int i = 0; i < 2; ++i)
#pragma unroll
                for (int j = 0; j < 4; ++j) { const unsigned char* gp = w.g8 + (size_t)(MP + r0 + 16 * i + fr) * 4096 + n0 + 16 * j + 4 * fq;
                    acc[i][j] = acc[i][j] * dec8x4(*(const unsigned*)gp) + acc2[i][j] * dec8x4(*(const unsigned*)(gp + 2048)); }
        } else if (MODE == 6) sg_accum(acc, w.merged + (size_t)MP * DM, DM, w.Wt_o, DM, r0, n0, wave, fr, fq);
        else sg_accum(acc, w.act + (size_t)MP * FF, FF, w.Wt_down, FF, r0, n0, wave, fr, fq);
        __syncthreads();
#pragma unroll
        for (int i = 0; i < 2; ++i)
#pragma unroll
            for (int j = 0; j < 4; ++j) red[(wave * 8 + i * 4 + j) * 64 + lane] = acc[i][j];
        __syncthreads();
        const int blk = tid >> 6;
        f32x4 v = red[blk * 64 + lane];
#pragma unroll
        for (int ww = 1; ww < 8; ++ww) v += red[(ww * 8 + blk) * 64 + lane];
        const int row = MP + r0 + 16 * (blk >> 2) + fr, col = n0 + 16 * (blk & 3) + 4 * fq;
        if (MODE == 5) { u32x2 o; o.x = pk2(v[0], v[1]); o.y = pk2(v[2], v[3]); *(u32x2*)(w.merged + (size_t)row * DM + col) = o; }
        else if (MODE == 6) {
            { const u32x2 xv = *(const u32x2*)(w.xb + (size_t)row * DM + col); const float xs_ = w.rstd1[row]; v[0] += bflo(xv.x) * xs_; v[1] += bfhi(xv.x) * xs_; v[2] += bflo(xv.y) * xs_; v[3] += bfhi(xv.y) * xs_; }
            u32x2 o; o.x = pk2(v[0], v[1]); o.y = pk2(v[2], v[3]); *(u32x2*)(w.xb + (size_t)row * DM + col) = o;
            atomicAdd(w.sumsq2 + row, (v[0] * v[0] + v[1] * v[1]) + (v[2] * v[2] + v[3] * v[3]));
        } else {
            float* dst = p.out + O_Y + (size_t)row * DM + col;
            { const u32x2 xv = *(const u32x2*)(w.xb + (size_t)row * DM + col); v[0] += bflo(xv.x); v[1] += bfhi(xv.x); v[2] += bflo(xv.y); v[3] += bfhi(xv.y); }
            atomicAdd(w.sumsq3 + row, (v[0] * v[0] + v[1] * v[1]) + (v[2] * v[2] + v[3] * v[3]));
            asm volatile("s_waitcnt vmcnt(0)" ::: "memory"); __syncthreads();
            if (tid == 0) panel_arrive_wait((unsigned*)(p.ws + WS_PCNT) + 16 * (64 + rg), 32u);
            __syncthreads();
            const float rs = rsqrtf(__hip_atomic_load(w.sumsq3 + row, __ATOMIC_RELAXED, __HIP_MEMORY_SCOPE_AGENT) * (1.0f / DM) + EPS);
            __builtin_nontemporal_store(v * rs * *(const f32x4*)(p.in[18] + col), (f32x4*)dst);
        }
        __syncthreads();
    }
}

#define XB_TMO      128
#define XB_XCNT(j)  (256  + 64 * (j))
#define XB_XSUB(j)  (1280 + 64 * (j))
#define XB_XGEN(j)  (2304 + 64 * (j))
#define XB_TOP      3328
#define XB_TOPGEN   3392
#define XCD_BAR_WORDS 3456
#define XB_SPIN_CAP (1u << 18)
__device__ __forceinline__ unsigned xb_ld(unsigned* p)              { return __hip_atomic_load(p, __ATOMIC_RELAXED, __HIP_MEMORY_SCOPE_AGENT); }
__device__ __forceinline__ unsigned xb_add(unsigned* p, unsigned v) { return __hip_atomic_fetch_add(p, v, __ATOMIC_RELAXED, __HIP_MEMORY_SCOPE_AGENT); }
__device__ __forceinline__ unsigned xb_xcc_id() { return (unsigned)__builtin_amdgcn_s_getreg((3 << 11) | 20) & 0xFu; }
#define XB_SPIN(cond, bar) do { unsigned _sp = 0; while (cond) { __builtin_amdgcn_s_sleep(1); \
    if ((++_sp & 255u) == 0u) { if (xb_ld(&(bar)[XB_TMO])) break; if (_sp > XB_SPIN_CAP) { atomicAdd(&(bar)[XB_TMO], 1u); break; } } } } while (0)
struct XcdBarrier { unsigned* bar; unsigned x; volatile LAS unsigned* st; };
__device__ __forceinline__ XcdBarrier xcd_barrier_post(unsigned* bar, volatile LAS unsigned* st) {
    XcdBarrier b; b.bar = bar; b.x = xb_xcc_id(); b.st = st;
    if (threadIdx.x == 0) (void)xb_add(&bar[XB_XCNT(b.x)], 1u);
    return b;
}
__device__ __forceinline__ void xcd_barrier_complete(unsigned* bar, unsigned x, unsigned& nloc, unsigned& nx) {
    const unsigned G = gridDim.x * gridDim.y * gridDim.z;
    unsigned sum, cnt, mine, sp = 0u;
    for (;;) {
        sum = 0u; cnt = 0u; mine = 0u;
#pragma unroll
        for (unsigned j = 0; j < 16; ++j) { const unsigned c = xb_ld(&bar[XB_XCNT(j)]); sum += c; cnt += (c > 0u) ? 1u : 0u; mine = (j == x) ? c : mine; }
        if (sum == G) break;
        __builtin_amdgcn_s_sleep(1);
        if ((++sp & 255u) == 0u) { if (xb_ld(&bar[XB_TMO])) break; if (sp > XB_SPIN_CAP) { atomicAdd(&bar[XB_TMO], 1u); break; } }
    }
    nloc = mine > 0u ? mine : 1u; nx = cnt > 0u ? cnt : 1u;
}
__device__ __forceinline__ void xcd_barrier(const XcdBarrier& b) {
    asm volatile("s_waitcnt vmcnt(0)" ::: "memory");
    __syncthreads();
    if (threadIdx.x == 0) {
        unsigned* bar = b.bar;
        __builtin_amdgcn_s_waitcnt(0);
        unsigned nloc = b.st[0], nx = b.st[1];
        if (nloc == 0u) { xcd_barrier_complete(bar, b.x, nloc, nx); b.st[0] = nloc; b.st[1] = nx; }
        const unsigned old = xb_add(&bar[XB_XSUB(b.x)], 1u);
        const unsigned gen = old / nloc;
        if (old + 1u == (gen + 1u) * nloc) {
            __builtin_amdgcn_fence(__ATOMIC_RELEASE, "agent");
            asm volatile("s_waitcnt vmcnt(0)" ::: "memory");
            const unsigned og = xb_add(&bar[XB_TOP], 1u);
            const unsigned tg = og / nx;
            if (og + 1u == (tg + 1u) * nx) xb_add(&bar[XB_TOPGEN], 1u);
            else XB_SPIN(xb_ld(&bar[XB_TOPGEN]) == tg, bar);
            __builtin_amdgcn_fence(__ATOMIC_ACQUIRE, "agent");
            xb_add(&bar[XB_XGEN(b.x)], 1u);
            asm volatile("s_waitcnt vmcnt(0)" ::: "memory");
        } else {
            XB_SPIN(xb_ld(&bar[XB_XGEN(b.x)]) == gen, bar);
            __builtin_amdgcn_fence(__ATOMIC_ACQUIRE, "agent");
            asm volatile("s_waitcnt vmcnt(0)" ::: "memory");
        }
    }
    __syncthreads();
}

constexpr int LDS_BYTES = 147456;
constexpr int LDS_BARST = 143360;
constexpr int NPHASE = 12;
__global__ void __launch_bounds__(512, 2) fwd_kernel(Params p) {
    extern __shared__ __attribute__((aligned(16))) unsigned char lds_raw[];
    LAS unsigned char* lds = (LAS unsigned char*)lds_raw;
    const Ws w = make_ws(p.ws);
    const int G = gridDim.x; const int bx = blockIdx.x;
    const int vcu = (G % 8 == 0) ? (bx % 8) * (G / 8) + bx / 8 : bx;
    const int lo = p.ph_lo, hi = p.ph_hi;
    volatile LAS unsigned* barst = (volatile LAS unsigned*)(lds + LDS_BARST);
    if (threadIdx.x < 2) barst[threadIdx.x] = 0u;
    __syncthreads();
    XcdBarrier bar = xcd_barrier_post((unsigned*)(p.ws + WS_BAR), barst);
#define IN(k) (lo <= (k) && (k) < hi)
    if (lo < 0) cg::this_grid().sync();
#define SEAM(k) do { if (IN(k) && IN((k) + 1)) xcd_barrier(bar); } while (0)
    if (IN(0)) { weight_transposes<0>(p, w, lds, vcu, G); p0_xconv(p, w, lds, vcu, G);
        if (KVSLACK < 100) kv_copy_range(p, KV_SPLIT, KV_TOTAL, vcu, G); } SEAM(0);
    const size_t kv_s1 = KV_SPLIT / 100 * 20;
    const int n1 = (65 * 50) % G, n7 = (67 * 44) % G;
    if (IN(1)) {
        pg8::Gemm g{w.xb, w.Wt_in, MT, INC, DM}; pg8::StaticOrder S; S.init(MT, INC, G, bx); EpiIn E{w, p.out};
        pg8::gemm_phase<EpiIn, pg8::StaticOrder, true, true>(lds, g, S, E);
        if (n1 == 0) { weight_transposes<1>(p, w, lds, vcu, G); kv_copy_range(p, 0, kv_s1, vcu, G); } else if (bx >= n1) { weight_transposes<1>(p, w, lds, bx - n1, G - n1); kv_copy_range(p, 0, kv_s1, bx - n1, G - n1); } } SEAM(1);
    if (vcu & 1) { if (IN(5)) { attn_sample(p, w, lds, vcu, G); __syncthreads(); } if (IN(4)) { ret_sample(p, w, lds, vcu, G); __syncthreads(); } }
    { const int per = (1536 + G - 1) / G;
      if (IN(2)) attn_phase(w, lds, vcu * per, min(per, 1536 - vcu * per)); }
    if (IN(3)) { for (int it = vcu; it < 1024; it += G) retA_item(w, lds, it); }
    if (!(vcu & 1)) { if (IN(4)) { ret_sample(p, w, lds, vcu, G); __syncthreads(); } if (IN(5)) { attn_sample(p, w, lds, vcu, G); } } SEAM(5);
    if (IN(6)) { if (vcu & 1) { attn_merge(w, vcu, G); ret_scan2(p, w, vcu, G); } else { ret_scan2(p, w, vcu, G); attn_merge(w, vcu, G); } } SEAM(6);
    if (IN(7)) { retC_phase(p, w, lds, vcu, G); } SEAM(7);
    if (IN(8)) {
        { pg8::Gemm g{w.G, w.Wt_reto, MP, DM, 1024}; pg8::SegOrder S; S.base.init(MP, DM, G, bx); S.A1 = w.Oatt; S.B1t = w.Wt_atto; S.nt0 = 16; S.nt1 = 8; EpiP5 E{w};
          pg8::gemm_phase<EpiP5, pg8::SegOrder, true, true>(lds, g, S, E); }
        sample_gemm<5>(p, w, lds, vcu, G); } SEAM(8);
    if (IN(9)) { pg8::Gemm g{w.merged, w.Wt_o, MP, DM, DM}; pg8::StaticOrder S; S.init(MP, DM, G, bx); EpiWo E{w};
        pg8::gemm_phase<EpiWo, pg8::StaticOrder, true, true>(lds, g, S, E);
        sample_gemm<6>(p, w, lds, vcu, G); } SEAM(9);
    if (IN(10)) {
        pg8::Gemm g{w.xb, w.Wt_up, MT, F2, DM}; pg8::UpOrder S; S.init_up(G, bx); EpiUp E{w, p.out, p.in[15], p.in[16], p.in[6]};
        pg8::gemm_phase<EpiUp, pg8::UpOrder, true, true>(lds, g, S, E);
        if (n7 == 0) { weight_transposes<2>(p, w, lds, vcu, G); kv_copy_range(p, kv_s1, KV_SPLIT, vcu, G); } else if (bx >= n7) { weight_transposes<2>(p, w, lds, bx - n7, G - n7); kv_copy_range(p, kv_s1, KV_SPLIT, bx - n7, G - n7); } } SEAM(10);
    if (IN(11)) { pg8::Gemm g{w.act, w.Wt_down, MP, DM, FF}; pg8::PanelOrder S{vcu}; EpiFin E{w, p.out, p.in[18], (unsigned*)(p.ws + WS_PCNT)};
        pg8::gemm_phase<EpiFin, pg8::PanelOrder, true, true>(lds, g, S, E);
        sample_gemm<8>(p, w, lds, vcu, G); }
#undef IN
#undef SEAM
}

extern "C" void kernel_launch(void* const* d_in, const int* in_sizes, int n_in, void* d_out, int out_size, void* d_ws, size_t ws_size, hipStream_t stream) {
    static int grid = 0;
    if (grid == 0) {
        if (n_in != 19 || (size_t)out_size != O_END || ws_size < WS_END) { fprintf(stderr, "kernel_launch: unexpected shapes: n_in %d out %d ws %zu\n", n_in, out_size, ws_size); grid = -1; return; }
        int dev = 0, cus = 0;
        if (hipGetDevice(&dev) != hipSuccess || hipDeviceGetAttribute(&cus, hipDeviceAttributeMultiprocessorCount, dev) != hipSuccess) { fprintf(stderr, "kernel_launch: device query failed\n"); grid = -1; return; }
        if (hipFuncSetAttribute((const void*)fwd_kernel, hipFuncAttributeMaxDynamicSharedMemorySize, LDS_BYTES) != hipSuccess) { fprintf(stderr, "kernel_launch: cannot get %d bytes of LDS\n", LDS_BYTES); grid = -1; return; }
        int per_cu = 0;
        if (hipOccupancyMaxActiveBlocksPerMultiprocessor(&per_cu, (const void*)fwd_kernel, 512, LDS_BYTES) != hipSuccess || per_cu < 1) fprintf(stderr, "kernel_launch: occupancy query says %d blocks/CU\n", per_cu);
        (void)hipGetLastError();
        grid = cus;
        if (grid != 256) { fprintf(stderr, "kernel_launch: this kernel is laid out for 256 CUs, device has %d\n", cus); grid = -1; return; }
    }
    if (grid < 0) return;
    if (hipMemsetAsync((char*)d_ws + WS_BAR, 0, 32768, stream) != hipSuccess) { fprintf(stderr, "kernel_launch: memset failed\n"); return; }
    Params p{};
    for (int i = 0; i < 19; ++i) p.in[i] = (const float*)d_in[i];
    p.out = (float*)d_out; p.ws = (unsigned char*)d_ws;
    p.ph_lo = 0; p.ph_hi = NPHASE;
    void* args[] = {&p};
    hipError_t e = hipLaunchCooperativeKernel((const void*)fwd_kernel, dim3(grid), dim3(512), args, LDS_BYTES, stream);
    if (e != hipSuccess) fprintf(stderr, "cooperative launch failed: %s (grid %d)\n", hipGetErrorString(e), grid);
}
```

```cpp
#include <hip/hip_runtime.h>
#include <hip/hip_cooperative_groups.h>
#include <cstdio>
#include <cstdint>
namespace cg = cooperative_groups;

#define LAS __attribute__((address_space(3)))
typedef unsigned short bf16_t;
typedef short bf16x8 __attribute__((ext_vector_type(8)));
typedef float f32x4 __attribute__((ext_vector_type(4)));
typedef float f32x2 __attribute__((ext_vector_type(2)));
typedef unsigned u32x4 __attribute__((ext_vector_type(4)));
typedef unsigned u32x2 __attribute__((ext_vector_type(2)));

constexpr int DM = 2048, SEQ = 8192, MP = 16384, MS = 256, MT = MP + MS;
constexpr int INC = 12800, FF = 5632, F2 = 11264;
constexpr int C_RQ = 0, C_RK = 1024, C_RV = 2048, C_RG = 3072, C_ATT = 4096, C_GR = 8704, C_GA = 10752;
constexpr float EPS = 1e-6f;
constexpr float QK_SCALE = 0.08838834764831845f;
constexpr size_t O_Y = 0;
constexpr size_t O_RETP = 34078720, O_RETS = 34340864;
constexpr size_t O_KV128P = 38535168, O_KV128S = 38797312, O_KV512P = 42991616, O_KV512S = 44040192, O_KV2048P = 60817408, O_KV2048S = 65011712;
constexpr size_t O_CONVP = 132120576, O_CONVS = 132165632, O_END = 132886528;
constexpr size_t MiB = 1u << 20;
constexpr size_t WS_CTL = 0;
constexpr size_t WS_WIN = 1 * MiB, WS_WRETO = 51 * MiB, WS_WATTO = 55 * MiB, WS_WO = 57 * MiB, WS_WUP = 65 * MiB, WS_WDOWN = 109 * MiB;
constexpr size_t WS_XB = 131 * MiB;
constexpr size_t WS_PROJ = 196 * MiB;
constexpr size_t WS_KVC = 603 * MiB;
constexpr size_t WS_SB = 667 * MiB;
constexpr size_t WS_G = 699 * MiB;
constexpr size_t WS_OG = 732 * MiB;
constexpr size_t WS_LSE = 781 * MiB;
constexpr size_t WS_OATT = 930 * MiB;
constexpr size_t WS_MERGED = 799 * MiB;
constexpr size_t WS_ACT = 603 * MiB;
constexpr size_t WS_G8 = 864 * MiB;
constexpr size_t WS_WATTO_P = 964 * MiB;
constexpr size_t WS_END = 968 * MiB;
constexpr size_t WS_BAR = 512 * 1024;
constexpr size_t WS_PCNT = WS_BAR + 16384;

struct Params {
    const float* in[19];
    float* out;
    unsigned char* ws;
    int ph_lo, ph_hi, dummy, pad;
};

constexpr size_t PSLAB = (size_t)MT * 128;
__device__ __forceinline__ size_t pofs(size_t row, int col) { return ((size_t)(col >> 7) * MT + row) * 128 + (col & 127); }
__device__ __forceinline__ float bflo(unsigned w) { return __uint_as_float(w << 16); }
__device__ __forceinline__ float bfhi(unsigned w) { return __uint_as_float(w & 0xffff0000u); }
__device__ __forceinline__ float bf2f(bf16_t b) { return __uint_as_float((unsigned)b << 16); }
__device__ __forceinline__ unsigned f2bf(float f) { unsigned u = __float_as_uint(f); return (u + 0x7fffu + ((u >> 16) & 1u)) >> 16; }
typedef __bf16 bf16x2_t __attribute__((ext_vector_type(2)));
__device__ __forceinline__ unsigned pk2(float lo, float hi) { f32x2 v = {lo, hi}; bf16x2_t b = __builtin_convertvector(v, bf16x2_t); return __builtin_bit_cast(unsigned, b); }
__device__ __forceinline__ unsigned enc8(float s) { const unsigned c = (unsigned)(s * 256.0f); return c > 255u ? 255u : c; }
__device__ __forceinline__ unsigned enc8x4(f32x4 s) {
    return enc8(s[0]) | (enc8(s[1]) << 8) | (enc8(s[2]) << 16) | (enc8(s[3]) << 24);
}
__device__ __forceinline__ f32x4 dec8x4(unsigned c) { return ((f32x4){(float)(c & 255u), (float)((c >> 8) & 255u), (float)((c >> 16) & 255u), (float)(c >> 24)} + 0.5f) * (1.0f / 256.0f); }
__device__ __forceinline__ float wave_sum(float v) {
#pragma unroll
    for (int o = 1; o < 64; o <<= 1) v += __shfl_xor(v, o);
    return v;
}
__device__ __forceinline__ float wave_max(float v) {
#pragma unroll
    for (int o = 1; o < 64; o <<= 1) v = fmaxf(v, __shfl_xor(v, o));
    return v;
}
__device__ __forceinline__ unsigned sigcode(float v) { return (unsigned)__builtin_amdgcn_rcpf(__builtin_amdgcn_exp2f(fmaf(v, -1.4426950408889634f, -7.99994364f)) + (1.0f / 255.99f)); }
__device__ __forceinline__ unsigned sigcode4(f32x4 s) { return sigcode(s[0]) | (sigcode(s[1]) << 8) | (sigcode(s[2]) << 16) | (sigcode(s[3]) << 24); }
__device__ __forceinline__ float sigmoidf_(float v) { return __builtin_amdgcn_rcpf(1.0f + __builtin_amdgcn_exp2f(v * -1.4426950408889634f)); }
#define LDS_WAIT() asm volatile("s_waitcnt lgkmcnt(0)" ::: "memory")
__device__ __forceinline__ int opaque_tid() { int t = threadIdx.x; asm volatile("" : "+v"(t)); return t; }

namespace pg8 {
#define PG8_LAS __attribute__((address_space(3)))
constexpr int BM = 256, BK = 64, HALF = 128, HTB = HALF * BK * 2, STAGE_BYTES = 8 * HTB, NXCD = 8, WGM = 4;
__host__ __device__ __forceinline__ int lds_byte(int r, int c) { const int st = (r >> 4) * 2 + (c >> 5), rr = r & 15, cc = c & 31, ob = rr * 64 + cc * 2; return st * 1024 + (ob ^ (((ob >> 9) & 1) << 5)); }
__host__ __device__ __forceinline__ void stage_rc(int b, int& R, int& C) { const int st = b / 1024, sb = b % 1024, swz = sb ^ (((sb >> 9) & 1) << 5); R = (st >> 1) * 16 + swz / 64; C = (st & 1) * 32 + (swz % 64) / 2; }
__host__ __device__ __forceinline__ int perm32(int rho) { const int n = rho >> 4, i = rho & 15; return 8 * (i >> 2) + 4 * n + (i & 3); }
struct Unit { int pm, pn, seg; };
struct Gemm { const bf16_t* A; const bf16_t* Bt; int M, N, K; };
struct StaticOrder {
    int nM, nN, nwg, G, c;
    __host__ __device__ void init(int M, int N, int G_, int c_) { nM = M / BM; nN = N / BM; nwg = nM * nN; G = G_; c = c_; }
    __host__ __device__ bool next(int i, Unit& u) const {
        const long L = (long)i * G + c; if (L >= nwg) return false;
        int wgid = (int)L; { const int q = nwg / NXCD, r = nwg % NXCD, xcd = wgid % NXCD, off = wgid / NXCD; wgid = (xcd < r ? xcd * (q + 1) : r * (q + 1) + (xcd - r) * q) + off; }
        const int nig = WGM * nN, gid = wgid / nig, fm = gid * WGM, gsz = (nM - fm) < WGM ? (nM - fm) : WGM;
        u.pm = fm + ((wgid % nig) % gsz); u.pn = (wgid % nig) / gsz; u.seg = 0; return true;
    }
    __device__ __forceinline__ void a_ready(const Unit&) const {}
    __device__ __forceinline__ void done(const Unit&) const {}
    __device__ __forceinline__ long a_off(const Unit& u, int K) const { return (long)u.pm * 256 * K * 2; }
    __device__ __forceinline__ const char* a_ptr(const Gemm& g, const Unit& u) const { return (const char*)g.A + a_off(u, g.K); }
    __device__ __forceinline__ const char* b_ptr(const Gemm& g, const Unit& u) const { return (const char*)g.Bt + (size_t)u.pn * 256 * g.K * 2; }
    __device__ __forceinline__ int nt(const Gemm& g, const Unit&) const { return g.K / BK; }
    __device__ __forceinline__ bool keep(const Unit&) const { return false; }
};
struct SegOrder {
    StaticOrder base; const bf16_t* A1; const bf16_t* B1t; int nt0, nt1;
    __device__ __forceinline__ bool next(int i, Unit& u) const { if (!base.next(i >> 1, u)) return false; u.seg = i & 1; return true; }
    __device__ __forceinline__ void a_ready(const Unit&) const {}
    __device__ __forceinline__ void done(const Unit&) const {}
    __device__ __forceinline__ const char* a_ptr(const Gemm& g, const Unit& u) const { return (const char*)(u.seg ? A1 : g.A) + (size_t)u.pm * 256 * g.K * 2; }
    __device__ __forceinline__ const char* b_ptr(const Gemm& g, const Unit& u) const { return (const char*)(u.seg ? B1t : g.Bt) + (size_t)u.pn * 256 * g.K * 2; }
    __device__ __forceinline__ int nt(const Gemm&, const Unit& u) const { return u.seg ? nt1 : nt0; }
    __device__ __forceinline__ bool keep(const Unit& u) const { return u.seg == 0; }
};
struct PanelOrder {
    int v;
    __device__ __forceinline__ bool next(int i, Unit& u) const { if (i >= 2) return false; u.pm = i * 32 + (v >> 3); u.pn = v & 7; u.seg = 0; return true; }
    __device__ __forceinline__ void a_ready(const Unit&) const {}
    __device__ __forceinline__ void done(const Unit&) const {}
    __device__ __forceinline__ const char* a_ptr(const Gemm& g, const Unit& u) const { return (const char*)g.A + (size_t)u.pm * 256 * g.K * 2; }
    __device__ __forceinline__ const char* b_ptr(const Gemm& g, const Unit& u) const { return (const char*)g.Bt + (size_t)u.pn * 256 * g.K * 2; }
    __device__ __forceinline__ int nt(const Gemm& g, const Unit&) const { return g.K / BK; }
    __device__ __forceinline__ bool keep(const Unit&) const { return false; }
};
struct UpOrder : StaticOrder {
    __host__ __device__ void init_up(int G_, int c_) { nM = 67; nN = 44; nwg = nM * nN; G = G_; c = c_; }
    __device__ __forceinline__ long a_off(const Unit& u, int K) const { const int row0 = (u.pm < 66) ? (u.pm / 33) * 8192 + 254 * (u.pm % 33) - 2 : 16384; return (long)row0 * K * 2; }
    __device__ __forceinline__ const char* a_ptr(const Gemm& g, const Unit& u) const { return (const char*)g.A + a_off(u, g.K); }
};

template <class Epi, class Sched, bool ALIGN_EPI = false, bool SP2 = false>
__device__ __forceinline__ void gemm_phase(PG8_LAS unsigned char* lds, const Gemm g, const Sched& S, const Epi& E) {
    const int tid = opaque_tid(), wid = __builtin_amdgcn_readfirstlane(tid >> 6), lane = tid & 63, wr = wid >> 2, wc = wid & 3, fr = lane & 15, fq = lane >> 4;
    const int K = g.K;
    unsigned voffA[2], voffB[2];
#pragma unroll
    for (int i = 0; i < 2; ++i) { int R, C; stage_rc(tid * 16 + i * 8192, R, C); const int Rb = Epi::PERM ? ((R & ~31) + perm32(R & 31)) : R;
        const int Ra = Epi::APERM ? ((R & ~63) + 4 * (R & 15) + ((R >> 4) & 3)) : R;
        voffA[i] = (unsigned)(Ra * K + C) * 2u; voffB[i] = (unsigned)(Rb * K + C) * 2u; }
    const size_t kstep = (size_t)(BK * 2);
    const size_t hstep = (size_t)HALF * K * 2;
    const unsigned ldsw = (unsigned)wid * 1024u;
    const int aoff = lds_byte(wr * 64 + fr, fq * 8), boff = lds_byte(wc * 32 + fr, fq * 8);
#define PG8_SA(b, h) (((b) * 2 + (h)) * HTB)
#define PG8_SB(b, h) ((4 + (b) * 2 + (h)) * HTB)
#define PG8_STAGE(bufoff, gbase, voff) do { _Pragma("unroll") for (int _i = 0; _i < 2; ++_i) \
        __builtin_amdgcn_global_load_lds((const unsigned*)((const char*)(gbase) + (voff)[_i]), (PG8_LAS unsigned*)(lds + (bufoff) + ldsw + _i * 8192), 16, 0, 0); } while (0)
#define PG8_LDA(dst, b, h) do { _Pragma("unroll") for (int m = 0; m < 4; ++m) _Pragma("unroll") for (int k = 0; k < 2; ++k) dst[m][k] = *(const PG8_LAS bf16x8*)(lds + PG8_SA(b, h) + aoff + m * 2048 + k * 1024); } while (0)
#define PG8_LDB(dst, b, h) do { _Pragma("unroll") for (int n = 0; n < 2; ++n) _Pragma("unroll") for (int k = 0; k < 2; ++k) dst[n][k] = *(const PG8_LAS bf16x8*)(lds + PG8_SB(b, h) + boff + n * 2048 + k * 1024); } while (0)
#define PG8_MMA(ai, bj, At, Bt) do { __builtin_amdgcn_s_setprio(1); _Pragma("unroll") for (int m = 0; m < 4; ++m) _Pragma("unroll") for (int n = 0; n < 2; ++n) _Pragma("unroll") for (int k = 0; k < 2; ++k) \
        acc[ai][bj][m][n] = __builtin_amdgcn_mfma_f32_16x16x32_bf16(Bt[n][k], At[m][k], acc[ai][bj][m][n], 0, 0, 0); __builtin_amdgcn_s_setprio(0); } while (0)
#define PG8_WAIT_V(n) asm volatile("s_waitcnt vmcnt(" #n ")" ::: "memory")
#define PG8_WAIT_L(n) asm volatile("s_waitcnt lgkmcnt(" #n ")" ::: "memory")
#define PG8_BAR __builtin_amdgcn_s_barrier()
#define PG8_SCHED __builtin_amdgcn_sched_barrier(0)
    Unit cur, nxt; int ui = 0;
    if (!S.next(0, cur)) return;
    f32x4 acc[2][2][4][2];
#pragma unroll
    for (int a = 0; a < 2; ++a)
#pragma unroll
        for (int b = 0; b < 2; ++b)
#pragma unroll
            for (int m = 0; m < 4; ++m)
#pragma unroll
                for (int n = 0; n < 2; ++n) acc[a][b][m][n] = (f32x4){0.f, 0.f, 0.f, 0.f};
    bf16x8 At[4][2], B0[2][2], B1[2][2];
    const char* cA = S.a_ptr(g, cur); const char* cB = S.b_ptr(g, cur);
    S.a_ready(cur);
    if constexpr (SP2) {
        PG8_STAGE(PG8_SB(0, 0), cB, voffB); PG8_STAGE(PG8_SB(0, 1), cB + hstep, voffB); PG8_STAGE(PG8_SA(0, 0), cA, voffA); PG8_STAGE(PG8_SA(0, 1), cA + hstep, voffA);
        if (wr == 1) PG8_BAR;
        PG8_WAIT_V(2); PG8_BAR;
        PG8_STAGE(PG8_SB(1, 0), cB + kstep, voffB); PG8_STAGE(PG8_SA(1, 0), cA + kstep, voffA); PG8_STAGE(PG8_SB(1, 1), cB + hstep + kstep, voffB);
        PG8_WAIT_V(6); PG8_BAR;
    } else {
        PG8_STAGE(PG8_SB(0, 0), cB, voffB); PG8_STAGE(PG8_SA(0, 0), cA, voffA); PG8_STAGE(PG8_SB(0, 1), cB + hstep, voffB); PG8_STAGE(PG8_SA(0, 1), cA + hstep, voffA);
        if (wr == 1) PG8_BAR;
        PG8_WAIT_V(4); PG8_BAR;
        PG8_STAGE(PG8_SB(1, 0), cB + kstep, voffB); PG8_STAGE(PG8_SA(1, 0), cA + kstep, voffA); PG8_STAGE(PG8_SB(1, 1), cB + hstep + kstep, voffB);
        PG8_WAIT_V(6); PG8_BAR;
    }
    for (;;) {
        const bool has_next = S.next(ui + 1, nxt);
        const char* nA = has_next ? S.a_ptr(g, nxt) : cA; const char* nB = has_next ? S.b_ptr(g, nxt) : cB;
        const int nt = S.nt(g, cur);
        for (int t = 0; t < nt; t += 2) {
            const bool last = (t == nt - 2);
            const char* a1 = cA + (size_t)(t + 1) * kstep;
            const char* a2 = last ? nA : cA + (size_t)(t + 2) * kstep; const char* b2 = last ? nB : cB + (size_t)(t + 2) * kstep;
            const char* a3 = a2 + kstep; const char* b3 = b2 + kstep;
            if (last && has_next) S.a_ready(nxt);
            if constexpr (Epi::DMA_PRE) { if (last) E.dma_prefetch(cur, lds, wid, lane); }
            if constexpr (SP2) {
            PG8_LDB(B0, 0, 0); PG8_LDB(B1, 0, 1); PG8_SCHED; PG8_LDA(At, 0, 0); PG8_STAGE(PG8_SA(1, 1), a1 + hstep, voffA);
            PG8_WAIT_V(8); PG8_WAIT_L(0); PG8_BAR; PG8_MMA(0, 0, At, B0); PG8_MMA(0, 1, At, B1); PG8_BAR; PG8_SCHED;
            PG8_LDA(At, 0, 1); PG8_STAGE(PG8_SB(0, 0), b2, voffB); PG8_STAGE(PG8_SB(0, 1), b2 + hstep, voffB); PG8_STAGE(PG8_SA(0, 0), a2, voffA);
            PG8_WAIT_V(8); PG8_WAIT_L(0); PG8_BAR; PG8_MMA(1, 0, At, B0); PG8_MMA(1, 1, At, B1); PG8_BAR; PG8_SCHED;
            PG8_LDB(B0, 1, 0); PG8_LDB(B1, 1, 1); PG8_SCHED; PG8_LDA(At, 1, 0); PG8_STAGE(PG8_SA(0, 1), a2 + hstep, voffA);
            PG8_WAIT_V(8); PG8_WAIT_L(0); PG8_BAR; PG8_MMA(0, 0, At, B0); PG8_MMA(0, 1, At, B1); PG8_BAR; PG8_SCHED;
            PG8_LDA(At, 1, 1); PG8_STAGE(PG8_SB(1, 0), b3, voffB); PG8_STAGE(PG8_SB(1, 1), b3 + hstep, voffB); PG8_STAGE(PG8_SA(1, 0), a3, voffA);
            PG8_WAIT_V(8); PG8_WAIT_L(0); PG8_BAR; PG8_MMA(1, 0, At, B0); PG8_MMA(1, 1, At, B1); PG8_BAR; PG8_SCHED;
            } else {
            PG8_LDB(B0, 0, 0); PG8_SCHED; PG8_LDA(At, 0, 0); PG8_STAGE(PG8_SA(1, 1), a1 + hstep, voffA);
            PG8_WAIT_L(8); PG8_BAR; PG8_WAIT_L(0); PG8_MMA(0, 0, At, B0); PG8_BAR; PG8_SCHED;
            PG8_LDB(B1, 0, 1); PG8_STAGE(PG8_SB(0, 0), b2, voffB);
            PG8_BAR; PG8_WAIT_L(0); PG8_MMA(0, 1, At, B1); PG8_BAR;
            PG8_LDA(At, 0, 1); PG8_STAGE(PG8_SA(0, 0), a2, voffA);
            PG8_BAR; PG8_WAIT_L(0); PG8_MMA(1, 0, At, B0); PG8_BAR; PG8_SCHED;
            PG8_STAGE(PG8_SB(0, 1), b2 + hstep, voffB);
            PG8_WAIT_V(6); PG8_BAR; PG8_MMA(1, 1, At, B1); PG8_BAR;
            PG8_LDB(B0, 1, 0); PG8_SCHED; PG8_LDA(At, 1, 0); PG8_STAGE(PG8_SA(0, 1), a2 + hstep, voffA);
            PG8_WAIT_L(8); PG8_BAR; PG8_WAIT_L(0); PG8_MMA(0, 0, At, B0); PG8_BAR; PG8_SCHED;
            PG8_LDB(B1, 1, 1); PG8_STAGE(PG8_SB(1, 0), b3, voffB);
            PG8_BAR; PG8_WAIT_L(0); PG8_MMA(0, 1, At, B1); PG8_BAR;
            PG8_LDA(At, 1, 1); PG8_STAGE(PG8_SA(1, 0), a3, voffA);
            PG8_BAR; PG8_WAIT_L(0); PG8_MMA(1, 0, At, B0); PG8_BAR; PG8_SCHED;
            PG8_STAGE(PG8_SB(1, 1), b3 + hstep, voffB);
            PG8_WAIT_V(6); PG8_BAR; PG8_MMA(1, 1, At, B1); PG8_BAR;
            }
        }
        if constexpr (ALIGN_EPI) { if (wr == 0) PG8_BAR; }
        E(acc, cur, wr, wc, fr, fq, lds); S.done(cur);
        if (!has_next) break;
        if (!S.keep(cur)) {
#pragma unroll
        for (int a = 0; a < 2; ++a)
#pragma unroll
            for (int b = 0; b < 2; ++b)
#pragma unroll
                for (int m = 0; m < 4; ++m)
#pragma unroll
                    for (int n = 0; n < 2; ++n) acc[a][b][m][n] = (f32x4){0.f, 0.f, 0.f, 0.f};
        }
        cur = nxt; cA = nA; cB = nB; ++ui;
        if constexpr (ALIGN_EPI) { if (wr == 1) PG8_BAR; }
    }
    PG8_WAIT_V(0);
    if constexpr (!ALIGN_EPI) { if (wr == 0) PG8_BAR; }
    PG8_BAR;
#undef PG8_SA
#undef PG8_SB
#undef PG8_STAGE
#undef PG8_LDA
#undef PG8_LDB
#undef PG8_MMA
#undef PG8_WAIT_V
#undef PG8_WAIT_L
#undef PG8_BAR
#undef PG8_SCHED
}
}

struct Ws {
    float *rstd1, *sumsq2, *sumsq3;
    bf16_t *Wt_in, *Wt_reto, *Wt_atto, *Wt_o, *Wt_up, *Wt_down;
    bf16_t *xb, *proj, *G, *Oatt, *merged, *act, *ub;
    float* kvc; bf16_t* sb; bf16_t* og; float* lse; unsigned char* g8; bf16_t* tmp;
};
__device__ __forceinline__ Ws make_ws(unsigned char* ws) {
    Ws w;
    w.rstd1 = (float*)(ws + WS_CTL); w.sumsq2 = w.rstd1 + MT; w.sumsq3 = w.sumsq2 + MT;
    w.Wt_in = (bf16_t*)(ws + WS_WIN); w.Wt_reto = (bf16_t*)(ws + WS_WRETO); w.Wt_atto = (bf16_t*)(ws + WS_WATTO_P); w.Wt_o = (bf16_t*)(ws + WS_WO);
    w.Wt_up = (bf16_t*)(ws + WS_WUP); w.Wt_down = (bf16_t*)(ws + WS_WDOWN);
    w.xb = (bf16_t*)(ws + WS_XB); w.proj = (bf16_t*)(ws + WS_PROJ); w.ub = (bf16_t*)(ws + WS_PROJ); w.G = (bf16_t*)(ws + WS_G); w.Oatt = (bf16_t*)(ws + WS_OATT);
    w.merged = (bf16_t*)(ws + WS_MERGED); w.act = (bf16_t*)(ws + WS_ACT); w.kvc = (float*)(ws + WS_KVC);
    w.g8 = ws + WS_G8; w.tmp = (bf16_t*)(ws + WS_KVC);
    w.sb = (bf16_t*)(ws + WS_SB); w.og = (bf16_t*)(ws + WS_OG); w.lse = (float*)(ws + WS_LSE);
    return w;
}

struct EpiIn {
    static constexpr bool PERM = true, DMA_PRE = false, APERM = false;
    Ws w; float* out;
    template <int CLS> __device__ __forceinline__ void body(f32x4 (&acc)[2][2][4][2], int row0, int col0, int grp, int kv) const {
#pragma unroll
        for (int ai = 0; ai < 2; ++ai)
#pragma unroll
            for (int m = 0; m < 4; ++m) {
                const int row = row0 + ai * 128 + m * 16;
#pragma unroll
                for (int bj = 0; bj < 2; ++bj) {
                    const int col = col0 + bj * 128;
                    f32x4 v0 = acc[ai][bj][m][0], v1 = acc[ai][bj][m][1];
                    if (CLS == 1) {
#pragma unroll
                        for (int i = 0; i < 4; ++i) { v0[i] = v0[i] * sigmoidf_(v0[i]); v1[i] = v1[i] * sigmoidf_(v1[i]); }
                    }
                    if (CLS == 2) { u32x2 o8; o8.x = sigcode4(v0); o8.y = sigcode4(v1); __builtin_nontemporal_store(o8, (u32x2*)(w.g8 + (unsigned)(row * 4096) + (col - C_GR))); }
                    else { u32x4 o; o.x = pk2(v0[0], v0[1]); o.y = pk2(v0[2], v0[3]); o.z = pk2(v1[0], v1[1]); o.w = pk2(v1[2], v1[3]);
                        *(u32x4*)(w.proj + (unsigned)(((col >> 7) * MT + row) * 128 + (col & 127))) = o; }
                    if (CLS == 3) {
                        const int win = 128 << (2 * grp);
                        const size_t obase_p = grp == 0 ? O_KV128P : (grp == 1 ? O_KV512P : O_KV2048P);
                        const size_t obase_s = grp == 0 ? O_KV128S : (grp == 1 ? O_KV512S : O_KV2048S);
                        const int c512 = (col & 511);
                        float* dst = nullptr;
                        if (row < MP) { const int b = row >> 13, t = row & 8191; if (t >= SEQ - win) dst = out + obase_p + ((size_t)(b * win + (t - (SEQ - win))) * 2 + kv) * 512 + c512; }
                        else { const int b = (row - MP) >> 3, t = (row - MP) & 7; dst = out + obase_s + ((size_t)(b * win + (win - 8 + t)) * 2 + kv) * 512 + c512; }
                        if (dst) { __builtin_nontemporal_store(v0, (f32x4*)dst); __builtin_nontemporal_store(v1, (f32x4*)(dst + 4)); }
                    }
                }
            }
    }
    __device__ __forceinline__ void operator()(f32x4 (&acc)[2][2][4][2], const pg8::Unit& u, int wr, int wc, int fr_, int fq_, LAS unsigned char*) const {
        int fr = fr_, fq = fq_; asm volatile("" : "+v"(fr), "+v"(fq));
        const int row0 = u.pm * 256 + wr * 64 + fr, col0 = u.pn * 256 + wc * 32 + 8 * fq;
        const int pn = u.pn;
        if (pn >= 34) body<2>(acc, row0, col0, 0, 0);
        else if (pn >= 12 && pn < 16) body<1>(acc, row0, col0, 0, 0);
        else if (pn >= 16) { const int q = (pn - 16) % 6, grp = (pn - 16) / 6;
            const int win = 128 << (2 * grp); const int t_hi = ((u.pm & 31) + 1) * 256;
            if (q >= 2 && (u.pm >= 64 || t_hi > SEQ - win)) body<3>(acc, row0, col0, grp, q >= 4 ? 1 : 0); else body<0>(acc, row0, col0, 0, 0); }
        else body<0>(acc, row0, col0, 0, 0);
    }
};
struct EpiWo {
    static constexpr bool PERM = true, DMA_PRE = false, APERM = false;
    Ws w;
    __device__ __forceinline__ void operator()(f32x4 (&acc)[2][2][4][2], const pg8::Unit& u, int wr, int wc, int fr_, int fq_, LAS unsigned char*) const {
        int fr = fr_, fq = fq_; asm volatile("" : "+v"(fr), "+v"(fq));
        const int row0 = u.pm * 256 + wr * 64 + fr;
        const int col0 = u.pn * 256 + wc * 32 + 8 * fq;
        float ssv[8];
#pragma unroll
        for (int ai = 0; ai < 2; ++ai)
#pragma unroll
            for (int m = 0; m < 4; ++m) {
                const int row = row0 + ai * 128 + m * 16;
                const float rs = w.rstd1[row];
                float ssq = 0.f;
#pragma unroll
                for (int bj = 0; bj < 2; ++bj) {
                    const int col = col0 + bj * 128;
                    f32x4 v0 = acc[ai][bj][m][0], v1 = acc[ai][bj][m][1];
                    { const u32x4 xv = *(const u32x4*)(w.xb + (unsigned)(row * DM) + col);
                      v0[0] += bflo(xv.x) * rs; v0[1] += bfhi(xv.x) * rs; v0[2] += bflo(xv.y) * rs; v0[3] += bfhi(xv.y) * rs;
                      v1[0] += bflo(xv.z) * rs; v1[1] += bfhi(xv.z) * rs; v1[2] += bflo(xv.w) * rs; v1[3] += bfhi(xv.w) * rs; }
                    u32x4 o; o.x = pk2(v0[0], v0[1]); o.y = pk2(v0[2], v0[3]); o.z = pk2(v1[0], v1[1]); o.w = pk2(v1[2], v1[3]);
                    *(u32x4*)(w.xb + (unsigned)(row * DM) + col) = o;
#pragma unroll
                    for (int i = 0; i < 4; ++i) ssq += v0[i] * v0[i] + v1[i] * v1[i];
                }
                ssq += __shfl_xor(ssq, 16); ssq += __shfl_xor(ssq, 32);
                ssv[ai * 4 + m] = ssq;
            }
        if (fq == 0) {
#pragma unroll
            for (int k = 0; k < 8; ++k) atomicAdd(w.sumsq2 + row0 + (k >> 2) * 128 + (k & 3) * 16, ssv[k]);
        }
    }
};

struct EpiP5 {
    static constexpr bool PERM = true, DMA_PRE = false, APERM = false;
    Ws w;
    __device__ __forceinline__ void operator()(f32x4 (&acc)[2][2][4][2], const pg8::Unit& u, int wr, int wc, int fr_, int fq_, LAS unsigned char*) const {
        int fr = fr_, fq = fq_; asm volatile("" : "+v"(fr), "+v"(fq));
        const int row0 = u.pm * 256 + wr * 64 + fr, col0 = u.pn * 256 + wc * 32 + 8 * fq;
        if (u.seg == 0) {
#pragma unroll
            for (int ai = 0; ai < 2; ++ai)
#pragma unroll
                for (int m = 0; m < 4; ++m) {
                    const int row = row0 + ai * 128 + m * 16;
#pragma unroll
                    for (int bj = 0; bj < 2; ++bj) { const unsigned char* gp = w.g8 + (unsigned)(row * 4096) + col0 + bj * 128;
                        const u32x2 gr = *(const u32x2*)gp, ga = *(const u32x2*)(gp + 2048);
                        const f32x4 a0 = dec8x4(ga.x), a1 = dec8x4(ga.y);
                        f32x4 q0 = dec8x4(gr.x), q1 = dec8x4(gr.y);
#pragma unroll
                        for (int i = 0; i < 4; ++i) { q0[i] *= __builtin_amdgcn_rcpf(a0[i]); q1[i] *= __builtin_amdgcn_rcpf(a1[i]); }
                        acc[ai][bj][m][0] *= q0; acc[ai][bj][m][1] *= q1; }
                }
        } else {
#pragma unroll
            for (int ai = 0; ai < 2; ++ai)
#pragma unroll
                for (int m = 0; m < 4; ++m) {
                    const int row = row0 + ai * 128 + m * 16;
#pragma unroll
                    for (int bj = 0; bj < 2; ++bj) { const int col = col0 + bj * 128;
                        const u32x2 ga = *(const u32x2*)(w.g8 + (unsigned)(row * 4096) + 2048 + col);
                        const f32x4 v0 = acc[ai][bj][m][0] * dec8x4(ga.x), v1 = acc[ai][bj][m][1] * dec8x4(ga.y);
                        u32x4 o; o.x = pk2(v0[0], v0[1]); o.y = pk2(v0[2], v0[3]); o.z = pk2(v1[0], v1[1]); o.w = pk2(v1[2], v1[3]);
                        *(u32x4*)(w.merged + (unsigned)(row * DM) + col) = o; }
                }
        }
    }
};

__device__ __forceinline__ float dpp_ror1(float v) { return __int_as_float(__builtin_amdgcn_mov_dpp(__float_as_int(v), 0x121, 0xf, 0xf, false)); }
__device__ __forceinline__ float dpp_keep(float v) { float d = dpp_ror1(v); asm volatile("" : "+v"(d)); return d; }
__device__ __forceinline__ float dpp_ror2(float v) { return __int_as_float(__builtin_amdgcn_mov_dpp(__float_as_int(v), 0x122, 0xf, 0xf, false)); }
typedef float f32x2 __attribute__((ext_vector_type(2)));
__device__ __forceinline__ f32x2 gelu_gate2(f32x2 v, f32x2 b) {
    f32x2 a; a.x = __builtin_amdgcn_fmed3f(fabsf(v.x), 0.f, 6.5f); a.y = __builtin_amdgcn_fmed3f(fabsf(v.y), 0.f, 6.5f);
    const f32x2 c9 = {3.819134520e-07f, 3.819134520e-07f}, c8 = {-7.616652965e-06f, -7.616652965e-06f}, c7 = {6.311968900e-05f, 6.311968900e-05f}, c6 = {-2.457886876e-04f, -2.457886876e-04f},
                c5 = {-5.764040543e-05f, -5.764040543e-05f}, c4 = {7.011611480e-03f, 7.011611480e-03f}, c3 = {-5.248568207e-02f, -5.248568207e-02f}, c2 = {-4.592045844e-01f, -4.592045844e-01f},
                c1 = {-1.151106715e+00f, -1.151106715e+00f}, c0 = {-9.999999404e-01f, -9.999999404e-01f};
    f32x2 p = c9 * a + c8; p = p * a + c7; p = p * a + c6; p = p * a + c5; p = p * a + c4; p = p * a + c3; p = p * a + c2; p = p * a + c1; p = p * a + c0;
    f32x2 e; e.x = __builtin_amdgcn_exp2f(p.x); e.y = __builtin_amdgcn_exp2f(p.y);
    f32x2 r; asm("v_max_f32 %0, 0, %1" : "=v"(r.x) : "v"(v.x)); asm("v_max_f32 %0, 0, %1" : "=v"(r.y) : "v"(v.y));
    return (r - a * e) * b;
}
#define CONV_SHR1(v, c, w) asm("v_fmac_f32_dpp %0, %1, %2 row_shr:1 row_mask:0xf bank_mask:0xf" : "+v"(v) : "v"(c), "v"(w))
constexpr int HALO_OFF = 131072;
constexpr int PRE_SS = HALO_OFF + 6144, PRE_CW = HALO_OFF + 7168;
struct EpiUp {
    static constexpr bool PERM = true, DMA_PRE = true, APERM = true;
    Ws w; float* out; const float* cw; const float* cb; const float* sconv;
    __device__ __forceinline__ void dma_prefetch(const pg8::Unit& u, LAS unsigned char* lds, int wid, int lane) const {
        if (wid == 0) {
            const bool samp = u.pm >= 66;
            const int rowbase = samp ? MP : (u.pm / 33) * SEQ + 254 * (u.pm % 33) - 2;
#pragma unroll
            for (int i = 0; i < 4; ++i) __builtin_amdgcn_global_load_lds((const unsigned*)(w.sumsq2 + rowbase + 64 * i + lane), (LAS unsigned*)(lds + PRE_SS + 256 * i), 4, 0, 0);
        } else if (wid == 1) {
            const int f0 = u.pn * 128 + 4 * (lane & 31), hb = (lane >> 5) * FF;
#pragma unroll
            for (int k = 0; k < 3; ++k) __builtin_amdgcn_global_load_lds((const unsigned*)(cw + (size_t)k * F2 + hb + f0), (LAS unsigned*)(lds + PRE_CW + 1024 * k), 16, 0, 0);
            __builtin_amdgcn_global_load_lds((const unsigned*)(cb + hb + f0), (LAS unsigned*)(lds + PRE_CW + 3072), 16, 0, 0);
        }
    }
    __device__ __forceinline__ void operator()(f32x4 (&acc)[2][2][4][2], const pg8::Unit& u, int wr, int wc, int fr_, int fq_, LAS unsigned char* lds) const {
        int fr = fr_, fq = fq_; asm volatile("" : "+v"(fr), "+v"(fq));
        const bool samp = u.pm >= 66;
        const int bb = samp ? 0 : u.pm / 33, jj = samp ? 0 : u.pm % 33;
        const int t0 = samp ? 0 : 254 * jj - 2;
        const int rowbase = samp ? MP : bb * SEQ + t0;
#pragma unroll
        for (int ai = 0; ai < 2; ++ai)
#pragma unroll
            for (int m = 0; m < 4; ++m) {
                const int rl = ai * 128 + wr * 64 + 4 * fr + m, t = t0 + rl;
                const bool ok = samp || (t >= 0 && t < SEQ);
                const float ss = *(const LAS float*)(lds + PRE_SS + 4 * rl);
                const float rs = ok ? __builtin_amdgcn_rsqf(ss * (1.0f / DM) + EPS) : 0.f;
#pragma unroll
                for (int bj = 0; bj < 2; ++bj) { acc[ai][bj][m][0] *= rs; acc[ai][bj][m][1] *= rs; }
            }
        asm volatile("" ::: "memory");
        LAS float* halo = (LAS float*)(lds + HALO_OFF);
        const int fcol = u.pn * 128 + wc * 32 + 8 * fq;
        if (!samp) {
            if (fr == 15) {
#pragma unroll
                for (int ai = 0; ai < 2; ++ai) { const int bd = 2 * ai + wr;
                    if (bd < 3) {
#pragma unroll
                        for (int m = 2; m < 4; ++m) { LAS f32x4* hp = (LAS f32x4*)(halo + (((bd * 4 + wc) * 8 + (m - 2) * 4 + fq) * 16));
                            hp[0] = acc[ai][0][m][0]; hp[1] = acc[ai][0][m][1]; hp[2] = acc[ai][1][m][0]; hp[3] = acc[ai][1][m][1]; } } }
            }
            asm volatile("s_waitcnt lgkmcnt(0)" ::: "memory"); __builtin_amdgcn_s_barrier(); asm volatile("" ::: "memory");
            u32x2 olo[2][4];
            const float zm = fr == 0 ? 1.0f : 0.0f;
            bf16_t* const dump = w.merged;
#pragma unroll
            for (int n = 0; n < 2; ++n) {
                const int f0 = fcol + 4 * n;
                f32x4 wa[3], wb[3];
                const LAS unsigned char* wl = lds + PRE_CW + 4 * (f0 - u.pn * 128);
#pragma unroll
                for (int k = 0; k < 3; ++k) { wa[k] = *(const LAS f32x4*)(wl + 1024 * k); wb[k] = *(const LAS f32x4*)(wl + 1024 * k + 512); }
                const f32x4 ba = *(const LAS f32x4*)(wl + 3072), bbv = *(const LAS f32x4*)(wl + 3072 + 512);
#pragma unroll
                for (int ai = 0; ai < 2; ++ai) {
                    const int gi = 2 * ai + wr;
                    const LAS f32x4* hp = (const LAS f32x4*)(halo + ((((gi > 0 ? gi - 1 : 0) * 4 + wc) * 8 + fq) * 16));
                    const f32x4 h62a = hp[n] * zm, h62b = hp[2 + n] * zm, h63a = hp[16 + n] * zm, h63b = hp[16 + 2 + n] * zm;
#pragma unroll
                    for (int m = 0; m < 4; ++m) {
                        const int rl = ai * 128 + wr * 64 + 4 * fr + m, t = t0 + rl;
                        const f32x4 ca = acc[ai][0][m][n], cbv = acc[ai][1][m][n];
                        f32x4 va = ba + wa[2] * ca, vb = bbv + wb[2] * cbv;
                        if (m >= 1) { va += wa[1] * acc[ai][0][m - 1][n]; vb += wb[1] * acc[ai][1][m - 1][n]; }
                        else { va += wa[1] * h63a; vb += wb[1] * h63b; }
                        if (m >= 2) { va += wa[0] * acc[ai][0][m - 2][n]; vb += wb[0] * acc[ai][1][m - 2][n]; }
                        else if (m == 1) { va += wa[0] * h63a; vb += wb[0] * h63b; }
                        else { va += wa[0] * h62a; vb += wb[0] * h62b; }
                        if (m < 2) {
#pragma unroll
                            for (int i = 0; i < 4; ++i) {
                                float ta = va[i], tb = vb[i];
                                if (m == 0) { CONV_SHR1(ta, acc[ai][0][3][n][i], wa[1][i]); CONV_SHR1(tb, acc[ai][1][3][n][i], wb[1][i]);
                                              CONV_SHR1(ta, acc[ai][0][2][n][i], wa[0][i]); CONV_SHR1(tb, acc[ai][1][2][n][i], wb[0][i]); }
                                else { CONV_SHR1(ta, acc[ai][0][3][n][i], wa[0][i]); CONV_SHR1(tb, acc[ai][1][3][n][i], wb[0][i]); }
                                va[i] = ta; vb[i] = tb;
                            }
                        }
                        const f32x2 g01 = gelu_gate2((f32x2){va[0], va[1]}, (f32x2){vb[0], vb[1]}), g23 = gelu_gate2((f32x2){va[2], va[3]}, (f32x2){vb[2], vb[3]});
                        u32x2 o; o.x = pk2(g01.x, g01.y); o.y = pk2(g23.x, g23.y);
                        if (n == 0) olo[ai][m] = o;
                        else { u32x4 o4; o4.x = olo[ai][m].x; o4.y = olo[ai][m].y; o4.z = o.x; o4.w = o.y;
                            const bool ok = rl >= 2 && t < SEQ;
                            bf16_t* dst = ok ? w.act + (unsigned)((rowbase + rl) * FF + fcol) : dump + (unsigned)(threadIdx.x * 8);
                            *(u32x4*)dst = o4; }
                        asm volatile("" ::: "memory");
                    }
                }
            }
            if (jj == 32) {
#pragma unroll
                for (int ai = 0; ai < 2; ++ai)
#pragma unroll
                    for (int m = 0; m < 4; ++m) { const int rl = ai * 128 + wr * 64 + 4 * fr + m, t = t0 + rl;
                        if (t >= SEQ - 2 && t < SEQ) {
#pragma unroll
                            for (int n = 0; n < 2; ++n) { float* d = out + O_CONVP + ((size_t)bb * 2 + (t - (SEQ - 2))) * F2 + fcol + 4 * n; *(f32x4*)d = acc[ai][0][m][n]; *(f32x4*)(d + FF) = acc[ai][1][m][n]; } } }
            }
        } else {
            const bool ev = !(fr & 1);
#pragma unroll
            for (int n = 0; n < 2; ++n) {
                const int f0 = fcol + 4 * n;
                f32x4 wa[3], wb[3];
                const LAS unsigned char* wl = lds + PRE_CW + 4 * (f0 - u.pn * 128);
#pragma unroll
                for (int k = 0; k < 3; ++k) { wa[k] = *(const LAS f32x4*)(wl + 1024 * k); wb[k] = *(const LAS f32x4*)(wl + 1024 * k + 512); }
                const f32x4 ba = *(const LAS f32x4*)(wl + 3072), bbv = *(const LAS f32x4*)(wl + 3072 + 512);
#pragma unroll
                for (int ai = 0; ai < 2; ++ai) {
                    const int bs = ai * 16 + wr * 8 + (fr >> 1);
                    f32x4 s1a = ba, s1b = ba, s0a = ba, s0b = ba;
                    if (ev) { const float* s1 = sconv + ((size_t)bs * 2 + 1) * F2 + f0; const float* s0 = sconv + ((size_t)bs * 2) * F2 + f0;
                        s1a = *(const f32x4*)s1; s1b = *(const f32x4*)(s1 + FF); s0a = *(const f32x4*)s0; s0b = *(const f32x4*)(s0 + FF); }
#pragma unroll
                    for (int m = 0; m < 4; ++m) {
                        const int rl = ai * 128 + wr * 64 + 4 * fr + m, ts = 4 * (fr & 1) + m;
                        const f32x4 ca = acc[ai][0][m][n], cbv = acc[ai][1][m][n];
                        f32x4 a1, a2, b1, b2;
                        if (m >= 1) { a1 = acc[ai][0][m - 1][n]; b1 = acc[ai][1][m - 1][n]; }
                        else {
#pragma unroll
                            for (int i = 0; i < 4; ++i) { const float da = dpp_keep(acc[ai][0][3][n][i]), db = dpp_keep(acc[ai][1][3][n][i]); a1[i] = ev ? s1a[i] : da; b1[i] = ev ? s1b[i] : db; } }
                        if (m >= 2) { a2 = acc[ai][0][m - 2][n]; b2 = acc[ai][1][m - 2][n]; }
                        else if (m == 1) {
#pragma unroll
                            for (int i = 0; i < 4; ++i) { const float da = dpp_keep(acc[ai][0][3][n][i]), db = dpp_keep(acc[ai][1][3][n][i]); a2[i] = ev ? s1a[i] : da; b2[i] = ev ? s1b[i] : db; } }
                        else {
#pragma unroll
                            for (int i = 0; i < 4; ++i) { const float da = dpp_keep(acc[ai][0][2][n][i]), db = dpp_keep(acc[ai][1][2][n][i]); a2[i] = ev ? s0a[i] : da; b2[i] = ev ? s0b[i] : db; } }
                        const f32x4 va = ba + wa[0] * a2 + wa[1] * a1 + wa[2] * ca;
                        const f32x4 vb = bbv + wb[0] * b2 + wb[1] * b1 + wb[2] * cbv;
                        const f32x2 g01 = gelu_gate2((f32x2){va[0], va[1]}, (f32x2){vb[0], vb[1]}), g23 = gelu_gate2((f32x2){va[2], va[3]}, (f32x2){vb[2], vb[3]});
                        u32x2 o; o.x = pk2(g01.x, g01.y); o.y = pk2(g23.x, g23.y);
                        *(u32x2*)(w.act + (unsigned)((MP + rl) * FF + f0)) = o;
                        if (ts >= 6) { float* d = out + O_CONVS + ((size_t)bs * 2 + (ts - 6)) * F2 + f0; *(f32x4*)d = ca; *(f32x4*)(d + FF) = cbv; }
                        asm volatile("" ::: "memory");
                    }
                }
            }
        }
    }
};


__device__ __forceinline__ void panel_arrive_wait(unsigned* cnt, unsigned want) {
    asm volatile("s_waitcnt vmcnt(0)" ::: "memory");
    __hip_atomic_fetch_add(cnt, 1u, __ATOMIC_RELAXED, __HIP_MEMORY_SCOPE_AGENT);
    unsigned sp = 0;
    while (__hip_atomic_load(cnt, __ATOMIC_RELAXED, __HIP_MEMORY_SCOPE_AGENT) < want) { __builtin_amdgcn_s_sleep(2); if (++sp > (1u << 22)) break; }
    asm volatile("s_waitcnt vmcnt(0)" ::: "memory");
}
struct EpiFin {
    static constexpr bool PERM = true, DMA_PRE = false, APERM = false;
    Ws w; float* out; const float* gfin; unsigned* pcnt;
    __device__ __forceinline__ void operator()(f32x4 (&acc)[2][2][4][2], const pg8::Unit& u, int wr, int wc, int fr_, int fq_, LAS unsigned char*) const {
        int fr = fr_, fq = fq_; asm volatile("" : "+v"(fr), "+v"(fq));
        const int row0 = u.pm * 256 + wr * 64 + fr;
        const int col0 = u.pn * 256 + wc * 32 + 8 * fq;
        float ssv[8];
#pragma unroll
        for (int ai = 0; ai < 2; ++ai)
#pragma unroll
            for (int m = 0; m < 4; ++m) {
                const int row = row0 + ai * 128 + m * 16;
                float ssq = 0.f;
#pragma unroll
                for (int bj = 0; bj < 2; ++bj) {
                    const int col = col0 + bj * 128;
                    const u32x4 xv = __builtin_nontemporal_load((const u32x4*)(w.xb + (unsigned)(row * DM) + col));
                    f32x4 v0 = acc[ai][bj][m][0], v1 = acc[ai][bj][m][1];
                    v0[0] += bflo(xv.x); v0[1] += bfhi(xv.x); v0[2] += bflo(xv.y); v0[3] += bfhi(xv.y);
                    v1[0] += bflo(xv.z); v1[1] += bfhi(xv.z); v1[2] += bflo(xv.w); v1[3] += bfhi(xv.w);
                    acc[ai][bj][m][0] = v0; acc[ai][bj][m][1] = v1;
#pragma unroll
                    for (int i = 0; i < 4; ++i) ssq += v0[i] * v0[i] + v1[i] * v1[i];
                }
                ssq += __shfl_xor(ssq, 16); ssq += __shfl_xor(ssq, 32);
                ssv[ai * 4 + m] = ssq;
            }
        if (fq == 0) {
#pragma unroll
            for (int k = 0; k < 8; ++k) atomicAdd(w.sumsq3 + row0 + (k >> 2) * 128 + (k & 3) * 16, ssv[k]);
        }
        asm volatile("s_waitcnt vmcnt(0)" ::: "memory"); __builtin_amdgcn_s_barrier(); asm volatile("" ::: "memory");
        if (threadIdx.x == 0) panel_arrive_wait(pcnt + 16 * u.pm, 8u);
        asm volatile("s_waitcnt vmcnt(0) lgkmcnt(0)" ::: "memory"); __builtin_amdgcn_s_barrier(); asm volatile("" ::: "memory");
        f32x4 g[2][2];
#pragma unroll
        for (int bj = 0; bj < 2; ++bj) { g[bj][0] = *(const f32x4*)(gfin + col0 + bj * 128); g[bj][1] = *(const f32x4*)(gfin + col0 + bj * 128 + 4); }
#pragma unroll
        for (int ai = 0; ai < 2; ++ai)
#pragma unroll
            for (int m = 0; m < 4; ++m) {
                const int row = row0 + ai * 128 + m * 16;
                const float rs = rsqrtf(__hip_atomic_load(w.sumsq3 + row, __ATOMIC_RELAXED, __HIP_MEMORY_SCOPE_AGENT) * (1.0f / DM) + EPS);
#pragma unroll
                for (int bj = 0; bj < 2; ++bj) { float* dst = out + O_Y + (unsigned)(row * DM) + col0 + bj * 128;
                    __builtin_nontemporal_store(acc[ai][bj][m][0] * rs * g[bj][0], (f32x4*)dst); __builtin_nontemporal_store(acc[ai][bj][m][1] * rs * g[bj][1], (f32x4*)(dst + 4)); }
            }
    }
};

__device__ __forceinline__ int up_rowmap(int n) { return n < FF ? ((n >> 7) * 256 + (n & 127)) : (((n - FF) >> 7) * 256 + 128 + ((n - FF) & 127)); }
__device__ __forceinline__ void p0_transpose_item(const float* W, int K, int N, bf16_t* WT, const float* g, bool upmap, LAS float* scr, int item, int lane, int ldt = 0) {
    if (ldt == 0) ldt = K;
    const int nblk = N / 32, kb = item / nblk, nb = item % nblk, k0 = 64 * kb, n0 = 32 * nb;
    float tv[32];
#pragma unroll
    for (int i = 0; i < 32; ++i) { const int kk = 2 * i + (lane >> 5); tv[i] = __builtin_nontemporal_load(W + (size_t)(k0 + kk) * N + n0 + (lane & 31)); }
    if (g) {
#pragma unroll
        for (int i = 0; i < 32; ++i) tv[i] *= g[k0 + 2 * i + (lane >> 5)];
    }
#pragma unroll
    for (int i = 0; i < 32; ++i) { const int kk = 2 * i + (lane >> 5); scr[kk * 33 + (lane & 31)] = tv[i]; }
    LDS_WAIT();
    const int c = lane & 7;
    const int nbase = upmap ? up_rowmap(n0) : n0;
#pragma unroll
    for (int j = 0; j < 4; ++j) { const int n = (lane >> 3) + 8 * j; const LAS float* s = scr + (8 * c) * 33 + n;
        u32x4 o; o.x = pk2(s[0 * 33], s[1 * 33]); o.y = pk2(s[2 * 33], s[3 * 33]); o.z = pk2(s[4 * 33], s[5 * 33]); o.w = pk2(s[6 * 33], s[7 * 33]);
        *(u32x4*)(WT + (size_t)(nbase + n) * ldt + k0 + 8 * c) = o; }
    LDS_WAIT();
}
#ifndef KVSLACK
#define KVSLACK 100
#endif
#define KV_SPLIT ((KVSLACK) >= 100 ? KV_TOTAL : KV_TOTAL / 100 * (KVSLACK))
template <int SET> __device__ __forceinline__ void weight_transposes(const Params& p, const Ws& w, LAS unsigned char* lds, int rk, int n) {
    const int tid = opaque_tid(), lane = tid & 63, wave = tid >> 6;
    LAS float* scr = (LAS float*)(lds + wave * 16384);
    const int gw = rk * 8 + wave, NGW = n * 8;
    constexpr int I_IN = (DM / 64) * (INC / 32), I_RO = (1024 / 64) * (DM / 32), I_AO = (512 / 64) * (DM / 32), I_O = (DM / 64) * (DM / 32), I_UP = (DM / 64) * (F2 / 32), I_DN = (FF / 64) * (DM / 32);
    constexpr int NITEMS = SET == 0 ? I_IN + I_UP : (SET == 1 ? I_RO + I_AO + I_O : I_DN);
    for (int it = gw; it < NITEMS; it += NGW) {
        int r = it;
        if (SET == 0) {
            if (r < I_IN) { p0_transpose_item(p.in[8], DM, INC, w.Wt_in, p.in[7], false, scr, r, lane); continue; } r -= I_IN;
            p0_transpose_item(p.in[14], DM, F2, w.Wt_up, p.in[13], true, scr, r, lane);
        } else if (SET == 1) {
            if (r < I_RO) { p0_transpose_item(p.in[10], 1024, DM, w.Wt_reto, nullptr, false, scr, r, lane); continue; } r -= I_RO;
            if (r < I_AO) { p0_transpose_item(p.in[11], 512, DM, w.Wt_atto, nullptr, false, scr, r, lane, 1024); continue; } r -= I_AO;
            p0_transpose_item(p.in[12], DM, DM, w.Wt_o, nullptr, false, scr, r, lane);
        } else p0_transpose_item(p.in[17], FF, DM, w.Wt_down, nullptr, false, scr, r, lane);
    }
}
__device__ __forceinline__ void p0_xconv(const Params& p, const Ws& w, LAS unsigned char* lds, int vcu, int G) {
    const int tid = opaque_tid(), lane = tid & 63, wave = tid >> 6;
    const int gw = vcu * 8 + wave, NGW = G * 8;
    for (int m = gw; m < MT; m += NGW) {
        const float* xr = (m < MP) ? p.in[0] + (size_t)m * DM : p.in[1] + (size_t)(m - MP) * DM;
        const f32x4* x4 = (const f32x4*)xr + lane;
        f32x4 v[8]; float s = 0.f;
#pragma unroll
        for (int j = 0; j < 8; ++j) { v[j] = __builtin_nontemporal_load(x4 + 64 * j); s += (v[j].x * v[j].x + v[j].y * v[j].y) + (v[j].z * v[j].z + v[j].w * v[j].w); }
        s = wave_sum(s);
        const float rs = rsqrtf(s * (1.0f / DM) + EPS);
        if (lane == 0) w.rstd1[m] = sqrtf(s * (1.0f / DM) + EPS);
        u32x2* o8 = (u32x2*)(w.xb + (size_t)m * DM) + lane;
#pragma unroll
        for (int j = 0; j < 8; ++j) { u32x2 o; o.x = pk2(v[j].x * rs, v[j].y * rs); o.y = pk2(v[j].z * rs, v[j].w * rs); o8[64 * j] = o; }
    }
    for (int i = vcu * 512 + tid; i < 2 * MT; i += G * 512) w.sumsq2[i] = 0.f;
}
constexpr size_t KV_TOTAL = (size_t)32 * 1024 * 256;
__device__ __forceinline__ void kv_resolve(const Params& p, size_t i, const f32x4*& src, f32x4*& dst) {
    const unsigned li = (unsigned)i, b = li >> 18, rr = (li >> 8) & 1023u, c4 = li & 255u, row = (rr >> 3) * 16 + 8 + (rr & 7);
    const size_t o = ((size_t)b * 2048 + row) * 256 + c4;
    src = (const f32x4*)p.in[5] + o; dst = (f32x4*)(p.out + O_KV2048S) + o - 2048;
}
__device__ __forceinline__ void kv_copy_range(const Params& p, size_t c0, size_t c1, int rk, int ncu) {
    const size_t step = (size_t)ncu * 512;
    for (size_t i0 = c0 + (size_t)rk * 512 + opaque_tid(); i0 < c1; i0 += 16 * step) {
        f32x4 v[16]; f32x4* dp[16];
#pragma unroll
        for (int k = 0; k < 16; ++k) { const size_t i = i0 + k * step; if (i < c1) { const f32x4* sp; kv_resolve(p, i, sp, dp[k]); v[k] = __builtin_nontemporal_load(sp); } }
#pragma unroll
        for (int k = 0; k < 16; ++k) { const size_t i = i0 + k * step; if (i < c1) __builtin_nontemporal_store(v[k], dp[k]); }
    }
}

__device__ __forceinline__ float lgamma_h(int h) { return logf(1.0f - exp2f(-5.0f - (float)h)); }
__device__ __forceinline__ void ret_sample(const Params& p, const Ws& w, LAS unsigned char* lds, int vcu, int G) {
    const int tid = opaque_tid(), lane = tid & 63, wave = tid >> 6;
    LAS float* qf = (LAS float*)lds;
    LAS float* kf = qf + 1024;
    LAS float* vf = kf + 1024;
    LAS float* part = vf + 1024;
    LAS float* sc = part + 4096;
    LAS float* yb = sc + 64;
    const float* gn = p.in[9];
    for (int item = vcu; item < 256; item += G) {
        const int bs = item >> 3, h = item & 7;
        const size_t m0 = MP + (size_t)bs * 8;
        const float lg = lgamma_h(h);
        __syncthreads();
        for (int i = tid; i < 1024; i += 512) { const int r = i >> 7, d = i & 127; const bf16_t* row = w.proj + pofs(m0 + r, h * 128 + d);
            qf[i] = bf2f(row[(C_RQ / 128) * PSLAB]); kf[i] = bf2f(row[(C_RK / 128) * PSLAB]) * QK_SCALE; vf[i] = bf2f(row[(C_RV / 128) * PSLAB]); }
        __syncthreads();
        if (tid < 64) { const int i = tid >> 3, j = tid & 7; float s = 0.f; for (int d = 0; d < 128; ++d) s += qf[i * 128 + d] * kf[j * 128 + d]; sc[tid] = (i >= j) ? s * __expf((float)(i - j) * lg) : 0.f; }
        const int e = tid & 127, dq = tid >> 7;
        const float* st = p.in[2] + (size_t)item * 16384;
        float* nst = p.out + O_RETS + (size_t)item * 16384;
        const float g8 = __expf(8.0f * lg);
        float kdec[8];
#pragma unroll
        for (int j = 0; j < 8; ++j) kdec[j] = __expf((float)(7 - j) * lg);
        float cr[8];
#pragma unroll
        for (int i = 0; i < 8; ++i) cr[i] = 0.f;
        float sv[32];
#pragma unroll
        for (int dd = 0; dd < 32; ++dd) sv[dd] = __builtin_nontemporal_load(st + (dq * 32 + dd) * 128 + e);
#pragma unroll
        for (int dd = 0; dd < 32; ++dd) {
            const int d = dq * 32 + dd;
            const float s = sv[dd];
            float ns = s * g8;
#pragma unroll
            for (int j = 0; j < 8; ++j) ns += kf[j * 128 + d] * kdec[j] * vf[j * 128 + e];
            __builtin_nontemporal_store(ns, nst + d * 128 + e);
#pragma unroll
            for (int i = 0; i < 8; ++i) cr[i] += qf[i * 128 + d] * s;
        }
#pragma unroll
        for (int i = 0; i < 8; ++i) part[(dq * 8 + i) * 128 + e] = cr[i];
        __syncthreads();
        for (int idx = tid; idx < 1024; idx += 512) { const int i = idx >> 7, ee = idx & 127;
            float y = (part[(0 * 8 + i) * 128 + ee] + part[(1 * 8 + i) * 128 + ee] + part[(2 * 8 + i) * 128 + ee] + part[(3 * 8 + i) * 128 + ee]) * __expf((float)(i + 1) * lg);
            for (int j = 0; j <= i; ++j) y += sc[i * 8 + j] * vf[j * 128 + ee];
            yb[idx] = y; }
        __syncthreads();
        {
            const int il = wave; const size_t m = m0 + il;
            const float a0 = yb[il * 128 + lane], a1 = yb[il * 128 + 64 + lane];
            const float mean = wave_sum(a0 + a1) * (1.0f / 128.0f);
            const float d0 = a0 - mean, d1 = a1 - mean;
            const float var = wave_sum(d0 * d0 + d1 * d1) * (1.0f / 128.0f);
            const float rstd = rsqrtf(var + EPS);
            const float g0 = bf2f(w.proj[pofs(m, C_RG + h * 128 + lane)]), g1 = bf2f(w.proj[pofs(m, C_RG + h * 128 + 64 + lane)]);
            w.G[m * 1024 + h * 128 + lane] = (bf16_t)f2bf(d0 * rstd * gn[h * 128 + lane] * g0);
            w.G[m * 1024 + h * 128 + 64 + lane] = (bf16_t)f2bf(d1 * rstd * gn[h * 128 + 64 + lane] * g1);
        }
    }
}
typedef short v4s __attribute__((ext_vector_type(4)));
__device__ __forceinline__ v4s tr16(const LAS unsigned char* p) { return __builtin_amdgcn_ds_read_tr16_b64_v4i16((LAS v4s*)p); }
__device__ __forceinline__ bf16x8 cat8(v4s a, v4s b) { return (bf16x8){a[0], a[1], a[2], a[3], b[0], b[1], b[2], b[3]}; }
#define MFMA16(a, b, c) __builtin_amdgcn_mfma_f32_16x16x32_bf16(a, b, c, 0, 0, 0)
constexpr float LOG2E = 1.4426950408889634f, LN2 = 0.6931471805599453f;
__device__ __forceinline__ float lg2gamma(int h) { return log2f(1.0f - exp2f(-5.0f - (float)h)); }
__device__ __forceinline__ bf16x8 pack8(const f32x4 a, const f32x4 b) {
    u32x4 o; o.x = pk2(a[0], a[1]); o.y = pk2(a[2], a[3]); o.z = pk2(b[0], b[1]); o.w = pk2(b[2], b[3]);
    return __builtin_bit_cast(bf16x8, o);
}
constexpr int KP = 272, VP = 288;

struct AttnDesc { int g, h, dil, qb, qcol; size_t rowbase; };
__device__ __forceinline__ AttnDesc attn_desc(int item) {
    AttnDesc d; const int rq = item & 63; d.h = (item >> 6) & 3; const int b = (item >> 8) & 1; d.g = item >> 9;
    d.dil = 1 << (2 * d.g); const int sh = 6 - 2 * d.g, r = rq >> sh; d.qb = rq & ((1 << sh) - 1);
    d.qcol = C_ATT + d.g * 1536 + d.h * 128; d.rowbase = (size_t)b * SEQ + r; return d;
}
__device__ __forceinline__ void attn_load(const Ws& w, const AttnDesc& d, int tid, bool fresh, u32x4 (&kreg)[8], u32x4 (&vreg)[8]) {
    const int s0 = 128 * (d.qb - 1);
#pragma unroll
    for (int i = 0; i < 4; ++i) { const int cidx = tid + 512 * i, c = 128 + (cidx >> 4), ch = cidx & 15, s = s0 + c;
        const bf16_t* rp = w.proj + pofs(d.rowbase + (size_t)d.dil * s, d.qcol + ch * 8); kreg[i] = __builtin_nontemporal_load((const u32x4*)(rp + 4 * PSLAB)); vreg[i] = __builtin_nontemporal_load((const u32x4*)(rp + 8 * PSLAB)); }
    if (fresh) {
#pragma unroll
        for (int i = 4; i < 8; ++i) { const int cidx = tid + 512 * (i - 4), c = cidx >> 4, ch = cidx & 15, s = max(s0 + c, 0);
            const bf16_t* rp = w.proj + pofs(d.rowbase + (size_t)d.dil * s, d.qcol + ch * 8); kreg[i] = __builtin_nontemporal_load((const u32x4*)(rp + 4 * PSLAB)); vreg[i] = __builtin_nontemporal_load((const u32x4*)(rp + 8 * PSLAB)); }
    }
}
__device__ __forceinline__ void attn_loadq(const Ws& w, const AttnDesc& d, int wave, int fr, int fg, bf16x8 (&qf)[4]) {
    const size_t mq = d.rowbase + (size_t)d.dil * (128 * d.qb + 16 * wave + fr);
#pragma unroll
    for (int ds = 0; ds < 4; ++ds) qf[ds] = __builtin_nontemporal_load((const bf16x8*)(w.proj + pofs(mq, d.qcol + 32 * ds + 8 * fg)));
}
__device__ __forceinline__ void attn_compute(const Ws& w, LAS unsigned char* lds, const AttnDesc& d, int off, bf16x8 (&qf)[4], int wave, int fr, int fg, bool has_next, const AttnDesc& dn, int tid, u32x4 (&kreg)[8], u32x4 (&vreg)[8]) {
    LAS unsigned char* Kt = lds; LAS unsigned char* Vt = lds + 256 * KP;
    const int g = d.g, h = d.h, qb = d.qb;
    asm volatile("" : "+v"(fr), "+v"(fg));
    const int iq = 16 * wave + fr;
    const size_t mq = d.rowbase + (size_t)d.dil * (128 * qb + iq);
    const int kbmin = (qb == 0) ? 8 : 0;
    const float c1 = QK_SCALE * LOG2E, c2 = exp2f(-8.0f * (float)(g * 4 + h + 1) / 12.0f) * (float)d.dil * LOG2E;
    f32x4 sc[9];
    float mx = -1e30f;
#pragma unroll
    for (int kk = 0; kk < 9; ++kk) {
        const int kb = wave + kk;
        if (kb >= kbmin) {
            f32x4 a = (f32x4){0.f, 0.f, 0.f, 0.f};
#pragma unroll
            for (int ds = 0; ds < 4; ++ds) { const bf16x8 kf = *(const LAS bf16x8*)(Kt + (((16 * kb + off) & 255) + fr) * KP + (32 * ds + 8 * fg) * 2); a = MFMA16(kf, qf[ds], a); }
#pragma unroll
            for (int r_ = 0; r_ < 4; ++r_) { const int dist = 128 + iq - (16 * kb + 4 * fg + r_); const float s = a[r_] * c1 - c2 * (float)dist; a[r_] = (dist >= 0 && dist <= 128) ? s : -1e30f; mx = fmaxf(mx, a[r_]); }
            sc[kk] = a;
        } else sc[kk] = (f32x4){-1e30f, -1e30f, -1e30f, -1e30f};
    }
    mx = fmaxf(mx, __shfl_xor(mx, 16)); mx = fmaxf(mx, __shfl_xor(mx, 32));
    float sum = 0.f;
#pragma unroll
    for (int kk = 0; kk < 9; ++kk)
#pragma unroll
        for (int r_ = 0; r_ < 4; ++r_) { const float e = __builtin_amdgcn_exp2f(sc[kk][r_] - mx); sc[kk][r_] = e; sum += e; }
    sum += __shfl_xor(sum, 16); sum += __shfl_xor(sum, 32);
    if (has_next) { attn_load(w, dn, tid, dn.qb == 0, kreg, vreg); attn_loadq(w, dn, wave, fr, fg, qf); }
    f32x4 o[8];
#pragma unroll
    for (int eb = 0; eb < 8; ++eb) o[eb] = (f32x4){0.f, 0.f, 0.f, 0.f};
    const int q4 = fr >> 2, p4 = fr & 3;
#pragma unroll
    for (int st = 0; st < 5; ++st) {
        const int kb0 = wave + 2 * st;
        const bf16x8 pf = (st < 4) ? pack8(sc[2 * st], sc[2 * st + 1]) : pack8(sc[8], (f32x4){0.f, 0.f, 0.f, 0.f});
        const LAS unsigned char* v0 = Vt + (((16 * kb0 + off) & 255) + 4 * fg + q4) * VP + 8 * p4;
        const LAS unsigned char* v1 = Vt + (((16 * kb0 + 16 + off) & 255) + 4 * fg + q4) * VP + 8 * p4;
#pragma unroll
        for (int eb = 0; eb < 8; ++eb) {
            const v4s a0 = tr16(v0 + 32 * eb);
            const v4s a1 = (st < 4) ? tr16(v1 + 32 * eb) : (v4s){0, 0, 0, 0};
            o[eb] = MFMA16(cat8(a0, a1), pf, o[eb]);
        }
    }
    const float inv = 1.0f / sum;
    bf16_t* orow = w.og + ((size_t)g * MT + mq) * 512 + h * 128 + 4 * fg;
#pragma unroll
    for (int eb = 0; eb < 8; ++eb) { u32x2 ov; ov.x = pk2(o[eb][0] * inv, o[eb][1] * inv); ov.y = pk2(o[eb][2] * inv, o[eb][3] * inv); *(u32x2*)(orow + 16 * eb) = ov; }
    if (fg == 0) w.lse[((size_t)g * MT + mq) * 4 + h] = mx * LN2 + __logf(sum);
}
__device__ __forceinline__ void attn_phase(const Ws& w, LAS unsigned char* lds, int first, int count) {
    const int tid = opaque_tid(), lane = tid & 63, wave = __builtin_amdgcn_readfirstlane(tid >> 6), fr = lane & 15, fg = lane >> 4;
    if (count <= 0) return;
    LAS unsigned char* Kt = lds; LAS unsigned char* Vt = lds + 256 * KP;
    u32x4 kreg[8], vreg[8]; bf16x8 qf[4];
    AttnDesc d = attn_desc(first);
    attn_load(w, d, tid, true, kreg, vreg); attn_loadq(w, d, wave, fr, fg, qf);
    int off = 0; bool fresh = true;
    for (int n = 0; n < count; ++n) {
        __syncthreads();
        if (fresh) off = 0; else off = (off + 128) & 255;
#pragma unroll
        for (int i = 0; i < 4; ++i) { const int cidx = tid + 512 * i, c = (128 + (cidx >> 4) + off) & 255, ch = cidx & 15;
            *(LAS u32x4*)(Kt + c * KP + ch * 16) = kreg[i]; *(LAS u32x4*)(Vt + c * VP + ch * 16) = vreg[i]; }
        if (fresh) {
#pragma unroll
            for (int i = 4; i < 8; ++i) { const int cidx = tid + 512 * (i - 4), c = ((cidx >> 4) + off) & 255, ch = cidx & 15;
                *(LAS u32x4*)(Kt + c * KP + ch * 16) = kreg[i]; *(LAS u32x4*)(Vt + c * VP + ch * 16) = vreg[i]; }
        }
        __syncthreads();
        const AttnDesc dc = d;
        const bool has_next = n + 1 < count;
        if (has_next) { d = attn_desc(first + n + 1); fresh = (d.qb == 0); }
        attn_compute(w, lds, dc, off, qf, wave, fr, fg, has_next, d, tid, kreg, vreg);
    }
    __syncthreads();
}

__device__ __forceinline__ float half_sum(float v) {
#pragma unroll
    for (int o = 1; o < 32; o <<= 1) v += __shfl_xor(v, o);
    return v;
}
__device__ __forceinline__ void attn_sample(const Params& p, const Ws& w, LAS unsigned char* lds, int vcu, int G) {
    const int tid = opaque_tid(), lane = tid & 63, wave = tid >> 6, half = lane >> 5, c = lane & 31;
    const int gw = vcu * 8 + wave, NGW = G * 8;
    for (int it = gw; it < MS * 12; it += NGW) {
        const int g = it % 3, mh = it / 3, ms = mh >> 2, h = mh & 3, m = MP + ms, b = ms >> 3, t = ms & 7;
        const int dil = 1 << (2 * g), Wb = 128 << (2 * g);
        const int qcol = C_ATT + g * 1536 + h * 128, kcol = qcol + 512, vcol = qcol + 1024;
        f32x4 q; { const u32x2 v = *(const u32x2*)(w.proj + pofs(m, qcol + 4 * c)); q = (f32x4){bflo(v.x), bfhi(v.x), bflo(v.y), bfhi(v.y)}; }
        const float slope = exp2f(-8.0f * (float)(g * 4 + h + 1) / 12.0f) * (float)dil;
        const float* cache = p.in[3 + g];
        const int jn = t >> (2 * g);
        const int ncache = 128 - jn, npair = (ncache + 1) >> 1;
        const float* kb0 = cache + ((size_t)(b * Wb + Wb + t) * 2 + 0) * 512 + h * 128 + 4 * c;
        float* kvout = p.out + (g == 0 ? O_KV128S : (g == 1 ? O_KV512S : O_KV2048S));
        const bool owner = (g == 0) ? (t == 0) : (g == 1 ? (t < 4) : true);
        float mrun = -1e30f, sum = 0.f; f32x4 o = (f32x4){0.f, 0.f, 0.f, 0.f};
#pragma unroll
        for (int j = 0; j < 8; ++j) if (j <= jn) {
            const u32x2 kk2 = *(const u32x2*)(w.proj + pofs(m - dil * j, kcol + 4 * c)), vv = *(const u32x2*)(w.proj + pofs(m - dil * j, vcol + 4 * c));
            const float s = half_sum((bflo(kk2.x) * q[0] + bfhi(kk2.x) * q[1]) + (bflo(kk2.y) * q[2] + bfhi(kk2.y) * q[3])) * QK_SCALE - slope * (float)j;
            if (half == 0) { const float mn = fmaxf(mrun, s), al = __expf(mrun - mn), e = __expf(s - mn); mrun = mn; sum = sum * al + e;
                o = o * al; o[0] += e * bflo(vv.x); o[1] += e * bfhi(vv.x); o[2] += e * bflo(vv.y); o[3] += e * bfhi(vv.y); }
        }
        for (int k0 = 0; k0 < npair; k0 += 16) {
            f32x4 kv[16], vv[16];
#pragma unroll
            for (int u = 0; u < 16; ++u) { const int j = jn + 1 + 2 * (k0 + u) + half;
                if (k0 + u < npair && j <= 128) { const float* rp = kb0 - (size_t)(dil * j) * 1024; kv[u] = __builtin_nontemporal_load((const f32x4*)rp); vv[u] = __builtin_nontemporal_load((const f32x4*)(rp + 512));
                    const int idx = Wb + t - dil * j;
                    if (owner && idx >= 8) { float* wp = kvout + ((size_t)(b * Wb + idx - 8) * 2) * 512 + h * 128 + 4 * c; __builtin_nontemporal_store(kv[u], (f32x4*)wp); __builtin_nontemporal_store(vv[u], (f32x4*)(wp + 512)); } }
                else { kv[u] = (f32x4){0.f, 0.f, 0.f, 0.f}; vv[u] = kv[u]; } }
            float s[16]; float bm = -1e30f;
#pragma unroll
            for (int u = 0; u < 16; ++u) { const int j = jn + 1 + 2 * (k0 + u) + half;
                const float d = half_sum((kv[u][0] * q[0] + kv[u][1] * q[1]) + (kv[u][2] * q[2] + kv[u][3] * q[3]));
                s[u] = (k0 + u < npair && j <= 128) ? d * QK_SCALE - slope * (float)j : -1e30f; bm = fmaxf(bm, s[u]); }
            const float mn = fmaxf(mrun, bm), al = __expf(mrun - mn); mrun = mn; sum *= al; o = o * al;
#pragma unroll
            for (int u = 0; u < 16; ++u) { const float e = __expf(s[u] - mn); sum += e; o += vv[u] * e; }
        }
        const float mo = __shfl_xor(mrun, 32), so = __shfl_xor(sum, 32);
        const float mt = fmaxf(mrun, mo), a0 = __expf(mrun - mt), a1 = __expf(mo - mt);
        const float st = sum * a0 + so * a1;
#pragma unroll
        for (int i = 0; i < 4; ++i) o[i] = o[i] * a0 + __shfl_xor(o[i], 32) * a1;
        const float inv = 1.0f / st;
        if (half == 0) { u32x2 ov; ov.x = pk2(o[0] * inv, o[1] * inv); ov.y = pk2(o[2] * inv, o[3] * inv); *(u32x2*)(w.og + ((size_t)g * MT + m) * 512 + h * 128 + 4 * c) = ov; }
        if (lane == 0) w.lse[((size_t)g * MT + m) * 4 + h] = mt + __logf(st);
    }
}

__device__ __forceinline__ void retA_load(const Ws& w, int item, int tid, u32x4 (&kr)[4], u32x4 (&vr)[4]) {
    const int c = item & 63, bh = item >> 6, h = bh & 7, b = bh >> 3;
    const size_t m0 = (size_t)b * SEQ + c * 128;
#pragma unroll
    for (int i = 0; i < 4; ++i) { const int cidx = tid + 512 * i, j = cidx >> 4, ch = cidx & 15;
        const bf16_t* rp = w.proj + pofs(m0 + j, h * 128 + ch * 8);
        kr[i] = *(const u32x4*)(rp + (C_RK / 128) * PSLAB); vr[i] = *(const u32x4*)(rp + (C_RV / 128) * PSLAB); }
}
__device__ __forceinline__ void retA_item(const Ws& w, LAS unsigned char* lds, int item, int next, u32x4 (&kr)[4], u32x4 (&vr)[4]) {
    const int tid = opaque_tid(), lane = tid & 63, wave = __builtin_amdgcn_readfirstlane(tid >> 6), fr = lane & 15, fg = lane >> 4;
    const int bh = item >> 6, h = bh & 7;
    const float lg2 = lg2gamma(h);
    LAS unsigned char* Kt = lds; LAS unsigned char* Vt = lds + 128 * VP;
#pragma unroll
    for (int i = 0; i < 4; ++i) { const int cidx = tid + 512 * i, j = cidx >> 4, ch = cidx & 15;
        const float kd = exp2f((float)(127 - j) * lg2) * QK_SCALE;
        u32x4 ks; ks.x = pk2(bflo(kr[i].x) * kd, bfhi(kr[i].x) * kd); ks.y = pk2(bflo(kr[i].y) * kd, bfhi(kr[i].y) * kd); ks.z = pk2(bflo(kr[i].z) * kd, bfhi(kr[i].z) * kd); ks.w = pk2(bflo(kr[i].w) * kd, bfhi(kr[i].w) * kd);
        *(LAS u32x4*)(Kt + j * VP + ch * 16) = ks; *(LAS u32x4*)(Vt + j * VP + ch * 16) = vr[i]; }
    __syncthreads();
    if (next >= 0) retA_load(w, next, tid, kr, vr);
    f32x4 acc[8];
#pragma unroll
    for (int db = 0; db < 8; ++db) acc[db] = (f32x4){0.f, 0.f, 0.f, 0.f};
    const int q4 = fr >> 2, p4 = fr & 3;
#pragma unroll
    for (int st = 0; st < 4; ++st) {
        const int rowoff = (32 * st + 4 * fg + q4) * VP + 8 * p4;
        const bf16x8 af = cat8(tr16(Vt + rowoff + 32 * wave), tr16(Vt + rowoff + 16 * VP + 32 * wave));
#pragma unroll
        for (int db = 0; db < 8; ++db) { const bf16x8 bfr = cat8(tr16(Kt + rowoff + 32 * db), tr16(Kt + rowoff + 16 * VP + 32 * db)); acc[db] = MFMA16(af, bfr, acc[db]); }
    }
    __syncthreads();
    {
        LAS bf16_t* stg = (LAS bf16_t*)(lds + wave * 4096);
#pragma unroll
        for (int db = 0; db < 8; ++db)
#pragma unroll
            for (int r_ = 0; r_ < 4; ++r_) stg[(4 * fg + r_) * 128 + 16 * db + fr] = (bf16_t)f2bf(acc[db][r_]);
        LDS_WAIT();
        bf16_t* dst = (bf16_t*)w.kvc + (size_t)item * 16384 + (size_t)(16 * wave) * 128;
#pragma unroll
        for (int i = 0; i < 4; ++i) { const int row = 4 * i + (lane >> 4), ch = lane & 15; *(u32x4*)(dst + row * 128 + ch * 8) = *(const LAS u32x4*)(stg + row * 128 + ch * 8); }
    }
    __syncthreads();
}
__device__ __forceinline__ void ret_scan2(const Params& p, const Ws& w, int vcu, int G) {
    for (int i = vcu * 512 + opaque_tid(); i < 16 * 8192; i += G * 512) {
        const int bh = i >> 13, idx = (i & 8191) * 2, h = bh & 7;
        const float g128 = exp2f(128.0f * lg2gamma(h));
        const bf16_t* base = (const bf16_t*)w.kvc + (size_t)bh * 64 * 16384 + idx;
        bf16_t* sbase = w.sb + (size_t)bh * 64 * 16384 + idx;
        float s0 = 0.f, s1 = 0.f;
        for (int c0 = 0; c0 < 64; c0 += 16) {
            unsigned kv[16];
#pragma unroll
            for (int k = 0; k < 16; ++k) kv[k] = __builtin_nontemporal_load((const unsigned*)(base + (size_t)(c0 + k) * 16384));
#pragma unroll
            for (int k = 0; k < 16; ++k) { *(unsigned*)(sbase + (size_t)(c0 + k) * 16384) = pk2(s0, s1); s0 = s0 * g128 + bflo(kv[k]); s1 = s1 * g128 + bfhi(kv[k]); }
        }
        const int e = idx >> 7, d = idx & 127;
        __builtin_nontemporal_store(s0, p.out + O_RETP + (size_t)bh * 16384 + d * 128 + e); __builtin_nontemporal_store(s1, p.out + O_RETP + (size_t)bh * 16384 + (d + 1) * 128 + e);
    }
}
struct MergeIn { float l0, l1, l2; u32x4 a, b, c; };
__device__ __forceinline__ MergeIn merge_load(const Ws& w, int i) {
    const int m = i >> 6, c8 = (i & 63) * 8, h = c8 >> 7; MergeIn r;
    r.l0 = w.lse[((size_t)0 * MT + m) * 4 + h]; r.l1 = w.lse[((size_t)1 * MT + m) * 4 + h]; r.l2 = w.lse[((size_t)2 * MT + m) * 4 + h];
    r.a = __builtin_nontemporal_load((const u32x4*)(w.og + ((size_t)0 * MT + m) * 512 + c8)); r.b = __builtin_nontemporal_load((const u32x4*)(w.og + ((size_t)1 * MT + m) * 512 + c8));
    r.c = __builtin_nontemporal_load((const u32x4*)(w.og + ((size_t)2 * MT + m) * 512 + c8));
    return r;
}
__device__ __forceinline__ void merge_store(const Ws& w, int i, const MergeIn& r) {
    const int m = i >> 6, c8 = (i & 63) * 8;
    const float mx = fmaxf(r.l0, fmaxf(r.l1, r.l2));
    float w0 = __expf(r.l0 - mx), w1 = __expf(r.l1 - mx), w2 = __expf(r.l2 - mx);
    const float inv = 1.0f / (w0 + w1 + w2); w0 *= inv; w1 *= inv; w2 *= inv;
    const u32x4 a = r.a, b = r.b, c = r.c;
    u32x4 o;
    o.x = pk2(w0 * bflo(a.x) + w1 * bflo(b.x) + w2 * bflo(c.x), w0 * bfhi(a.x) + w1 * bfhi(b.x) + w2 * bfhi(c.x));
    o.y = pk2(w0 * bflo(a.y) + w1 * bflo(b.y) + w2 * bflo(c.y), w0 * bfhi(a.y) + w1 * bfhi(b.y) + w2 * bfhi(c.y));
    o.z = pk2(w0 * bflo(a.z) + w1 * bflo(b.z) + w2 * bflo(c.z), w0 * bfhi(a.z) + w1 * bfhi(b.z) + w2 * bfhi(c.z));
    o.w = pk2(w0 * bflo(a.w) + w1 * bflo(b.w) + w2 * bflo(c.w), w0 * bfhi(a.w) + w1 * bfhi(b.w) + w2 * bfhi(c.w));
    *(u32x4*)(w.Oatt + (size_t)m * 1024 + c8) = o;
}
__device__ __forceinline__ void attn_merge(const Ws& w, int vcu, int G) {
    const int step = G * 512, N = MT * 64;
    for (int i = vcu * 512 + opaque_tid(); i < N; i += 3 * step) {
        const int i2 = i + step, i3 = i + 2 * step; const bool t2 = i2 < N, t3 = i3 < N;
        const MergeIn r0 = merge_load(w, i), r1 = merge_load(w, t2 ? i2 : i), r2 = merge_load(w, t3 ? i3 : i);
        merge_store(w, i, r0);
        if (t2) merge_store(w, i2, r1);
        if (t3) merge_store(w, i3, r2);
    }
}
__device__ __forceinline__ void retC_load(const Ws& w, int item, int tid, u32x4 (&kr)[4], u32x4 (&vr)[4], u32x4 (&sr)[4]) {
    const int c = item & 63, bh = item >> 6, h = bh & 7, b = bh >> 3;
    const size_t m0 = (size_t)b * SEQ + c * 128;
    const bf16_t* sbp = w.sb + (size_t)item * 16384;
#pragma unroll
    for (int i = 0; i < 4; ++i) { const int cidx = tid + 512 * i, j = cidx >> 4, ch = cidx & 15;
        const bf16_t* rp = w.proj + pofs(m0 + j, h * 128 + ch * 8);
        kr[i] = __builtin_nontemporal_load((const u32x4*)(rp + (C_RK / 128) * PSLAB)); vr[i] = __builtin_nontemporal_load((const u32x4*)(rp + (C_RV / 128) * PSLAB)); sr[i] = __builtin_nontemporal_load((const u32x4*)(sbp + j * 128 + ch * 8)); }
}
__device__ __forceinline__ void retC_loadq(const Ws& w, int item, int wave, int fr, int fg, bf16x8 (&qf)[4]) {
    const int c = item & 63, bh = item >> 6, h = bh & 7, b = bh >> 3;
    const size_t mq = (size_t)b * SEQ + c * 128 + 16 * wave + fr;
#pragma unroll
    for (int ds = 0; ds < 4; ++ds) qf[ds] = __builtin_nontemporal_load((const bf16x8*)(w.proj + pofs(mq, C_RQ + h * 128 + 32 * ds + 8 * fg)));
}
__device__ __forceinline__ void retC_compute(const Params& p, const Ws& w, LAS unsigned char* lds, int item, bf16x8 (&qf)[4], int wave, int fr, int fg, int next_item, int tid, u32x4 (&kr)[4], u32x4 (&vr)[4], u32x4 (&sr)[4]) {
    const int c = item & 63, bh = item >> 6, h = bh & 7, b = bh >> 3;
    const size_t m0 = (size_t)b * SEQ + c * 128;
    const float lg2 = lg2gamma(h);
    LAS unsigned char* Kt = lds; LAS unsigned char* Vt = lds + 128 * KP; LAS unsigned char* St = Vt + 128 * VP;
    asm volatile("" : "+v"(fr), "+v"(fg));
    const int iq = 16 * wave + fr;
    const size_t mq = m0 + iq;
    f32x4 sc[8];
#pragma unroll
    for (int kb = 0; kb < 8; ++kb) {
        if (kb <= wave) {
            f32x4 a = (f32x4){0.f, 0.f, 0.f, 0.f};
#pragma unroll
            for (int ds = 0; ds < 4; ++ds) { const bf16x8 kf = *(const LAS bf16x8*)(Kt + (16 * kb + fr) * KP + (32 * ds + 8 * fg) * 2); a = MFMA16(kf, qf[ds], a); }
#pragma unroll
            for (int r_ = 0; r_ < 4; ++r_) { const int dj = iq - (16 * kb + 4 * fg + r_); a[r_] = (dj >= 0) ? a[r_] * QK_SCALE * exp2f((float)dj * lg2) : 0.f; }
            sc[kb] = a;
        } else sc[kb] = (f32x4){0.f, 0.f, 0.f, 0.f};
    }
    f32x4 y[8], cr[8];
#pragma unroll
    for (int eb = 0; eb < 8; ++eb) { y[eb] = (f32x4){0.f, 0.f, 0.f, 0.f}; cr[eb] = (f32x4){0.f, 0.f, 0.f, 0.f}; }
    const int q4 = fr >> 2, p4 = fr & 3;
#pragma unroll
    for (int st = 0; st < 4; ++st) {
        if (2 * st <= wave) {
            const bf16x8 pf = pack8(sc[2 * st], sc[2 * st + 1]);
            const LAS unsigned char* v0 = Vt + (32 * st + 4 * fg + q4) * VP + 8 * p4;
#pragma unroll
            for (int eb = 0; eb < 8; ++eb) y[eb] = MFMA16(cat8(tr16(v0 + 32 * eb), tr16(v0 + 16 * VP + 32 * eb)), pf, y[eb]);
        }
    }
#pragma unroll
    for (int eb = 0; eb < 8; ++eb)
#pragma unroll
        for (int ds = 0; ds < 4; ++ds) { const bf16x8 sf = *(const LAS bf16x8*)(St + (16 * eb + fr) * KP + (32 * ds + 8 * fg) * 2); cr[eb] = MFMA16(sf, qf[ds], cr[eb]); }
    if (next_item >= 0) { retC_load(w, next_item, tid, kr, vr, sr); retC_loadq(w, next_item, wave, fr, fg, qf); }
    const float qd = exp2f((float)(iq + 1) * lg2);
    float s = 0.f;
#pragma unroll
    for (int eb = 0; eb < 8; ++eb) { y[eb] = y[eb] + cr[eb] * qd; s += (y[eb][0] + y[eb][1]) + (y[eb][2] + y[eb][3]); }
    s += __shfl_xor(s, 16); s += __shfl_xor(s, 32);
    const float mean = s * (1.0f / 128.0f);
    float v = 0.f;
#pragma unroll
    for (int eb = 0; eb < 8; ++eb) { y[eb] = y[eb] - mean; v += (y[eb][0] * y[eb][0] + y[eb][1] * y[eb][1]) + (y[eb][2] * y[eb][2] + y[eb][3] * y[eb][3]); }
    v += __shfl_xor(v, 16); v += __shfl_xor(v, 32);
    const float rstd = rsqrtf(v * (1.0f / 128.0f) + EPS);
    const float* gn = p.in[9] + h * 128 + 4 * fg;
    const bf16_t* grow = w.proj + pofs(mq, C_RG + h * 128 + 4 * fg);
    bf16_t* orow = w.G + mq * 1024 + h * 128 + 4 * fg;
#pragma unroll
    for (int eb = 0; eb < 8; ++eb) { const f32x4 gv = *(const f32x4*)(gn + 16 * eb); const u32x2 sg = __builtin_nontemporal_load((const u32x2*)(grow + 16 * eb));
        u32x2 ov; ov.x = pk2(y[eb][0] * rstd * gv[0] * bflo(sg.x), y[eb][1] * rstd * gv[1] * bfhi(sg.x)); ov.y = pk2(y[eb][2] * rstd * gv[2] * bflo(sg.y), y[eb][3] * rstd * gv[3] * bfhi(sg.y));
        *(u32x2*)(orow + 16 * eb) = ov; }
}
__device__ __forceinline__ void retC_phase(const Params& p, const Ws& w, LAS unsigned char* lds, int vcu, int G) {
    const int tid = opaque_tid(), lane = tid & 63, wave = __builtin_amdgcn_readfirstlane(tid >> 6), fr = lane & 15, fg = lane >> 4;
    if (vcu >= 1024) return;
    LAS unsigned char* Kt = lds; LAS unsigned char* Vt = lds + 128 * KP; LAS unsigned char* St = Vt + 128 * VP;
    u32x4 kr[4], vr[4], sr[4]; bf16x8 qf[4];
    retC_load(w, vcu, tid, kr, vr, sr); retC_loadq(w, vcu, wave, fr, fg, qf);
    for (int item = vcu; item < 1024; item += G) {
        __syncthreads();
#pragma unroll
        for (int i = 0; i < 4; ++i) { const int cidx = tid + 512 * i, j = cidx >> 4, ch = cidx & 15;
            *(LAS u32x4*)(Kt + j * KP + ch * 16) = kr[i]; *(LAS u32x4*)(Vt + j * VP + ch * 16) = vr[i]; *(LAS u32x4*)(St + j * KP + ch * 16) = sr[i]; }
        __syncthreads();
        retC_compute(p, w, lds, item, qf, wave, fr, fg, (item + G < 1024) ? item + G : -1, tid, kr, vr, sr);
    }
    __syncthreads();
}

__device__ __forceinline__ void panel_arrive_wait(unsigned* cnt, unsigned want);
__device__ __forceinline__ void sg_accum(f32x4 (&acc)[2][4], const bf16_t* A, int lda, const bf16_t* Bt, int K, int r0, int n0, int wave, int fr, int fq, int ldb = 0) {
    if (ldb == 0) ldb = K;
    const int kw = K / 8, k0 = wave * kw;
    const bf16_t* ap = A + (size_t)(r0 + fr) * lda + k0 + 8 * fq;
    const bf16_t* bp = Bt + (size_t)(n0 + fr) * ldb + k0 + 8 * fq;
    int ks = 0;
    for (; ks + 128 <= kw; ks += 128) {
        bf16x8 a[4][2], b[4][4];
#pragma unroll
        for (int s = 0; s < 4; ++s) {
#pragma unroll
            for (int i = 0; i < 2; ++i) a[s][i] = *(const bf16x8*)(ap + (size_t)(16 * i) * lda + ks + 32 * s);
#pragma unroll
            for (int j = 0; j < 4; ++j) b[s][j] = *(const bf16x8*)(bp + (size_t)(16 * j) * ldb + ks + 32 * s);
        }
#pragma unroll
        for (int s = 0; s < 4; ++s)
#pragma unroll
            for (int i = 0; i < 2; ++i)
#pragma unroll
                for (int j = 0; j < 4; ++j) acc[i][j] = MFMA16(b[s][j], a[s][i], acc[i][j]);
    }
    for (; ks < kw; ks += 64) {
        bf16x8 a[2][2], b[2][4];
#pragma unroll
        for (int s = 0; s < 2; ++s) {
#pragma unroll
            for (int i = 0; i < 2; ++i) a[s][i] = *(const bf16x8*)(ap + (size_t)(16 * i) * lda + ks + 32 * s);
#pragma unroll
            for (int j = 0; j < 4; ++j) b[s][j] = *(const bf16x8*)(bp + (size_t)(16 * j) * ldb + ks + 32 * s);
        }
#pragma unroll
        for (int s = 0; s < 2; ++s)
#pragma unroll
            for (int i = 0; i < 2; ++i)
#pragma unroll
                for (int j = 0; j < 4; ++j) acc[i][j] = MFMA16(b[s][j], a[s][i], acc[i][j]);
    }
}
template <int MODE>
__device__ __forceinline__ void sample_gemm(const Params& p, const Ws& w, LAS unsigned char* lds, int vcu, int G) {
    const int tid = opaque_tid(), lane = tid & 63, wave = __builtin_amdgcn_readfirstlane(tid >> 6), fr = lane & 15, fq = lane >> 4;
    LAS f32x4* red = (LAS f32x4*)lds;
    for (int unit = vcu; unit < 256; unit += G) {
        const int rg = (unit & 31) >> 2, r0 = rg * 32, n0 = ((unit >> 5) * 4 + (unit & 3)) * 64;
        f32x4 acc[2][4];
#pragma unroll
        for (int i = 0; i < 2; ++i)
#pragma unroll
            for (int j = 0; j < 4; ++j) acc[i][j] = (f32x4){0.f, 0.f, 0.f, 0.f};
        if (MODE == 5) {
            sg_accum(acc, w.G + (size_t)MP * 1024, 1024, w.Wt_reto, 1024, r0, n0, wave, fr, fq);
            f32x4 acc2[2][4];
#pragma unroll
            for (int i = 0; i < 2; ++i)
#pragma unroll
                for (int j = 0; j < 4; ++j) acc2[i][j] = (f32x4){0.f, 0.f, 0.f, 0.f};
            sg_accum(acc2, w.Oatt + (size_t)MP * 1024, 1024, w.Wt_atto, 512, r0, n0, wave, fr, fq, 1024);
#pragma unroll
            for (int i = 0; i < 2; ++i)
#pragma unroll
                for (int j = 0; j < 4; ++j) { const unsigned char* gp = w.g8 + (size_t)(MP + r0 + 16 * i + fr) * 4096 + n0 + 16 * j + 4 * fq;
                    acc[i][j] = acc[i][j] * dec8x4(*(const unsigned*)gp) + acc2[i][j] * dec8x4(*(const unsigned*)(gp + 2048)); }
        } else if (MODE == 6) sg_accum(acc, w.merged + (size_t)MP * DM, DM, w.Wt_o, DM, r0, n0, wave, fr, fq);
        else sg_accum(acc, w.act + (size_t)MP * FF, FF, w.Wt_down, FF, r0, n0, wave, fr, fq);
        __syncthreads();
#pragma unroll
        for (int i = 0; i < 2; ++i)
#pragma unroll
            for (int j = 0; j < 4; ++j) red[(wave * 8 + i * 4 + j) * 64 + lane] = acc[i][j];
        __syncthreads();
        const int blk = tid >> 6;
        f32x4 v = red[blk * 64 + lane];
#pragma unroll
        for (int ww = 1; ww < 8; ++ww) v += red[(ww * 8 + blk) * 64 + lane];
        const int row = MP + r0 + 16 * (blk >> 2) + fr, col = n0 + 16 * (blk & 3) + 4 * fq;
        if (MODE == 5) { u32x2 o; o.x = pk2(v[0], v[1]); o.y = pk2(v[2], v[3]); *(u32x2*)(w.merged + (size_t)row * DM + col) = o; }
        else if (MODE == 6) {
            { const u32x2 xv = *(const u32x2*)(w.xb + (size_t)row * DM + col); const float xs_ = w.rstd1[row]; v[0] += bflo(xv.x) * xs_; v[1] += bfhi(xv.x) * xs_; v[2] += bflo(xv.y) * xs_; v[3] += bfhi(xv.y) * xs_; }
            u32x2 o; o.x = pk2(v[0], v[1]); o.y = pk2(v[2], v[3]); *(u32x2*)(w.xb + (size_t)row * DM + col) = o;
            atomicAdd(w.sumsq2 + row, (v[0] * v[0] + v[1] * v[1]) + (v[2] * v[2] + v[3] * v[3]));
        } else {
            float* dst = p.out + O_Y + (size_t)row * DM + col;
            { const u32x2 xv = *(const u32x2*)(w.xb + (size_t)row * DM + col); v[0] += bflo(xv.x); v[1] += bfhi(xv.x); v[2] += bflo(xv.y); v[3] += bfhi(xv.y); }
            atomicAdd(w.sumsq3 + row, (v[0] * v[0] + v[1] * v[1]) + (v[2] * v[2] + v[3] * v[3]));
            asm volatile("s_waitcnt vmcnt(0)" ::: "memory"); __syncthreads();
            if (tid == 0) panel_arrive_wait((unsigned*)(p.ws + WS_PCNT) + 16 * (64 + rg), 32u);
            __syncthreads();
            const float rs = rsqrtf(__hip_atomic_load(w.sumsq3 + row, __ATOMIC_RELAXED, __HIP_MEMORY_SCOPE_AGENT) * (1.0f / DM) + EPS);
            __builtin_nontemporal_store(v * rs * *(const f32x4*)(p.in[18] + col), (f32x4*)dst);
        }
        __syncthreads();
    }
}

#define XB_TMO      128
#define XB_XCNT(j)  (256  + 64 * (j))
#define XB_XSUB(j)  (1280 + 64 * (j))
#define XB_XGEN(j)  (2304 + 64 * (j))
#define XB_TOP      3328
#define XB_TOPGEN   3392
#define XCD_BAR_WORDS 3456
#define XB_SPIN_CAP (1u << 18)
__device__ __forceinline__ unsigned xb_ld(unsigned* p)              { return __hip_atomic_load(p, __ATOMIC_RELAXED, __HIP_MEMORY_SCOPE_AGENT); }
__device__ __forceinline__ unsigned xb_add(unsigned* p, unsigned v) { return __hip_atomic_fetch_add(p, v, __ATOMIC_RELAXED, __HIP_MEMORY_SCOPE_AGENT); }
__device__ __forceinline__ unsigned xb_xcc_id() { return (unsigned)__builtin_amdgcn_s_getreg((3 << 11) | 20) & 0xFu; }
#define XB_SPIN(cond, bar) do { unsigned _sp = 0; while (cond) { __builtin_amdgcn_s_sleep(1); \
    if ((++_sp & 255u) == 0u) { if (xb_ld(&(bar)[XB_TMO])) break; if (_sp > XB_SPIN_CAP) { atomicAdd(&(bar)[XB_TMO], 1u); break; } } } } while (0)
struct XcdBarrier { unsigned* bar; unsigned x; volatile LAS unsigned* st; };
__device__ __forceinline__ XcdBarrier xcd_barrier_post(unsigned* bar, volatile LAS unsigned* st) {
    XcdBarrier b; b.bar = bar; b.x = xb_xcc_id(); b.st = st;
    if (threadIdx.x == 0) (void)xb_add(&bar[XB_XCNT(b.x)], 1u);
    return b;
}
__device__ __forceinline__ void xcd_barrier_complete(unsigned* bar, unsigned x, unsigned& nloc, unsigned& nx) {
    const unsigned G = gridDim.x * gridDim.y * gridDim.z;
    unsigned sum, cnt, mine, sp = 0u;
    for (;;) {
        sum = 0u; cnt = 0u; mine = 0u;
#pragma unroll
        for (unsigned j = 0; j < 16; ++j) { const unsigned c = xb_ld(&bar[XB_XCNT(j)]); sum += c; cnt += (c > 0u) ? 1u : 0u; mine = (j == x) ? c : mine; }
        if (sum == G) break;
        __builtin_amdgcn_s_sleep(1);
        if ((++sp & 255u) == 0u) { if (xb_ld(&bar[XB_TMO])) break; if (sp > XB_SPIN_CAP) { atomicAdd(&bar[XB_TMO], 1u); break; } }
    }
    nloc = mine > 0u ? mine : 1u; nx = cnt > 0u ? cnt : 1u;
}
__device__ __forceinline__ void xcd_barrier(const XcdBarrier& b) {
    asm volatile("s_waitcnt vmcnt(0)" ::: "memory");
    __syncthreads();
    if (threadIdx.x == 0) {
        unsigned* bar = b.bar;
        __builtin_amdgcn_s_waitcnt(0);
        unsigned nloc = b.st[0], nx = b.st[1];
        if (nloc == 0u) { xcd_barrier_complete(bar, b.x, nloc, nx); b.st[0] = nloc; b.st[1] = nx; }
        const unsigned old = xb_add(&bar[XB_XSUB(b.x)], 1u);
        const unsigned gen = old / nloc;
        if (old + 1u == (gen + 1u) * nloc) {
            __builtin_amdgcn_fence(__ATOMIC_RELEASE, "agent");
            asm volatile("s_waitcnt vmcnt(0)" ::: "memory");
            const unsigned og = xb_add(&bar[XB_TOP], 1u);
            const unsigned tg = og / nx;
            if (og + 1u == (tg + 1u) * nx) xb_add(&bar[XB_TOPGEN], 1u);
            else XB_SPIN(xb_ld(&bar[XB_TOPGEN]) == tg, bar);
            __builtin_amdgcn_fence(__ATOMIC_ACQUIRE, "agent");
            xb_add(&bar[XB_XGEN(b.x)], 1u);
            asm volatile("s_waitcnt vmcnt(0)" ::: "memory");
        } else {
            XB_SPIN(xb_ld(&bar[XB_XGEN(b.x)]) == gen, bar);
            __builtin_amdgcn_fence(__ATOMIC_ACQUIRE, "agent");
            asm volatile("s_waitcnt vmcnt(0)" ::: "memory");
        }
    }
    __syncthreads();
}

constexpr int LDS_BYTES = 147456;
constexpr int LDS_BARST = 143360;
constexpr int NPHASE = 12;
__global__ void __launch_bounds__(512, 2) fwd_kernel(Params p) {
    extern __shared__ __attribute__((aligned(16))) unsigned char lds_raw[];
    LAS unsigned char* lds = (LAS unsigned char*)lds_raw;
    const Ws w = make_ws(p.ws);
    const int G = gridDim.x; const int bx = blockIdx.x;
    const int vcu = (G % 8 == 0) ? (bx % 8) * (G / 8) + bx / 8 : bx;
    const int lo = p.ph_lo, hi = p.ph_hi;
    volatile LAS unsigned* barst = (volatile LAS unsigned*)(lds + LDS_BARST);
    if (threadIdx.x < 2) barst[threadIdx.x] = 0u;
    __syncthreads();
    XcdBarrier bar = xcd_barrier_post((unsigned*)(p.ws + WS_BAR), barst);
#define IN(k) (lo <= (k) && (k) < hi)
    if (lo < 0) cg::this_grid().sync();
#define SEAM(k) do { if (IN(k) && IN((k) + 1)) xcd_barrier(bar); } while (0)
    if (IN(0)) { weight_transposes<0>(p, w, lds, vcu, G); p0_xconv(p, w, lds, vcu, G);
        if (KVSLACK < 100) kv_copy_range(p, KV_SPLIT, KV_TOTAL, vcu, G); } SEAM(0);
    const size_t kv_s1 = KV_SPLIT / 100 * 20;
    const int n1 = (65 * 50) % G, n7 = (67 * 44) % G;
    if (IN(1)) {
        pg8::Gemm g{w.xb, w.Wt_in, MT, INC, DM}; pg8::StaticOrder S; S.init(MT, INC, G, bx); EpiIn E{w, p.out};
        pg8::gemm_phase<EpiIn, pg8::StaticOrder, true, true>(lds, g, S, E);
        if (n1 == 0) { weight_transposes<1>(p, w, lds, vcu, G); kv_copy_range(p, 0, kv_s1, vcu, G); } else if (bx >= n1) { weight_transposes<1>(p, w, lds, bx - n1, G - n1); kv_copy_range(p, 0, kv_s1, bx - n1, G - n1); } } SEAM(1);
    if (vcu & 1) { if (IN(5)) { attn_sample(p, w, lds, vcu, G); __syncthreads(); } if (IN(4)) { ret_sample(p, w, lds, vcu, G); __syncthreads(); } }
    { const int per = (1536 + G - 1) / G;
      if (IN(2)) attn_phase(w, lds, vcu * per, min(per, 1536 - vcu * per)); }
    if (IN(3)) { u32x4 kr[4], vr[4]; if (vcu < 1024) retA_load(w, vcu, opaque_tid(), kr, vr);
        for (int it = vcu; it < 1024; it += G) retA_item(w, lds, it, it + G < 1024 ? it + G : -1, kr, vr); }
    if (!(vcu & 1)) { if (IN(4)) { ret_sample(p, w, lds, vcu, G); __syncthreads(); } if (IN(5)) { attn_sample(p, w, lds, vcu, G); } } SEAM(5);
    if (IN(6)) { ret_scan2(p, w, vcu, G); attn_merge(w, vcu, G); } SEAM(6);
    if (IN(7)) { retC_phase(p, w, lds, vcu, G); } SEAM(7);
    if (IN(8)) {
        { pg8::Gemm g{w.G, w.Wt_reto, MP, DM, 1024}; pg8::SegOrder S; S.base.init(MP, DM, G, bx); S.A1 = w.Oatt; S.B1t = w.Wt_atto; S.nt0 = 16; S.nt1 = 8; EpiP5 E{w};
          pg8::gemm_phase<EpiP5, pg8::SegOrder, true, true>(lds, g, S, E); }
        sample_gemm<5>(p, w, lds, vcu, G); } SEAM(8);
    if (IN(9)) { pg8::Gemm g{w.merged, w.Wt_o, MP, DM, DM}; pg8::StaticOrder S; S.init(MP, DM, G, bx); EpiWo E{w};
        pg8::gemm_phase<EpiWo, pg8::StaticOrder, true, true>(lds, g, S, E);
        sample_gemm<6>(p, w, lds, vcu, G); } SEAM(9);
    if (IN(10)) {
        pg8::Gemm g{w.xb, w.Wt_up, MT, F2, DM}; pg8::UpOrder S; S.init_up(G, bx); EpiUp E{w, p.out, p.in[15], p.in[16], p.in[6]};
        pg8::gemm_phase<EpiUp, pg8::UpOrder, true, true>(lds, g, S, E);
        if (n7 == 0) { weight_transposes<2>(p, w, lds, vcu, G); kv_copy_range(p, kv_s1, KV_SPLIT, vcu, G); } else if (bx >= n7) { weight_transposes<2>(p, w, lds, bx - n7, G - n7); kv_copy_range(p, kv_s1, KV_SPLIT, bx - n7, G - n7); } } SEAM(10);
    if (IN(11)) { pg8::Gemm g{w.act, w.Wt_down, MP, DM, FF}; pg8::PanelOrder S{vcu}; EpiFin E{w, p.out, p.in[18], (unsigned*)(p.ws + WS_PCNT)};
        pg8::gemm_phase<EpiFin, pg8::PanelOrder, true, true>(lds, g, S, E);
        sample_gemm<8>(p, w, lds, vcu, G); }
#undef IN
#undef SEAM
}

extern "C" void kernel_launch(void* const* d_in, const int* in_sizes, int n_in, void* d_out, int out_size, void* d_ws, size_t ws_size, hipStream_t stream) {
    static int grid = 0;
    if (grid == 0) {
        if (n_in != 19 || (size_t)out_size != O_END || ws_size < WS_END) { fprintf(stderr, "kernel_launch: unexpected shapes: n_in %d out %d ws %zu\n", n_in, out_size, ws_size); grid = -1; return; }
        int dev = 0, cus = 0;
        if (hipGetDevice(&dev) != hipSuccess || hipDeviceGetAttribute(&cus, hipDeviceAttributeMultiprocessorCount, dev) != hipSuccess) { fprintf(stderr, "kernel_launch: device query failed\n"); grid = -1; return; }
        if (hipFuncSetAttribute((const void*)fwd_kernel, hipFuncAttributeMaxDynamicSharedMemorySize, LDS_BYTES) != hipSuccess) { fprintf(stderr, "kernel_launch: cannot get %d bytes of LDS\n", LDS_BYTES); grid = -1; return; }
        int per_cu = 0;
        if (hipOccupancyMaxActiveBlocksPerMultiprocessor(&per_cu, (const void*)fwd_kernel, 512, LDS_BYTES) != hipSuccess || per_cu < 1) fprintf(stderr, "kernel_launch: occupancy query says %d blocks/CU\n", per_cu);
        (void)hipGetLastError();
        grid = cus;
        if (grid != 256) { fprintf(stderr, "kernel_launch: this kernel is laid out for 256 CUs, device has %d\n", cus); grid = -1; return; }
    }
    if (grid < 0) return;
    if (hipMemsetAsync((char*)d_ws + WS_BAR, 0, 32768, stream) != hipSuccess) { fprintf(stderr, "kernel_launch: memset failed\n"); return; }
    Params p{};
    for (int i = 0; i < 19; ++i) p.in[i] = (const float*)d_in[i];
    p.out = (float*)d_out; p.ws = (unsigned char*)d_ws;
    p.ph_lo = 0; p.ph_hi = NPHASE;
    void* args[] = {&p};
    hipError_t e = hipLaunchCooperativeKernel((const void*)fwd_kernel, dim3(grid), dim3(512), args, LDS_BYTES, stream);
    if (e != hipSuccess) fprintf(stderr, "cooperative launch failed: %s (grid %d)\n", hipGetErrorString(e), grid);
}
```

```cpp
#include <hip/hip_runtime.h>
#include <hip/hip_cooperative_groups.h>
#include <cstdio>
#include <cstdint>
namespace cg = cooperative_groups;

#define LAS __attribute__((address_space(3)))
typedef unsigned short bf16_t;
typedef short bf16x8 __attribute__((ext_vector_type(8)));
typedef float f32x4 __attribute__((ext_vector_type(4)));
typedef float f32x2 __attribute__((ext_vector_type(2)));
typedef unsigned u32x4 __attribute__((ext_vector_type(4)));
typedef unsigned u32x2 __attribute__((ext_vector_type(2)));

constexpr int DM = 2048, SEQ = 8192, MP = 16384, MS = 256, MT = MP + MS;
constexpr int INC = 12800, FF = 5632, F2 = 11264;
constexpr int C_RQ = 0, C_RK = 1024, C_RV = 2048, C_RG = 3072, C_ATT = 4096, C_GR = 8704, C_GA = 10752;
constexpr float EPS = 1e-6f;
constexpr float QK_SCALE = 0.08838834764831845f;
constexpr size_t O_Y = 0;
constexpr size_t O_RETP = 34078720, O_RETS = 34340864;
constexpr size_t O_KV128P = 38535168, O_KV128S = 38797312, O_KV512P = 42991616, O_KV512S = 44040192, O_KV2048P = 60817408, O_KV2048S = 65011712;
constexpr size_t O_CONVP = 132120576, O_CONVS = 132165632, O_END = 132886528;
constexpr size_t MiB = 1u << 20;
constexpr size_t WS_CTL = 0;
constexpr size_t WS_WIN = 1 * MiB, WS_WRETO = 51 * MiB, WS_WATTO = 55 * MiB, WS_WO = 57 * MiB, WS_WUP = 65 * MiB, WS_WDOWN = 109 * MiB;
constexpr size_t WS_XB = 131 * MiB;
constexpr size_t WS_PROJ = 196 * MiB;
constexpr size_t WS_KVC = 603 * MiB;
constexpr size_t WS_SB = 667 * MiB;
constexpr size_t WS_G = 699 * MiB;
constexpr size_t WS_OG = 732 * MiB;
constexpr size_t WS_LSE = 781 * MiB;
constexpr size_t WS_OATT = 930 * MiB;
constexpr size_t WS_MERGED = 799 * MiB;
constexpr size_t WS_ACT = 603 * MiB;
constexpr size_t WS_G8 = 864 * MiB;
constexpr size_t WS_WATTO_P = 964 * MiB;
constexpr size_t WS_END = 968 * MiB;
constexpr size_t WS_BAR = 512 * 1024;
constexpr size_t WS_PCNT = WS_BAR + 16384;

struct Params {
    const float* in[19];
    float* out;
    unsigned char* ws;
    int ph_lo, ph_hi, dummy, pad;
};

constexpr size_t PSLAB = (size_t)MT * 128;
__device__ __forceinline__ size_t pofs(size_t row, int col) { return ((size_t)(col >> 7) * MT + row) * 128 + (col & 127); }
__device__ __forceinline__ float bflo(unsigned w) { return __uint_as_float(w << 16); }
__device__ __forceinline__ float bfhi(unsigned w) { return __uint_as_float(w & 0xffff0000u); }
__device__ __forceinline__ float bf2f(bf16_t b) { return __uint_as_float((unsigned)b << 16); }
__device__ __forceinline__ unsigned f2bf(float f) { unsigned u = __float_as_uint(f); return (u + 0x7fffu + ((u >> 16) & 1u)) >> 16; }
typedef __bf16 bf16x2_t __attribute__((ext_vector_type(2)));
__device__ __forceinline__ unsigned pk2(float lo, float hi) { f32x2 v = {lo, hi}; bf16x2_t b = __builtin_convertvector(v, bf16x2_t); return __builtin_bit_cast(unsigned, b); }
__device__ __forceinline__ unsigned enc8(float s) { const unsigned c = (unsigned)(s * 256.0f); return c > 255u ? 255u : c; }
__device__ __forceinline__ unsigned enc8x4(f32x4 s) {
    return enc8(s[0]) | (enc8(s[1]) << 8) | (enc8(s[2]) << 16) | (enc8(s[3]) << 24);
}
__device__ __forceinline__ f32x4 dec8x4(unsigned c) { return ((f32x4){(float)(c & 255u), (float)((c >> 8) & 255u), (float)((c >> 16) & 255u), (float)(c >> 24)} + 0.5f) * (1.0f / 256.0f); }
__device__ __forceinline__ float wave_sum(float v) {
#pragma unroll
    for (int o = 1; o < 64; o <<= 1) v += __shfl_xor(v, o);
    return v;
}
__device__ __forceinline__ float wave_max(float v) {
#pragma unroll
    for (int o = 1; o < 64; o <<= 1) v = fmaxf(v, __shfl_xor(v, o));
    return v;
}
__device__ __forceinline__ unsigned sigcode(float v) { return (unsigned)__builtin_amdgcn_rcpf(__builtin_amdgcn_exp2f(fmaf(v, -1.4426950408889634f, -7.99994364f)) + (1.0f / 255.99f)); }
__device__ __forceinline__ unsigned sigcode4(f32x4 s) { return sigcode(s[0]) | (sigcode(s[1]) << 8) | (sigcode(s[2]) << 16) | (sigcode(s[3]) << 24); }
__device__ __forceinline__ float sigmoidf_(float v) { return __builtin_amdgcn_rcpf(1.0f + __builtin_amdgcn_exp2f(v * -1.4426950408889634f)); }
#define LDS_WAIT() asm volatile("s_waitcnt lgkmcnt(0)" ::: "memory")
__device__ __forceinline__ int opaque_tid() { int t = threadIdx.x; asm volatile("" : "+v"(t)); return t; }

namespace pg8 {
#define PG8_LAS __attribute__((address_space(3)))
constexpr int BM = 256, BK = 64, HALF = 128, HTB = HALF * BK * 2, STAGE_BYTES = 8 * HTB, NXCD = 8, WGM = 4;
__host__ __device__ __forceinline__ int lds_byte(int r, int c) { const int st = (r >> 4) * 2 + (c >> 5), rr = r & 15, cc = c & 31, ob = rr * 64 + cc * 2; return st * 1024 + (ob ^ (((ob >> 9) & 1) << 5)); }
__host__ __device__ __forceinline__ void stage_rc(int b, int& R, int& C) { const int st = b / 1024, sb = b % 1024, swz = sb ^ (((sb >> 9) & 1) << 5); R = (st >> 1) * 16 + swz / 64; C = (st & 1) * 32 + (swz % 64) / 2; }
__host__ __device__ __forceinline__ int perm32(int rho) { const int n = rho >> 4, i = rho & 15; return 8 * (i >> 2) + 4 * n + (i & 3); }
struct Unit { int pm, pn, seg; };
struct Gemm { const bf16_t* A; const bf16_t* Bt; int M, N, K; };
struct StaticOrder {
    int nM, nN, nwg, G, c, pmul;
    __host__ __device__ void init(int M, int N, int G_, int c_) { nM = M / BM; nN = N / BM; nwg = nM * nN; G = G_; c = c_; pmul = 1; }
    __host__ __device__ bool next(int i, Unit& u) const {
        const long L = (long)i * G + c; if (L >= nwg) return false;
        int wgid = (int)L; { const int q = nwg / NXCD, r = nwg % NXCD, xcd = wgid % NXCD, off = wgid / NXCD; wgid = (xcd < r ? xcd * (q + 1) : r * (q + 1) + (xcd - r) * q) + off; }
        const int nig = WGM * nN, gid = wgid / nig, fm = gid * WGM, gsz = (nM - fm) < WGM ? (nM - fm) : WGM;
        u.pm = fm + ((wgid % nig) % gsz); u.pn = (((wgid % nig) / gsz) * pmul) % nN; u.seg = 0; return true;
    }
    __device__ __forceinline__ void a_ready(const Unit&) const {}
    __device__ __forceinline__ void done(const Unit&) const {}
    __device__ __forceinline__ long a_off(const Unit& u, int K) const { return (long)u.pm * 256 * K * 2; }
    __device__ __forceinline__ const char* a_ptr(const Gemm& g, const Unit& u) const { return (const char*)g.A + a_off(u, g.K); }
    __device__ __forceinline__ const char* b_ptr(const Gemm& g, const Unit& u) const { return (const char*)g.Bt + (size_t)u.pn * 256 * g.K * 2; }
    __device__ __forceinline__ int nt(const Gemm& g, const Unit&) const { return g.K / BK; }
    __device__ __forceinline__ bool keep(const Unit&) const { return false; }
};
struct SegOrder {
    StaticOrder base; const bf16_t* A1; const bf16_t* B1t; int nt0, nt1;
    __device__ __forceinline__ bool next(int i, Unit& u) const { if (!base.next(i >> 1, u)) return false; u.seg = i & 1; return true; }
    __device__ __forceinline__ void a_ready(const Unit&) const {}
    __device__ __forceinline__ void done(const Unit&) const {}
    __device__ __forceinline__ const char* a_ptr(const Gemm& g, const Unit& u) const { return (const char*)(u.seg ? A1 : g.A) + (size_t)u.pm * 256 * g.K * 2; }
    __device__ __forceinline__ const char* b_ptr(const Gemm& g, const Unit& u) const { return (const char*)(u.seg ? B1t : g.Bt) + (size_t)u.pn * 256 * g.K * 2; }
    __device__ __forceinline__ int nt(const Gemm&, const Unit& u) const { return u.seg ? nt1 : nt0; }
    __device__ __forceinline__ bool keep(const Unit& u) const { return u.seg == 0; }
};
struct PanelOrder {
    int v;
    __device__ __forceinline__ bool next(int i, Unit& u) const { if (i >= 2) return false; u.pm = i * 32 + (v >> 3); u.pn = v & 7; u.seg = 0; return true; }
    __device__ __forceinline__ void a_ready(const Unit&) const {}
    __device__ __forceinline__ void done(const Unit&) const {}
    __device__ __forceinline__ const char* a_ptr(const Gemm& g, const Unit& u) const { return (const char*)g.A + (size_t)u.pm * 256 * g.K * 2; }
    __device__ __forceinline__ const char* b_ptr(const Gemm& g, const Unit& u) const { return (const char*)g.Bt + (size_t)u.pn * 256 * g.K * 2; }
    __device__ __forceinline__ int nt(const Gemm& g, const Unit&) const { return g.K / BK; }
    __device__ __forceinline__ bool keep(const Unit&) const { return false; }
};
struct UpOrder : StaticOrder {
    __host__ __device__ void init_up(int G_, int c_) { nM = 67; nN = 44; nwg = nM * nN; G = G_; c = c_; pmul = 1; }
    __device__ __forceinline__ long a_off(const Unit& u, int K) const { const int row0 = (u.pm < 66) ? (u.pm / 33) * 8192 + 254 * (u.pm % 33) - 2 : 16384; return (long)row0 * K * 2; }
    __device__ __forceinline__ const char* a_ptr(const Gemm& g, const Unit& u) const { return (const char*)g.A + a_off(u, g.K); }
};

template <class Epi, class Sched, bool ALIGN_EPI = false, bool SP2 = false>
__device__ __forceinline__ void gemm_phase(PG8_LAS unsigned char* lds, const Gemm g, const Sched& S, const Epi& E) {
    const int tid = opaque_tid(), wid = __builtin_amdgcn_readfirstlane(tid >> 6), lane = tid & 63, wr = wid >> 2, wc = wid & 3, fr = lane & 15, fq = lane >> 4;
    const int K = g.K;
    unsigned voffA[2], voffB[2];
#pragma unroll
    for (int i = 0; i < 2; ++i) { int R, C; stage_rc(tid * 16 + i * 8192, R, C); const int Rb = Epi::PERM ? ((R & ~31) + perm32(R & 31)) : R;
        const int Ra = Epi::APERM ? ((R & ~63) + 4 * (R & 15) + ((R >> 4) & 3)) : R;
        voffA[i] = (unsigned)(Ra * K + C) * 2u; voffB[i] = (unsigned)(Rb * K + C) * 2u; }
    const size_t kstep = (size_t)(BK * 2);
    const size_t hstep = (size_t)HALF * K * 2;
    const unsigned ldsw = (unsigned)wid * 1024u;
    const int aoff = lds_byte(wr * 64 + fr, fq * 8), boff = lds_byte(wc * 32 + fr, fq * 8);
#define PG8_SA(b, h) (((b) * 2 + (h)) * HTB)
#define PG8_SB(b, h) ((4 + (b) * 2 + (h)) * HTB)
#define PG8_STAGE(bufoff, gbase, voff) do { _Pragma("unroll") for (int _i = 0; _i < 2; ++_i) \
        __builtin_amdgcn_global_load_lds((const unsigned*)((const char*)(gbase) + (voff)[_i]), (PG8_LAS unsigned*)(lds + (bufoff) + ldsw + _i * 8192), 16, 0, 0); } while (0)
#define PG8_LDA(dst, b, h) do { _Pragma("unroll") for (int m = 0; m < 4; ++m) _Pragma("unroll") for (int k = 0; k < 2; ++k) dst[m][k] = *(const PG8_LAS bf16x8*)(lds + PG8_SA(b, h) + aoff + m * 2048 + k * 1024); } while (0)
#define PG8_LDB(dst, b, h) do { _Pragma("unroll") for (int n = 0; n < 2; ++n) _Pragma("unroll") for (int k = 0; k < 2; ++k) dst[n][k] = *(const PG8_LAS bf16x8*)(lds + PG8_SB(b, h) + boff + n * 2048 + k * 1024); } while (0)
#define PG8_MMA(ai, bj, At, Bt) do { __builtin_amdgcn_s_setprio(1); _Pragma("unroll") for (int m = 0; m < 4; ++m) _Pragma("unroll") for (int n = 0; n < 2; ++n) _Pragma("unroll") for (int k = 0; k < 2; ++k) \
        acc[ai][bj][m][n] = __builtin_amdgcn_mfma_f32_16x16x32_bf16(Bt[n][k], At[m][k], acc[ai][bj][m][n], 0, 0, 0); __builtin_amdgcn_s_setprio(0); } while (0)
#define PG8_WAIT_V(n) asm volatile("s_waitcnt vmcnt(" #n ")" ::: "memory")
#define PG8_WAIT_L(n) asm volatile("s_waitcnt lgkmcnt(" #n ")" ::: "memory")
#define PG8_BAR __builtin_amdgcn_s_barrier()
#define PG8_SCHED __builtin_amdgcn_sched_barrier(0)
    Unit cur, nxt; int ui = 0;
    if (!S.next(0, cur)) return;
    f32x4 acc[2][2][4][2];
#pragma unroll
    for (int a = 0; a < 2; ++a)
#pragma unroll
        for (int b = 0; b < 2; ++b)
#pragma unroll
            for (int m = 0; m < 4; ++m)
#pragma unroll
                for (int n = 0; n < 2; ++n) acc[a][b][m][n] = (f32x4){0.f, 0.f, 0.f, 0.f};
    bf16x8 At[4][2], B0[2][2], B1[2][2];
    const char* cA = S.a_ptr(g, cur); const char* cB = S.b_ptr(g, cur);
    S.a_ready(cur);
    if constexpr (SP2) {
        PG8_STAGE(PG8_SB(0, 0), cB, voffB); PG8_STAGE(PG8_SB(0, 1), cB + hstep, voffB); PG8_STAGE(PG8_SA(0, 0), cA, voffA); PG8_STAGE(PG8_SA(0, 1), cA + hstep, voffA);
        if (wr == 1) PG8_BAR;
        PG8_WAIT_V(2); PG8_BAR;
        PG8_STAGE(PG8_SB(1, 0), cB + kstep, voffB); PG8_STAGE(PG8_SA(1, 0), cA + kstep, voffA); PG8_STAGE(PG8_SB(1, 1), cB + hstep + kstep, voffB);
        PG8_WAIT_V(6); PG8_BAR;
    } else {
        PG8_STAGE(PG8_SB(0, 0), cB, voffB); PG8_STAGE(PG8_SA(0, 0), cA, voffA); PG8_STAGE(PG8_SB(0, 1), cB + hstep, voffB); PG8_STAGE(PG8_SA(0, 1), cA + hstep, voffA);
        if (wr == 1) PG8_BAR;
        PG8_WAIT_V(4); PG8_BAR;
        PG8_STAGE(PG8_SB(1, 0), cB + kstep, voffB); PG8_STAGE(PG8_SA(1, 0), cA + kstep, voffA); PG8_STAGE(PG8_SB(1, 1), cB + hstep + kstep, voffB);
        PG8_WAIT_V(6); PG8_BAR;
    }
    for (;;) {
        const bool has_next = S.next(ui + 1, nxt);
        const char* nA = has_next ? S.a_ptr(g, nxt) : cA; const char* nB = has_next ? S.b_ptr(g, nxt) : cB;
        const int nt = S.nt(g, cur);
        for (int t = 0; t < nt; t += 2) {
            const bool last = (t == nt - 2);
            const char* a1 = cA + (size_t)(t + 1) * kstep;
            const char* a2 = last ? nA : cA + (size_t)(t + 2) * kstep; const char* b2 = last ? nB : cB + (size_t)(t + 2) * kstep;
            const char* a3 = a2 + kstep; const char* b3 = b2 + kstep;
            if (last && has_next) S.a_ready(nxt);
            if constexpr (Epi::DMA_PRE) { if (last) E.dma_prefetch(cur, lds, wid, lane); }
            if constexpr (SP2) {
            PG8_LDB(B0, 0, 0); PG8_LDB(B1, 0, 1); PG8_SCHED; PG8_LDA(At, 0, 0); PG8_STAGE(PG8_SA(1, 1), a1 + hstep, voffA);
            PG8_WAIT_V(8); PG8_WAIT_L(0); PG8_BAR; PG8_MMA(0, 0, At, B0); PG8_MMA(0, 1, At, B1); PG8_BAR; PG8_SCHED;
            PG8_LDA(At, 0, 1); PG8_STAGE(PG8_SB(0, 0), b2, voffB); PG8_STAGE(PG8_SB(0, 1), b2 + hstep, voffB); PG8_STAGE(PG8_SA(0, 0), a2, voffA);
            PG8_WAIT_V(8); PG8_WAIT_L(0); PG8_BAR; PG8_MMA(1, 0, At, B0); PG8_MMA(1, 1, At, B1); PG8_BAR; PG8_SCHED;
            PG8_LDB(B0, 1, 0); PG8_LDB(B1, 1, 1); PG8_SCHED; PG8_LDA(At, 1, 0); PG8_STAGE(PG8_SA(0, 1), a2 + hstep, voffA);
            PG8_WAIT_V(8); PG8_WAIT_L(0); PG8_BAR; PG8_MMA(0, 0, At, B0); PG8_MMA(0, 1, At, B1); PG8_BAR; PG8_SCHED;
            PG8_LDA(At, 1, 1); PG8_STAGE(PG8_SB(1, 0), b3, voffB); PG8_STAGE(PG8_SB(1, 1), b3 + hstep, voffB); PG8_STAGE(PG8_SA(1, 0), a3, voffA);
            PG8_WAIT_V(8); PG8_WAIT_L(0); PG8_BAR; PG8_MMA(1, 0, At, B0); PG8_MMA(1, 1, At, B1); PG8_BAR; PG8_SCHED;
            } else {
            PG8_LDB(B0, 0, 0); PG8_SCHED; PG8_LDA(At, 0, 0); PG8_STAGE(PG8_SA(1, 1), a1 + hstep, voffA);
            PG8_WAIT_L(8); PG8_BAR; PG8_WAIT_L(0); PG8_MMA(0, 0, At, B0); PG8_BAR; PG8_SCHED;
            PG8_LDB(B1, 0, 1); PG8_STAGE(PG8_SB(0, 0), b2, voffB);
            PG8_BAR; PG8_WAIT_L(0); PG8_MMA(0, 1, At, B1); PG8_BAR;
            PG8_LDA(At, 0, 1); PG8_STAGE(PG8_SA(0, 0), a2, voffA);
            PG8_BAR; PG8_WAIT_L(0); PG8_MMA(1, 0, At, B0); PG8_BAR; PG8_SCHED;
            PG8_STAGE(PG8_SB(0, 1), b2 + hstep, voffB);
            PG8_WAIT_V(6); PG8_BAR; PG8_MMA(1, 1, At, B1); PG8_BAR;
            PG8_LDB(B0, 1, 0); PG8_SCHED; PG8_LDA(At, 1, 0); PG8_STAGE(PG8_SA(0, 1), a2 + hstep, voffA);
            PG8_WAIT_L(8); PG8_BAR; PG8_WAIT_L(0); PG8_MMA(0, 0, At, B0); PG8_BAR; PG8_SCHED;
            PG8_LDB(B1, 1, 1); PG8_STAGE(PG8_SB(1, 0), b3, voffB);
            PG8_BAR; PG8_WAIT_L(0); PG8_MMA(0, 1, At, B1); PG8_BAR;
            PG8_LDA(At, 1, 1); PG8_STAGE(PG8_SA(1, 0), a3, voffA);
            PG8_BAR; PG8_WAIT_L(0); PG8_MMA(1, 0, At, B0); PG8_BAR; PG8_SCHED;
            PG8_STAGE(PG8_SB(1, 1), b3 + hstep, voffB);
            PG8_WAIT_V(6); PG8_BAR; PG8_MMA(1, 1, At, B1); PG8_BAR;
            }
        }
        if constexpr (ALIGN_EPI) { if (wr == 0) PG8_BAR; }
        E(acc, cur, wr, wc, fr, fq, lds); S.done(cur);
        if (!has_next) break;
        if (!S.keep(cur)) {
#pragma unroll
        for (int a = 0; a < 2; ++a)
#pragma unroll
            for (int b = 0; b < 2; ++b)
#pragma unroll
                for (int m = 0; m < 4; ++m)
#pragma unroll
                    for (int n = 0; n < 2; ++n) acc[a][b][m][n] = (f32x4){0.f, 0.f, 0.f, 0.f};
        }
        cur = nxt; cA = nA; cB = nB; ++ui;
        if constexpr (ALIGN_EPI) { if (wr == 1) PG8_BAR; }
    }
    PG8_WAIT_V(0);
    if constexpr (!ALIGN_EPI) { if (wr == 0) PG8_BAR; }
    PG8_BAR;
#undef PG8_SA
#undef PG8_SB
#undef PG8_STAGE
#undef PG8_LDA
#undef PG8_LDB
#undef PG8_MMA
#undef PG8_WAIT_V
#undef PG8_WAIT_L
#undef PG8_BAR
#undef PG8_SCHED
}
}

struct Ws {
    float *rstd1, *sumsq2, *sumsq3;
    bf16_t *Wt_in, *Wt_reto, *Wt_atto, *Wt_o, *Wt_up, *Wt_down;
    bf16_t *xb, *proj, *G, *Oatt, *merged, *act, *ub;
    float* kvc; bf16_t* sb; bf16_t* og; float* lse; unsigned char* g8; bf16_t* tmp;
};
__device__ __forceinline__ Ws make_ws(unsigned char* ws) {
    Ws w;
    w.rstd1 = (float*)(ws + WS_CTL); w.sumsq2 = w.rstd1 + MT; w.sumsq3 = w.sumsq2 + MT;
    w.Wt_in = (bf16_t*)(ws + WS_WIN); w.Wt_reto = (bf16_t*)(ws + WS_WRETO); w.Wt_atto = (bf16_t*)(ws + WS_WATTO_P); w.Wt_o = (bf16_t*)(ws + WS_WO);
    w.Wt_up = (bf16_t*)(ws + WS_WUP); w.Wt_down = (bf16_t*)(ws + WS_WDOWN);
    w.xb = (bf16_t*)(ws + WS_XB); w.proj = (bf16_t*)(ws + WS_PROJ); w.ub = (bf16_t*)(ws + WS_PROJ); w.G = (bf16_t*)(ws + WS_G); w.Oatt = (bf16_t*)(ws + WS_OATT);
    w.merged = (bf16_t*)(ws + WS_MERGED); w.act = (bf16_t*)(ws + WS_ACT); w.kvc = (float*)(ws + WS_KVC);
    w.g8 = ws + WS_G8; w.tmp = (bf16_t*)(ws + WS_KVC);
    w.sb = (bf16_t*)(ws + WS_SB); w.og = (bf16_t*)(ws + WS_OG); w.lse = (float*)(ws + WS_LSE);
    return w;
}

struct EpiIn {
    static constexpr bool PERM = true, DMA_PRE = false, APERM = false;
    Ws w; float* out;
    template <int CLS> __device__ __forceinline__ void body(f32x4 (&acc)[2][2][4][2], int row0, int col0, int grp, int kv) const {
#pragma unroll
        for (int ai = 0; ai < 2; ++ai)
#pragma unroll
            for (int m = 0; m < 4; ++m) {
                const int row = row0 + ai * 128 + m * 16;
#pragma unroll
                for (int bj = 0; bj < 2; ++bj) {
                    const int col = col0 + bj * 128;
                    f32x4 v0 = acc[ai][bj][m][0], v1 = acc[ai][bj][m][1];
                    if (CLS == 1) {
#pragma unroll
                        for (int i = 0; i < 4; ++i) { v0[i] = v0[i] * sigmoidf_(v0[i]); v1[i] = v1[i] * sigmoidf_(v1[i]); }
                    }
                    if (CLS == 2) { u32x2 o8; o8.x = sigcode4(v0); o8.y = sigcode4(v1); __builtin_nontemporal_store(o8, (u32x2*)(w.g8 + (unsigned)(row * 4096) + (col - C_GR))); }
                    else { u32x4 o; o.x = pk2(v0[0], v0[1]); o.y = pk2(v0[2], v0[3]); o.z = pk2(v1[0], v1[1]); o.w = pk2(v1[2], v1[3]);
                        *(u32x4*)(w.proj + (unsigned)(((col >> 7) * MT + row) * 128 + (col & 127))) = o; }
                    if (CLS == 3) {
                        const int win = 128 << (2 * grp);
                        const size_t obase_p = grp == 0 ? O_KV128P : (grp == 1 ? O_KV512P : O_KV2048P);
                        const size_t obase_s = grp == 0 ? O_KV128S : (grp == 1 ? O_KV512S : O_KV2048S);
                        const int c512 = (col & 511);
                        float* dst = nullptr;
                        if (row < MP) { const int b = row >> 13, t = row & 8191; if (t >= SEQ - win) dst = out + obase_p + ((size_t)(b * win + (t - (SEQ - win))) * 2 + kv) * 512 + c512; }
                        else { const int b = (row - MP) >> 3, t = (row - MP) & 7; dst = out + obase_s + ((size_t)(b * win + (win - 8 + t)) * 2 + kv) * 512 + c512; }
                        if (dst) { __builtin_nontemporal_store(v0, (f32x4*)dst); __builtin_nontemporal_store(v1, (f32x4*)(dst + 4)); }
                    }
                }
            }
    }
    __device__ __forceinline__ void operator()(f32x4 (&acc)[2][2][4][2], const pg8::Unit& u, int wr, int wc, int fr_, int fq_, LAS unsigned char*) const {
        int fr = fr_, fq = fq_; asm volatile("" : "+v"(fr), "+v"(fq));
        const int row0 = u.pm * 256 + wr * 64 + fr, col0 = u.pn * 256 + wc * 32 + 8 * fq;
        const int pn = u.pn;
        if (pn >= 34) body<2>(acc, row0, col0, 0, 0);
        else if (pn >= 12 && pn < 16) body<1>(acc, row0, col0, 0, 0);
        else if (pn >= 16) { const int q = (pn - 16) % 6, grp = (pn - 16) / 6;
            const int win = 128 << (2 * grp); const int t_hi = ((u.pm & 31) + 1) * 256;
            if (q >= 2 && (u.pm >= 64 || t_hi > SEQ - win)) body<3>(acc, row0, col0, grp, q >= 4 ? 1 : 0); else body<0>(acc, row0, col0, 0, 0); }
        else body<0>(acc, row0, col0, 0, 0);
    }
};
struct EpiWo {
    static constexpr bool PERM = true, DMA_PRE = false, APERM = false;
    Ws w;
    __device__ __forceinline__ void operator()(f32x4 (&acc)[2][2][4][2], const pg8::Unit& u, int wr, int wc, int fr_, int fq_, LAS unsigned char*) const {
        int fr = fr_, fq = fq_; asm volatile("" : "+v"(fr), "+v"(fq));
        const int row0 = u.pm * 256 + wr * 64 + fr;
        const int col0 = u.pn * 256 + wc * 32 + 8 * fq;
        float ssv[8];
#pragma unroll
        for (int ai = 0; ai < 2; ++ai)
#pragma unroll
            for (int m = 0; m < 4; ++m) {
                const int row = row0 + ai * 128 + m * 16;
                const float rs = w.rstd1[row];
                float ssq = 0.f;
#pragma unroll
                for (int bj = 0; bj < 2; ++bj) {
                    const int col = col0 + bj * 128;
                    f32x4 v0 = acc[ai][bj][m][0], v1 = acc[ai][bj][m][1];
                    { const u32x4 xv = *(const u32x4*)(w.xb + (unsigned)(row * DM) + col);
                      v0[0] += bflo(xv.x) * rs; v0[1] += bfhi(xv.x) * rs; v0[2] += bflo(xv.y) * rs; v0[3] += bfhi(xv.y) * rs;
                      v1[0] += bflo(xv.z) * rs; v1[1] += bfhi(xv.z) * rs; v1[2] += bflo(xv.w) * rs; v1[3] += bfhi(xv.w) * rs; }
                    u32x4 o; o.x = pk2(v0[0], v0[1]); o.y = pk2(v0[2], v0[3]); o.z = pk2(v1[0], v1[1]); o.w = pk2(v1[2], v1[3]);
                    *(u32x4*)(w.xb + (unsigned)(row * DM) + col) = o;
#pragma unroll
                    for (int i = 0; i < 4; ++i) ssq += v0[i] * v0[i] + v1[i] * v1[i];
                }
                ssq += __shfl_xor(ssq, 16); ssq += __shfl_xor(ssq, 32);
                ssv[ai * 4 + m] = ssq;
            }
        if (fq == 0) {
#pragma unroll
            for (int k = 0; k < 8; ++k) atomicAdd(w.sumsq2 + row0 + (k >> 2) * 128 + (k & 3) * 16, ssv[k]);
        }
    }
};

struct EpiP5 {
    static constexpr bool PERM = true, DMA_PRE = false, APERM = false;
    Ws w;
    __device__ __forceinline__ void operator()(f32x4 (&acc)[2][2][4][2], const pg8::Unit& u, int wr, int wc, int fr_, int fq_, LAS unsigned char*) const {
        int fr = fr_, fq = fq_; asm volatile("" : "+v"(fr), "+v"(fq));
        const int row0 = u.pm * 256 + wr * 64 + fr, col0 = u.pn * 256 + wc * 32 + 8 * fq;
        if (u.seg == 0) {
#pragma unroll
            for (int ai = 0; ai < 2; ++ai)
#pragma unroll
                for (int m = 0; m < 4; ++m) {
                    const int row = row0 + ai * 128 + m * 16;
#pragma unroll
                    for (int bj = 0; bj < 2; ++bj) { const unsigned char* gp = w.g8 + (unsigned)(row * 4096) + col0 + bj * 128;
                        const u32x2 gr = *(const u32x2*)gp, ga = *(const u32x2*)(gp + 2048);
                        const f32x4 a0 = dec8x4(ga.x), a1 = dec8x4(ga.y);
                        f32x4 q0 = dec8x4(gr.x), q1 = dec8x4(gr.y);
#pragma unroll
                        for (int i = 0; i < 4; ++i) { q0[i] *= __builtin_amdgcn_rcpf(a0[i]); q1[i] *= __builtin_amdgcn_rcpf(a1[i]); }
                        acc[ai][bj][m][0] *= q0; acc[ai][bj][m][1] *= q1; }
                }
        } else {
#pragma unroll
            for (int ai = 0; ai < 2; ++ai)
#pragma unroll
                for (int m = 0; m < 4; ++m) {
                    const int row = row0 + ai * 128 + m * 16;
#pragma unroll
                    for (int bj = 0; bj < 2; ++bj) { const int col = col0 + bj * 128;
                        const u32x2 ga = *(const u32x2*)(w.g8 + (unsigned)(row * 4096) + 2048 + col);
                        const f32x4 v0 = acc[ai][bj][m][0] * dec8x4(ga.x), v1 = acc[ai][bj][m][1] * dec8x4(ga.y);
                        u32x4 o; o.x = pk2(v0[0], v0[1]); o.y = pk2(v0[2], v0[3]); o.z = pk2(v1[0], v1[1]); o.w = pk2(v1[2], v1[3]);
                        *(u32x4*)(w.merged + (unsigned)(row * DM) + col) = o; }
                }
        }
    }
};

__device__ __forceinline__ float dpp_ror1(float v) { return __int_as_float(__builtin_amdgcn_mov_dpp(__float_as_int(v), 0x121, 0xf, 0xf, false)); }
__device__ __forceinline__ float dpp_keep(float v) { float d = dpp_ror1(v); asm volatile("" : "+v"(d)); return d; }
__device__ __forceinline__ float dpp_ror2(float v) { return __int_as_float(__builtin_amdgcn_mov_dpp(__float_as_int(v), 0x122, 0xf, 0xf, false)); }
typedef float f32x2 __attribute__((ext_vector_type(2)));
__device__ __forceinline__ f32x2 gelu_gate2(f32x2 v, f32x2 b) {
    f32x2 a; a.x = __builtin_amdgcn_fmed3f(fabsf(v.x), 0.f, 6.5f); a.y = __builtin_amdgcn_fmed3f(fabsf(v.y), 0.f, 6.5f);
    const f32x2 c9 = {3.819134520e-07f, 3.819134520e-07f}, c8 = {-7.616652965e-06f, -7.616652965e-06f}, c7 = {6.311968900e-05f, 6.311968900e-05f}, c6 = {-2.457886876e-04f, -2.457886876e-04f},
                c5 = {-5.764040543e-05f, -5.764040543e-05f}, c4 = {7.011611480e-03f, 7.011611480e-03f}, c3 = {-5.248568207e-02f, -5.248568207e-02f}, c2 = {-4.592045844e-01f, -4.592045844e-01f},
                c1 = {-1.151106715e+00f, -1.151106715e+00f}, c0 = {-9.999999404e-01f, -9.999999404e-01f};
    f32x2 p = c9 * a + c8; p = p * a + c7; p = p * a + c6; p = p * a + c5; p = p * a + c4; p = p * a + c3; p = p * a + c2; p = p * a + c1; p = p * a + c0;
    f32x2 e; e.x = __builtin_amdgcn_exp2f(p.x); e.y = __builtin_amdgcn_exp2f(p.y);
    f32x2 r; asm("v_max_f32 %0, 0, %1" : "=v"(r.x) : "v"(v.x)); asm("v_max_f32 %0, 0, %1" : "=v"(r.y) : "v"(v.y));
    return (r - a * e) * b;
}
#define CONV_SHR1(v, c, w) asm("v_fmac_f32_dpp %0, %1, %2 row_shr:1 row_mask:0xf bank_mask:0xf" : "+v"(v) : "v"(c), "v"(w))
constexpr int HALO_OFF = 131072;
constexpr int PRE_SS = HALO_OFF + 6144, PRE_CW = HALO_OFF + 7168;
struct EpiUp {
    static constexpr bool PERM = true, DMA_PRE = true, APERM = true;
    Ws w; float* out; const float* cw; const float* cb; const float* sconv;
    __device__ __forceinline__ void dma_prefetch(const pg8::Unit& u, LAS unsigned char* lds, int wid, int lane) const {
        if (wid == 0) {
            const bool samp = u.pm >= 66;
            const int rowbase = samp ? MP : (u.pm / 33) * SEQ + 254 * (u.pm % 33) - 2;
#pragma unroll
            for (int i = 0; i < 4; ++i) __builtin_amdgcn_global_load_lds((const unsigned*)(w.sumsq2 + rowbase + 64 * i + lane), (LAS unsigned*)(lds + PRE_SS + 256 * i), 4, 0, 0);
        } else if (wid == 1) {
            const int f0 = u.pn * 128 + 4 * (lane & 31), hb = (lane >> 5) * FF;
#pragma unroll
            for (int k = 0; k < 3; ++k) __builtin_amdgcn_global_load_lds((const unsigned*)(cw + (size_t)k * F2 + hb + f0), (LAS unsigned*)(lds + PRE_CW + 1024 * k), 16, 0, 0);
            __builtin_amdgcn_global_load_lds((const unsigned*)(cb + hb + f0), (LAS unsigned*)(lds + PRE_CW + 3072), 16, 0, 0);
        }
    }
    __device__ __forceinline__ void operator()(f32x4 (&acc)[2][2][4][2], const pg8::Unit& u, int wr, int wc, int fr_, int fq_, LAS unsigned char* lds) const {
        int fr = fr_, fq = fq_; asm volatile("" : "+v"(fr), "+v"(fq));
        const bool samp = u.pm >= 66;
        const int bb = samp ? 0 : u.pm / 33, jj = samp ? 0 : u.pm % 33;
        const int t0 = samp ? 0 : 254 * jj - 2;
        const int rowbase = samp ? MP : bb * SEQ + t0;
#pragma unroll
        for (int ai = 0; ai < 2; ++ai)
#pragma unroll
            for (int m = 0; m < 4; ++m) {
                const int rl = ai * 128 + wr * 64 + 4 * fr + m, t = t0 + rl;
                const bool ok = samp || (t >= 0 && t < SEQ);
                const float ss = *(const LAS float*)(lds + PRE_SS + 4 * rl);
                const float rs = ok ? __builtin_amdgcn_rsqf(ss * (1.0f / DM) + EPS) : 0.f;
#pragma unroll
                for (int bj = 0; bj < 2; ++bj) { acc[ai][bj][m][0] *= rs; acc[ai][bj][m][1] *= rs; }
            }
        asm volatile("" ::: "memory");
        LAS float* halo = (LAS float*)(lds + HALO_OFF);
        const int fcol = u.pn * 128 + wc * 32 + 8 * fq;
        if (!samp) {
            if (fr == 15) {
#pragma unroll
                for (int ai = 0; ai < 2; ++ai) { const int bd = 2 * ai + wr;
                    if (bd < 3) {
#pragma unroll
                        for (int m = 2; m < 4; ++m) { LAS f32x4* hp = (LAS f32x4*)(halo + (((bd * 4 + wc) * 8 + (m - 2) * 4 + fq) * 16));
                            hp[0] = acc[ai][0][m][0]; hp[1] = acc[ai][0][m][1]; hp[2] = acc[ai][1][m][0]; hp[3] = acc[ai][1][m][1]; } } }
            }
            asm volatile("s_waitcnt lgkmcnt(0)" ::: "memory"); __builtin_amdgcn_s_barrier(); asm volatile("" ::: "memory");
            u32x2 olo[2][4];
            const float zm = fr == 0 ? 1.0f : 0.0f;
            bf16_t* const dump = w.merged;
#pragma unroll
            for (int n = 0; n < 2; ++n) {
                const int f0 = fcol + 4 * n;
                f32x4 wa[3], wb[3];
                const LAS unsigned char* wl = lds + PRE_CW + 4 * (f0 - u.pn * 128);
#pragma unroll
                for (int k = 0; k < 3; ++k) { wa[k] = *(const LAS f32x4*)(wl + 1024 * k); wb[k] = *(const LAS f32x4*)(wl + 1024 * k + 512); }
                const f32x4 ba = *(const LAS f32x4*)(wl + 3072), bbv = *(const LAS f32x4*)(wl + 3072 + 512);
#pragma unroll
                for (int ai = 0; ai < 2; ++ai) {
                    const int gi = 2 * ai + wr;
                    const LAS f32x4* hp = (const LAS f32x4*)(halo + ((((gi > 0 ? gi - 1 : 0) * 4 + wc) * 8 + fq) * 16));
                    const f32x4 h62a = hp[n] * zm, h62b = hp[2 + n] * zm, h63a = hp[16 + n] * zm, h63b = hp[16 + 2 + n] * zm;
#pragma unroll
                    for (int m = 0; m < 4; ++m) {
                        const int rl = ai * 128 + wr * 64 + 4 * fr + m, t = t0 + rl;
                        const f32x4 ca = acc[ai][0][m][n], cbv = acc[ai][1][m][n];
                        f32x4 va = ba + wa[2] * ca, vb = bbv + wb[2] * cbv;
                        if (m >= 1) { va += wa[1] * acc[ai][0][m - 1][n]; vb += wb[1] * acc[ai][1][m - 1][n]; }
                        else { va += wa[1] * h63a; vb += wb[1] * h63b; }
                        if (m >= 2) { va += wa[0] * acc[ai][0][m - 2][n]; vb += wb[0] * acc[ai][1][m - 2][n]; }
                        else if (m == 1) { va += wa[0] * h63a; vb += wb[0] * h63b; }
                        else { va += wa[0] * h62a; vb += wb[0] * h62b; }
                        if (m < 2) {
#pragma unroll
                            for (int i = 0; i < 4; ++i) {
                                float ta = va[i], tb = vb[i];
                                if (m == 0) { CONV_SHR1(ta, acc[ai][0][3][n][i], wa[1][i]); CONV_SHR1(tb, acc[ai][1][3][n][i], wb[1][i]);
                                              CONV_SHR1(ta, acc[ai][0][2][n][i], wa[0][i]); CONV_SHR1(tb, acc[ai][1][2][n][i], wb[0][i]); }
                                else { CONV_SHR1(ta, acc[ai][0][3][n][i], wa[0][i]); CONV_SHR1(tb, acc[ai][1][3][n][i], wb[0][i]); }
                                va[i] = ta; vb[i] = tb;
                            }
                        }
                        const f32x2 g01 = gelu_gate2((f32x2){va[0], va[1]}, (f32x2){vb[0], vb[1]}), g23 = gelu_gate2((f32x2){va[2], va[3]}, (f32x2){vb[2], vb[3]});
                        u32x2 o; o.x = pk2(g01.x, g01.y); o.y = pk2(g23.x, g23.y);
                        if (n == 0) olo[ai][m] = o;
                        else { u32x4 o4; o4.x = olo[ai][m].x; o4.y = olo[ai][m].y; o4.z = o.x; o4.w = o.y;
                            const bool ok = rl >= 2 && t < SEQ;
                            bf16_t* dst = ok ? w.act + (unsigned)((rowbase + rl) * FF + fcol) : dump + (unsigned)(threadIdx.x * 8);
                            *(u32x4*)dst = o4; }
                        asm volatile("" ::: "memory");
                    }
                }
            }
            if (jj == 32) {
#pragma unroll
                for (int ai = 0; ai < 2; ++ai)
#pragma unroll
                    for (int m = 0; m < 4; ++m) { const int rl = ai * 128 + wr * 64 + 4 * fr + m, t = t0 + rl;
                        if (t >= SEQ - 2 && t < SEQ) {
#pragma unroll
                            for (int n = 0; n < 2; ++n) { float* d = out + O_CONVP + ((size_t)bb * 2 + (t - (SEQ - 2))) * F2 + fcol + 4 * n; *(f32x4*)d = acc[ai][0][m][n]; *(f32x4*)(d + FF) = acc[ai][1][m][n]; } } }
            }
        } else {
            const bool ev = !(fr & 1);
#pragma unroll
            for (int n = 0; n < 2; ++n) {
                const int f0 = fcol + 4 * n;
                f32x4 wa[3], wb[3];
                const LAS unsigned char* wl = lds + PRE_CW + 4 * (f0 - u.pn * 128);
#pragma unroll
                for (int k = 0; k < 3; ++k) { wa[k] = *(const LAS f32x4*)(wl + 1024 * k); wb[k] = *(const LAS f32x4*)(wl + 1024 * k + 512); }
                const f32x4 ba = *(const LAS f32x4*)(wl + 3072), bbv = *(const LAS f32x4*)(wl + 3072 + 512);
#pragma unroll
                for (int ai = 0; ai < 2; ++ai) {
                    const int bs = ai * 16 + wr * 8 + (fr >> 1);
                    f32x4 s1a = ba, s1b = ba, s0a = ba, s0b = ba;
                    if (ev) { const float* s1 = sconv + ((size_t)bs * 2 + 1) * F2 + f0; const float* s0 = sconv + ((size_t)bs * 2) * F2 + f0;
                        s1a = *(const f32x4*)s1; s1b = *(const f32x4*)(s1 + FF); s0a = *(const f32x4*)s0; s0b = *(const f32x4*)(s0 + FF); }
#pragma unroll
                    for (int m = 0; m < 4; ++m) {
                        const int rl = ai * 128 + wr * 64 + 4 * fr + m, ts = 4 * (fr & 1) + m;
                        const f32x4 ca = acc[ai][0][m][n], cbv = acc[ai][1][m][n];
                        f32x4 a1, a2, b1, b2;
                        if (m >= 1) { a1 = acc[ai][0][m - 1][n]; b1 = acc[ai][1][m - 1][n]; }
                        else {
#pragma unroll
                            for (int i = 0; i < 4; ++i) { const float da = dpp_keep(acc[ai][0][3][n][i]), db = dpp_keep(acc[ai][1][3][n][i]); a1[i] = ev ? s1a[i] : da; b1[i] = ev ? s1b[i] : db; } }
                        if (m >= 2) { a2 = acc[ai][0][m - 2][n]; b2 = acc[ai][1][m - 2][n]; }
                        else if (m == 1) {
#pragma unroll
                            for (int i = 0; i < 4; ++i) { const float da = dpp_keep(acc[ai][0][3][n][i]), db = dpp_keep(acc[ai][1][3][n][i]); a2[i] = ev ? s1a[i] : da; b2[i] = ev ? s1b[i] : db; } }
                        else {
#pragma unroll
                            for (int i = 0; i < 4; ++i) { const float da = dpp_keep(acc[ai][0][2][n][i]), db = dpp_keep(acc[ai][1][2][n][i]); a2[i] = ev ? s0a[i] : da; b2[i] = ev ? s0b[i] : db; } }
                        const f32x4 va = ba + wa[0] * a2 + wa[1] * a1 + wa[2] * ca;
                        const f32x4 vb = bbv + wb[0] * b2 + wb[1] * b1 + wb[2] * cbv;
                        const f32x2 g01 = gelu_gate2((f32x2){va[0], va[1]}, (f32x2){vb[0], vb[1]}), g23 = gelu_gate2((f32x2){va[2], va[3]}, (f32x2){vb[2], vb[3]});
                        u32x2 o; o.x = pk2(g01.x, g01.y); o.y = pk2(g23.x, g23.y);
                        *(u32x2*)(w.act + (unsigned)((MP + rl) * FF + f0)) = o;
                        if (ts >= 6) { float* d = out + O_CONVS + ((size_t)bs * 2 + (ts - 6)) * F2 + f0; *(f32x4*)d = ca; *(f32x4*)(d + FF) = cbv; }
                        asm volatile("" ::: "memory");
                    }
                }
            }
        }
    }
};


__device__ __forceinline__ void panel_arrive_wait(unsigned* cnt, unsigned want) {
    asm volatile("s_waitcnt vmcnt(0)" ::: "memory");
    __hip_atomic_fetch_add(cnt, 1u, __ATOMIC_RELAXED, __HIP_MEMORY_SCOPE_AGENT);
    unsigned sp = 0;
    while (__hip_atomic_load(cnt, __ATOMIC_RELAXED, __HIP_MEMORY_SCOPE_AGENT) < want) { __builtin_amdgcn_s_sleep(2); if (++sp > (1u << 22)) break; }
    asm volatile("s_waitcnt vmcnt(0)" ::: "memory");
}
struct EpiFin {
    static constexpr bool PERM = true, DMA_PRE = false, APERM = false;
    Ws w; float* out; const float* gfin; unsigned* pcnt;
    __device__ __forceinline__ void operator()(f32x4 (&acc)[2][2][4][2], const pg8::Unit& u, int wr, int wc, int fr_, int fq_, LAS unsigned char*) const {
        int fr = fr_, fq = fq_; asm volatile("" : "+v"(fr), "+v"(fq));
        const int row0 = u.pm * 256 + wr * 64 + fr;
        const int col0 = u.pn * 256 + wc * 32 + 8 * fq;
        float ssv[8];
#pragma unroll
        for (int ai = 0; ai < 2; ++ai)
#pragma unroll
            for (int m = 0; m < 4; ++m) {
                const int row = row0 + ai * 128 + m * 16;
                float ssq = 0.f;
#pragma unroll
                for (int bj = 0; bj < 2; ++bj) {
                    const int col = col0 + bj * 128;
                    const u32x4 xv = __builtin_nontemporal_load((const u32x4*)(w.xb + (unsigned)(row * DM) + col));
                    f32x4 v0 = acc[ai][bj][m][0], v1 = acc[ai][bj][m][1];
                    v0[0] += bflo(xv.x); v0[1] += bfhi(xv.x); v0[2] += bflo(xv.y); v0[3] += bfhi(xv.y);
                    v1[0] += bflo(xv.z); v1[1] += bfhi(xv.z); v1[2] += bflo(xv.w); v1[3] += bfhi(xv.w);
                    acc[ai][bj][m][0] = v0; acc[ai][bj][m][1] = v1;
#pragma unroll
                    for (int i = 0; i < 4; ++i) ssq += v0[i] * v0[i] + v1[i] * v1[i];
                }
                ssq += __shfl_xor(ssq, 16); ssq += __shfl_xor(ssq, 32);
                ssv[ai * 4 + m] = ssq;
            }
        if (fq == 0) {
#pragma unroll
            for (int k = 0; k < 8; ++k) atomicAdd(w.sumsq3 + row0 + (k >> 2) * 128 + (k & 3) * 16, ssv[k]);
        }
        asm volatile("s_waitcnt vmcnt(0)" ::: "memory"); __builtin_amdgcn_s_barrier(); asm volatile("" ::: "memory");
        if (threadIdx.x == 0) panel_arrive_wait(pcnt + 16 * u.pm, 8u);
        asm volatile("s_waitcnt vmcnt(0) lgkmcnt(0)" ::: "memory"); __builtin_amdgcn_s_barrier(); asm volatile("" ::: "memory");
        f32x4 g[2][2];
#pragma unroll
        for (int bj = 0; bj < 2; ++bj) { g[bj][0] = *(const f32x4*)(gfin + col0 + bj * 128); g[bj][1] = *(const f32x4*)(gfin + col0 + bj * 128 + 4); }
#pragma unroll
        for (int ai = 0; ai < 2; ++ai)
#pragma unroll
            for (int m = 0; m < 4; ++m) {
                const int row = row0 + ai * 128 + m * 16;
                const float rs = rsqrtf(__hip_atomic_load(w.sumsq3 + row, __ATOMIC_RELAXED, __HIP_MEMORY_SCOPE_AGENT) * (1.0f / DM) + EPS);
#pragma unroll
                for (int bj = 0; bj < 2; ++bj) { float* dst = out + O_Y + (unsigned)(row * DM) + col0 + bj * 128;
                    __builtin_nontemporal_store(acc[ai][bj][m][0] * rs * g[bj][0], (f32x4*)dst); __builtin_nontemporal_store(acc[ai][bj][m][1] * rs * g[bj][1], (f32x4*)(dst + 4)); }
            }
    }
};

__device__ __forceinline__ int up_rowmap(int n) { return n < FF ? ((n >> 7) * 256 + (n & 127)) : (((n - FF) >> 7) * 256 + 128 + ((n - FF) & 127)); }
__device__ __forceinline__ void p0_transpose_item(const float* W, int K, int N, bf16_t* WT, const float* g, bool upmap, LAS float* scr, int item, int lane, int ldt = 0, bool ntst = false) {
    if (ldt == 0) ldt = K;
    const int nblk = N / 32, kb = item / nblk, nb = item % nblk, k0 = 64 * kb, n0 = 32 * nb;
    float tv[32];
#pragma unroll
    for (int i = 0; i < 32; ++i) { const int kk = 2 * i + (lane >> 5); tv[i] = __builtin_nontemporal_load(W + (size_t)(k0 + kk) * N + n0 + (lane & 31)); }
    if (g) {
#pragma unroll
        for (int i = 0; i < 32; ++i) tv[i] *= g[k0 + 2 * i + (lane >> 5)];
    }
#pragma unroll
    for (int i = 0; i < 32; ++i) { const int kk = 2 * i + (lane >> 5); scr[kk * 33 + (lane & 31)] = tv[i]; }
    LDS_WAIT();
    const int c = lane & 7;
    const int nbase = upmap ? up_rowmap(n0) : n0;
#pragma unroll
    for (int j = 0; j < 4; ++j) { const int n = (lane >> 3) + 8 * j; const LAS float* s = scr + (8 * c) * 33 + n;
        u32x4 o; o.x = pk2(s[0 * 33], s[1 * 33]); o.y = pk2(s[2 * 33], s[3 * 33]); o.z = pk2(s[4 * 33], s[5 * 33]); o.w = pk2(s[6 * 33], s[7 * 33]);
        if (ntst) __builtin_nontemporal_store(o, (u32x4*)(WT + (size_t)(nbase + n) * ldt + k0 + 8 * c)); else *(u32x4*)(WT + (size_t)(nbase + n) * ldt + k0 + 8 * c) = o; }
    LDS_WAIT();
}
#ifndef KVSLACK
#define KVSLACK 100
#endif
#define KV_SPLIT ((KVSLACK) >= 100 ? KV_TOTAL : KV_TOTAL / 100 * (KVSLACK))
template <int SET> __device__ __forceinline__ void weight_transposes(const Params& p, const Ws& w, LAS unsigned char* lds, int rk, int n) {
    const int tid = opaque_tid(), lane = tid & 63, wave = tid >> 6;
    LAS float* scr = (LAS float*)(lds + wave * 16384);
    const int gw = rk * 8 + wave, NGW = n * 8;
    constexpr int I_IN = (DM / 64) * (INC / 32), I_RO = (1024 / 64) * (DM / 32), I_AO = (512 / 64) * (DM / 32), I_O = (DM / 64) * (DM / 32), I_UP = (DM / 64) * (F2 / 32), I_DN = (FF / 64) * (DM / 32);
    constexpr int NITEMS = SET == 0 ? I_IN + I_UP : (SET == 1 ? I_RO + I_AO + I_O : I_DN);
    for (int it = gw; it < NITEMS; it += NGW) {
        int r = it;
        if (SET == 0) {
            if (r < I_IN) { p0_transpose_item(p.in[8], DM, INC, w.Wt_in, p.in[7], false, scr, r, lane); continue; } r -= I_IN;
            p0_transpose_item(p.in[14], DM, F2, w.Wt_up, p.in[13], true, scr, r, lane);
        } else if (SET == 1) {
            if (r < I_RO) { p0_transpose_item(p.in[10], 1024, DM, w.Wt_reto, nullptr, false, scr, r, lane, 0, true); continue; } r -= I_RO;
            if (r < I_AO) { p0_transpose_item(p.in[11], 512, DM, w.Wt_atto, nullptr, false, scr, r, lane, 1024, true); continue; } r -= I_AO;
            p0_transpose_item(p.in[12], DM, DM, w.Wt_o, nullptr, false, scr, r, lane, 0, true);
        } else p0_transpose_item(p.in[17], FF, DM, w.Wt_down, nullptr, false, scr, r, lane);
    }
}
__device__ __forceinline__ void p0_xconv(const Params& p, const Ws& w, LAS unsigned char* lds, int vcu, int G) {
    const int tid = opaque_tid(), lane = tid & 63, wave = tid >> 6;
    const int gw = vcu * 8 + wave, NGW = G * 8;
    for (int m = gw; m < MT; m += NGW) {
        const float* xr = (m < MP) ? p.in[0] + (size_t)m * DM : p.in[1] + (size_t)(m - MP) * DM;
        const f32x4* x4 = (const f32x4*)xr + lane;
        f32x4 v[8]; float s = 0.f;
#pragma unroll
        for (int j = 0; j < 8; ++j) { v[j] = __builtin_nontemporal_load(x4 + 64 * j); s += (v[j].x * v[j].x + v[j].y * v[j].y) + (v[j].z * v[j].z + v[j].w * v[j].w); }
        s = wave_sum(s);
        const float rs = rsqrtf(s * (1.0f / DM) + EPS);
        if (lane == 0) w.rstd1[m] = sqrtf(s * (1.0f / DM) + EPS);
        u32x2* o8 = (u32x2*)(w.xb + (size_t)m * DM) + lane;
#pragma unroll
        for (int j = 0; j < 8; ++j) { u32x2 o; o.x = pk2(v[j].x * rs, v[j].y * rs); o.y = pk2(v[j].z * rs, v[j].w * rs); o8[64 * j] = o; }
    }
    for (int i = vcu * 512 + tid; i < 2 * MT; i += G * 512) w.sumsq2[i] = 0.f;
}
constexpr size_t KV_TOTAL = (size_t)32 * 1024 * 256;
__device__ __forceinline__ void kv_resolve(const Params& p, size_t i, const f32x4*& src, f32x4*& dst) {
    const unsigned li = (unsigned)i, b = li >> 18, rr = (li >> 8) & 1023u, c4 = li & 255u, row = (rr >> 3) * 16 + 8 + (rr & 7);
    const size_t o = ((size_t)b * 2048 + row) * 256 + c4;
    src = (const f32x4*)p.in[5] + o; dst = (f32x4*)(p.out + O_KV2048S) + o - 2048;
}
__device__ __forceinline__ void kv_copy_range(const Params& p, size_t c0, size_t c1, int rk, int ncu) {
    const size_t step = (size_t)ncu * 512;
    for (size_t i0 = c0 + (size_t)rk * 512 + opaque_tid(); i0 < c1; i0 += 16 * step) {
        f32x4 v[16]; f32x4* dp[16];
#pragma unroll
        for (int k = 0; k < 16; ++k) { const size_t i = i0 + k * step; if (i < c1) { const f32x4* sp; kv_resolve(p, i, sp, dp[k]); v[k] = __builtin_nontemporal_load(sp); } }
#pragma unroll
        for (int k = 0; k < 16; ++k) { const size_t i = i0 + k * step; if (i < c1) __builtin_nontemporal_store(v[k], dp[k]); }
    }
}

__device__ __forceinline__ float lgamma_h(int h) { return logf(1.0f - exp2f(-5.0f - (float)h)); }
__device__ __forceinline__ void ret_sample(const Params& p, const Ws& w, LAS unsigned char* lds, int vcu, int G) {
    const int tid = opaque_tid(), lane = tid & 63, wave = tid >> 6;
    LAS float* qf = (LAS float*)lds;
    LAS float* kf = qf + 1024;
    LAS float* vf = kf + 1024;
    LAS float* part = vf + 1024;
    LAS float* sc = part + 4096;
    LAS float* yb = sc + 64;
    const float* gn = p.in[9];
    for (int item = vcu; item < 256; item += G) {
        const int bs = item >> 3, h = item & 7;
        const size_t m0 = MP + (size_t)bs * 8;
        const float lg = lgamma_h(h);
        __syncthreads();
        for (int i = tid; i < 1024; i += 512) { const int r = i >> 7, d = i & 127; const bf16_t* row = w.proj + pofs(m0 + r, h * 128 + d);
            qf[i] = bf2f(row[(C_RQ / 128) * PSLAB]); kf[i] = bf2f(row[(C_RK / 128) * PSLAB]) * QK_SCALE; vf[i] = bf2f(row[(C_RV / 128) * PSLAB]); }
        __syncthreads();
        if (tid < 64) { const int i = tid >> 3, j = tid & 7; float s = 0.f; for (int d = 0; d < 128; ++d) s += qf[i * 128 + d] * kf[j * 128 + d]; sc[tid] = (i >= j) ? s * __expf((float)(i - j) * lg) : 0.f; }
        const int e = tid & 127, dq = tid >> 7;
        const float* st = p.in[2] + (size_t)item * 16384;
        float* nst = p.out + O_RETS + (size_t)item * 16384;
        const float g8 = __expf(8.0f * lg);
        float kdec[8];
#pragma unroll
        for (int j = 0; j < 8; ++j) kdec[j] = __expf((float)(7 - j) * lg);
        float cr[8];
#pragma unroll
        for (int i = 0; i < 8; ++i) cr[i] = 0.f;
        float sv[32];
#pragma unroll
        for (int dd = 0; dd < 32; ++dd) sv[dd] = __builtin_nontemporal_load(st + (dq * 32 + dd) * 128 + e);
#pragma unroll
        for (int dd = 0; dd < 32; ++dd) {
            const int d = dq * 32 + dd;
            const float s = sv[dd];
            float ns = s * g8;
#pragma unroll
            for (int j = 0; j < 8; ++j) ns += kf[j * 128 + d] * kdec[j] * vf[j * 128 + e];
            __builtin_nontemporal_store(ns, nst + d * 128 + e);
#pragma unroll
            for (int i = 0; i < 8; ++i) cr[i] += qf[i * 128 + d] * s;
        }
#pragma unroll
        for (int i = 0; i < 8; ++i) part[(dq * 8 + i) * 128 + e] = cr[i];
        __syncthreads();
        for (int idx = tid; idx < 1024; idx += 512) { const int i = idx >> 7, ee = idx & 127;
            float y = (part[(0 * 8 + i) * 128 + ee] + part[(1 * 8 + i) * 128 + ee] + part[(2 * 8 + i) * 128 + ee] + part[(3 * 8 + i) * 128 + ee]) * __expf((float)(i + 1) * lg);
            for (int j = 0; j <= i; ++j) y += sc[i * 8 + j] * vf[j * 128 + ee];
            yb[idx] = y; }
        __syncthreads();
        {
            const int il = wave; const size_t m = m0 + il;
            const float a0 = yb[il * 128 + lane], a1 = yb[il * 128 + 64 + lane];
            const float mean = wave_sum(a0 + a1) * (1.0f / 128.0f);
            const float d0 = a0 - mean, d1 = a1 - mean;
            const float var = wave_sum(d0 * d0 + d1 * d1) * (1.0f / 128.0f);
            const float rstd = rsqrtf(var + EPS);
            const float g0 = bf2f(w.proj[pofs(m, C_RG + h * 128 + lane)]), g1 = bf2f(w.proj[pofs(m, C_RG + h * 128 + 64 + lane)]);
            w.G[m * 1024 + h * 128 + lane] = (bf16_t)f2bf(d0 * rstd * gn[h * 128 + lane] * g0);
            w.G[m * 1024 + h * 128 + 64 + lane] = (bf16_t)f2bf(d1 * rstd * gn[h * 128 + 64 + lane] * g1);
        }
    }
}
typedef short v4s __attribute__((ext_vector_type(4)));
__device__ __forceinline__ v4s tr16(const LAS unsigned char* p) { return __builtin_amdgcn_ds_read_tr16_b64_v4i16((LAS v4s*)p); }
__device__ __forceinline__ bf16x8 cat8(v4s a, v4s b) { return (bf16x8){a[0], a[1], a[2], a[3], b[0], b[1], b[2], b[3]}; }
#define MFMA16(a, b, c) __builtin_amdgcn_mfma_f32_16x16x32_bf16(a, b, c, 0, 0, 0)
constexpr float LOG2E = 1.4426950408889634f, LN2 = 0.6931471805599453f;
__device__ __forceinline__ float lg2gamma(int h) { return log2f(1.0f - exp2f(-5.0f - (float)h)); }
__device__ __forceinline__ bf16x8 pack8(const f32x4 a, const f32x4 b) {
    u32x4 o; o.x = pk2(a[0], a[1]); o.y = pk2(a[2], a[3]); o.z = pk2(b[0], b[1]); o.w = pk2(b[2], b[3]);
    return __builtin_bit_cast(bf16x8, o);
}
constexpr int KP = 272, VP = 288;

struct AttnDesc { int g, h, dil, qb, qcol; size_t rowbase; };
__device__ __forceinline__ AttnDesc attn_desc(int item) {
    AttnDesc d; const int rq = item & 63; d.h = (item >> 6) & 3; const int b = (item >> 8) & 1; d.g = item >> 9;
    d.dil = 1 << (2 * d.g); const int sh = 6 - 2 * d.g, r = rq >> sh; d.qb = rq & ((1 << sh) - 1);
    d.qcol = C_ATT + d.g * 1536 + d.h * 128; d.rowbase = (size_t)b * SEQ + r; return d;
}
__device__ __forceinline__ void attn_load(const Ws& w, const AttnDesc& d, int tid, bool fresh, u32x4 (&kreg)[8], u32x4 (&vreg)[8]) {
    const int s0 = 128 * (d.qb - 1);
#pragma unroll
    for (int i = 0; i < 4; ++i) { const int cidx = tid + 512 * i, c = 128 + (cidx >> 4), ch = cidx & 15, s = s0 + c;
        const bf16_t* rp = w.proj + pofs(d.rowbase + (size_t)d.dil * s, d.qcol + ch * 8); kreg[i] = __builtin_nontemporal_load((const u32x4*)(rp + 4 * PSLAB)); vreg[i] = __builtin_nontemporal_load((const u32x4*)(rp + 8 * PSLAB)); }
    if (fresh) {
#pragma unroll
        for (int i = 4; i < 8; ++i) { const int cidx = tid + 512 * (i - 4), c = cidx >> 4, ch = cidx & 15, s = max(s0 + c, 0);
            const bf16_t* rp = w.proj + pofs(d.rowbase + (size_t)d.dil * s, d.qcol + ch * 8); kreg[i] = __builtin_nontemporal_load((const u32x4*)(rp + 4 * PSLAB)); vreg[i] = __builtin_nontemporal_load((const u32x4*)(rp + 8 * PSLAB)); }
    }
}
__device__ __forceinline__ void attn_loadq(const Ws& w, const AttnDesc& d, int wave, int fr, int fg, bf16x8 (&qf)[4]) {
    const size_t mq = d.rowbase + (size_t)d.dil * (128 * d.qb + 16 * wave + fr);
#pragma unroll
    for (int ds = 0; ds < 4; ++ds) qf[ds] = __builtin_nontemporal_load((const bf16x8*)(w.proj + pofs(mq, d.qcol + 32 * ds + 8 * fg)));
}
__device__ __forceinline__ void attn_compute(const Ws& w, LAS unsigned char* lds, const AttnDesc& d, int off, bf16x8 (&qf)[4], int wave, int fr, int fg, bool has_next, const AttnDesc& dn, int tid, u32x4 (&kreg)[8], u32x4 (&vreg)[8]) {
    LAS unsigned char* Kt = lds; LAS unsigned char* Vt = lds + 256 * KP;
    const int g = d.g, h = d.h, qb = d.qb;
    asm volatile("" : "+v"(fr), "+v"(fg));
    const int iq = 16 * wave + fr;
    const size_t mq = d.rowbase + (size_t)d.dil * (128 * qb + iq);
    const int kbmin = (qb == 0) ? 8 : 0;
    const float c1 = QK_SCALE * LOG2E, c2 = exp2f(-8.0f * (float)(g * 4 + h + 1) / 12.0f) * (float)d.dil * LOG2E;
    f32x4 sc[9];
    float mx = -1e30f;
#pragma unroll
    for (int kk = 0; kk < 9; ++kk) {
        const int kb = wave + kk;
        if (kb >= kbmin) {
            f32x4 a = (f32x4){0.f, 0.f, 0.f, 0.f};
#pragma unroll
            for (int ds = 0; ds < 4; ++ds) { const bf16x8 kf = *(const LAS bf16x8*)(Kt + (((16 * kb + off) & 255) + fr) * KP + (32 * ds + 8 * fg) * 2); a = MFMA16(kf, qf[ds], a); }
#pragma unroll
            for (int r_ = 0; r_ < 4; ++r_) { const int dist = 128 + iq - (16 * kb + 4 * fg + r_); const float s = a[r_] * c1 - c2 * (float)dist; a[r_] = (dist >= 0 && dist <= 128) ? s : -1e30f; mx = fmaxf(mx, a[r_]); }
            sc[kk] = a;
        } else sc[kk] = (f32x4){-1e30f, -1e30f, -1e30f, -1e30f};
    }
    mx = fmaxf(mx, __shfl_xor(mx, 16)); mx = fmaxf(mx, __shfl_xor(mx, 32));
    float sum = 0.f;
#pragma unroll
    for (int kk = 0; kk < 9; ++kk)
#pragma unroll
        for (int r_ = 0; r_ < 4; ++r_) { const float e = __builtin_amdgcn_exp2f(sc[kk][r_] - mx); sc[kk][r_] = e; sum += e; }
    sum += __shfl_xor(sum, 16); sum += __shfl_xor(sum, 32);
    if (has_next) { attn_load(w, dn, tid, dn.qb == 0, kreg, vreg); attn_loadq(w, dn, wave, fr, fg, qf); }
    f32x4 o[8];
#pragma unroll
    for (int eb = 0; eb < 8; ++eb) o[eb] = (f32x4){0.f, 0.f, 0.f, 0.f};
    const int q4 = fr >> 2, p4 = fr & 3;
#pragma unroll
    for (int st = 0; st < 5; ++st) {
        const int kb0 = wave + 2 * st;
        const bf16x8 pf = (st < 4) ? pack8(sc[2 * st], sc[2 * st + 1]) : pack8(sc[8], (f32x4){0.f, 0.f, 0.f, 0.f});
        const LAS unsigned char* v0 = Vt + (((16 * kb0 + off) & 255) + 4 * fg + q4) * VP + 8 * p4;
        const LAS unsigned char* v1 = Vt + (((16 * kb0 + 16 + off) & 255) + 4 * fg + q4) * VP + 8 * p4;
#pragma unroll
        for (int eb = 0; eb < 8; ++eb) {
            const v4s a0 = tr16(v0 + 32 * eb);
            const v4s a1 = (st < 4) ? tr16(v1 + 32 * eb) : (v4s){0, 0, 0, 0};
            o[eb] = MFMA16(cat8(a0, a1), pf, o[eb]);
        }
    }
    const float inv = 1.0f / sum;
    bf16_t* orow = w.og + ((size_t)g * MT + mq) * 512 + h * 128 + 4 * fg;
#pragma unroll
    for (int eb = 0; eb < 8; ++eb) { u32x2 ov; ov.x = pk2(o[eb][0] * inv, o[eb][1] * inv); ov.y = pk2(o[eb][2] * inv, o[eb][3] * inv); *(u32x2*)(orow + 16 * eb) = ov; }
    if (fg == 0) w.lse[((size_t)g * MT + mq) * 4 + h] = mx * LN2 + __logf(sum);
}
__device__ __forceinline__ void attn_phase(const Ws& w, LAS unsigned char* lds, int first, int count) {
    const int tid = opaque_tid(), lane = tid & 63, wave = __builtin_amdgcn_readfirstlane(tid >> 6), fr = lane & 15, fg = lane >> 4;
    if (count <= 0) return;
    LAS unsigned char* Kt = lds; LAS unsigned char* Vt = lds + 256 * KP;
    u32x4 kreg[8], vreg[8]; bf16x8 qf[4];
    AttnDesc d = attn_desc(first);
    attn_load(w, d, tid, true, kreg, vreg); attn_loadq(w, d, wave, fr, fg, qf);
    int off = 0; bool fresh = true;
    for (int n = 0; n < count; ++n) {
        __syncthreads();
        if (fresh) off = 0; else off = (off + 128) & 255;
#pragma unroll
        for (int i = 0; i < 4; ++i) { const int cidx = tid + 512 * i, c = (128 + (cidx >> 4) + off) & 255, ch = cidx & 15;
            *(LAS u32x4*)(Kt + c * KP + ch * 16) = kreg[i]; *(LAS u32x4*)(Vt + c * VP + ch * 16) = vreg[i]; }
        if (fresh) {
#pragma unroll
            for (int i = 4; i < 8; ++i) { const int cidx = tid + 512 * (i - 4), c = ((cidx >> 4) + off) & 255, ch = cidx & 15;
                *(LAS u32x4*)(Kt + c * KP + ch * 16) = kreg[i]; *(LAS u32x4*)(Vt + c * VP + ch * 16) = vreg[i]; }
        }
        __syncthreads();
        const AttnDesc dc = d;
        const bool has_next = n + 1 < count;
        if (has_next) { d = attn_desc(first + n + 1); fresh = (d.qb == 0); }
        attn_compute(w, lds, dc, off, qf, wave, fr, fg, has_next, d, tid, kreg, vreg);
    }
    __syncthreads();
}

__device__ __forceinline__ float half_sum(float v) {
#pragma unroll
    for (int o = 1; o < 32; o <<= 1) v += __shfl_xor(v, o);
    return v;
}
__device__ __forceinline__ void attn_sample(const Params& p, const Ws& w, LAS unsigned char* lds, int vcu, int G) {
    const int tid = opaque_tid(), lane = tid & 63, wave = tid >> 6, half = lane >> 5, c = lane & 31;
    const int gw = vcu * 8 + wave, NGW = G * 8;
    for (int it = gw; it < MS * 12; it += NGW) {
        const int g = it % 3, mh = it / 3, ms = mh >> 2, h = mh & 3, m = MP + ms, b = ms >> 3, t = ms & 7;
        const int dil = 1 << (2 * g), Wb = 128 << (2 * g);
        const int qcol = C_ATT + g * 1536 + h * 128, kcol = qcol + 512, vcol = qcol + 1024;
        f32x4 q; { const u32x2 v = *(const u32x2*)(w.proj + pofs(m, qcol + 4 * c)); q = (f32x4){bflo(v.x), bfhi(v.x), bflo(v.y), bfhi(v.y)}; }
        const float slope = exp2f(-8.0f * (float)(g * 4 + h + 1) / 12.0f) * (float)dil;
        const float* cache = p.in[3 + g];
        const int jn = t >> (2 * g);
        const int ncache = 128 - jn, npair = (ncache + 1) >> 1;
        const float* kb0 = cache + ((size_t)(b * Wb + Wb + t) * 2 + 0) * 512 + h * 128 + 4 * c;
        float* kvout = p.out + (g == 0 ? O_KV128S : (g == 1 ? O_KV512S : O_KV2048S));
        const bool owner = (g == 0) ? (t == 0) : (g == 1 ? (t < 4) : true);
        float mrun = -1e30f, sum = 0.f; f32x4 o = (f32x4){0.f, 0.f, 0.f, 0.f};
#pragma unroll
        for (int j = 0; j < 8; ++j) if (j <= jn) {
            const u32x2 kk2 = *(const u32x2*)(w.proj + pofs(m - dil * j, kcol + 4 * c)), vv = *(const u32x2*)(w.proj + pofs(m - dil * j, vcol + 4 * c));
            const float s = half_sum((bflo(kk2.x) * q[0] + bfhi(kk2.x) * q[1]) + (bflo(kk2.y) * q[2] + bfhi(kk2.y) * q[3])) * QK_SCALE - slope * (float)j;
            if (half == 0) { const float mn = fmaxf(mrun, s), al = __expf(mrun - mn), e = __expf(s - mn); mrun = mn; sum = sum * al + e;
                o = o * al; o[0] += e * bflo(vv.x); o[1] += e * bfhi(vv.x); o[2] += e * bflo(vv.y); o[3] += e * bfhi(vv.y); }
        }
        for (int k0 = 0; k0 < npair; k0 += 16) {
            f32x4 kv[16], vv[16];
#pragma unroll
            for (int u = 0; u < 16; ++u) { const int j = jn + 1 + 2 * (k0 + u) + half;
                if (k0 + u < npair && j <= 128) { const float* rp = kb0 - (size_t)(dil * j) * 1024; kv[u] = __builtin_nontemporal_load((const f32x4*)rp); vv[u] = __builtin_nontemporal_load((const f32x4*)(rp + 512));
                    const int idx = Wb + t - dil * j;
                    if (owner && idx >= 8) { float* wp = kvout + ((size_t)(b * Wb + idx - 8) * 2) * 512 + h * 128 + 4 * c; __builtin_nontemporal_store(kv[u], (f32x4*)wp); __builtin_nontemporal_store(vv[u], (f32x4*)(wp + 512)); } }
                else { kv[u] = (f32x4){0.f, 0.f, 0.f, 0.f}; vv[u] = kv[u]; } }
            float s[16]; float bm = -1e30f;
#pragma unroll
            for (int u = 0; u < 16; ++u) { const int j = jn + 1 + 2 * (k0 + u) + half;
                const float d = half_sum((kv[u][0] * q[0] + kv[u][1] * q[1]) + (kv[u][2] * q[2] + kv[u][3] * q[3]));
                s[u] = (k0 + u < npair && j <= 128) ? d * QK_SCALE - slope * (float)j : -1e30f; bm = fmaxf(bm, s[u]); }
            const float mn = fmaxf(mrun, bm), al = __expf(mrun - mn); mrun = mn; sum *= al; o = o * al;
#pragma unroll
            for (int u = 0; u < 16; ++u) { const float e = __expf(s[u] - mn); sum += e; o += vv[u] * e; }
        }
        const float mo = __shfl_xor(mrun, 32), so = __shfl_xor(sum, 32);
        const float mt = fmaxf(mrun, mo), a0 = __expf(mrun - mt), a1 = __expf(mo - mt);
        const float st = sum * a0 + so * a1;
#pragma unroll
        for (int i = 0; i < 4; ++i) o[i] = o[i] * a0 + __shfl_xor(o[i], 32) * a1;
        const float inv = 1.0f / st;
        if (half == 0) { u32x2 ov; ov.x = pk2(o[0] * inv, o[1] * inv); ov.y = pk2(o[2] * inv, o[3] * inv); *(u32x2*)(w.og + ((size_t)g * MT + m) * 512 + h * 128 + 4 * c) = ov; }
        if (lane == 0) w.lse[((size_t)g * MT + m) * 4 + h] = mt + __logf(st);
    }
}

__device__ __forceinline__ void retA_item(const Ws& w, LAS unsigned char* lds, int item) {
    const int tid = opaque_tid(), lane = tid & 63, wave = __builtin_amdgcn_readfirstlane(tid >> 6), fr = lane & 15, fg = lane >> 4;
    const int c = item & 63, bh = item >> 6, h = bh & 7, b = bh >> 3;
    const size_t m0 = (size_t)b * SEQ + c * 128;
    const float lg2 = lg2gamma(h);
    LAS unsigned char* Kt = lds; LAS unsigned char* Vt = lds + 128 * VP;
#pragma unroll
    for (int i = 0; i < 4; ++i) { const int cidx = tid + 512 * i, j = cidx >> 4, ch = cidx & 15;
        const bf16_t* rp = w.proj + pofs(m0 + j, h * 128 + ch * 8);
        const u32x4 kr = *(const u32x4*)(rp + (C_RK / 128) * PSLAB), vr = *(const u32x4*)(rp + (C_RV / 128) * PSLAB);
        const float kd = exp2f((float)(127 - j) * lg2) * QK_SCALE;
        u32x4 ks; ks.x = pk2(bflo(kr.x) * kd, bfhi(kr.x) * kd); ks.y = pk2(bflo(kr.y) * kd, bfhi(kr.y) * kd); ks.z = pk2(bflo(kr.z) * kd, bfhi(kr.z) * kd); ks.w = pk2(bflo(kr.w) * kd, bfhi(kr.w) * kd);
        *(LAS u32x4*)(Kt + j * VP + ch * 16) = ks; *(LAS u32x4*)(Vt + j * VP + ch * 16) = vr; }
    __syncthreads();
    f32x4 acc[8];
#pragma unroll
    for (int db = 0; db < 8; ++db) acc[db] = (f32x4){0.f, 0.f, 0.f, 0.f};
    const int q4 = fr >> 2, p4 = fr & 3;
#pragma unroll
    for (int st = 0; st < 4; ++st) {
        const int rowoff = (32 * st + 4 * fg + q4) * VP + 8 * p4;
        const bf16x8 af = cat8(tr16(Vt + rowoff + 32 * wave), tr16(Vt + rowoff + 16 * VP + 32 * wave));
#pragma unroll
        for (int db = 0; db < 8; ++db) { const bf16x8 bfr = cat8(tr16(Kt + rowoff + 32 * db), tr16(Kt + rowoff + 16 * VP + 32 * db)); acc[db] = MFMA16(af, bfr, acc[db]); }
    }
    __syncthreads();
    {
        LAS bf16_t* stg = (LAS bf16_t*)(lds + wave * 4096);
#pragma unroll
        for (int db = 0; db < 8; ++db)
#pragma unroll
            for (int r_ = 0; r_ < 4; ++r_) stg[(4 * fg + r_) * 128 + 16 * db + fr] = (bf16_t)f2bf(acc[db][r_]);
        LDS_WAIT();
        bf16_t* dst = (bf16_t*)w.kvc + (size_t)item * 16384 + (size_t)(16 * wave) * 128;
#pragma unroll
        for (int i = 0; i < 4; ++i) { const int row = 4 * i + (lane >> 4), ch = lane & 15; *(u32x4*)(dst + row * 128 + ch * 8) = *(const LAS u32x4*)(stg + row * 128 + ch * 8); }
    }
    __syncthreads();
}
__device__ __forceinline__ void ret_scan2(const Params& p, const Ws& w, int vcu, int G) {
    for (int i = vcu * 512 + opaque_tid(); i < 16 * 8192; i += G * 512) {
        const int bh = i >> 13, idx = (i & 8191) * 2, h = bh & 7;
        const float g128 = exp2f(128.0f * lg2gamma(h));
        const bf16_t* base = (const bf16_t*)w.kvc + (size_t)bh * 64 * 16384 + idx;
        bf16_t* sbase = w.sb + (size_t)bh * 64 * 16384 + idx;
        float s0 = 0.f, s1 = 0.f;
        for (int c0 = 0; c0 < 64; c0 += 16) {
            unsigned kv[16];
#pragma unroll
            for (int k = 0; k < 16; ++k) kv[k] = __builtin_nontemporal_load((const unsigned*)(base + (size_t)(c0 + k) * 16384));
#pragma unroll
            for (int k = 0; k < 16; ++k) { *(unsigned*)(sbase + (size_t)(c0 + k) * 16384) = pk2(s0, s1); s0 = s0 * g128 + bflo(kv[k]); s1 = s1 * g128 + bfhi(kv[k]); }
        }
        const int e = idx >> 7, d = idx & 127;
        __builtin_nontemporal_store(s0, p.out + O_RETP + (size_t)bh * 16384 + d * 128 + e); __builtin_nontemporal_store(s1, p.out + O_RETP + (size_t)bh * 16384 + (d + 1) * 128 + e);
    }
}
struct MergeIn { float l0, l1, l2; u32x4 a, b, c; };
__device__ __forceinline__ MergeIn merge_load(const Ws& w, int i) {
    const int m = i >> 6, c8 = (i & 63) * 8, h = c8 >> 7; MergeIn r;
    r.l0 = w.lse[((size_t)0 * MT + m) * 4 + h]; r.l1 = w.lse[((size_t)1 * MT + m) * 4 + h]; r.l2 = w.lse[((size_t)2 * MT + m) * 4 + h];
    r.a = __builtin_nontemporal_load((const u32x4*)(w.og + ((size_t)0 * MT + m) * 512 + c8)); r.b = __builtin_nontemporal_load((const u32x4*)(w.og + ((size_t)1 * MT + m) * 512 + c8));
    r.c = __builtin_nontemporal_load((const u32x4*)(w.og + ((size_t)2 * MT + m) * 512 + c8));
    return r;
}
__device__ __forceinline__ void merge_store(const Ws& w, int i, const MergeIn& r) {
    const int m = i >> 6, c8 = (i & 63) * 8;
    const float mx = fmaxf(r.l0, fmaxf(r.l1, r.l2));
    float w0 = __expf(r.l0 - mx), w1 = __expf(r.l1 - mx), w2 = __expf(r.l2 - mx);
    const float inv = 1.0f / (w0 + w1 + w2); w0 *= inv; w1 *= inv; w2 *= inv;
    const u32x4 a = r.a, b = r.b, c = r.c;
    u32x4 o;
    o.x = pk2(w0 * bflo(a.x) + w1 * bflo(b.x) + w2 * bflo(c.x), w0 * bfhi(a.x) + w1 * bfhi(b.x) + w2 * bfhi(c.x));
    o.y = pk2(w0 * bflo(a.y) + w1 * bflo(b.y) + w2 * bflo(c.y), w0 * bfhi(a.y) + w1 * bfhi(b.y) + w2 * bfhi(c.y));
    o.z = pk2(w0 * bflo(a.z) + w1 * bflo(b.z) + w2 * bflo(c.z), w0 * bfhi(a.z) + w1 * bfhi(b.z) + w2 * bfhi(c.z));
    o.w = pk2(w0 * bflo(a.w) + w1 * bflo(b.w) + w2 * bflo(c.w), w0 * bfhi(a.w) + w1 * bfhi(b.w) + w2 * bfhi(c.w));
    *(u32x4*)(w.Oatt + (size_t)m * 1024 + c8) = o;
}
__device__ __forceinline__ void attn_merge(const Ws& w, int vcu, int G) {
    const int step = G * 512, N = MT * 64;
    for (int i = vcu * 512 + opaque_tid(); i < N; i += 3 * step) {
        const int i2 = i + step, i3 = i + 2 * step; const bool t2 = i2 < N, t3 = i3 < N;
        const MergeIn r0 = merge_load(w, i), r1 = merge_load(w, t2 ? i2 : i), r2 = merge_load(w, t3 ? i3 : i);
        merge_store(w, i, r0);
        if (t2) merge_store(w, i2, r1);
        if (t3) merge_store(w, i3, r2);
    }
}
__device__ __forceinline__ void retC_load(const Ws& w, int item, int tid, u32x4 (&kr)[4], u32x4 (&vr)[4], u32x4 (&sr)[4]) {
    const int c = item & 63, bh = item >> 6, h = bh & 7, b = bh >> 3;
    const size_t m0 = (size_t)b * SEQ + c * 128;
    const bf16_t* sbp = w.sb + (size_t)item * 16384;
#pragma unroll
    for (int i = 0; i < 4; ++i) { const int cidx = tid + 512 * i, j = cidx >> 4, ch = cidx & 15;
        const bf16_t* rp = w.proj + pofs(m0 + j, h * 128 + ch * 8);
        kr[i] = __builtin_nontemporal_load((const u32x4*)(rp + (C_RK / 128) * PSLAB)); vr[i] = __builtin_nontemporal_load((const u32x4*)(rp + (C_RV / 128) * PSLAB)); sr[i] = __builtin_nontemporal_load((const u32x4*)(sbp + j * 128 + ch * 8)); }
}
__device__ __forceinline__ void retC_loadq(const Ws& w, int item, int wave, int fr, int fg, bf16x8 (&qf)[4]) {
    const int c = item & 63, bh = item >> 6, h = bh & 7, b = bh >> 3;
    const size_t mq = (size_t)b * SEQ + c * 128 + 16 * wave + fr;
#pragma unroll
    for (int ds = 0; ds < 4; ++ds) qf[ds] = __builtin_nontemporal_load((const bf16x8*)(w.proj + pofs(mq, C_RQ + h * 128 + 32 * ds + 8 * fg)));
}
__device__ __forceinline__ void retC_compute(const Params& p, const Ws& w, LAS unsigned char* lds, int item, bf16x8 (&qf)[4], int wave, int fr, int fg, int next_item, int tid, u32x4 (&kr)[4], u32x4 (&vr)[4], u32x4 (&sr)[4]) {
    const int c = item & 63, bh = item >> 6, h = bh & 7, b = bh >> 3;
    const size_t m0 = (size_t)b * SEQ + c * 128;
    const float lg2 = lg2gamma(h);
    LAS unsigned char* Kt = lds; LAS unsigned char* Vt = lds + 128 * KP; LAS unsigned char* St = Vt + 128 * VP;
    asm volatile("" : "+v"(fr), "+v"(fg));
    const int iq = 16 * wave + fr;
    const size_t mq = m0 + iq;
    f32x4 sc[8];
#pragma unroll
    for (int kb = 0; kb < 8; ++kb) {
        if (kb <= wave) {
            f32x4 a = (f32x4){0.f, 0.f, 0.f, 0.f};
#pragma unroll
            for (int ds = 0; ds < 4; ++ds) { const bf16x8 kf = *(const LAS bf16x8*)(Kt + (16 * kb + fr) * KP + (32 * ds + 8 * fg) * 2); a = MFMA16(kf, qf[ds], a); }
#pragma unroll
            for (int r_ = 0; r_ < 4; ++r_) { const int dj = iq - (16 * kb + 4 * fg + r_); a[r_] = (dj >= 0) ? a[r_] * QK_SCALE * exp2f((float)dj * lg2) : 0.f; }
            sc[kb] = a;
        } else sc[kb] = (f32x4){0.f, 0.f, 0.f, 0.f};
    }
    f32x4 y[8], cr[8];
#pragma unroll
    for (int eb = 0; eb < 8; ++eb) { y[eb] = (f32x4){0.f, 0.f, 0.f, 0.f}; cr[eb] = (f32x4){0.f, 0.f, 0.f, 0.f}; }
    const int q4 = fr >> 2, p4 = fr & 3;
#pragma unroll
    for (int st = 0; st < 4; ++st) {
        if (2 * st <= wave) {
            const bf16x8 pf = pack8(sc[2 * st], sc[2 * st + 1]);
            const LAS unsigned char* v0 = Vt + (32 * st + 4 * fg + q4) * VP + 8 * p4;
#pragma unroll
            for (int eb = 0; eb < 8; ++eb) y[eb] = MFMA16(cat8(tr16(v0 + 32 * eb), tr16(v0 + 16 * VP + 32 * eb)), pf, y[eb]);
        }
    }
#pragma unroll
    for (int eb = 0; eb < 8; ++eb)
#pragma unroll
        for (int ds = 0; ds < 4; ++ds) { const bf16x8 sf = *(const LAS bf16x8*)(St + (16 * eb + fr) * KP + (32 * ds + 8 * fg) * 2); cr[eb] = MFMA16(sf, qf[ds], cr[eb]); }
    if (next_item >= 0) { retC_load(w, next_item, tid, kr, vr, sr); retC_loadq(w, next_item, wave, fr, fg, qf); }
    const float qd = exp2f((float)(iq + 1) * lg2);
    float s = 0.f;
#pragma unroll
    for (int eb = 0; eb < 8; ++eb) { y[eb] = y[eb] + cr[eb] * qd; s += (y[eb][0] + y[eb][1]) + (y[eb][2] + y[eb][3]); }
    s += __shfl_xor(s, 16); s += __shfl_xor(s, 32);
    const float mean = s * (1.0f / 128.0f);
    float v = 0.f;
#pragma unroll
    for (int eb = 0; eb < 8; ++eb) { y[eb] = y[eb] - mean; v += (y[eb][0] * y[eb][0] + y[eb][1] * y[eb][1]) + (y[eb][2] * y[eb][2] + y[eb][3] * y[eb][3]); }
    v += __shfl_xor(v, 16); v += __shfl_xor(v, 32);
    const float rstd = rsqrtf(v * (1.0f / 128.0f) + EPS);
    const float* gn = p.in[9] + h * 128 + 4 * fg;
    const bf16_t* grow = w.proj + pofs(mq, C_RG + h * 128 + 4 * fg);
    bf16_t* orow = w.G + mq * 1024 + h * 128 + 4 * fg;
#pragma unroll
    for (int eb = 0; eb < 8; ++eb) { const f32x4 gv = *(const f32x4*)(gn + 16 * eb); const u32x2 sg = __builtin_nontemporal_load((const u32x2*)(grow + 16 * eb));
        u32x2 ov; ov.x = pk2(y[eb][0] * rstd * gv[0] * bflo(sg.x), y[eb][1] * rstd * gv[1] * bfhi(sg.x)); ov.y = pk2(y[eb][2] * rstd * gv[2] * bflo(sg.y), y[eb][3] * rstd * gv[3] * bfhi(sg.y));
        *(u32x2*)(orow + 16 * eb) = ov; }
}
__device__ __forceinline__ void retC_phase(const Params& p, const Ws& w, LAS unsigned char* lds, int vcu, int G) {
    const int tid = opaque_tid(), lane = tid & 63, wave = __builtin_amdgcn_readfirstlane(tid >> 6), fr = lane & 15, fg = lane >> 4;
    if (vcu >= 1024) return;
    LAS unsigned char* Kt = lds; LAS unsigned char* Vt = lds + 128 * KP; LAS unsigned char* St = Vt + 128 * VP;
    u32x4 kr[4], vr[4], sr[4]; bf16x8 qf[4];
    retC_load(w, vcu, tid, kr, vr, sr); retC_loadq(w, vcu, wave, fr, fg, qf);
    for (int item = vcu; item < 1024; item += G) {
        __syncthreads();
#pragma unroll
        for (int i = 0; i < 4; ++i) { const int cidx = tid + 512 * i, j = cidx >> 4, ch = cidx & 15;
            *(LAS u32x4*)(Kt + j * KP + ch * 16) = kr[i]; *(LAS u32x4*)(Vt + j * VP + ch * 16) = vr[i]; *(LAS u32x4*)(St + j * KP + ch * 16) = sr[i]; }
        __syncthreads();
        retC_compute(p, w, lds, item, qf, wave, fr, fg, (item + G < 1024) ? item + G : -1, tid, kr, vr, sr);
    }
    __syncthreads();
}

__device__ __forceinline__ void panel_arrive_wait(unsigned* cnt, unsigned want);
__device__ __forceinline__ void sg_accum(f32x4 (&acc)[2][4], const bf16_t* A, int lda, const bf16_t* Bt, int K, int r0, int n0, int wave, int fr, int fq, int ldb = 0) {
    if (ldb == 0) ldb = K;
    const int kw = K / 8, k0 = wave * kw;
    const bf16_t* ap = A + (size_t)(r0 + fr) * lda + k0 + 8 * fq;
    const bf16_t* bp = Bt + (size_t)(n0 + fr) * ldb + k0 + 8 * fq;
    int ks = 0;
    for (; ks + 128 <= kw; ks += 128) {
        bf16x8 a[4][2], b[4][4];
#pragma unroll
        for (int s = 0; s < 4; ++s) {
#pragma unroll
            for (int i = 0; i < 2; ++i) a[s][i] = *(const bf16x8*)(ap + (size_t)(16 * i) * lda + ks + 32 * s);
#pragma unroll
            for (int j = 0; j < 4; ++j) b[s][j] = *(const bf16x8*)(bp + (size_t)(16 * j) * ldb + ks + 32 * s);
        }
#pragma unroll
        for (int s = 0; s < 4; ++s)
#pragma unroll
            for (int i = 0; i < 2; ++i)
#pragma unroll
                for (int j = 0; j < 4; ++j) acc[i][j] = MFMA16(b[s][j], a[s][i], acc[i][j]);
    }
    for (; ks < kw; ks += 64) {
        bf16x8 a[2][2], b[2][4];
#pragma unroll
        for (int s = 0; s < 2; ++s) {
#pragma unroll
            for (int i = 0; i < 2; ++i) a[s][i] = *(const bf16x8*)(ap + (size_t)(16 * i) * lda + ks + 32 * s);
#pragma unroll
            for (int j = 0; j < 4; ++j) b[s][j] = *(const bf16x8*)(bp + (size_t)(16 * j) * ldb + ks + 32 * s);
        }
#pragma unroll
        for (int s = 0; s < 2; ++s)
#pragma unroll
            for (int i = 0; i < 2; ++i)
#pragma unroll
                for (int j = 0; j < 4; ++j) acc[i][j] = MFMA16(b[s][j], a[s][i], acc[i][j]);
    }
}
template <int MODE>
__device__ __forceinline__ void sample_gemm(const Params& p, const Ws& w, LAS unsigned char* lds, int vcu, int G) {
    const int tid = opaque_tid(), lane = tid & 63, wave = __builtin_amdgcn_readfirstlane(tid >> 6), fr = lane & 15, fq = lane >> 4;
    LAS f32x4* red = (LAS f32x4*)lds;
    for (int unit = vcu; unit < 256; unit += G) {
        const int rg = (unit & 31) >> 2, r0 = rg * 32, n0 = ((unit >> 5) * 4 + (unit & 3)) * 64;
        f32x4 acc[2][4];
#pragma unroll
        for (int i = 0; i < 2; ++i)
#pragma unroll
            for (int j = 0; j < 4; ++j) acc[i][j] = (f32x4){0.f, 0.f, 0.f, 0.f};
        if (MODE == 5) {
            sg_accum(acc, w.G + (size_t)MP * 1024, 1024, w.Wt_reto, 1024, r0, n0, wave, fr, fq);
            f32x4 acc2[2][4];
#pragma unroll
            for (int i = 0; i < 2; ++i)
#pragma unroll
                for (int j = 0; j < 4; ++j) acc2[i][j] = (f32x4){0.f, 0.f, 0.f, 0.f};
            sg_accum(acc2, w.Oatt + (size_t)MP * 1024, 1024, w.Wt_atto, 512, r0, n0, wave, fr, fq, 1024);
#pragma unroll
            for (int i = 0; i < 2; ++i)
#pragma unroll
                for (int j = 0; j < 4; ++j) { const unsigned char* gp = w.g8 + (size_t)(MP + r0 + 16 * i + fr) * 4096 + n0 + 16 * j + 4 * fq;
                    acc[i][j] = acc[i][j] * dec8x4(*(const unsigned*)gp) + acc2[i][j] * dec8x4(*(const unsigned*)(gp + 2048)); }
        } else if (MODE == 6) sg_accum(acc, w.merged + (size_t)MP * DM, DM, w.Wt_o, DM, r0, n0, wave, fr, fq);
        else sg_accum(acc, w.act + (size_t)MP * FF, FF, w.Wt_down, FF, r0, n0, wave, fr, fq);
        __syncthreads();
#pragma unroll
        for (int i = 0; i < 2; ++i)
#pragma unroll
            for (int j = 0; j < 4; ++j) red[(wave * 8 + i * 4 + j) * 64 + lane] = acc[i][j];
        __syncthreads();
        const int blk = tid >> 6;
        f32x4 v = red[blk * 64 + lane];
#pragma unroll
        for (int ww = 1; ww < 8; ++ww) v += red[(ww * 8 + blk) * 64 + lane];
        const int row = MP + r0 + 16 * (blk >> 2) + fr, col = n0 + 16 * (blk & 3) + 4 * fq;
        if (MODE == 5) { u32x2 o; o.x = pk2(v[0], v[1]); o.y = pk2(v[2], v[3]); *(u32x2*)(w.merged + (size_t)row * DM + col) = o; }
        else if (MODE == 6) {
            { const u32x2 xv = *(const u32x2*)(w.xb + (size_t)row * DM + col); const float xs_ = w.rstd1[row]; v[0] += bflo(xv.x) * xs_; v[1] += bfhi(xv.x) * xs_; v[2] += bflo(xv.y) * xs_; v[3] += bfhi(xv.y) * xs_; }
            u32x2 o; o.x = pk2(v[0], v[1]); o.y = pk2(v[2], v[3]); *(u32x2*)(w.xb + (size_t)row * DM + col) = o;
            atomicAdd(w.sumsq2 + row, (v[0] * v[0] + v[1] * v[1]) + (v[2] * v[2] + v[3] * v[3]));
        } else {
            float* dst = p.out + O_Y + (size_t)row * DM + col;
            { const u32x2 xv = *(const u32x2*)(w.xb + (size_t)row * DM + col); v[0] += bflo(xv.x); v[1] += bfhi(xv.x); v[2] += bflo(xv.y); v[3] += bfhi(xv.y); }
            atomicAdd(w.sumsq3 + row, (v[0] * v[0] + v[1] * v[1]) + (v[2] * v[2] + v[3] * v[3]));
            asm volatile("s_waitcnt vmcnt(0)" ::: "memory"); __syncthreads();
            if (tid == 0) panel_arrive_wait((unsigned*)(p.ws + WS_PCNT) + 16 * (64 + rg), 32u);
            __syncthreads();
            const float rs = rsqrtf(__hip_atomic_load(w.sumsq3 + row, __ATOMIC_RELAXED, __HIP_MEMORY_SCOPE_AGENT) * (1.0f / DM) + EPS);
            __builtin_nontemporal_store(v * rs * *(const f32x4*)(p.in[18] + col), (f32x4*)dst);
        }
        __syncthreads();
    }
}

#define XB_TMO      128
#define XB_XCNT(j)  (256  + 64 * (j))
#define XB_XSUB(j)  (1280 + 64 * (j))
#define XB_XGEN(j)  (2304 + 64 * (j))
#define XB_TOP      3328
#define XB_TOPGEN   3392
#define XCD_BAR_WORDS 3456
#define XB_SPIN_CAP (1u << 18)
__device__ __forceinline__ unsigned xb_ld(unsigned* p)              { return __hip_atomic_load(p, __ATOMIC_RELAXED, __HIP_MEMORY_SCOPE_AGENT); }
__device__ __forceinline__ unsigned xb_add(unsigned* p, unsigned v) { return __hip_atomic_fetch_add(p, v, __ATOMIC_RELAXED, __HIP_MEMORY_SCOPE_AGENT); }
__device__ __forceinline__ unsigned xb_xcc_id() { return (unsigned)__builtin_amdgcn_s_getreg((3 << 11) | 20) & 0xFu; }
#define XB_SPIN(cond, bar) do { unsigned _sp = 0; while (cond) { __builtin_amdgcn_s_sleep(1); \
    if ((++_sp & 255u) == 0u) { if (xb_ld(&(bar)[XB_TMO])) break; if (_sp > XB_SPIN_CAP) { atomicAdd(&(bar)[XB_TMO], 1u); break; } } } } while (0)
struct XcdBarrier { unsigned* bar; unsigned x; volatile LAS unsigned* st; };
__device__ __forceinline__ XcdBarrier xcd_barrier_post(unsigned* bar, volatile LAS unsigned* st) {
    XcdBarrier b; b.bar = bar; b.x = xb_xcc_id(); b.st = st;
    if (threadIdx.x == 0) (void)xb_add(&bar[XB_XCNT(b.x)], 1u);
    return b;
}
__device__ __forceinline__ void xcd_barrier_complete(unsigned* bar, unsigned x, unsigned& nloc, unsigned& nx) {
    const unsigned G = gridDim.x * gridDim.y * gridDim.z;
    unsigned sum, cnt, mine, sp = 0u;
    for (;;) {
        sum = 0u; cnt = 0u; mine = 0u;
#pragma unroll
        for (unsigned j = 0; j < 16; ++j) { const unsigned c = xb_ld(&bar[XB_XCNT(j)]); sum += c; cnt += (c > 0u) ? 1u : 0u; mine = (j == x) ? c : mine; }
        if (sum == G) break;
        __builtin_amdgcn_s_sleep(1);
        if ((++sp & 255u) == 0u) { if (xb_ld(&bar[XB_TMO])) break; if (sp > XB_SPIN_CAP) { atomicAdd(&bar[XB_TMO], 1u); break; } }
    }
    nloc = mine > 0u ? mine : 1u; nx = cnt > 0u ? cnt : 1u;
}
__device__ __forceinline__ void xcd_barrier(const XcdBarrier& b) {
    asm volatile("s_waitcnt vmcnt(0)" ::: "memory");
    __syncthreads();
    if (threadIdx.x == 0) {
        unsigned* bar = b.bar;
        __builtin_amdgcn_s_waitcnt(0);
        unsigned nloc = b.st[0], nx = b.st[1];
        if (nloc == 0u) { xcd_barrier_complete(bar, b.x, nloc, nx); b.st[0] = nloc; b.st[1] = nx; }
        const unsigned old = xb_add(&bar[XB_XSUB(b.x)], 1u);
        const unsigned gen = old / nloc;
        if (old + 1u == (gen + 1u) * nloc) {
            __builtin_amdgcn_fence(__ATOMIC_RELEASE, "agent");
            asm volatile("s_waitcnt vmcnt(0)" ::: "memory");
            const unsigned og = xb_add(&bar[XB_TOP], 1u);
            const unsigned tg = og / nx;
            if (og + 1u == (tg + 1u) * nx) xb_add(&bar[XB_TOPGEN], 1u);
            else XB_SPIN(xb_ld(&bar[XB_TOPGEN]) == tg, bar);
            __builtin_amdgcn_fence(__ATOMIC_ACQUIRE, "agent");
            xb_add(&bar[XB_XGEN(b.x)], 1u);
            asm volatile("s_waitcnt vmcnt(0)" ::: "memory");
        } else {
            XB_SPIN(xb_ld(&bar[XB_XGEN(b.x)]) == gen, bar);
            __builtin_amdgcn_fence(__ATOMIC_ACQUIRE, "agent");
            asm volatile("s_waitcnt vmcnt(0)" ::: "memory");
        }
    }
    __syncthreads();
}

constexpr int LDS_BYTES = 147456;
constexpr int LDS_BARST = 143360;
constexpr int NPHASE = 12;
__global__ void __launch_bounds__(512, 2) fwd_kernel(Params p) {
    extern __shared__ __attribute__((aligned(16))) unsigned char lds_raw[];
    LAS unsigned char* lds = (LAS unsigned char*)lds_raw;
    const Ws w = make_ws(p.ws);
    const int G = gridDim.x; const int bx = blockIdx.x;
    const int vcu = (G % 8 == 0) ? (bx % 8) * (G / 8) + bx / 8 : bx;
    const int lo = p.ph_lo, hi = p.ph_hi;
    volatile LAS unsigned* barst = (volatile LAS unsigned*)(lds + LDS_BARST);
    if (threadIdx.x < 2) barst[threadIdx.x] = 0u;
    __syncthreads();
    XcdBarrier bar = xcd_barrier_post((unsigned*)(p.ws + WS_BAR), barst);
#define IN(k) (lo <= (k) && (k) < hi)
    if (lo < 0) cg::this_grid().sync();
#define SEAM(k) do { if (IN(k) && IN((k) + 1)) xcd_barrier(bar); } while (0)
    if (IN(0)) { weight_transposes<0>(p, w, lds, vcu, G); p0_xconv(p, w, lds, vcu, G);
        if (KVSLACK < 100) kv_copy_range(p, KV_SPLIT, KV_TOTAL, vcu, G); } SEAM(0);
    const size_t kv_s1 = KV_SPLIT / 100 * 20;
    const int n1 = (65 * 50) % G, n7 = (67 * 44) % G;
    if (IN(1)) {
        pg8::Gemm g{w.xb, w.Wt_in, MT, INC, DM}; pg8::StaticOrder S; S.init(MT, INC, G, bx); S.pmul = 13; EpiIn E{w, p.out};
        pg8::gemm_phase<EpiIn, pg8::StaticOrder, true, true>(lds, g, S, E);
        if (n1 == 0) { weight_transposes<1>(p, w, lds, vcu, G); kv_copy_range(p, 0, kv_s1, vcu, G); } else if (bx >= n1) { weight_transposes<1>(p, w, lds, bx - n1, G - n1); kv_copy_range(p, 0, kv_s1, bx - n1, G - n1); } } SEAM(1);
    if (vcu & 1) { if (IN(5)) { attn_sample(p, w, lds, vcu, G); __syncthreads(); } if (IN(4)) { ret_sample(p, w, lds, vcu, G); __syncthreads(); } }
    { const int per = (1536 + G - 1) / G;
      if (IN(2)) attn_phase(w, lds, vcu * per, min(per, 1536 - vcu * per)); }
    if (IN(3)) { for (int it = vcu; it < 1024; it += G) retA_item(w, lds, it); }
    if (!(vcu & 1)) { if (IN(4)) { ret_sample(p, w, lds, vcu, G); __syncthreads(); } if (IN(5)) { attn_sample(p, w, lds, vcu, G); } } SEAM(5);
    if (IN(6)) { ret_scan2(p, w, vcu, G); attn_merge(w, vcu, G); } SEAM(6);
    if (IN(7)) { retC_phase(p, w, lds, vcu, G); } SEAM(7);
    if (IN(8)) {
        { pg8::Gemm g{w.G, w.Wt_reto, MP, DM, 1024}; pg8::SegOrder S; S.base.init(MP, DM, G, bx); S.A1 = w.Oatt; S.B1t = w.Wt_atto; S.nt0 = 16; S.nt1 = 8; EpiP5 E{w};
          pg8::gemm_phase<EpiP5, pg8::SegOrder, true, true>(lds, g, S, E); }
        sample_gemm<5>(p, w, lds, vcu, G); } SEAM(8);
    if (IN(9)) { pg8::Gemm g{w.merged, w.Wt_o, MP, DM, DM}; pg8::StaticOrder S; S.init(MP, DM, G, bx); EpiWo E{w};
        pg8::gemm_phase<EpiWo, pg8::StaticOrder, true, true>(lds, g, S, E);
        sample_gemm<6>(p, w, lds, vcu, G); } SEAM(9);
    if (IN(10)) {
        pg8::Gemm g{w.xb, w.Wt_up, MT, F2, DM}; pg8::UpOrder S; S.init_up(G, bx); EpiUp E{w, p.out, p.in[15], p.in[16], p.in[6]};
        pg8::gemm_phase<EpiUp, pg8::UpOrder, true, true>(lds, g, S, E);
        if (n7 == 0) { weight_transposes<2>(p, w, lds, vcu, G); kv_copy_range(p, kv_s1, KV_SPLIT, vcu, G); } else if (bx >= n7) { weight_transposes<2>(p, w, lds, bx - n7, G - n7); kv_copy_range(p, kv_s1, KV_SPLIT, bx - n7, G - n7); } } SEAM(10);
    if (IN(11)) { pg8::Gemm g{w.act, w.Wt_down, MP, DM, FF}; pg8::PanelOrder S{vcu}; EpiFin E{w, p.out, p.in[18], (unsigned*)(p.ws + WS_PCNT)};
        pg8::gemm_phase<EpiFin, pg8::PanelOrder, true, true>(lds, g, S, E);
        sample_gemm<8>(p, w, lds, vcu, G); }
#undef IN
#undef SEAM
}

extern "C" void kernel_launch(void* const* d_in, const int* in_sizes, int n_in, void* d_out, int out_size, void* d_ws, size_t ws_size, hipStream_t stream) {
    static int grid = 0;
    if (grid == 0) {
        if (n_in != 19 || (size_t)out_size != O_END || ws_size < WS_END) { fprintf(stderr, "kernel_launch: unexpected shapes: n_in %d out %d ws %zu\n", n_in, out_size, ws_size); grid = -1; return; }
        int dev = 0, cus = 0;
        if (hipGetDevice(&dev) != hipSuccess || hipDeviceGetAttribute(&cus, hipDeviceAttributeMultiprocessorCount, dev) != hipSuccess) { fprintf(stderr, "kernel_launch: device query failed\n"); grid = -1; return; }
        if (hipFuncSetAttribute((const void*)fwd_kernel, hipFuncAttributeMaxDynamicSharedMemorySize, LDS_BYTES) != hipSuccess) { fprintf(stderr, "kernel_launch: cannot get %d bytes of LDS\n", LDS_BYTES); grid = -1; return; }
        int per_cu = 0;
        if (hipOccupancyMaxActiveBlocksPerMultiprocessor(&per_cu, (const void*)fwd_kernel, 512, LDS_BYTES) != hipSuccess || per_cu < 1) fprintf(stderr, "kernel_launch: occupancy query says %d blocks/CU\n", per_cu);
        (void)hipGetLastError();
        grid = cus;
        if (grid != 256) { fprintf(stderr, "kernel_launch: this kernel is laid out for 256 CUs, device has %d\n", cus); grid = -1; return; }
    }
    if (grid < 0) return;
    if (hipMemsetAsync((char*)d_ws + WS_BAR, 0, 32768, stream) != hipSuccess) { fprintf(stderr, "kernel_launch: memset failed\n"); return; }
    Params p{};
    for (int i = 0; i < 19; ++i) p.in[i] = (const float*)d_in[i];
    p.out = (float*)d_out; p.ws = (unsigned char*)d_ws;
    p.ph_lo = 0; p.ph_hi = NPHASE;
    void* args[] = {&p};
    hipError_t e = hipLaunchCooperativeKernel((const void*)fwd_kernel, dim3(grid), dim3(512), args, LDS_BYTES, stream);
    if (e != hipSuccess) fprintf(stderr, "cooperative launch failed: %s (grid %d)\n", hipGetErrorString(e), grid);
}
```

```cpp
#include <hip/hip_runtime.h>
#include <hip/hip_cooperative_groups.h>
#include <cstdio>
#include <cstdint>
namespace cg = cooperative_groups;

#define LAS __attribute__((address_space(3)))
typedef unsigned short bf16_t;
typedef short bf16x8 __attribute__((ext_vector_type(8)));
typedef float f32x4 __attribute__((ext_vector_type(4)));
typedef float f32x2 __attribute__((ext_vector_type(2)));
typedef unsigned u32x4 __attribute__((ext_vector_type(4)));
typedef unsigned u32x2 __attribute__((ext_vector_type(2)));

constexpr int DM = 2048, SEQ = 8192, MP = 16384, MS = 256, MT = MP + MS;
constexpr int INC = 12800, FF = 5632, F2 = 11264;
constexpr int C_RQ = 0, C_RK = 1024, C_RV = 2048, C_RG = 3072, C_ATT = 4096, C_GR = 8704, C_GA = 10752;
constexpr float EPS = 1e-6f;
constexpr float QK_SCALE = 0.08838834764831845f;
constexpr size_t O_Y = 0;
constexpr size_t O_RETP = 34078720, O_RETS = 34340864;
constexpr size_t O_KV128P = 38535168, O_KV128S = 38797312, O_KV512P = 42991616, O_KV512S = 44040192, O_KV2048P = 60817408, O_KV2048S = 65011712;
constexpr size_t O_CONVP = 132120576, O_CONVS = 132165632, O_END = 132886528;
constexpr size_t MiB = 1u << 20;
constexpr size_t WS_CTL = 0;
constexpr size_t WS_WIN = 1 * MiB, WS_WRETO = 51 * MiB, WS_WATTO = 55 * MiB, WS_WO = 57 * MiB, WS_WUP = 65 * MiB, WS_WDOWN = 109 * MiB;
constexpr size_t WS_XB = 131 * MiB;
constexpr size_t WS_PROJ = 196 * MiB;
constexpr size_t WS_KVC = 603 * MiB;
constexpr size_t WS_SB = 667 * MiB;
constexpr size_t WS_G = 699 * MiB;
constexpr size_t WS_OG = 732 * MiB;
constexpr size_t WS_LSE = 781 * MiB;
constexpr size_t WS_OATT = 930 * MiB;
constexpr size_t WS_MERGED = 799 * MiB;
constexpr size_t WS_ACT = 603 * MiB;
constexpr size_t WS_G8 = 864 * MiB;
constexpr size_t WS_WATTO_P = 964 * MiB;
constexpr size_t WS_END = 968 * MiB;
constexpr size_t WS_BAR = 512 * 1024;
constexpr size_t WS_PCNT = WS_BAR + 16384;

struct Params {
    const float* in[19];
    float* out;
    unsigned char* ws;
    int ph_lo, ph_hi, dummy, pad;
};

constexpr size_t PSLAB = (size_t)MT * 128;
__device__ __forceinline__ size_t pofs(size_t row, int col) { return ((size_t)(col >> 7) * MT + row) * 128 + (col & 127); }
__device__ __forceinline__ float bflo(unsigned w) { return __uint_as_float(w << 16); }
__device__ __forceinline__ float bfhi(unsigned w) { return __uint_as_float(w & 0xffff0000u); }
__device__ __forceinline__ float bf2f(bf16_t b) { return __uint_as_float((unsigned)b << 16); }
__device__ __forceinline__ unsigned f2bf(float f) { unsigned u = __float_as_uint(f); return (u + 0x7fffu + ((u >> 16) & 1u)) >> 16; }
typedef __bf16 bf16x2_t __attribute__((ext_vector_type(2)));
__device__ __forceinline__ unsigned pk2(float lo, float hi) { f32x2 v = {lo, hi}; bf16x2_t b = __builtin_convertvector(v, bf16x2_t); return __builtin_bit_cast(unsigned, b); }
__device__ __forceinline__ unsigned enc8(float s) { const unsigned c = (unsigned)(s * 256.0f); return c > 255u ? 255u : c; }
__device__ __forceinline__ unsigned enc8x4(f32x4 s) {
    return enc8(s[0]) | (enc8(s[1]) << 8) | (enc8(s[2]) << 16) | (enc8(s[3]) << 24);
}
__device__ __forceinline__ f32x4 dec8x4(unsigned c) { return ((f32x4){(float)(c & 255u), (float)((c >> 8) & 255u), (float)((c >> 16) & 255u), (float)(c >> 24)} + 0.5f) * (1.0f / 256.0f); }
__device__ __forceinline__ float wave_sum(float v) {
#pragma unroll
    for (int o = 1; o < 64; o <<= 1) v += __shfl_xor(v, o);
    return v;
}
__device__ __forceinline__ float wave_max(float v) {
#pragma unroll
    for (int o = 1; o < 64; o <<= 1) v = fmaxf(v, __shfl_xor(v, o));
    return v;
}
__device__ __forceinline__ unsigned sigcode(float v) { return (unsigned)__builtin_amdgcn_rcpf(__builtin_amdgcn_exp2f(fmaf(v, -1.4426950408889634f, -7.99994364f)) + (1.0f / 255.99f)); }
__device__ __forceinline__ unsigned sigcode4(f32x4 s) { return sigcode(s[0]) | (sigcode(s[1]) << 8) | (sigcode(s[2]) << 16) | (sigcode(s[3]) << 24); }
__device__ __forceinline__ float sigmoidf_(float v) { return __builtin_amdgcn_rcpf(1.0f + __builtin_amdgcn_exp2f(v * -1.4426950408889634f)); }
#define LDS_WAIT() asm volatile("s_waitcnt lgkmcnt(0)" ::: "memory")
__device__ __forceinline__ int opaque_tid() { int t = threadIdx.x; asm volatile("" : "+v"(t)); return t; }

namespace pg8 {
#define PG8_LAS __attribute__((address_space(3)))
constexpr int BM = 256, BK = 64, HALF = 128, HTB = HALF * BK * 2, STAGE_BYTES = 8 * HTB, NXCD = 8, WGM = 4;
__host__ __device__ __forceinline__ int lds_byte(int r, int c) { const int st = (r >> 4) * 2 + (c >> 5), rr = r & 15, cc = c & 31, ob = rr * 64 + cc * 2; return st * 1024 + (ob ^ (((ob >> 9) & 1) << 5)); }
__host__ __device__ __forceinline__ void stage_rc(int b, int& R, int& C) { const int st = b / 1024, sb = b % 1024, swz = sb ^ (((sb >> 9) & 1) << 5); R = (st >> 1) * 16 + swz / 64; C = (st & 1) * 32 + (swz % 64) / 2; }
__host__ __device__ __forceinline__ int perm32(int rho) { const int n = rho >> 4, i = rho & 15; return 8 * (i >> 2) + 4 * n + (i & 3); }
struct Unit { int pm, pn, seg; };
struct Gemm { const bf16_t* A; const bf16_t* Bt; int M, N, K; };
struct StaticOrder {
    int nM, nN, nwg, G, c, pmul;
    __host__ __device__ void init(int M, int N, int G_, int c_) { nM = M / BM; nN = N / BM; nwg = nM * nN; G = G_; c = c_; pmul = 1; }
    __host__ __device__ bool next(int i, Unit& u) const {
        const long L = (long)i * G + c; if (L >= nwg) return false;
        int wgid = (int)L; { const int q = nwg / NXCD, r = nwg % NXCD, xcd = wgid % NXCD, off = wgid / NXCD; wgid = (xcd < r ? xcd * (q + 1) : r * (q + 1) + (xcd - r) * q) + off; }
        const int nig = WGM * nN, gid = wgid / nig, fm = gid * WGM, gsz = (nM - fm) < WGM ? (nM - fm) : WGM;
        u.pm = fm + ((wgid % nig) % gsz); u.pn = (((wgid % nig) / gsz) * pmul) % nN; u.seg = 0; return true;
    }
    __device__ __forceinline__ void a_ready(const Unit&) const {}
    __device__ __forceinline__ void done(const Unit&) const {}
    __device__ __forceinline__ long a_off(const Unit& u, int K) const { return (long)u.pm * 256 * K * 2; }
    __device__ __forceinline__ const char* a_ptr(const Gemm& g, const Unit& u) const { return (const char*)g.A + a_off(u, g.K); }
    __device__ __forceinline__ const char* b_ptr(const Gemm& g, const Unit& u) const { return (const char*)g.Bt + (size_t)u.pn * 256 * g.K * 2; }
    __device__ __forceinline__ int nt(const Gemm& g, const Unit&) const { return g.K / BK; }
    __device__ __forceinline__ bool keep(const Unit&) const { return false; }
};
struct SegOrder {
    StaticOrder base; const bf16_t* A1; const bf16_t* B1t; int nt0, nt1;
    __device__ __forceinline__ bool next(int i, Unit& u) const { if (!base.next(i >> 1, u)) return false; u.seg = i & 1; return true; }
    __device__ __forceinline__ void a_ready(const Unit&) const {}
    __device__ __forceinline__ void done(const Unit&) const {}
    __device__ __forceinline__ const char* a_ptr(const Gemm& g, const Unit& u) const { return (const char*)(u.seg ? A1 : g.A) + (size_t)u.pm * 256 * g.K * 2; }
    __device__ __forceinline__ const char* b_ptr(const Gemm& g, const Unit& u) const { return (const char*)(u.seg ? B1t : g.Bt) + (size_t)u.pn * 256 * g.K * 2; }
    __device__ __forceinline__ int nt(const Gemm&, const Unit& u) const { return u.seg ? nt1 : nt0; }
    __device__ __forceinline__ bool keep(const Unit& u) const { return u.seg == 0; }
};
struct PanelOrder {
    int v;
    __device__ __forceinline__ bool next(int i, Unit& u) const { if (i >= 2) return false; u.pm = i * 32 + (v >> 3); u.pn = v & 7; u.seg = 0; return true; }
    __device__ __forceinline__ void a_ready(const Unit&) const {}
    __device__ __forceinline__ void done(const Unit&) const {}
    __device__ __forceinline__ const char* a_ptr(const Gemm& g, const Unit& u) const { return (const char*)g.A + (size_t)u.pm * 256 * g.K * 2; }
    __device__ __forceinline__ const char* b_ptr(const Gemm& g, const Unit& u) const { return (const char*)g.Bt + (size_t)u.pn * 256 * g.K * 2; }
    __device__ __forceinline__ int nt(const Gemm& g, const Unit&) const { return g.K / BK; }
    __device__ __forceinline__ bool keep(const Unit&) const { return false; }
};
struct UpOrder : StaticOrder {
    __host__ __device__ void init_up(int G_, int c_) { nM = 67; nN = 44; nwg = nM * nN; G = G_; c = c_; pmul = 1; }
    __device__ __forceinline__ long a_off(const Unit& u, int K) const { const int row0 = (u.pm < 66) ? (u.pm / 33) * 8192 + 254 * (u.pm % 33) - 2 : 16384; return (long)row0 * K * 2; }
    __device__ __forceinline__ const char* a_ptr(const Gemm& g, const Unit& u) const { return (const char*)g.A + a_off(u, g.K); }
};

template <class Epi, class Sched, bool ALIGN_EPI = false, bool SP2 = false>
__device__ __forceinline__ void gemm_phase(PG8_LAS unsigned char* lds, const Gemm g, const Sched& S, const Epi& E) {
    const int tid = opaque_tid(), wid = __builtin_amdgcn_readfirstlane(tid >> 6), lane = tid & 63, wr = wid >> 2, wc = wid & 3, fr = lane & 15, fq = lane >> 4;
    const int K = g.K;
    unsigned voffA[2], voffB[2];
#pragma unroll
    for (int i = 0; i < 2; ++i) { int R, C; stage_rc(tid * 16 + i * 8192, R, C); const int Rb = Epi::PERM ? ((R & ~31) + perm32(R & 31)) : R;
        const int Ra = Epi::APERM ? ((R & ~63) + 4 * (R & 15) + ((R >> 4) & 3)) : R;
        voffA[i] = (unsigned)(Ra * K + C) * 2u; voffB[i] = (unsigned)(Rb * K + C) * 2u; }
    const size_t kstep = (size_t)(BK * 2);
    const size_t hstep = (size_t)HALF * K * 2;
    const unsigned ldsw = (unsigned)wid * 1024u;
    const int aoff = lds_byte(wr * 64 + fr, fq * 8), boff = lds_byte(wc * 32 + fr, fq * 8);
#define PG8_SA(b, h) (((b) * 2 + (h)) * HTB)
#define PG8_SB(b, h) ((4 + (b) * 2 + (h)) * HTB)
#define PG8_STAGE(bufoff, gbase, voff) do { _Pragma("unroll") for (int _i = 0; _i < 2; ++_i) \
        __builtin_amdgcn_global_load_lds((const unsigned*)((const char*)(gbase) + (voff)[_i]), (PG8_LAS unsigned*)(lds + (bufoff) + ldsw + _i * 8192), 16, 0, 0); } while (0)
#define PG8_LDA(dst, b, h) do { _Pragma("unroll") for (int m = 0; m < 4; ++m) _Pragma("unroll") for (int k = 0; k < 2; ++k) dst[m][k] = *(const PG8_LAS bf16x8*)(lds + PG8_SA(b, h) + aoff + m * 2048 + k * 1024); } while (0)
#define PG8_LDB(dst, b, h) do { _Pragma("unroll") for (int n = 0; n < 2; ++n) _Pragma("unroll") for (int k = 0; k < 2; ++k) dst[n][k] = *(const PG8_LAS bf16x8*)(lds + PG8_SB(b, h) + boff + n * 2048 + k * 1024); } while (0)
#define PG8_MMA(ai, bj, At, Bt) do { __builtin_amdgcn_s_setprio(1); _Pragma("unroll") for (int m = 0; m < 4; ++m) _Pragma("unroll") for (int n = 0; n < 2; ++n) _Pragma("unroll") for (int k = 0; k < 2; ++k) \
        acc[ai][bj][m][n] = __builtin_amdgcn_mfma_f32_16x16x32_bf16(Bt[n][k], At[m][k], acc[ai][bj][m][n], 0, 0, 0); __builtin_amdgcn_s_setprio(0); } while (0)
#define PG8_WAIT_V(n) asm volatile("s_waitcnt vmcnt(" #n ")" ::: "memory")
#define PG8_WAIT_L(n) asm volatile("s_waitcnt lgkmcnt(" #n ")" ::: "memory")
#define PG8_BAR __builtin_amdgcn_s_barrier()
#define PG8_SCHED __builtin_amdgcn_sched_barrier(0)
    Unit cur, nxt; int ui = 0;
    if (!S.next(0, cur)) return;
    f32x4 acc[2][2][4][2];
#pragma unroll
    for (int a = 0; a < 2; ++a)
#pragma unroll
        for (int b = 0; b < 2; ++b)
#pragma unroll
            for (int m = 0; m < 4; ++m)
#pragma unroll
                for (int n = 0; n < 2; ++n) acc[a][b][m][n] = (f32x4){0.f, 0.f, 0.f, 0.f};
    bf16x8 At[4][2], B0[2][2], B1[2][2];
    const char* cA = S.a_ptr(g, cur); const char* cB = S.b_ptr(g, cur);
    S.a_ready(cur);
    if constexpr (SP2) {
        PG8_STAGE(PG8_SB(0, 0), cB, voffB); PG8_STAGE(PG8_SB(0, 1), cB + hstep, voffB); PG8_STAGE(PG8_SA(0, 0), cA, voffA); PG8_STAGE(PG8_SA(0, 1), cA + hstep, voffA);
        if (wr == 1) PG8_BAR;
        PG8_WAIT_V(2); PG8_BAR;
        PG8_STAGE(PG8_SB(1, 0), cB + kstep, voffB); PG8_STAGE(PG8_SA(1, 0), cA + kstep, voffA); PG8_STAGE(PG8_SB(1, 1), cB + hstep + kstep, voffB);
        PG8_WAIT_V(6); PG8_BAR;
    } else {
        PG8_STAGE(PG8_SB(0, 0), cB, voffB); PG8_STAGE(PG8_SA(0, 0), cA, voffA); PG8_STAGE(PG8_SB(0, 1), cB + hstep, voffB); PG8_STAGE(PG8_SA(0, 1), cA + hstep, voffA);
        if (wr == 1) PG8_BAR;
        PG8_WAIT_V(4); PG8_BAR;
        PG8_STAGE(PG8_SB(1, 0), cB + kstep, voffB); PG8_STAGE(PG8_SA(1, 0), cA + kstep, voffA); PG8_STAGE(PG8_SB(1, 1), cB + hstep + kstep, voffB);
        PG8_WAIT_V(6); PG8_BAR;
    }
    for (;;) {
        const bool has_next = S.next(ui + 1, nxt);
        const char* nA = has_next ? S.a_ptr(g, nxt) : cA; const char* nB = has_next ? S.b_ptr(g, nxt) : cB;
        const int nt = S.nt(g, cur);
        for (int t = 0; t < nt; t += 2) {
            const bool last = (t == nt - 2);
            const char* a1 = cA + (size_t)(t + 1) * kstep;
            const char* a2 = last ? nA : cA + (size_t)(t + 2) * kstep; const char* b2 = last ? nB : cB + (size_t)(t + 2) * kstep;
            const char* a3 = a2 + kstep; const char* b3 = b2 + kstep;
            if (last && has_next) S.a_ready(nxt);
            if constexpr (Epi::DMA_PRE) { if (last) E.dma_prefetch(cur, lds, wid, lane); }
            if constexpr (SP2) {
            PG8_LDB(B0, 0, 0); PG8_LDB(B1, 0, 1); PG8_SCHED; PG8_LDA(At, 0, 0); PG8_STAGE(PG8_SA(1, 1), a1 + hstep, voffA);
            PG8_WAIT_V(8); PG8_WAIT_L(0); PG8_BAR; PG8_MMA(0, 0, At, B0); PG8_MMA(0, 1, At, B1); PG8_BAR; PG8_SCHED;
            PG8_LDA(At, 0, 1); PG8_STAGE(PG8_SB(0, 0), b2, voffB); PG8_STAGE(PG8_SB(0, 1), b2 + hstep, voffB); PG8_STAGE(PG8_SA(0, 0), a2, voffA);
            PG8_WAIT_V(8); PG8_WAIT_L(0); PG8_BAR; PG8_MMA(1, 0, At, B0); PG8_MMA(1, 1, At, B1); PG8_BAR; PG8_SCHED;
            PG8_LDB(B0, 1, 0); PG8_LDB(B1, 1, 1); PG8_SCHED; PG8_LDA(At, 1, 0); PG8_STAGE(PG8_SA(0, 1), a2 + hstep, voffA);
            PG8_WAIT_V(8); PG8_WAIT_L(0); PG8_BAR; PG8_MMA(0, 0, At, B0); PG8_MMA(0, 1, At, B1); PG8_BAR; PG8_SCHED;
            PG8_LDA(At, 1, 1); PG8_STAGE(PG8_SB(1, 0), b3, voffB); PG8_STAGE(PG8_SB(1, 1), b3 + hstep, voffB); PG8_STAGE(PG8_SA(1, 0), a3, voffA);
            PG8_WAIT_V(8); PG8_WAIT_L(0); PG8_BAR; PG8_MMA(1, 0, At, B0); PG8_MMA(1, 1, At, B1); PG8_BAR; PG8_SCHED;
            } else {
            PG8_LDB(B0, 0, 0); PG8_SCHED; PG8_LDA(At, 0, 0); PG8_STAGE(PG8_SA(1, 1), a1 + hstep, voffA);
            PG8_WAIT_L(8); PG8_BAR; PG8_WAIT_L(0); PG8_MMA(0, 0, At, B0); PG8_BAR; PG8_SCHED;
            PG8_LDB(B1, 0, 1); PG8_STAGE(PG8_SB(0, 0), b2, voffB);
            PG8_BAR; PG8_WAIT_L(0); PG8_MMA(0, 1, At, B1); PG8_BAR;
            PG8_LDA(At, 0, 1); PG8_STAGE(PG8_SA(0, 0), a2, voffA);
            PG8_BAR; PG8_WAIT_L(0); PG8_MMA(1, 0, At, B0); PG8_BAR; PG8_SCHED;
            PG8_STAGE(PG8_SB(0, 1), b2 + hstep, voffB);
            PG8_WAIT_V(6); PG8_BAR; PG8_MMA(1, 1, At, B1); PG8_BAR;
            PG8_LDB(B0, 1, 0); PG8_SCHED; PG8_LDA(At, 1, 0); PG8_STAGE(PG8_SA(0, 1), a2 + hstep, voffA);
            PG8_WAIT_L(8); PG8_BAR; PG8_WAIT_L(0); PG8_MMA(0, 0, At, B0); PG8_BAR; PG8_SCHED;
            PG8_LDB(B1, 1, 1); PG8_STAGE(PG8_SB(1, 0), b3, voffB);
            PG8_BAR; PG8_WAIT_L(0); PG8_MMA(0, 1, At, B1); PG8_BAR;
            PG8_LDA(At, 1, 1); PG8_STAGE(PG8_SA(1, 0), a3, voffA);
            PG8_BAR; PG8_WAIT_L(0); PG8_MMA(1, 0, At, B0); PG8_BAR; PG8_SCHED;
            PG8_STAGE(PG8_SB(1, 1), b3 + hstep, voffB);
            PG8_WAIT_V(6); PG8_BAR; PG8_MMA(1, 1, At, B1); PG8_BAR;
            }
        }
        if constexpr (ALIGN_EPI) { if (wr == 0) PG8_BAR; }
        E(acc, cur, wr, wc, fr, fq, lds); S.done(cur);
        if (!has_next) break;
        if (!S.keep(cur)) {
#pragma unroll
        for (int a = 0; a < 2; ++a)
#pragma unroll
            for (int b = 0; b < 2; ++b)
#pragma unroll
                for (int m = 0; m < 4; ++m)
#pragma unroll
                    for (int n = 0; n < 2; ++n) acc[a][b][m][n] = (f32x4){0.f, 0.f, 0.f, 0.f};
        }
        cur = nxt; cA = nA; cB = nB; ++ui;
        if constexpr (ALIGN_EPI) { if (wr == 1) PG8_BAR; }
    }
    PG8_WAIT_V(0);
    if constexpr (!ALIGN_EPI) { if (wr == 0) PG8_BAR; }
    PG8_BAR;
#undef PG8_SA
#undef PG8_SB
#undef PG8_STAGE
#undef PG8_LDA
#undef PG8_LDB
#undef PG8_MMA
#undef PG8_WAIT_V
#undef PG8_WAIT_L
#undef PG8_BAR
#undef PG8_SCHED
}
}

struct Ws {
    float *rstd1, *sumsq2, *sumsq3;
    bf16_t *Wt_in, *Wt_reto, *Wt_atto, *Wt_o, *Wt_up, *Wt_down;
    bf16_t *xb, *proj, *G, *Oatt, *merged, *act, *ub;
    float* kvc; bf16_t* sb; bf16_t* og; float* lse; unsigned char* g8; bf16_t* tmp;
};
__device__ __forceinline__ Ws make_ws(unsigned char* ws) {
    Ws w;
    w.rstd1 = (float*)(ws + WS_CTL); w.sumsq2 = w.rstd1 + MT; w.sumsq3 = w.sumsq2 + MT;
    w.Wt_in = (bf16_t*)(ws + WS_WIN); w.Wt_reto = (bf16_t*)(ws + WS_WRETO); w.Wt_atto = (bf16_t*)(ws + WS_WATTO_P); w.Wt_o = (bf16_t*)(ws + WS_WO);
    w.Wt_up = (bf16_t*)(ws + WS_WUP); w.Wt_down = (bf16_t*)(ws + WS_WDOWN);
    w.xb = (bf16_t*)(ws + WS_XB); w.proj = (bf16_t*)(ws + WS_PROJ); w.ub = (bf16_t*)(ws + WS_PROJ); w.G = (bf16_t*)(ws + WS_G); w.Oatt = (bf16_t*)(ws + WS_OATT);
    w.merged = (bf16_t*)(ws + WS_MERGED); w.act = (bf16_t*)(ws + WS_ACT); w.kvc = (float*)(ws + WS_KVC);
    w.g8 = ws + WS_G8; w.tmp = (bf16_t*)(ws + WS_KVC);
    w.sb = (bf16_t*)(ws + WS_SB); w.og = (bf16_t*)(ws + WS_OG); w.lse = (float*)(ws + WS_LSE);
    return w;
}

struct EpiIn {
    static constexpr bool PERM = true, DMA_PRE = false, APERM = false;
    Ws w; float* out;
    template <int CLS> __device__ __forceinline__ void body(f32x4 (&acc)[2][2][4][2], int row0, int col0, int grp, int kv) const {
#pragma unroll
        for (int ai = 0; ai < 2; ++ai)
#pragma unroll
            for (int m = 0; m < 4; ++m) {
                const int row = row0 + ai * 128 + m * 16;
#pragma unroll
                for (int bj = 0; bj < 2; ++bj) {
                    const int col = col0 + bj * 128;
                    f32x4 v0 = acc[ai][bj][m][0], v1 = acc[ai][bj][m][1];
                    if (CLS == 1) {
#pragma unroll
                        for (int i = 0; i < 4; ++i) { v0[i] = v0[i] * sigmoidf_(v0[i]); v1[i] = v1[i] * sigmoidf_(v1[i]); }
                    }
                    if (CLS == 2) { u32x2 o8; o8.x = sigcode4(v0); o8.y = sigcode4(v1); __builtin_nontemporal_store(o8, (u32x2*)(w.g8 + (unsigned)(row * 4096) + (col - C_GR))); }
                    else { u32x4 o; o.x = pk2(v0[0], v0[1]); o.y = pk2(v0[2], v0[3]); o.z = pk2(v1[0], v1[1]); o.w = pk2(v1[2], v1[3]);
                        *(u32x4*)(w.proj + (unsigned)(((col >> 7) * MT + row) * 128 + (col & 127))) = o; }
                    if (CLS == 3) {
                        const int win = 128 << (2 * grp);
                        const size_t obase_p = grp == 0 ? O_KV128P : (grp == 1 ? O_KV512P : O_KV2048P);
                        const size_t obase_s = grp == 0 ? O_KV128S : (grp == 1 ? O_KV512S : O_KV2048S);
                        const int c512 = (col & 511);
                        float* dst = nullptr;
                        if (row < MP) { const int b = row >> 13, t = row & 8191; if (t >= SEQ - win) dst = out + obase_p + ((size_t)(b * win + (t - (SEQ - win))) * 2 + kv) * 512 + c512; }
                        else { const int b = (row - MP) >> 3, t = (row - MP) & 7; dst = out + obase_s + ((size_t)(b * win + (win - 8 + t)) * 2 + kv) * 512 + c512; }
                        if (dst) { __builtin_nontemporal_store(v0, (f32x4*)dst); __builtin_nontemporal_store(v1, (f32x4*)(dst + 4)); }
                    }
                }
            }
    }
    __device__ __forceinline__ void operator()(f32x4 (&acc)[2][2][4][2], const pg8::Unit& u, int wr, int wc, int fr_, int fq_, LAS unsigned char*) const {
        int fr = fr_, fq = fq_; asm volatile("" : "+v"(fr), "+v"(fq));
        const int row0 = u.pm * 256 + wr * 64 + fr, col0 = u.pn * 256 + wc * 32 + 8 * fq;
        const int pn = u.pn;
        if (pn >= 34) body<2>(acc, row0, col0, 0, 0);
        else if (pn >= 12 && pn < 16) body<1>(acc, row0, col0, 0, 0);
        else if (pn >= 16) { const int q = (pn - 16) % 6, grp = (pn - 16) / 6;
            const int win = 128 << (2 * grp); const int t_hi = ((u.pm & 31) + 1) * 256;
            if (q >= 2 && (u.pm >= 64 || t_hi > SEQ - win)) body<3>(acc, row0, col0, grp, q >= 4 ? 1 : 0); else body<0>(acc, row0, col0, 0, 0); }
        else body<0>(acc, row0, col0, 0, 0);
    }
};
struct EpiWo {
    static constexpr bool PERM = true, DMA_PRE = false, APERM = false;
    Ws w;
    __device__ __forceinline__ void operator()(f32x4 (&acc)[2][2][4][2], const pg8::Unit& u, int wr, int wc, int fr_, int fq_, LAS unsigned char*) const {
        int fr = fr_, fq = fq_; asm volatile("" : "+v"(fr), "+v"(fq));
        const int row0 = u.pm * 256 + wr * 64 + fr;
        const int col0 = u.pn * 256 + wc * 32 + 8 * fq;
        float ssv[8];
#pragma unroll
        for (int ai = 0; ai < 2; ++ai)
#pragma unroll
            for (int m = 0; m < 4; ++m) {
                const int row = row0 + ai * 128 + m * 16;
                const float rs = w.rstd1[row];
                float ssq = 0.f;
#pragma unroll
                for (int bj = 0; bj < 2; ++bj) {
                    const int col = col0 + bj * 128;
                    f32x4 v0 = acc[ai][bj][m][0], v1 = acc[ai][bj][m][1];
                    { const u32x4 xv = *(const u32x4*)(w.xb + (unsigned)(row * DM) + col);
                      v0[0] += bflo(xv.x) * rs; v0[1] += bfhi(xv.x) * rs; v0[2] += bflo(xv.y) * rs; v0[3] += bfhi(xv.y) * rs;
                      v1[0] += bflo(xv.z) * rs; v1[1] += bfhi(xv.z) * rs; v1[2] += bflo(xv.w) * rs; v1[3] += bfhi(xv.w) * rs; }
                    u32x4 o; o.x = pk2(v0[0], v0[1]); o.y = pk2(v0[2], v0[3]); o.z = pk2(v1[0], v1[1]); o.w = pk2(v1[2], v1[3]);
                    *(u32x4*)(w.xb + (unsigned)(row * DM) + col) = o;
#pragma unroll
                    for (int i = 0; i < 4; ++i) ssq += v0[i] * v0[i] + v1[i] * v1[i];
                }
                ssq += __shfl_xor(ssq, 16); ssq += __shfl_xor(ssq, 32);
                ssv[ai * 4 + m] = ssq;
            }
        if (fq == 0) {
#pragma unroll
            for (int k = 0; k < 8; ++k) atomicAdd(w.sumsq2 + row0 + (k >> 2) * 128 + (k & 3) * 16, ssv[k]);
        }
    }
};

struct EpiP5 {
    static constexpr bool PERM = true, DMA_PRE = false, APERM = false;
    Ws w;
    __device__ __forceinline__ void operator()(f32x4 (&acc)[2][2][4][2], const pg8::Unit& u, int wr, int wc, int fr_, int fq_, LAS unsigned char*) const {
        int fr = fr_, fq = fq_; asm volatile("" : "+v"(fr), "+v"(fq));
        const int row0 = u.pm * 256 + wr * 64 + fr, col0 = u.pn * 256 + wc * 32 + 8 * fq;
        if (u.seg == 0) {
#pragma unroll
            for (int ai = 0; ai < 2; ++ai)
#pragma unroll
                for (int m = 0; m < 4; ++m) {
                    const int row = row0 + ai * 128 + m * 16;
#pragma unroll
                    for (int bj = 0; bj < 2; ++bj) { const unsigned char* gp = w.g8 + (unsigned)(row * 4096) + col0 + bj * 128;
                        const u32x2 gr = *(const u32x2*)gp, ga = *(const u32x2*)(gp + 2048);
                        const f32x4 a0 = dec8x4(ga.x), a1 = dec8x4(ga.y);
                        f32x4 q0 = dec8x4(gr.x), q1 = dec8x4(gr.y);
#pragma unroll
                        for (int i = 0; i < 4; ++i) { q0[i] *= __builtin_amdgcn_rcpf(a0[i]); q1[i] *= __builtin_amdgcn_rcpf(a1[i]); }
                        acc[ai][bj][m][0] *= q0; acc[ai][bj][m][1] *= q1; }
                }
        } else {
#pragma unroll
            for (int ai = 0; ai < 2; ++ai)
#pragma unroll
                for (int m = 0; m < 4; ++m) {
                    const int row = row0 + ai * 128 + m * 16;
#pragma unroll
                    for (int bj = 0; bj < 2; ++bj) { const int col = col0 + bj * 128;
                        const u32x2 ga = *(const u32x2*)(w.g8 + (unsigned)(row * 4096) + 2048 + col);
                        const f32x4 v0 = acc[ai][bj][m][0] * dec8x4(ga.x), v1 = acc[ai][bj][m][1] * dec8x4(ga.y);
                        u32x4 o; o.x = pk2(v0[0], v0[1]); o.y = pk2(v0[2], v0[3]); o.z = pk2(v1[0], v1[1]); o.w = pk2(v1[2], v1[3]);
                        *(u32x4*)(w.merged + (unsigned)(row * DM) + col) = o; }
                }
        }
    }
};

__device__ __forceinline__ float dpp_ror1(float v) { return __int_as_float(__builtin_amdgcn_mov_dpp(__float_as_int(v), 0x121, 0xf, 0xf, false)); }
__device__ __forceinline__ float dpp_keep(float v) { float d = dpp_ror1(v); asm volatile("" : "+v"(d)); return d; }
__device__ __forceinline__ float dpp_ror2(float v) { return __int_as_float(__builtin_amdgcn_mov_dpp(__float_as_int(v), 0x122, 0xf, 0xf, false)); }
typedef float f32x2 __attribute__((ext_vector_type(2)));
__device__ __forceinline__ f32x2 gelu_gate2(f32x2 v, f32x2 b) {
    f32x2 a; a.x = __builtin_amdgcn_fmed3f(fabsf(v.x), 0.f, 6.5f); a.y = __builtin_amdgcn_fmed3f(fabsf(v.y), 0.f, 6.5f);
    const f32x2 c9 = {3.819134520e-07f, 3.819134520e-07f}, c8 = {-7.616652965e-06f, -7.616652965e-06f}, c7 = {6.311968900e-05f, 6.311968900e-05f}, c6 = {-2.457886876e-04f, -2.457886876e-04f},
                c5 = {-5.764040543e-05f, -5.764040543e-05f}, c4 = {7.011611480e-03f, 7.011611480e-03f}, c3 = {-5.248568207e-02f, -5.248568207e-02f}, c2 = {-4.592045844e-01f, -4.592045844e-01f},
                c1 = {-1.151106715e+00f, -1.151106715e+00f}, c0 = {-9.999999404e-01f, -9.999999404e-01f};
    f32x2 p = c9 * a + c8; p = p * a + c7; p = p * a + c6; p = p * a + c5; p = p * a + c4; p = p * a + c3; p = p * a + c2; p = p * a + c1; p = p * a + c0;
    f32x2 e; e.x = __builtin_amdgcn_exp2f(p.x); e.y = __builtin_amdgcn_exp2f(p.y);
    f32x2 r; asm("v_max_f32 %0, 0, %1" : "=v"(r.x) : "v"(v.x)); asm("v_max_f32 %0, 0, %1" : "=v"(r.y) : "v"(v.y));
    return (r - a * e) * b;
}
#define CONV_SHR1(v, c, w) asm("v_fmac_f32_dpp %0, %1, %2 row_shr:1 row_mask:0xf bank_mask:0xf" : "+v"(v) : "v"(c), "v"(w))
constexpr int HALO_OFF = 131072;
constexpr int PRE_SS = HALO_OFF + 6144, PRE_CW = HALO_OFF + 7168;
struct EpiUp {
    static constexpr bool PERM = true, DMA_PRE = true, APERM = true;
    Ws w; float* out; const float* cw; const float* cb; const float* sconv;
    __device__ __forceinline__ void dma_prefetch(const pg8::Unit& u, LAS unsigned char* lds, int wid, int lane) const {
        if (wid == 0) {
            const bool samp = u.pm >= 66;
            const int rowbase = samp ? MP : (u.pm / 33) * SEQ + 254 * (u.pm % 33) - 2;
#pragma unroll
            for (int i = 0; i < 4; ++i) __builtin_amdgcn_global_load_lds((const unsigned*)(w.sumsq2 + rowbase + 64 * i + lane), (LAS unsigned*)(lds + PRE_SS + 256 * i), 4, 0, 0);
        } else if (wid == 1) {
            const int f0 = u.pn * 128 + 4 * (lane & 31), hb = (lane >> 5) * FF;
#pragma unroll
            for (int k = 0; k < 3; ++k) __builtin_amdgcn_global_load_lds((const unsigned*)(cw + (size_t)k * F2 + hb + f0), (LAS unsigned*)(lds + PRE_CW + 1024 * k), 16, 0, 0);
            __builtin_amdgcn_global_load_lds((const unsigned*)(cb + hb + f0), (LAS unsigned*)(lds + PRE_CW + 3072), 16, 0, 0);
        }
    }
    __device__ __forceinline__ void operator()(f32x4 (&acc)[2][2][4][2], const pg8::Unit& u, int wr, int wc, int fr_, int fq_, LAS unsigned char* lds) const {
        int fr = fr_, fq = fq_; asm volatile("" : "+v"(fr), "+v"(fq));
        const bool samp = u.pm >= 66;
        const int bb = samp ? 0 : u.pm / 33, jj = samp ? 0 : u.pm % 33;
        const int t0 = samp ? 0 : 254 * jj - 2;
        const int rowbase = samp ? MP : bb * SEQ + t0;
#pragma unroll
        for (int ai = 0; ai < 2; ++ai)
#pragma unroll
            for (int m = 0; m < 4; ++m) {
                const int rl = ai * 128 + wr * 64 + 4 * fr + m, t = t0 + rl;
                const bool ok = samp || (t >= 0 && t < SEQ);
                const float ss = *(const LAS float*)(lds + PRE_SS + 4 * rl);
                const float rs = ok ? __builtin_amdgcn_rsqf(ss * (1.0f / DM) + EPS) : 0.f;
#pragma unroll
                for (int bj = 0; bj < 2; ++bj) { acc[ai][bj][m][0] *= rs; acc[ai][bj][m][1] *= rs; }
            }
        asm volatile("" ::: "memory");
        LAS float* halo = (LAS float*)(lds + HALO_OFF);
        const int fcol = u.pn * 128 + wc * 32 + 8 * fq;
        if (!samp) {
            if (fr == 15) {
#pragma unroll
                for (int ai = 0; ai < 2; ++ai) { const int bd = 2 * ai + wr;
                    if (bd < 3) {
#pragma unroll
                        for (int m = 2; m < 4; ++m) { LAS f32x4* hp = (LAS f32x4*)(halo + (((bd * 4 + wc) * 8 + (m - 2) * 4 + fq) * 16));
                            hp[0] = acc[ai][0][m][0]; hp[1] = acc[ai][0][m][1]; hp[2] = acc[ai][1][m][0]; hp[3] = acc[ai][1][m][1]; } } }
            }
            asm volatile("s_waitcnt lgkmcnt(0)" ::: "memory"); __builtin_amdgcn_s_barrier(); asm volatile("" ::: "memory");
            u32x2 olo[2][4];
            const float zm = fr == 0 ? 1.0f : 0.0f;
            bf16_t* const dump = w.merged;
#pragma unroll
            for (int n = 0; n < 2; ++n) {
                const int f0 = fcol + 4 * n;
                f32x4 wa[3], wb[3];
                const LAS unsigned char* wl = lds + PRE_CW + 4 * (f0 - u.pn * 128);
#pragma unroll
                for (int k = 0; k < 3; ++k) { wa[k] = *(const LAS f32x4*)(wl + 1024 * k); wb[k] = *(const LAS f32x4*)(wl + 1024 * k + 512); }
                const f32x4 ba = *(const LAS f32x4*)(wl + 3072), bbv = *(const LAS f32x4*)(wl + 3072 + 512);
#pragma unroll
                for (int ai = 0; ai < 2; ++ai) {
                    const int gi = 2 * ai + wr;
                    const LAS f32x4* hp = (const LAS f32x4*)(halo + ((((gi > 0 ? gi - 1 : 0) * 4 + wc) * 8 + fq) * 16));
                    const f32x4 h62a = hp[n] * zm, h62b = hp[2 + n] * zm, h63a = hp[16 + n] * zm, h63b = hp[16 + 2 + n] * zm;
#pragma unroll
                    for (int m = 0; m < 4; ++m) {
                        const int rl = ai * 128 + wr * 64 + 4 * fr + m, t = t0 + rl;
                        const f32x4 ca = acc[ai][0][m][n], cbv = acc[ai][1][m][n];
                        f32x4 va = ba + wa[2] * ca, vb = bbv + wb[2] * cbv;
                        if (m >= 1) { va += wa[1] * acc[ai][0][m - 1][n]; vb += wb[1] * acc[ai][1][m - 1][n]; }
                        else { va += wa[1] * h63a; vb += wb[1] * h63b; }
                        if (m >= 2) { va += wa[0] * acc[ai][0][m - 2][n]; vb += wb[0] * acc[ai][1][m - 2][n]; }
                        else if (m == 1) { va += wa[0] * h63a; vb += wb[0] * h63b; }
                        else { va += wa[0] * h62a; vb += wb[0] * h62b; }
                        if (m < 2) {
#pragma unroll
                            for (int i = 0; i < 4; ++i) {
                                float ta = va[i], tb = vb[i];
                                if (m == 0) { CONV_SHR1(ta, acc[ai][0][3][n][i], wa[1][i]); CONV_SHR1(tb, acc[ai][1][3][n][i], wb[1][i]);
                                              CONV_SHR1(ta, acc[ai][0][2][n][i], wa[0][i]); CONV_SHR1(tb, acc[ai][1][2][n][i], wb[0][i]); }
                                else { CONV_SHR1(ta, acc[ai][0][3][n][i], wa[0][i]); CONV_SHR1(tb, acc[ai][1][3][n][i], wb[0][i]); }
                                va[i] = ta; vb[i] = tb;
                            }
                        }
                        const f32x2 g01 = gelu_gate2((f32x2){va[0], va[1]}, (f32x2){vb[0], vb[1]}), g23 = gelu_gate2((f32x2){va[2], va[3]}, (f32x2){vb[2], vb[3]});
                        u32x2 o; o.x = pk2(g01.x, g01.y); o.y = pk2(g23.x, g23.y);
                        if (n == 0) olo[ai][m] = o;
                        else { u32x4 o4; o4.x = olo[ai][m].x; o4.y = olo[ai][m].y; o4.z = o.x; o4.w = o.y;
                            const bool ok = rl >= 2 && t < SEQ;
                            bf16_t* dst = ok ? w.act + (unsigned)((rowbase + rl) * FF + fcol) : dump + (unsigned)(threadIdx.x * 8);
                            *(u32x4*)dst = o4; }
                        asm volatile("" ::: "memory");
                    }
                }
            }
            if (jj == 32) {
#pragma unroll
                for (int ai = 0; ai < 2; ++ai)
#pragma unroll
                    for (int m = 0; m < 4; ++m) { const int rl = ai * 128 + wr * 64 + 4 * fr + m, t = t0 + rl;
                        if (t >= SEQ - 2 && t < SEQ) {
#pragma unroll
                            for (int n = 0; n < 2; ++n) { float* d = out + O_CONVP + ((size_t)bb * 2 + (t - (SEQ - 2))) * F2 + fcol + 4 * n; *(f32x4*)d = acc[ai][0][m][n]; *(f32x4*)(d + FF) = acc[ai][1][m][n]; } } }
            }
        } else {
            const bool ev = !(fr & 1);
#pragma unroll
            for (int n = 0; n < 2; ++n) {
                const int f0 = fcol + 4 * n;
                f32x4 wa[3], wb[3];
                const LAS unsigned char* wl = lds + PRE_CW + 4 * (f0 - u.pn * 128);
#pragma unroll
                for (int k = 0; k < 3; ++k) { wa[k] = *(const LAS f32x4*)(wl + 1024 * k); wb[k] = *(const LAS f32x4*)(wl + 1024 * k + 512); }
                const f32x4 ba = *(const LAS f32x4*)(wl + 3072), bbv = *(const LAS f32x4*)(wl + 3072 + 512);
#pragma unroll
                for (int ai = 0; ai < 2; ++ai) {
                    const int bs = ai * 16 + wr * 8 + (fr >> 1);
                    f32x4 s1a = ba, s1b = ba, s0a = ba, s0b = ba;
                    if (ev) { const float* s1 = sconv + ((size_t)bs * 2 + 1) * F2 + f0; const float* s0 = sconv + ((size_t)bs * 2) * F2 + f0;
                        s1a = *(const f32x4*)s1; s1b = *(const f32x4*)(s1 + FF); s0a = *(const f32x4*)s0; s0b = *(const f32x4*)(s0 + FF); }
#pragma unroll
                    for (int m = 0; m < 4; ++m) {
                        const int rl = ai * 128 + wr * 64 + 4 * fr + m, ts = 4 * (fr & 1) + m;
                        const f32x4 ca = acc[ai][0][m][n], cbv = acc[ai][1][m][n];
                        f32x4 a1, a2, b1, b2;
                        if (m >= 1) { a1 = acc[ai][0][m - 1][n]; b1 = acc[ai][1][m - 1][n]; }
                        else {
#pragma unroll
                            for (int i = 0; i < 4; ++i) { const float da = dpp_keep(acc[ai][0][3][n][i]), db = dpp_keep(acc[ai][1][3][n][i]); a1[i] = ev ? s1a[i] : da; b1[i] = ev ? s1b[i] : db; } }
                        if (m >= 2) { a2 = acc[ai][0][m - 2][n]; b2 = acc[ai][1][m - 2][n]; }
                        else if (m == 1) {
#pragma unroll
                            for (int i = 0; i < 4; ++i) { const float da = dpp_keep(acc[ai][0][3][n][i]), db = dpp_keep(acc[ai][1][3][n][i]); a2[i] = ev ? s1a[i] : da; b2[i] = ev ? s1b[i] : db; } }
                        else {
#pragma unroll
                            for (int i = 0; i < 4; ++i) { const float da = dpp_keep(acc[ai][0][2][n][i]), db = dpp_keep(acc[ai][1][2][n][i]); a2[i] = ev ? s0a[i] : da; b2[i] = ev ? s0b[i] : db; } }
                        const f32x4 va = ba + wa[0] * a2 + wa[1] * a1 + wa[2] * ca;
                        const f32x4 vb = bbv + wb[0] * b2 + wb[1] * b1 + wb[2] * cbv;
                        const f32x2 g01 = gelu_gate2((f32x2){va[0], va[1]}, (f32x2){vb[0], vb[1]}), g23 = gelu_gate2((f32x2){va[2], va[3]}, (f32x2){vb[2], vb[3]});
                        u32x2 o; o.x = pk2(g01.x, g01.y); o.y = pk2(g23.x, g23.y);
                        *(u32x2*)(w.act + (unsigned)((MP + rl) * FF + f0)) = o;
                        if (ts >= 6) { float* d = out + O_CONVS + ((size_t)bs * 2 + (ts - 6)) * F2 + f0; *(f32x4*)d = ca; *(f32x4*)(d + FF) = cbv; }
                        asm volatile("" ::: "memory");
                    }
                }
            }
        }
    }
};


__device__ __forceinline__ void panel_arrive_wait(unsigned* cnt, unsigned want) {
    asm volatile("s_waitcnt vmcnt(0)" ::: "memory");
    __hip_atomic_fetch_add(cnt, 1u, __ATOMIC_RELAXED, __HIP_MEMORY_SCOPE_AGENT);
    unsigned sp = 0;
    while (__hip_atomic_load(cnt, __ATOMIC_RELAXED, __HIP_MEMORY_SCOPE_AGENT) < want) { __builtin_amdgcn_s_sleep(2); if (++sp > (1u << 22)) break; }
    asm volatile("s_waitcnt vmcnt(0)" ::: "memory");
}
struct EpiFin {
    static constexpr bool PERM = true, DMA_PRE = false, APERM = false;
    Ws w; float* out; const float* gfin; unsigned* pcnt;
    __device__ __forceinline__ void operator()(f32x4 (&acc)[2][2][4][2], const pg8::Unit& u, int wr, int wc, int fr_, int fq_, LAS unsigned char*) const {
        int fr = fr_, fq = fq_; asm volatile("" : "+v"(fr), "+v"(fq));
        const int row0 = u.pm * 256 + wr * 64 + fr;
        const int col0 = u.pn * 256 + wc * 32 + 8 * fq;
        float ssv[8];
#pragma unroll
        for (int ai = 0; ai < 2; ++ai)
#pragma unroll
            for (int m = 0; m < 4; ++m) {
                const int row = row0 + ai * 128 + m * 16;
                float ssq = 0.f;
#pragma unroll
                for (int bj = 0; bj < 2; ++bj) {
                    const int col = col0 + bj * 128;
                    const u32x4 xv = __builtin_nontemporal_load((const u32x4*)(w.xb + (unsigned)(row * DM) + col));
                    f32x4 v0 = acc[ai][bj][m][0], v1 = acc[ai][bj][m][1];
                    v0[0] += bflo(xv.x); v0[1] += bfhi(xv.x); v0[2] += bflo(xv.y); v0[3] += bfhi(xv.y);
                    v1[0] += bflo(xv.z); v1[1] += bfhi(xv.z); v1[2] += bflo(xv.w); v1[3] += bfhi(xv.w);
                    acc[ai][bj][m][0] = v0; acc[ai][bj][m][1] = v1;
#pragma unroll
                    for (int i = 0; i < 4; ++i) ssq += v0[i] * v0[i] + v1[i] * v1[i];
                }
                ssq += __shfl_xor(ssq, 16); ssq += __shfl_xor(ssq, 32);
                ssv[ai * 4 + m] = ssq;
            }
        if (fq == 0) {
#pragma unroll
            for (int k = 0; k < 8; ++k) atomicAdd(w.sumsq3 + row0 + (k >> 2) * 128 + (k & 3) * 16, ssv[k]);
        }
        asm volatile("s_waitcnt vmcnt(0)" ::: "memory"); __builtin_amdgcn_s_barrier(); asm volatile("" ::: "memory");
        if (threadIdx.x == 0) panel_arrive_wait(pcnt + 16 * u.pm, 8u);
        asm volatile("s_waitcnt vmcnt(0) lgkmcnt(0)" ::: "memory"); __builtin_amdgcn_s_barrier(); asm volatile("" ::: "memory");
        f32x4 g[2][2];
#pragma unroll
        for (int bj = 0; bj < 2; ++bj) { g[bj][0] = *(const f32x4*)(gfin + col0 + bj * 128); g[bj][1] = *(const f32x4*)(gfin + col0 + bj * 128 + 4); }
#pragma unroll
        for (int ai = 0; ai < 2; ++ai)
#pragma unroll
            for (int m = 0; m < 4; ++m) {
                const int row = row0 + ai * 128 + m * 16;
                const float rs = rsqrtf(__hip_atomic_load(w.sumsq3 + row, __ATOMIC_RELAXED, __HIP_MEMORY_SCOPE_AGENT) * (1.0f / DM) + EPS);
#pragma unroll
                for (int bj = 0; bj < 2; ++bj) { float* dst = out + O_Y + (unsigned)(row * DM) + col0 + bj * 128;
                    __builtin_nontemporal_store(acc[ai][bj][m][0] * rs * g[bj][0], (f32x4*)dst); __builtin_nontemporal_store(acc[ai][bj][m][1] * rs * g[bj][1], (f32x4*)(dst + 4)); }
            }
    }
};

__device__ __forceinline__ int up_rowmap(int n) { return n < FF ? ((n >> 7) * 256 + (n & 127)) : (((n - FF) >> 7) * 256 + 128 + ((n - FF) & 127)); }
__device__ __forceinline__ void p0_transpose_item(const float* W, int K, int N, bf16_t* WT, const float* g, bool upmap, LAS float* scr, int item, int lane, int ldt = 0, bool ntst = false) {
    if (ldt == 0) ldt = K;
    const int nblk = N / 32, kb = item / nblk, nb = item % nblk, k0 = 64 * kb, n0 = 32 * nb;
    float tv[32];
#pragma unroll
    for (int i = 0; i < 32; ++i) { const int kk = 2 * i + (lane >> 5); tv[i] = __builtin_nontemporal_load(W + (size_t)(k0 + kk) * N + n0 + (lane & 31)); }
    if (g) {
#pragma unroll
        for (int i = 0; i < 32; ++i) tv[i] *= g[k0 + 2 * i + (lane >> 5)];
    }
#pragma unroll
    for (int i = 0; i < 32; ++i) { const int kk = 2 * i + (lane >> 5); scr[kk * 33 + (lane & 31)] = tv[i]; }
    LDS_WAIT();
    const int c = lane & 7;
    const int nbase = upmap ? up_rowmap(n0) : n0;
#pragma unroll
    for (int j = 0; j < 4; ++j) { const int n = (lane >> 3) + 8 * j; const LAS float* s = scr + (8 * c) * 33 + n;
        u32x4 o; o.x = pk2(s[0 * 33], s[1 * 33]); o.y = pk2(s[2 * 33], s[3 * 33]); o.z = pk2(s[4 * 33], s[5 * 33]); o.w = pk2(s[6 * 33], s[7 * 33]);
        if (ntst) __builtin_nontemporal_store(o, (u32x4*)(WT + (size_t)(nbase + n) * ldt + k0 + 8 * c)); else *(u32x4*)(WT + (size_t)(nbase + n) * ldt + k0 + 8 * c) = o; }
    LDS_WAIT();
}
#ifndef KVSLACK
#define KVSLACK 100
#endif
#define KV_SPLIT ((KVSLACK) >= 100 ? KV_TOTAL : KV_TOTAL / 100 * (KVSLACK))
template <int SET> __device__ __forceinline__ void weight_transposes(const Params& p, const Ws& w, LAS unsigned char* lds, int rk, int n) {
    const int tid = opaque_tid(), lane = tid & 63, wave = tid >> 6;
    LAS float* scr = (LAS float*)(lds + wave * 16384);
    const int gw = rk * 8 + wave, NGW = n * 8;
    constexpr int I_IN = (DM / 64) * (INC / 32), I_RO = (1024 / 64) * (DM / 32), I_AO = (512 / 64) * (DM / 32), I_O = (DM / 64) * (DM / 32), I_UP = (DM / 64) * (F2 / 32), I_DN = (FF / 64) * (DM / 32);
    constexpr int NITEMS = SET == 0 ? I_IN + I_UP : (SET == 1 ? I_RO + I_AO + I_O : I_DN);
    for (int it = gw; it < NITEMS; it += NGW) {
        int r = it;
        if (SET == 0) {
            if (r < I_IN) { p0_transpose_item(p.in[8], DM, INC, w.Wt_in, p.in[7], false, scr, r, lane); continue; } r -= I_IN;
            p0_transpose_item(p.in[14], DM, F2, w.Wt_up, p.in[13], true, scr, r, lane);
        } else if (SET == 1) {
            if (r < I_RO) { p0_transpose_item(p.in[10], 1024, DM, w.Wt_reto, nullptr, false, scr, r, lane, 0, true); continue; } r -= I_RO;
            if (r < I_AO) { p0_transpose_item(p.in[11], 512, DM, w.Wt_atto, nullptr, false, scr, r, lane, 1024, true); continue; } r -= I_AO;
            p0_transpose_item(p.in[12], DM, DM, w.Wt_o, nullptr, false, scr, r, lane, 0, true);
        } else p0_transpose_item(p.in[17], FF, DM, w.Wt_down, nullptr, false, scr, r, lane);
    }
}
__device__ __forceinline__ void p0_xconv(const Params& p, const Ws& w, LAS unsigned char* lds, int vcu, int G) {
    const int tid = opaque_tid(), lane = tid & 63, wave = tid >> 6;
    const int gw = vcu * 8 + wave, NGW = G * 8;
    for (int m = gw; m < MT; m += NGW) {
        const float* xr = (m < MP) ? p.in[0] + (size_t)m * DM : p.in[1] + (size_t)(m - MP) * DM;
        const f32x4* x4 = (const f32x4*)xr + lane;
        f32x4 v[8]; float s = 0.f;
#pragma unroll
        for (int j = 0; j < 8; ++j) { v[j] = __builtin_nontemporal_load(x4 + 64 * j); s += (v[j].x * v[j].x + v[j].y * v[j].y) + (v[j].z * v[j].z + v[j].w * v[j].w); }
        s = wave_sum(s);
        const float rs = rsqrtf(s * (1.0f / DM) + EPS);
        if (lane == 0) w.rstd1[m] = sqrtf(s * (1.0f / DM) + EPS);
        u32x2* o8 = (u32x2*)(w.xb + (size_t)m * DM) + lane;
#pragma unroll
        for (int j = 0; j < 8; ++j) { u32x2 o; o.x = pk2(v[j].x * rs, v[j].y * rs); o.y = pk2(v[j].z * rs, v[j].w * rs); o8[64 * j] = o; }
    }
    for (int i = vcu * 512 + tid; i < 2 * MT; i += G * 512) w.sumsq2[i] = 0.f;
}
constexpr size_t KV_TOTAL = (size_t)32 * 1024 * 256;
__device__ __forceinline__ void kv_resolve(const Params& p, size_t i, const f32x4*& src, f32x4*& dst) {
    const unsigned li = (unsigned)i, b = li >> 18, rr = (li >> 8) & 1023u, c4 = li & 255u, row = (rr >> 3) * 16 + 8 + (rr & 7);
    const size_t o = ((size_t)b * 2048 + row) * 256 + c4;
    src = (const f32x4*)p.in[5] + o; dst = (f32x4*)(p.out + O_KV2048S) + o - 2048;
}
__device__ __forceinline__ void kv_copy_range(const Params& p, size_t c0, size_t c1, int rk, int ncu) {
    const size_t step = (size_t)ncu * 512;
    for (size_t i0 = c0 + (size_t)rk * 512 + opaque_tid(); i0 < c1; i0 += 16 * step) {
        f32x4 v[16]; f32x4* dp[16];
#pragma unroll
        for (int k = 0; k < 16; ++k) { const size_t i = i0 + k * step; if (i < c1) { const f32x4* sp; kv_resolve(p, i, sp, dp[k]); v[k] = __builtin_nontemporal_load(sp); } }
#pragma unroll
        for (int k = 0; k < 16; ++k) { const size_t i = i0 + k * step; if (i < c1) __builtin_nontemporal_store(v[k], dp[k]); }
    }
}

__device__ __forceinline__ float lgamma_h(int h) { return logf(1.0f - exp2f(-5.0f - (float)h)); }
__device__ __forceinline__ void ret_sample(const Params& p, const Ws& w, LAS unsigned char* lds, int vcu, int G) {
    const int tid = opaque_tid(), lane = tid & 63, wave = tid >> 6;
    LAS float* qf = (LAS float*)lds;
    LAS float* kf = qf + 1024;
    LAS float* vf = kf + 1024;
    LAS float* part = vf + 1024;
    LAS float* sc = part + 4096;
    LAS float* yb = sc + 64;
    const float* gn = p.in[9];
    for (int item = vcu; item < 256; item += G) {
        const int bs = item >> 3, h = item & 7;
        const size_t m0 = MP + (size_t)bs * 8;
        const float lg = lgamma_h(h);
        __syncthreads();
        for (int i = tid; i < 1024; i += 512) { const int r = i >> 7, d = i & 127; const bf16_t* row = w.proj + pofs(m0 + r, h * 128 + d);
            qf[i] = bf2f(row[(C_RQ / 128) * PSLAB]); kf[i] = bf2f(row[(C_RK / 128) * PSLAB]) * QK_SCALE; vf[i] = bf2f(row[(C_RV / 128) * PSLAB]); }
        __syncthreads();
        if (tid < 64) { const int i = tid >> 3, j = tid & 7; float s = 0.f; for (int d = 0; d < 128; ++d) s += qf[i * 128 + d] * kf[j * 128 + d]; sc[tid] = (i >= j) ? s * __expf((float)(i - j) * lg) : 0.f; }
        const int e = tid & 127, dq = tid >> 7;
        const float* st = p.in[2] + (size_t)item * 16384;
        float* nst = p.out + O_RETS + (size_t)item * 16384;
        const float g8 = __expf(8.0f * lg);
        float kdec[8];
#pragma unroll
        for (int j = 0; j < 8; ++j) kdec[j] = __expf((float)(7 - j) * lg);
        float cr[8];
#pragma unroll
        for (int i = 0; i < 8; ++i) cr[i] = 0.f;
        float sv[32];
#pragma unroll
        for (int dd = 0; dd < 32; ++dd) sv[dd] = __builtin_nontemporal_load(st + (dq * 32 + dd) * 128 + e);
#pragma unroll
        for (int dd = 0; dd < 32; ++dd) {
            const int d = dq * 32 + dd;
            const float s = sv[dd];
            float ns = s * g8;
#pragma unroll
            for (int j = 0; j < 8; ++j) ns += kf[j * 128 + d] * kdec[j] * vf[j * 128 + e];
            __builtin_nontemporal_store(ns, nst + d * 128 + e);
#pragma unroll
            for (int i = 0; i < 8; ++i) cr[i] += qf[i * 128 + d] * s;
        }
#pragma unroll
        for (int i = 0; i < 8; ++i) part[(dq * 8 + i) * 128 + e] = cr[i];
        __syncthreads();
        for (int idx = tid; idx < 1024; idx += 512) { const int i = idx >> 7, ee = idx & 127;
            float y = (part[(0 * 8 + i) * 128 + ee] + part[(1 * 8 + i) * 128 + ee] + part[(2 * 8 + i) * 128 + ee] + part[(3 * 8 + i) * 128 + ee]) * __expf((float)(i + 1) * lg);
            for (int j = 0; j <= i; ++j) y += sc[i * 8 + j] * vf[j * 128 + ee];
            yb[idx] = y; }
        __syncthreads();
        {
            const int il = wave; const size_t m = m0 + il;
            const float a0 = yb[il * 128 + lane], a1 = yb[il * 128 + 64 + lane];
            const float mean = wave_sum(a0 + a1) * (1.0f / 128.0f);
            const float d0 = a0 - mean, d1 = a1 - mean;
            const float var = wave_sum(d0 * d0 + d1 * d1) * (1.0f / 128.0f);
            const float rstd = rsqrtf(var + EPS);
            const float g0 = bf2f(w.proj[pofs(m, C_RG + h * 128 + lane)]), g1 = bf2f(w.proj[pofs(m, C_RG + h * 128 + 64 + lane)]);
            w.G[m * 1024 + h * 128 + lane] = (bf16_t)f2bf(d0 * rstd * gn[h * 128 + lane] * g0);
            w.G[m * 1024 + h * 128 + 64 + lane] = (bf16_t)f2bf(d1 * rstd * gn[h * 128 + 64 + lane] * g1);
        }
    }
}
typedef short v4s __attribute__((ext_vector_type(4)));
__device__ __forceinline__ v4s tr16(const LAS unsigned char* p) { return __builtin_amdgcn_ds_read_tr16_b64_v4i16((LAS v4s*)p); }
__device__ __forceinline__ bf16x8 cat8(v4s a, v4s b) { return (bf16x8){a[0], a[1], a[2], a[3], b[0], b[1], b[2], b[3]}; }
#define MFMA16(a, b, c) __builtin_amdgcn_mfma_f32_16x16x32_bf16(a, b, c, 0, 0, 0)
constexpr float LOG2E = 1.4426950408889634f, LN2 = 0.6931471805599453f;
__device__ __forceinline__ float lg2gamma(int h) { return log2f(1.0f - exp2f(-5.0f - (float)h)); }
__device__ __forceinline__ bf16x8 pack8(const f32x4 a, const f32x4 b) {
    u32x4 o; o.x = pk2(a[0], a[1]); o.y = pk2(a[2], a[3]); o.z = pk2(b[0], b[1]); o.w = pk2(b[2], b[3]);
    return __builtin_bit_cast(bf16x8, o);
}
constexpr int KP = 272, VP = 288;

struct AttnDesc { int g, h, dil, qb, qcol; size_t rowbase; };
__device__ __forceinline__ AttnDesc attn_desc(int item) {
    AttnDesc d; const int rq = item & 63; d.h = (item >> 6) & 3; const int b = (item >> 8) & 1; d.g = item >> 9;
    d.dil = 1 << (2 * d.g); const int sh = 6 - 2 * d.g, r = rq >> sh; d.qb = rq & ((1 << sh) - 1);
    d.qcol = C_ATT + d.g * 1536 + d.h * 128; d.rowbase = (size_t)b * SEQ + r; return d;
}
__device__ __forceinline__ void attn_load(const Ws& w, const AttnDesc& d, int tid, bool fresh, u32x4 (&kreg)[8], u32x4 (&vreg)[8]) {
    const int s0 = 128 * (d.qb - 1);
#pragma unroll
    for (int i = 0; i < 4; ++i) { const int cidx = tid + 512 * i, c = 128 + (cidx >> 4), ch = cidx & 15, s = s0 + c;
        const bf16_t* rp = w.proj + pofs(d.rowbase + (size_t)d.dil * s, d.qcol + ch * 8); kreg[i] = __builtin_nontemporal_load((const u32x4*)(rp + 4 * PSLAB)); vreg[i] = __builtin_nontemporal_load((const u32x4*)(rp + 8 * PSLAB)); }
    if (fresh) {
#pragma unroll
        for (int i = 4; i < 8; ++i) { const int cidx = tid + 512 * (i - 4), c = cidx >> 4, ch = cidx & 15, s = max(s0 + c, 0);
            const bf16_t* rp = w.proj + pofs(d.rowbase + (size_t)d.dil * s, d.qcol + ch * 8); kreg[i] = __builtin_nontemporal_load((const u32x4*)(rp + 4 * PSLAB)); vreg[i] = __builtin_nontemporal_load((const u32x4*)(rp + 8 * PSLAB)); }
    }
}
__device__ __forceinline__ void attn_loadq(const Ws& w, const AttnDesc& d, int wave, int fr, int fg, bf16x8 (&qf)[4]) {
    const size_t mq = d.rowbase + (size_t)d.dil * (128 * d.qb + 16 * wave + fr);
#pragma unroll
    for (int ds = 0; ds < 4; ++ds) qf[ds] = __builtin_nontemporal_load((const bf16x8*)(w.proj + pofs(mq, d.qcol + 32 * ds + 8 * fg)));
}
__device__ __forceinline__ void attn_compute(const Ws& w, LAS unsigned char* lds, const AttnDesc& d, int off, bf16x8 (&qf)[4], int wave, int fr, int fg, bool has_next, const AttnDesc& dn, int tid, u32x4 (&kreg)[8], u32x4 (&vreg)[8]) {
    LAS unsigned char* Kt = lds; LAS unsigned char* Vt = lds + 256 * KP;
    const int g = d.g, h = d.h, qb = d.qb;
    asm volatile("" : "+v"(fr), "+v"(fg));
    const int iq = 16 * wave + fr;
    const size_t mq = d.rowbase + (size_t)d.dil * (128 * qb + iq);
    const int kbmin = (qb == 0) ? 8 : 0;
    const float c1 = QK_SCALE * LOG2E, c2 = exp2f(-8.0f * (float)(g * 4 + h + 1) / 12.0f) * (float)d.dil * LOG2E;
    f32x4 sc[9];
    float mx = -1e30f;
#pragma unroll
    for (int kk = 0; kk < 9; ++kk) {
        const int kb = wave + kk;
        if (kb >= kbmin) {
            f32x4 a = (f32x4){0.f, 0.f, 0.f, 0.f};
#pragma unroll
            for (int ds = 0; ds < 4; ++ds) { const bf16x8 kf = *(const LAS bf16x8*)(Kt + (((16 * kb + off) & 255) + fr) * KP + (32 * ds + 8 * fg) * 2); a = MFMA16(kf, qf[ds], a); }
#pragma unroll
            for (int r_ = 0; r_ < 4; ++r_) { const int dist = 128 + iq - (16 * kb + 4 * fg + r_); const float s = a[r_] * c1 - c2 * (float)dist; a[r_] = (dist >= 0 && dist <= 128) ? s : -1e30f; mx = fmaxf(mx, a[r_]); }
            sc[kk] = a;
        } else sc[kk] = (f32x4){-1e30f, -1e30f, -1e30f, -1e30f};
    }
    mx = fmaxf(mx, __shfl_xor(mx, 16)); mx = fmaxf(mx, __shfl_xor(mx, 32));
    float sum = 0.f;
#pragma unroll
    for (int kk = 0; kk < 9; ++kk)
#pragma unroll
        for (int r_ = 0; r_ < 4; ++r_) { const float e = __builtin_amdgcn_exp2f(sc[kk][r_] - mx); sc[kk][r_] = e; sum += e; }
    sum += __shfl_xor(sum, 16); sum += __shfl_xor(sum, 32);
    if (has_next) { attn_load(w, dn, tid, dn.qb == 0, kreg, vreg); attn_loadq(w, dn, wave, fr, fg, qf); }
    f32x4 o[8];
#pragma unroll
    for (int eb = 0; eb < 8; ++eb) o[eb] = (f32x4){0.f, 0.f, 0.f, 0.f};
    const int q4 = fr >> 2, p4 = fr & 3;
#pragma unroll
    for (int st = 0; st < 5; ++st) {
        const int kb0 = wave + 2 * st;
        const bf16x8 pf = (st < 4) ? pack8(sc[2 * st], sc[2 * st + 1]) : pack8(sc[8], (f32x4){0.f, 0.f, 0.f, 0.f});
        const LAS unsigned char* v0 = Vt + (((16 * kb0 + off) & 255) + 4 * fg + q4) * VP + 8 * p4;
        const LAS unsigned char* v1 = Vt + (((16 * kb0 + 16 + off) & 255) + 4 * fg + q4) * VP + 8 * p4;
#pragma unroll
        for (int eb = 0; eb < 8; ++eb) {
            const v4s a0 = tr16(v0 + 32 * eb);
            const v4s a1 = (st < 4) ? tr16(v1 + 32 * eb) : (v4s){0, 0, 0, 0};
            o[eb] = MFMA16(cat8(a0, a1), pf, o[eb]);
        }
    }
    const float inv = 1.0f / sum;
    bf16_t* orow = w.og + ((size_t)g * MT + mq) * 512 + h * 128 + 4 * fg;
#pragma unroll
    for (int eb = 0; eb < 8; ++eb) { u32x2 ov; ov.x = pk2(o[eb][0] * inv, o[eb][1] * inv); ov.y = pk2(o[eb][2] * inv, o[eb][3] * inv); *(u32x2*)(orow + 16 * eb) = ov; }
    if (fg == 0) w.lse[((size_t)g * MT + mq) * 4 + h] = mx * LN2 + __logf(sum);
}
__device__ __forceinline__ void attn_phase(const Ws& w, LAS unsigned char* lds, int first, int count) {
    const int tid = opaque_tid(), lane = tid & 63, wave = __builtin_amdgcn_readfirstlane(tid >> 6), fr = lane & 15, fg = lane >> 4;
    if (count <= 0) return;
    LAS unsigned char* Kt = lds; LAS unsigned char* Vt = lds + 256 * KP;
    u32x4 kreg[8], vreg[8]; bf16x8 qf[4];
    AttnDesc d = attn_desc(first);
    attn_load(w, d, tid, true, kreg, vreg); attn_loadq(w, d, wave, fr, fg, qf);
    int off = 0; bool fresh = true;
    for (int n = 0; n < count; ++n) {
        __syncthreads();
        if (fresh) off = 0; else off = (off + 128) & 255;
#pragma unroll
        for (int i = 0; i < 4; ++i) { const int cidx = tid + 512 * i, c = (128 + (cidx >> 4) + off) & 255, ch = cidx & 15;
            *(LAS u32x4*)(Kt + c * KP + ch * 16) = kreg[i]; *(LAS u32x4*)(Vt + c * VP + ch * 16) = vreg[i]; }
        if (fresh) {
#pragma unroll
            for (int i = 4; i < 8; ++i) { const int cidx = tid + 512 * (i - 4), c = ((cidx >> 4) + off) & 255, ch = cidx & 15;
                *(LAS u32x4*)(Kt + c * KP + ch * 16) = kreg[i]; *(LAS u32x4*)(Vt + c * VP + ch * 16) = vreg[i]; }
        }
        __syncthreads();
        const AttnDesc dc = d;
        const bool has_next = n + 1 < count;
        if (has_next) { d = attn_desc(first + n + 1); fresh = (d.qb == 0); }
        attn_compute(w, lds, dc, off, qf, wave, fr, fg, has_next, d, tid, kreg, vreg);
    }
    __syncthreads();
}

__device__ __forceinline__ float half_sum(float v) {
#pragma unroll
    for (int o = 1; o < 32; o <<= 1) v += __shfl_xor(v, o);
    return v;
}
__device__ __forceinline__ void attn_sample(const Params& p, const Ws& w, LAS unsigned char* lds, int vcu, int G) {
    const int tid = opaque_tid(), lane = tid & 63, wave = tid >> 6, half = lane >> 5, c = lane & 31;
    const int gw = vcu * 8 + wave, NGW = G * 8;
    for (int it = gw; it < MS * 12; it += NGW) {
        const int g = it % 3, mh = it / 3, ms = mh >> 2, h = mh & 3, m = MP + ms, b = ms >> 3, t = ms & 7;
        const int dil = 1 << (2 * g), Wb = 128 << (2 * g);
        const int qcol = C_ATT + g * 1536 + h * 128, kcol = qcol + 512, vcol = qcol + 1024;
        f32x4 q; { const u32x2 v = *(const u32x2*)(w.proj + pofs(m, qcol + 4 * c)); q = (f32x4){bflo(v.x), bfhi(v.x), bflo(v.y), bfhi(v.y)}; }
        const float slope = exp2f(-8.0f * (float)(g * 4 + h + 1) / 12.0f) * (float)dil;
        const float* cache = p.in[3 + g];
        const int jn = t >> (2 * g);
        const int ncache = 128 - jn, npair = (ncache + 1) >> 1;
        const float* kb0 = cache + ((size_t)(b * Wb + Wb + t) * 2 + 0) * 512 + h * 128 + 4 * c;
        float* kvout = p.out + (g == 0 ? O_KV128S : (g == 1 ? O_KV512S : O_KV2048S));
        const bool owner = (g == 0) ? (t == 0) : (g == 1 ? (t < 4) : true);
        float mrun = -1e30f, sum = 0.f; f32x4 o = (f32x4){0.f, 0.f, 0.f, 0.f};
#pragma unroll
        for (int j = 0; j < 8; ++j) if (j <= jn) {
            const u32x2 kk2 = *(const u32x2*)(w.proj + pofs(m - dil * j, kcol + 4 * c)), vv = *(const u32x2*)(w.proj + pofs(m - dil * j, vcol + 4 * c));
            const float s = half_sum((bflo(kk2.x) * q[0] + bfhi(kk2.x) * q[1]) + (bflo(kk2.y) * q[2] + bfhi(kk2.y) * q[3])) * QK_SCALE - slope * (float)j;
            if (half == 0) { const float mn = fmaxf(mrun, s), al = __expf(mrun - mn), e = __expf(s - mn); mrun = mn; sum = sum * al + e;
                o = o * al; o[0] += e * bflo(vv.x); o[1] += e * bfhi(vv.x); o[2] += e * bflo(vv.y); o[3] += e * bfhi(vv.y); }
        }
        for (int k0 = 0; k0 < npair; k0 += 16) {
            f32x4 kv[16], vv[16];
#pragma unroll
            for (int u = 0; u < 16; ++u) { const int j = jn + 1 + 2 * (k0 + u) + half;
                if (k0 + u < npair && j <= 128) { const float* rp = kb0 - (size_t)(dil * j) * 1024; kv[u] = __builtin_nontemporal_load((const f32x4*)rp); vv[u] = __builtin_nontemporal_load((const f32x4*)(rp + 512));
                    const int idx = Wb + t - dil * j;
                    if (owner && idx >= 8) { float* wp = kvout + ((size_t)(b * Wb + idx - 8) * 2) * 512 + h * 128 + 4 * c; __builtin_nontemporal_store(kv[u], (f32x4*)wp); __builtin_nontemporal_store(vv[u], (f32x4*)(wp + 512)); } }
                else { kv[u] = (f32x4){0.f, 0.f, 0.f, 0.f}; vv[u] = kv[u]; } }
            float s[16]; float bm = -1e30f;
#pragma unroll
            for (int u = 0; u < 16; ++u) { const int j = jn + 1 + 2 * (k0 + u) + half;
                const float d = half_sum((kv[u][0] * q[0] + kv[u][1] * q[1]) + (kv[u][2] * q[2] + kv[u][3] * q[3]));
                s[u] = (k0 + u < npair && j <= 128) ? d * QK_SCALE - slope * (float)j : -1e30f; bm = fmaxf(bm, s[u]); }
            const float mn = fmaxf(mrun, bm), al = __expf(mrun - mn); mrun = mn; sum *= al; o = o * al;
#pragma unroll
            for (int u = 0; u < 16; ++u) { const float e = __expf(s[u] - mn); sum += e; o += vv[u] * e; }
        }
        const float mo = __shfl_xor(mrun, 32), so = __shfl_xor(sum, 32);
        const float mt = fmaxf(mrun, mo), a0 = __expf(mrun - mt), a1 = __expf(mo - mt);
        const float st = sum * a0 + so * a1;
#pragma unroll
        for (int i = 0; i < 4; ++i) o[i] = o[i] * a0 + __shfl_xor(o[i], 32) * a1;
        const float inv = 1.0f / st;
        if (half == 0) { u32x2 ov; ov.x = pk2(o[0] * inv, o[1] * inv); ov.y = pk2(o[2] * inv, o[3] * inv); *(u32x2*)(w.og + ((size_t)g * MT + m) * 512 + h * 128 + 4 * c) = ov; }
        if (lane == 0) w.lse[((size_t)g * MT + m) * 4 + h] = mt + __logf(st);
    }
}

__device__ __forceinline__ void retA_load(const Ws& w, int item, int tid, u32x4 (&kr)[4], u32x4 (&vr)[4]) {
    const int c = item & 63, bh = item >> 6, h = bh & 7, b = bh >> 3;
    const size_t m0 = (size_t)b * SEQ + c * 128;
#pragma unroll
    for (int i = 0; i < 4; ++i) { const int cidx = tid + 512 * i, j = cidx >> 4, ch = cidx & 15;
        const bf16_t* rp = w.proj + pofs(m0 + j, h * 128 + ch * 8);
        kr[i] = *(const u32x4*)(rp + (C_RK / 128) * PSLAB); vr[i] = *(const u32x4*)(rp + (C_RV / 128) * PSLAB); }
}
__device__ __forceinline__ void retA_item(const Ws& w, LAS unsigned char* lds, int item, int next, u32x4 (&kr)[4], u32x4 (&vr)[4]) {
    const int tid = opaque_tid(), lane = tid & 63, wave = __builtin_amdgcn_readfirstlane(tid >> 6), fr = lane & 15, fg = lane >> 4;
    const int bh = item >> 6, h = bh & 7;
    const float lg2 = lg2gamma(h);
    LAS unsigned char* Kt = lds; LAS unsigned char* Vt = lds + 128 * VP;
#pragma unroll
    for (int i = 0; i < 4; ++i) { const int cidx = tid + 512 * i, j = cidx >> 4, ch = cidx & 15;
        const float kd = exp2f((float)(127 - j) * lg2) * QK_SCALE;
        u32x4 ks; ks.x = pk2(bflo(kr[i].x) * kd, bfhi(kr[i].x) * kd); ks.y = pk2(bflo(kr[i].y) * kd, bfhi(kr[i].y) * kd); ks.z = pk2(bflo(kr[i].z) * kd, bfhi(kr[i].z) * kd); ks.w = pk2(bflo(kr[i].w) * kd, bfhi(kr[i].w) * kd);
        *(LAS u32x4*)(Kt + j * VP + ch * 16) = ks; *(LAS u32x4*)(Vt + j * VP + ch * 16) = vr[i]; }
    __syncthreads();
    if (next >= 0) retA_load(w, next, tid, kr, vr);
    f32x4 acc[8];
#pragma unroll
    for (int db = 0; db < 8; ++db) acc[db] = (f32x4){0.f, 0.f, 0.f, 0.f};
    const int q4 = fr >> 2, p4 = fr & 3;
#pragma unroll
    for (int st = 0; st < 4; ++st) {
        const int rowoff = (32 * st + 4 * fg + q4) * VP + 8 * p4;
        const bf16x8 af = cat8(tr16(Vt + rowoff + 32 * wave), tr16(Vt + rowoff + 16 * VP + 32 * wave));
#pragma unroll
        for (int db = 0; db < 8; ++db) { const bf16x8 bfr = cat8(tr16(Kt + rowoff + 32 * db), tr16(Kt + rowoff + 16 * VP + 32 * db)); acc[db] = MFMA16(af, bfr, acc[db]); }
    }
    __syncthreads();
    {
        LAS bf16_t* stg = (LAS bf16_t*)(lds + wave * 4096);
#pragma unroll
        for (int db = 0; db < 8; ++db)
#pragma unroll
            for (int r_ = 0; r_ < 4; ++r_) stg[(4 * fg + r_) * 128 + 16 * db + fr] = (bf16_t)f2bf(acc[db][r_]);
        LDS_WAIT();
        bf16_t* dst = (bf16_t*)w.kvc + (size_t)item * 16384 + (size_t)(16 * wave) * 128;
#pragma unroll
        for (int i = 0; i < 4; ++i) { const int row = 4 * i + (lane >> 4), ch = lane & 15; *(u32x4*)(dst + row * 128 + ch * 8) = *(const LAS u32x4*)(stg + row * 128 + ch * 8); }
    }
    __syncthreads();
}
__device__ __forceinline__ void ret_scan2(const Params& p, const Ws& w, int vcu, int G) {
    for (int i = vcu * 512 + opaque_tid(); i < 16 * 8192; i += G * 512) {
        const int bh = i >> 13, idx = (i & 8191) * 2, h = bh & 7;
        const float g128 = exp2f(128.0f * lg2gamma(h));
        const bf16_t* base = (const bf16_t*)w.kvc + (size_t)bh * 64 * 16384 + idx;
        bf16_t* sbase = w.sb + (size_t)bh * 64 * 16384 + idx;
        float s0 = 0.f, s1 = 0.f;
        for (int c0 = 0; c0 < 64; c0 += 16) {
            unsigned kv[16];
#pragma unroll
            for (int k = 0; k < 16; ++k) kv[k] = __builtin_nontemporal_load((const unsigned*)(base + (size_t)(c0 + k) * 16384));
#pragma unroll
            for (int k = 0; k < 16; ++k) { *(unsigned*)(sbase + (size_t)(c0 + k) * 16384) = pk2(s0, s1); s0 = s0 * g128 + bflo(kv[k]); s1 = s1 * g128 + bfhi(kv[k]); }
        }
        const int e = idx >> 7, d = idx & 127;
        __builtin_nontemporal_store(s0, p.out + O_RETP + (size_t)bh * 16384 + d * 128 + e); __builtin_nontemporal_store(s1, p.out + O_RETP + (size_t)bh * 16384 + (d + 1) * 128 + e);
    }
}
struct MergeIn { float l0, l1, l2; u32x4 a, b, c; };
__device__ __forceinline__ MergeIn merge_load(const Ws& w, int i) {
    const int m = i >> 6, c8 = (i & 63) * 8, h = c8 >> 7; MergeIn r;
    r.l0 = w.lse[((size_t)0 * MT + m) * 4 + h]; r.l1 = w.lse[((size_t)1 * MT + m) * 4 + h]; r.l2 = w.lse[((size_t)2 * MT + m) * 4 + h];
    r.a = __builtin_nontemporal_load((const u32x4*)(w.og + ((size_t)0 * MT + m) * 512 + c8)); r.b = __builtin_nontemporal_load((const u32x4*)(w.og + ((size_t)1 * MT + m) * 512 + c8));
    r.c = __builtin_nontemporal_load((const u32x4*)(w.og + ((size_t)2 * MT + m) * 512 + c8));
    return r;
}
__device__ __forceinline__ void merge_store(const Ws& w, int i, const MergeIn& r) {
    const int m = i >> 6, c8 = (i & 63) * 8;
    const float mx = fmaxf(r.l0, fmaxf(r.l1, r.l2));
    float w0 = __expf(r.l0 - mx), w1 = __expf(r.l1 - mx), w2 = __expf(r.l2 - mx);
    const float inv = 1.0f / (w0 + w1 + w2); w0 *= inv; w1 *= inv; w2 *= inv;
    const u32x4 a = r.a, b = r.b, c = r.c;
    u32x4 o;
    o.x = pk2(w0 * bflo(a.x) + w1 * bflo(b.x) + w2 * bflo(c.x), w0 * bfhi(a.x) + w1 * bfhi(b.x) + w2 * bfhi(c.x));
    o.y = pk2(w0 * bflo(a.y) + w1 * bflo(b.y) + w2 * bflo(c.y), w0 * bfhi(a.y) + w1 * bfhi(b.y) + w2 * bfhi(c.y));
    o.z = pk2(w0 * bflo(a.z) + w1 * bflo(b.z) + w2 * bflo(c.z), w0 * bfhi(a.z) + w1 * bfhi(b.z) + w2 * bfhi(c.z));
    o.w = pk2(w0 * bflo(a.w) + w1 * bflo(b.w) + w2 * bflo(c.w), w0 * bfhi(a.w) + w1 * bfhi(b.w) + w2 * bfhi(c.w));
    *(u32x4*)(w.Oatt + (size_t)m * 1024 + c8) = o;
}
__device__ __forceinline__ void attn_merge(const Ws& w, int vcu, int G) {
    const int step = G * 512, N = MT * 64;
    for (int i = vcu * 512 + opaque_tid(); i < N; i += 3 * step) {
        const int i2 = i + step, i3 = i + 2 * step; const bool t2 = i2 < N, t3 = i3 < N;
        const MergeIn r0 = merge_load(w, i), r1 = merge_load(w, t2 ? i2 : i), r2 = merge_load(w, t3 ? i3 : i);
        merge_store(w, i, r0);
        if (t2) merge_store(w, i2, r1);
        if (t3) merge_store(w, i3, r2);
    }
}
__device__ __forceinline__ void retC_load(const Ws& w, int item, int tid, u32x4 (&kr)[4], u32x4 (&vr)[4], u32x4 (&sr)[4]) {
    const int c = item & 63, bh = item >> 6, h = bh & 7, b = bh >> 3;
    const size_t m0 = (size_t)b * SEQ + c * 128;
    const bf16_t* sbp = w.sb + (size_t)item * 16384;
#pragma unroll
    for (int i = 0; i < 4; ++i) { const int cidx = tid + 512 * i, j = cidx >> 4, ch = cidx & 15;
        const bf16_t* rp = w.proj + pofs(m0 + j, h * 128 + ch * 8);
        kr[i] = __builtin_nontemporal_load((const u32x4*)(rp + (C_RK / 128) * PSLAB)); vr[i] = __builtin_nontemporal_load((const u32x4*)(rp + (C_RV / 128) * PSLAB)); sr[i] = __builtin_nontemporal_load((const u32x4*)(sbp + j * 128 + ch * 8)); }
}
__device__ __forceinline__ void retC_loadq(const Ws& w, int item, int wave, int fr, int fg, bf16x8 (&qf)[4]) {
    const int c = item & 63, bh = item >> 6, h = bh & 7, b = bh >> 3;
    const size_t mq = (size_t)b * SEQ + c * 128 + 16 * wave + fr;
#pragma unroll
    for (int ds = 0; ds < 4; ++ds) qf[ds] = __builtin_nontemporal_load((const bf16x8*)(w.proj + pofs(mq, C_RQ + h * 128 + 32 * ds + 8 * fg)));
}
__device__ __forceinline__ void retC_compute(const Params& p, const Ws& w, LAS unsigned char* lds, int item, bf16x8 (&qf)[4], int wave, int fr, int fg, int next_item, int tid, u32x4 (&kr)[4], u32x4 (&vr)[4], u32x4 (&sr)[4]) {
    const int c = item & 63, bh = item >> 6, h = bh & 7, b = bh >> 3;
    const size_t m0 = (size_t)b * SEQ + c * 128;
    const float lg2 = lg2gamma(h);
    LAS unsigned char* Kt = lds; LAS unsigned char* Vt = lds + 128 * KP; LAS unsigned char* St = Vt + 128 * VP;
    asm volatile("" : "+v"(fr), "+v"(fg));
    const int iq = 16 * wave + fr;
    const size_t mq = m0 + iq;
    f32x4 sc[8];
#pragma unroll
    for (int kb = 0; kb < 8; ++kb) {
        if (kb <= wave) {
            f32x4 a = (f32x4){0.f, 0.f, 0.f, 0.f};
#pragma unroll
            for (int ds = 0; ds < 4; ++ds) { const bf16x8 kf = *(const LAS bf16x8*)(Kt + (16 * kb + fr) * KP + (32 * ds + 8 * fg) * 2); a = MFMA16(kf, qf[ds], a); }
#pragma unroll
            for (int r_ = 0; r_ < 4; ++r_) { const int dj = iq - (16 * kb + 4 * fg + r_); a[r_] = (dj >= 0) ? a[r_] * QK_SCALE * exp2f((float)dj * lg2) : 0.f; }
            sc[kb] = a;
        } else sc[kb] = (f32x4){0.f, 0.f, 0.f, 0.f};
    }
    f32x4 y[8], cr[8];
#pragma unroll
    for (int eb = 0; eb < 8; ++eb) { y[eb] = (f32x4){0.f, 0.f, 0.f, 0.f}; cr[eb] = (f32x4){0.f, 0.f, 0.f, 0.f}; }
    const int q4 = fr >> 2, p4 = fr & 3;
#pragma unroll
    for (int st = 0; st < 4; ++st) {
        if (2 * st <= wave) {
            const bf16x8 pf = pack8(sc[2 * st], sc[2 * st + 1]);
            const LAS unsigned char* v0 = Vt + (32 * st + 4 * fg + q4) * VP + 8 * p4;
#pragma unroll
            for (int eb = 0; eb < 8; ++eb) y[eb] = MFMA16(cat8(tr16(v0 + 32 * eb), tr16(v0 + 16 * VP + 32 * eb)), pf, y[eb]);
        }
    }
#pragma unroll
    for (int eb = 0; eb < 8; ++eb)
#pragma unroll
        for (int ds = 0; ds < 4; ++ds) { const bf16x8 sf = *(const LAS bf16x8*)(St + (16 * eb + fr) * KP + (32 * ds + 8 * fg) * 2); cr[eb] = MFMA16(sf, qf[ds], cr[eb]); }
    if (next_item >= 0) { retC_load(w, next_item, tid, kr, vr, sr); retC_loadq(w, next_item, wave, fr, fg, qf); }
    const float qd = exp2f((float)(iq + 1) * lg2);
    float s = 0.f;
#pragma unroll
    for (int eb = 0; eb < 8; ++eb) { y[eb] = y[eb] + cr[eb] * qd; s += (y[eb][0] + y[eb][1]) + (y[eb][2] + y[eb][3]); }
    s += __shfl_xor(s, 16); s += __shfl_xor(s, 32);
    const float mean = s * (1.0f / 128.0f);
    float v = 0.f;
#pragma unroll
    for (int eb = 0; eb < 8; ++eb) { y[eb] = y[eb] - mean; v += (y[eb][0] * y[eb][0] + y[eb][1] * y[eb][1]) + (y[eb][2] * y[eb][2] + y[eb][3] * y[eb][3]); }
    v += __shfl_xor(v, 16); v += __shfl_xor(v, 32);
    const float rstd = rsqrtf(v * (1.0f / 128.0f) + EPS);
    const float* gn = p.in[9] + h * 128 + 4 * fg;
    const bf16_t* grow = w.proj + pofs(mq, C_RG + h * 128 + 4 * fg);
    bf16_t* orow = w.G + mq * 1024 + h * 128 + 4 * fg;
#pragma unroll
    for (int eb = 0; eb < 8; ++eb) { const f32x4 gv = *(const f32x4*)(gn + 16 * eb); const u32x2 sg = __builtin_nontemporal_load((const u32x2*)(grow + 16 * eb));
        u32x2 ov; ov.x = pk2(y[eb][0] * rstd * gv[0] * bflo(sg.x), y[eb][1] * rstd * gv[1] * bfhi(sg.x)); ov.y = pk2(y[eb][2] * rstd * gv[2] * bflo(sg.y), y[eb][3] * rstd * gv[3] * bfhi(sg.y));
        *(u32x2*)(orow + 16 * eb) = ov; }
}
__device__ __forceinline__ void retC_phase(const Params& p, const Ws& w, LAS unsigned char* lds, int vcu, int G) {
    const int tid = opaque_tid(), lane = tid & 63, wave = __builtin_amdgcn_readfirstlane(tid >> 6), fr = lane & 15, fg = lane >> 4;
    if (vcu >= 1024) return;
    LAS unsigned char* Kt = lds; LAS unsigned char* Vt = lds + 128 * KP; LAS unsigned char* St = Vt + 128 * VP;
    u32x4 kr[4], vr[4], sr[4]; bf16x8 qf[4];
    retC_load(w, vcu, tid, kr, vr, sr); retC_loadq(w, vcu, wave, fr, fg, qf);
    for (int item = vcu; item < 1024; item += G) {
        __syncthreads();
#pragma unroll
        for (int i = 0; i < 4; ++i) { const int cidx = tid + 512 * i, j = cidx >> 4, ch = cidx & 15;
            *(LAS u32x4*)(Kt + j * KP + ch * 16) = kr[i]; *(LAS u32x4*)(Vt + j * VP + ch * 16) = vr[i]; *(LAS u32x4*)(St + j * KP + ch * 16) = sr[i]; }
        __syncthreads();
        retC_compute(p, w, lds, item, qf, wave, fr, fg, (item + G < 1024) ? item + G : -1, tid, kr, vr, sr);
    }
    __syncthreads();
}

__device__ __forceinline__ void panel_arrive_wait(unsigned* cnt, unsigned want);
__device__ __forceinline__ void sg_accum(f32x4 (&acc)[2][4], const bf16_t* A, int lda, const bf16_t* Bt, int K, int r0, int n0, int wave, int fr, int fq, int ldb = 0) {
    if (ldb == 0) ldb = K;
    const int kw = K / 8, k0 = wave * kw;
    const bf16_t* ap = A + (size_t)(r0 + fr) * lda + k0 + 8 * fq;
    const bf16_t* bp = Bt + (size_t)(n0 + fr) * ldb + k0 + 8 * fq;
    int ks = 0;
    for (; ks + 128 <= kw; ks += 128) {
        bf16x8 a[4][2], b[4][4];
#pragma unroll
        for (int s = 0; s < 4; ++s) {
#pragma unroll
            for (int i = 0; i < 2; ++i) a[s][i] = *(const bf16x8*)(ap + (size_t)(16 * i) * lda + ks + 32 * s);
#pragma unroll
            for (int j = 0; j < 4; ++j) b[s][j] = *(const bf16x8*)(bp + (size_t)(16 * j) * ldb + ks + 32 * s);
        }
#pragma unroll
        for (int s = 0; s < 4; ++s)
#pragma unroll
            for (int i = 0; i < 2; ++i)
#pragma unroll
                for (int j = 0; j < 4; ++j) acc[i][j] = MFMA16(b[s][j], a[s][i], acc[i][j]);
    }
    for (; ks < kw; ks += 64) {
        bf16x8 a[2][2], b[2][4];
#pragma unroll
        for (int s = 0; s < 2; ++s) {
#pragma unroll
            for (int i = 0; i < 2; ++i) a[s][i] = *(const bf16x8*)(ap + (size_t)(16 * i) * lda + ks + 32 * s);
#pragma unroll
            for (int j = 0; j < 4; ++j) b[s][j] = *(const bf16x8*)(bp + (size_t)(16 * j) * ldb + ks + 32 * s);
        }
#pragma unroll
        for (int s = 0; s < 2; ++s)
#pragma unroll
            for (int i = 0; i < 2; ++i)
#pragma unroll
                for (int j = 0; j < 4; ++j) acc[i][j] = MFMA16(b[s][j], a[s][i], acc[i][j]);
    }
}
template <int MODE>
__device__ __forceinline__ void sample_gemm(const Params& p, const Ws& w, LAS unsigned char* lds, int vcu, int G) {
    const int tid = opaque_tid(), lane = tid & 63, wave = __builtin_amdgcn_readfirstlane(tid >> 6), fr = lane & 15, fq = lane >> 4;
    LAS f32x4* red = (LAS f32x4*)lds;
    for (int unit = vcu; unit < 256; unit += G) {
        const int rg = (unit & 31) >> 2, r0 = rg * 32, n0 = ((unit >> 5) * 4 + (unit & 3)) * 64;
        f32x4 acc[2][4];
#pragma unroll
        for (int i = 0; i < 2; ++i)
#pragma unroll
            for (int j = 0; j < 4; ++j) acc[i][j] = (f32x4){0.f, 0.f, 0.f, 0.f};
        if (MODE == 5) {
            sg_accum(acc, w.G + (size_t)MP * 1024, 1024, w.Wt_reto, 1024, r0, n0, wave, fr, fq);
            f32x4 acc2[2][4];
#pragma unroll
            for (int i = 0; i < 2; ++i)
#pragma unroll
                for (int j = 0; j < 4; ++j) acc2[i][j] = (f32x4){0.f, 0.f, 0.f, 0.f};
            sg_accum(acc2, w.Oatt + (size_t)MP * 1024, 1024, w.Wt_atto, 512, r0, n0, wave, fr, fq, 1024);
#pragma unroll
            for (int i = 0; i < 2; ++i)
#pragma unroll
                for (int j = 0; j < 4; ++j) { const unsigned char* gp = w.g8 + (size_t)(MP + r0 + 16 * i + fr) * 4096 + n0 + 16 * j + 4 * fq;
                    acc[i][j] = acc[i][j] * dec8x4(*(const unsigned*)gp) + acc2[i][j] * dec8x4(*(const unsigned*)(gp + 2048)); }
        } else if (MODE == 6) sg_accum(acc, w.merged + (size_t)MP * DM, DM, w.Wt_o, DM, r0, n0, wave, fr, fq);
        else sg_accum(acc, w.act + (size_t)MP * FF, FF, w.Wt_down, FF, r0, n0, wave, fr, fq);
        __syncthreads();
#pragma unroll
        for (int i = 0; i < 2; ++i)
#pragma unroll
            for (int j = 0; j < 4; ++j) red[(wave * 8 + i * 4 + j) * 64 + lane] = acc[i][j];
        __syncthreads();
        const int blk = tid >> 6;
        f32x4 v = red[blk * 64 + lane];
#pragma unroll
        for (int ww = 1; ww < 8; ++ww) v += red[(ww * 8 + blk) * 64 + lane];
        const int row = MP + r0 + 16 * (blk >> 2) + fr, col = n0 + 16 * (blk & 3) + 4 * fq;
        if (MODE == 5) { u32x2 o; o.x = pk2(v[0], v[1]); o.y = pk2(v[2], v[3]); *(u32x2*)(w.merged + (size_t)row * DM + col) = o; }
        else if (MODE == 6) {
            { const u32x2 xv = *(const u32x2*)(w.xb + (size_t)row * DM + col); const float xs_ = w.rstd1[row]; v[0] += bflo(xv.x) * xs_; v[1] += bfhi(xv.x) * xs_; v[2] += bflo(xv.y) * xs_; v[3] += bfhi(xv.y) * xs_; }
            u32x2 o; o.x = pk2(v[0], v[1]); o.y = pk2(v[2], v[3]); *(u32x2*)(w.xb + (size_t)row * DM + col) = o;
            atomicAdd(w.sumsq2 + row, (v[0] * v[0] + v[1] * v[1]) + (v[2] * v[2] + v[3] * v[3]));
        } else {
            float* dst = p.out + O_Y + (size_t)row * DM + col;
            { const u32x2 xv = *(const u32x2*)(w.xb + (size_t)row * DM + col); v[0] += bflo(xv.x); v[1] += bfhi(xv.x); v[2] += bflo(xv.y); v[3] += bfhi(xv.y); }
            atomicAdd(w.sumsq3 + row, (v[0] * v[0] + v[1] * v[1]) + (v[2] * v[2] + v[3] * v[3]));
            asm volatile("s_waitcnt vmcnt(0)" ::: "memory"); __syncthreads();
            if (tid == 0) panel_arrive_wait((unsigned*)(p.ws + WS_PCNT) + 16 * (64 + rg), 32u);
            __syncthreads();
            const float rs = rsqrtf(__hip_atomic_load(w.sumsq3 + row, __ATOMIC_RELAXED, __HIP_MEMORY_SCOPE_AGENT) * (1.0f / DM) + EPS);
            __builtin_nontemporal_store(v * rs * *(const f32x4*)(p.in[18] + col), (f32x4*)dst);
        }
        __syncthreads();
    }
}

#define XB_TMO      128
#define XB_XCNT(j)  (256  + 64 * (j))
#define XB_XSUB(j)  (1280 + 64 * (j))
#define XB_XGEN(j)  (2304 + 64 * (j))
#define XB_TOP      3328
#define XB_TOPGEN   3392
#define XCD_BAR_WORDS 3456
#define XB_SPIN_CAP (1u << 18)
__device__ __forceinline__ unsigned xb_ld(unsigned* p)              { return __hip_atomic_load(p, __ATOMIC_RELAXED, __HIP_MEMORY_SCOPE_AGENT); }
__device__ __forceinline__ unsigned xb_add(unsigned* p, unsigned v) { return __hip_atomic_fetch_add(p, v, __ATOMIC_RELAXED, __HIP_MEMORY_SCOPE_AGENT); }
__device__ __forceinline__ unsigned xb_xcc_id() { return (unsigned)__builtin_amdgcn_s_getreg((3 << 11) | 20) & 0xFu; }
#define XB_SPIN(cond, bar) do { unsigned _sp = 0; while (cond) { __builtin_amdgcn_s_sleep(1); \
    if ((++_sp & 255u) == 0u) { if (xb_ld(&(bar)[XB_TMO])) break; if (_sp > XB_SPIN_CAP) { atomicAdd(&(bar)[XB_TMO], 1u); break; } } } } while (0)
struct XcdBarrier { unsigned* bar; unsigned x; volatile LAS unsigned* st; };
__device__ __forceinline__ XcdBarrier xcd_barrier_post(unsigned* bar, volatile LAS unsigned* st) {
    XcdBarrier b; b.bar = bar; b.x = xb_xcc_id(); b.st = st;
    if (threadIdx.x == 0) (void)xb_add(&bar[XB_XCNT(b.x)], 1u);
    return b;
}
__device__ __forceinline__ void xcd_barrier_complete(unsigned* bar, unsigned x, unsigned& nloc, unsigned& nx) {
    const unsigned G = gridDim.x * gridDim.y * gridDim.z;
    unsigned sum, cnt, mine, sp = 0u;
    for (;;) {
        sum = 0u; cnt = 0u; mine = 0u;
#pragma unroll
        for (unsigned j = 0; j < 16; ++j) { const unsigned c = xb_ld(&bar[XB_XCNT(j)]); sum += c; cnt += (c > 0u) ? 1u : 0u; mine = (j == x) ? c : mine; }
        if (sum == G) break;
        __builtin_amdgcn_s_sleep(1);
        if ((++sp & 255u) == 0u) { if (xb_ld(&bar[XB_TMO])) break; if (sp > XB_SPIN_CAP) { atomicAdd(&bar[XB_TMO], 1u); break; } }
    }
    nloc = mine > 0u ? mine : 1u; nx = cnt > 0u ? cnt : 1u;
}
__device__ __forceinline__ void xcd_barrier(const XcdBarrier& b) {
    asm volatile("s_waitcnt vmcnt(0)" ::: "memory");
    __syncthreads();
    if (threadIdx.x == 0) {
        unsigned* bar = b.bar;
        __builtin_amdgcn_s_waitcnt(0);
        unsigned nloc = b.st[0], nx = b.st[1];
        if (nloc == 0u) { xcd_barrier_complete(bar, b.x, nloc, nx); b.st[0] = nloc; b.st[1] = nx; }
        const unsigned old = xb_add(&bar[XB_XSUB(b.x)], 1u);
        const unsigned gen = old / nloc;
        if (old + 1u == (gen + 1u) * nloc) {
            __builtin_amdgcn_fence(__ATOMIC_RELEASE, "agent");
            asm volatile("s_waitcnt vmcnt(0)" ::: "memory");
            const unsigned og = xb_add(&bar[XB_TOP], 1u);
            const unsigned tg = og / nx;
            if (og + 1u == (tg + 1u) * nx) xb_add(&bar[XB_TOPGEN], 1u);
            else XB_SPIN(xb_ld(&bar[XB_TOPGEN]) == tg, bar);
            __builtin_amdgcn_fence(__ATOMIC_ACQUIRE, "agent");
            xb_add(&bar[XB_XGEN(b.x)], 1u);
            asm volatile("s_waitcnt vmcnt(0)" ::: "memory");
        } else {
            XB_SPIN(xb_ld(&bar[XB_XGEN(b.x)]) == gen, bar);
            __builtin_amdgcn_fence(__ATOMIC_ACQUIRE, "agent");
            asm volatile("s_waitcnt vmcnt(0)" ::: "memory");
        }
    }
    __syncthreads();
}

constexpr int LDS_BYTES = 147456;
constexpr int LDS_BARST = 143360;
constexpr int NPHASE = 12;
__global__ void __launch_bounds__(512, 2) fwd_kernel(Params p) {
    extern __shared__ __attribute__((aligned(16))) unsigned char lds_raw[];
    LAS unsigned char* lds = (LAS unsigned char*)lds_raw;
    const Ws w = make_ws(p.ws);
    const int G = gridDim.x; const int bx = blockIdx.x;
    const int vcu = (G % 8 == 0) ? (bx % 8) * (G / 8) + bx / 8 : bx;
    const int lo = p.ph_lo, hi = p.ph_hi;
    volatile LAS unsigned* barst = (volatile LAS unsigned*)(lds + LDS_BARST);
    if (threadIdx.x < 2) barst[threadIdx.x] = 0u;
    __syncthreads();
    XcdBarrier bar = xcd_barrier_post((unsigned*)(p.ws + WS_BAR), barst);
#define IN(k) (lo <= (k) && (k) < hi)
    if (lo < 0) cg::this_grid().sync();
#define SEAM(k) do { if (IN(k) && IN((k) + 1)) xcd_barrier(bar); } while (0)
    if (IN(0)) { weight_transposes<0>(p, w, lds, vcu, G); p0_xconv(p, w, lds, vcu, G);
        if (KVSLACK < 100) kv_copy_range(p, KV_SPLIT, KV_TOTAL, vcu, G); } SEAM(0);
    const size_t kv_s1 = KV_SPLIT / 100 * 20;
    const int n1 = (65 * 50) % G, n7 = (67 * 44) % G;
    if (IN(1)) {
        pg8::Gemm g{w.xb, w.Wt_in, MT, INC, DM}; pg8::StaticOrder S; S.init(MT, INC, G, bx); S.pmul = 13; EpiIn E{w, p.out};
        pg8::gemm_phase<EpiIn, pg8::StaticOrder, true, true>(lds, g, S, E);
        if (n1 == 0) { weight_transposes<1>(p, w, lds, vcu, G); kv_copy_range(p, 0, kv_s1, vcu, G); } else if (bx >= n1) { weight_transposes<1>(p, w, lds, bx - n1, G - n1); kv_copy_range(p, 0, kv_s1, bx - n1, G - n1); } } SEAM(1);
    if (vcu & 1) { if (IN(5)) { attn_sample(p, w, lds, vcu, G); __syncthreads(); } if (IN(4)) { ret_sample(p, w, lds, vcu, G); __syncthreads(); } }
    { const int per = (1536 + G - 1) / G;
      if (IN(2)) attn_phase(w, lds, vcu * per, min(per, 1536 - vcu * per)); }
    if (IN(3)) { u32x4 kr[4], vr[4]; if (vcu < 1024) retA_load(w, vcu, opaque_tid(), kr, vr);
        for (int it = vcu; it < 1024; it += G) retA_item(w, lds, it, it + G < 1024 ? it + G : -1, kr, vr); }
    if (!(vcu & 1)) { if (IN(4)) { ret_sample(p, w, lds, vcu, G); __syncthreads(); } if (IN(5)) { attn_sample(p, w, lds, vcu, G); } } SEAM(5);
    if (IN(6)) { ret_scan2(p, w, vcu, G); attn_merge(w, vcu, G); } SEAM(6);
    if (IN(7)) { retC_phase(p, w, lds, vcu, G); } SEAM(7);
    if (IN(8)) {
        { pg8::Gemm g{w.G, w.Wt_reto, MP, DM, 1024}; pg8::SegOrder S; S.base.init(MP, DM, G, bx); S.A1 = w.Oatt; S.B1t = w.Wt_atto; S.nt0 = 16; S.nt1 = 8; EpiP5 E{w};
          pg8::gemm_phase<EpiP5, pg8::SegOrder, true, true>(lds, g, S, E); }
        sample_gemm<5>(p, w, lds, vcu, G); } SEAM(8);
    if (IN(9)) { pg8::Gemm g{w.merged, w.Wt_o, MP, DM, DM}; pg8::StaticOrder S; S.init(MP, DM, G, bx); EpiWo E{w};
        pg8::gemm_phase<EpiWo, pg8::StaticOrder, true, true>(lds, g, S, E);
        sample_gemm<6>(p, w, lds, vcu, G); } SEAM(9);
    if (IN(10)) {
        pg8::Gemm g{w.xb, w.Wt_up, MT, F2, DM}; pg8::UpOrder S; S.init_up(G, bx); EpiUp E{w, p.out, p.in[15], p.in[16], p.in[6]};
        pg8::gemm_phase<EpiUp, pg8::UpOrder, true, true>(lds, g, S, E);
        if (n7 == 0) { weight_transposes<2>(p, w, lds, vcu, G); kv_copy_range(p, kv_s1, KV_SPLIT, vcu, G); } else if (bx >= n7) { weight_transposes<2>(p, w, lds, bx - n7, G - n7); kv_copy_range(p, kv_s1, KV_SPLIT, bx - n7, G - n7); } } SEAM(10);
    if (IN(11)) { pg8::Gemm g{w.act, w.Wt_down, MP, DM, FF}; pg8::PanelOrder S{vcu}; EpiFin E{w, p.out, p.in[18], (unsigned*)(p.ws + WS_PCNT)};
        pg8::gemm_phase<EpiFin, pg8::PanelOrder, true, true>(lds, g, S, E);
        sample_gemm<8>(p, w, lds, vcu, G); }
#undef IN
#undef SEAM
}

extern "C" void kernel_launch(void* const* d_in, const int* in_sizes, int n_in, void* d_out, int out_size, void* d_ws, size_t ws_size, hipStream_t stream) {
    static int grid = 0;
    if (grid == 0) {
        if (n_in != 19 || (size_t)out_size != O_END || ws_size < WS_END) { fprintf(stderr, "kernel_launch: unexpected shapes: n_in %d out %d ws %zu\n", n_in, out_size, ws_size); grid = -1; return; }
        int dev = 0, cus = 0;
        if (hipGetDevice(&dev) != hipSuccess || hipDeviceGetAttribute(&cus, hipDeviceAttributeMultiprocessorCount, dev) != hipSuccess) { fprintf(stderr, "kernel_launch: device query failed\n"); grid = -1; return; }
        if (hipFuncSetAttribute((const void*)fwd_kernel, hipFuncAttributeMaxDynamicSharedMemorySize, LDS_BYTES) != hipSuccess) { fprintf(stderr, "kernel_launch: cannot get %d bytes of LDS\n", LDS_BYTES); grid = -1; return; }
        int per_cu = 0;
        if (hipOccupancyMaxActiveBlocksPerMultiprocessor(&per_cu, (const void*)fwd_kernel, 512, LDS_BYTES) != hipSuccess || per_cu < 1) fprintf(stderr, "kernel_launch: occupancy query says %d blocks/CU\n", per_cu);
        (void)hipGetLastError();
        grid = cus;
        if (grid != 256) { fprintf(stderr, "kernel_launch: this kernel is laid out for 256 CUs, device has %d\n", cus); grid = -1; return; }
    }
    if (grid < 0) return;
    if (hipMemsetAsync((char*)d_ws + WS_BAR, 0, 32768, stream) != hipSuccess) { fprintf(stderr, "kernel_launch: memset failed\n"); return; }
    Params p{};
    for (int i = 0; i < 19; ++i) p.in[i] = (const float*)d_in[i];
    p.out = (float*)d_out; p.ws = (unsigned char*)d_ws;
    p.ph_lo = 0; p.ph_hi = NPHASE;
    void* args[] = {&p};
    hipError_t e = hipLaunchCooperativeKernel((const void*)fwd_kernel, dim3(grid), dim3(512), args, LDS_BYTES, stream);
    if (e != hipSuccess) fprintf(stderr, "cooperative launch failed: %s (grid %d)\n", hipGetErrorString(e), grid);
}
```

```cpp
#include <hip/hip_runtime.h>
#include <hip/hip_cooperative_groups.h>
#include <cstdio>
#include <cstdint>
namespace cg = cooperative_groups;

#define LAS __attribute__((address_space(3)))
typedef unsigned short bf16_t;
typedef short bf16x8 __attribute__((ext_vector_type(8)));
typedef float f32x4 __attribute__((ext_vector_type(4)));
typedef float f32x2 __attribute__((ext_vector_type(2)));
typedef unsigned u32x4 __attribute__((ext_vector_type(4)));
typedef unsigned u32x2 __attribute__((ext_vector_type(2)));

constexpr int DM = 2048, SEQ = 8192, MP = 16384, MS = 256, MT = MP + MS;
constexpr int INC = 12800, FF = 5632, F2 = 11264;
constexpr int C_RQ = 0, C_RK = 1024, C_RV = 2048, C_RG = 3072, C_ATT = 4096, C_GR = 8704, C_GA = 10752;
constexpr float EPS = 1e-6f;
constexpr float QK_SCALE = 0.08838834764831845f;
constexpr size_t O_Y = 0;
constexpr size_t O_RETP = 34078720, O_RETS = 34340864;
constexpr size_t O_KV128P = 38535168, O_KV128S = 38797312, O_KV512P = 42991616, O_KV512S = 44040192, O_KV2048P = 60817408, O_KV2048S = 65011712;
constexpr size_t O_CONVP = 132120576, O_CONVS = 132165632, O_END = 132886528;
constexpr size_t MiB = 1u << 20;
constexpr size_t WS_CTL = 0;
constexpr size_t WS_WIN = 1 * MiB, WS_WRETO = 51 * MiB, WS_WATTO = 55 * MiB, WS_WO = 57 * MiB, WS_WUP = 65 * MiB, WS_WDOWN = 109 * MiB;
constexpr size_t WS_XB = 131 * MiB;
constexpr size_t WS_PROJ = 196 * MiB;
constexpr size_t WS_KVC = 603 * MiB;
constexpr size_t WS_SB = 667 * MiB;
constexpr size_t WS_G = 699 * MiB;
constexpr size_t WS_OG = 732 * MiB;
constexpr size_t WS_LSE = 781 * MiB;
constexpr size_t WS_OATT = 930 * MiB;
constexpr size_t WS_MERGED = 799 * MiB;
constexpr size_t WS_ACT = 603 * MiB;
constexpr size_t WS_G8 = 864 * MiB;
constexpr size_t WS_WATTO_P = 964 * MiB;
constexpr size_t WS_END = 968 * MiB;
constexpr size_t WS_BAR = 512 * 1024;
constexpr size_t WS_PCNT = WS_BAR + 16384;

struct Params {
    const float* in[19];
    float* out;
    unsigned char* ws;
    int ph_lo, ph_hi, dummy, pad;
};

constexpr size_t PSLAB = (size_t)MT * 128;
__device__ __forceinline__ size_t pofs(size_t row, int col) { return ((size_t)(col >> 7) * MT + row) * 128 + (col & 127); }
__device__ __forceinline__ float bflo(unsigned w) { return __uint_as_float(w << 16); }
__device__ __forceinline__ float bfhi(unsigned w) { return __uint_as_float(w & 0xffff0000u); }
__device__ __forceinline__ float bf2f(bf16_t b) { return __uint_as_float((unsigned)b << 16); }
__device__ __forceinline__ unsigned f2bf(float f) { unsigned u = __float_as_uint(f); return (u + 0x7fffu + ((u >> 16) & 1u)) >> 16; }
typedef __bf16 bf16x2_t __attribute__((ext_vector_type(2)));
__device__ __forceinline__ unsigned pk2(float lo, float hi) { f32x2 v = {lo, hi}; bf16x2_t b = __builtin_convertvector(v, bf16x2_t); return __builtin_bit_cast(unsigned, b); }
__device__ __forceinline__ unsigned enc8(float s) { const unsigned c = (unsigned)(s * 256.0f); return c > 255u ? 255u : c; }
__device__ __forceinline__ unsigned enc8x4(f32x4 s) {
    return enc8(s[0]) | (enc8(s[1]) << 8) | (enc8(s[2]) << 16) | (enc8(s[3]) << 24);
}
__device__ __forceinline__ f32x4 dec8x4(unsigned c) { return ((f32x4){(float)(c & 255u), (float)((c >> 8) & 255u), (float)((c >> 16) & 255u), (float)(c >> 24)} + 0.5f) * (1.0f / 256.0f); }
__device__ __forceinline__ float wave_sum(float v) {
#pragma unroll
    for (int o = 1; o < 64; o <<= 1) v += __shfl_xor(v, o);
    return v;
}
__device__ __forceinline__ float wave_max(float v) {
#pragma unroll
    for (int o = 1; o < 64; o <<= 1) v = fmaxf(v, __shfl_xor(v, o));
    return v;
}
__device__ __forceinline__ unsigned sigcode(float v) { return (unsigned)__builtin_amdgcn_rcpf(__builtin_amdgcn_exp2f(fmaf(v, -1.4426950408889634f, -7.99994364f)) + (1.0f / 255.99f)); }
__device__ __forceinline__ unsigned sigcode4(f32x4 s) { return sigcode(s[0]) | (sigcode(s[1]) << 8) | (sigcode(s[2]) << 16) | (sigcode(s[3]) << 24); }
__device__ __forceinline__ float sigmoidf_(float v) { return __builtin_amdgcn_rcpf(1.0f + __builtin_amdgcn_exp2f(v * -1.4426950408889634f)); }
#define LDS_WAIT() asm volatile("s_waitcnt lgkmcnt(0)" ::: "memory")
__device__ __forceinline__ int opaque_tid() { int t = threadIdx.x; asm volatile("" : "+v"(t)); return t; }

namespace pg8 {
#define PG8_LAS __attribute__((address_space(3)))
constexpr int BM = 256, BK = 64, HALF = 128, HTB = HALF * BK * 2, STAGE_BYTES = 8 * HTB, NXCD = 8, WGM = 4;
__host__ __device__ __forceinline__ int lds_byte(int r, int c) { const int st = (r >> 4) * 2 + (c >> 5), rr = r & 15, cc = c & 31, ob = rr * 64 + cc * 2; return st * 1024 + (ob ^ (((ob >> 9) & 1) << 5)); }
__host__ __device__ __forceinline__ void stage_rc(int b, int& R, int& C) { const int st = b / 1024, sb = b % 1024, swz = sb ^ (((sb >> 9) & 1) << 5); R = (st >> 1) * 16 + swz / 64; C = (st & 1) * 32 + (swz % 64) / 2; }
__host__ __device__ __forceinline__ int perm32(int rho) { const int n = rho >> 4, i = rho & 15; return 8 * (i >> 2) + 4 * n + (i & 3); }
struct Unit { int pm, pn, seg; };
struct Gemm { const bf16_t* A; const bf16_t* Bt; int M, N, K; };
struct StaticOrder {
    int nM, nN, nwg, G, c;
    __host__ __device__ void init(int M, int N, int G_, int c_) { nM = M / BM; nN = N / BM; nwg = nM * nN; G = G_; c = c_; }
    __host__ __device__ bool next(int i, Unit& u) const {
        const long L = (long)i * G + c; if (L >= nwg) return false;
        int wgid = (int)L; { const int q = nwg / NXCD, r = nwg % NXCD, xcd = wgid % NXCD, off = wgid / NXCD; wgid = (xcd < r ? xcd * (q + 1) : r * (q + 1) + (xcd - r) * q) + off; }
        const int nig = WGM * nN, gid = wgid / nig, fm = gid * WGM, gsz = (nM - fm) < WGM ? (nM - fm) : WGM;
        u.pm = fm + ((wgid % nig) % gsz); u.pn = (wgid % nig) / gsz; u.seg = 0; return true;
    }
    __device__ __forceinline__ void a_ready(const Unit&) const {}
    __device__ __forceinline__ void done(const Unit&) const {}
    __device__ __forceinline__ long a_off(const Unit& u, int K) const { return (long)u.pm * 256 * K * 2; }
    __device__ __forceinline__ const char* a_ptr(const Gemm& g, const Unit& u) const { return (const char*)g.A + a_off(u, g.K); }
    __device__ __forceinline__ const char* b_ptr(const Gemm& g, const Unit& u) const { return (const char*)g.Bt + (size_t)u.pn * 256 * g.K * 2; }
    __device__ __forceinline__ int nt(const Gemm& g, const Unit&) const { return g.K / BK; }
    __device__ __forceinline__ bool keep(const Unit&) const { return false; }
};
struct SegOrder {
    StaticOrder base; const bf16_t* A1; const bf16_t* B1t; int nt0, nt1;
    __device__ __forceinline__ bool next(int i, Unit& u) const { if (!base.next(i >> 1, u)) return false; u.seg = i & 1; return true; }
    __device__ __forceinline__ void a_ready(const Unit&) const {}
    __device__ __forceinline__ void done(const Unit&) const {}
    __device__ __forceinline__ const char* a_ptr(const Gemm& g, const Unit& u) const { return (const char*)(u.seg ? A1 : g.A) + (size_t)u.pm * 256 * g.K * 2; }
    __device__ __forceinline__ const char* b_ptr(const Gemm& g, const Unit& u) const { return (const char*)(u.seg ? B1t : g.Bt) + (size_t)u.pn * 256 * g.K * 2; }
    __device__ __forceinline__ int nt(const Gemm&, const Unit& u) const { return u.seg ? nt1 : nt0; }
    __device__ __forceinline__ bool keep(const Unit& u) const { return u.seg == 0; }
};
struct PanelOrder {
    int v;
    __device__ __forceinline__ bool next(int i, Unit& u) const { if (i >= 2) return false; u.pm = i * 32 + (v >> 3); u.pn = v & 7; u.seg = 0; return true; }
    __device__ __forceinline__ void a_ready(const Unit&) const {}
    __device__ __forceinline__ void done(const Unit&) const {}
    __device__ __forceinline__ const char* a_ptr(const Gemm& g, const Unit& u) const { return (const char*)g.A + (size_t)u.pm * 256 * g.K * 2; }
    __device__ __forceinline__ const char* b_ptr(const Gemm& g, const Unit& u) const { return (const char*)g.Bt + (size_t)u.pn * 256 * g.K * 2; }
    __device__ __forceinline__ int nt(const Gemm& g, const Unit&) const { return g.K / BK; }
    __device__ __forceinline__ bool keep(const Unit&) const { return false; }
};
struct UpOrder : StaticOrder {
    __host__ __device__ void init_up(int G_, int c_) { nM = 67; nN = 44; nwg = nM * nN; G = G_; c = c_; }
    __device__ __forceinline__ long a_off(const Unit& u, int K) const { const int row0 = (u.pm < 66) ? (u.pm / 33) * 8192 + 254 * (u.pm % 33) - 2 : 16384; return (long)row0 * K * 2; }
    __device__ __forceinline__ const char* a_ptr(const Gemm& g, const Unit& u) const { return (const char*)g.A + a_off(u, g.K); }
};

template <class Epi, class Sched, bool ALIGN_EPI = false, bool SP2 = false>
__device__ __forceinline__ void gemm_phase(PG8_LAS unsigned char* lds, const Gemm g, const Sched& S, const Epi& E) {
    const int tid = opaque_tid(), wid = __builtin_amdgcn_readfirstlane(tid >> 6), lane = tid & 63, wr = wid >> 2, wc = wid & 3, fr = lane & 15, fq = lane >> 4;
    const int K = g.K;
    unsigned voffA[2], voffB[2];
#pragma unroll
    for (int i = 0; i < 2; ++i) { int R, C; stage_rc(tid * 16 + i * 8192, R, C); const int Rb = Epi::PERM ? ((R & ~31) + perm32(R & 31)) : R;
        const int Ra = Epi::APERM ? ((R & ~63) + 4 * (R & 15) + ((R >> 4) & 3)) : R;
        voffA[i] = (unsigned)(Ra * K + C) * 2u; voffB[i] = (unsigned)(Rb * K + C) * 2u; }
    const size_t kstep = (size_t)(BK * 2);
    const size_t hstep = (size_t)HALF * K * 2;
    const unsigned ldsw = (unsigned)wid * 1024u;
    const int aoff = lds_byte(wr * 64 + fr, fq * 8), boff = lds_byte(wc * 32 + fr, fq * 8);
#define PG8_SA(b, h) (((b) * 2 + (h)) * HTB)
#define PG8_SB(b, h) ((4 + (b) * 2 + (h)) * HTB)
#define PG8_STAGE(bufoff, gbase, voff) do { _Pragma("unroll") for (int _i = 0; _i < 2; ++_i) \
        __builtin_amdgcn_global_load_lds((const unsigned*)((const char*)(gbase) + (voff)[_i]), (PG8_LAS unsigned*)(lds + (bufoff) + ldsw + _i * 8192), 16, 0, 0); } while (0)
#define PG8_LDA(dst, b, h) do { _Pragma("unroll") for (int m = 0; m < 4; ++m) _Pragma("unroll") for (int k = 0; k < 2; ++k) dst[m][k] = *(const PG8_LAS bf16x8*)(lds + PG8_SA(b, h) + aoff + m * 2048 + k * 1024); } while (0)
#define PG8_LDB(dst, b, h) do { _Pragma("unroll") for (int n = 0; n < 2; ++n) _Pragma("unroll") for (int k = 0; k < 2; ++k) dst[n][k] = *(const PG8_LAS bf16x8*)(lds + PG8_SB(b, h) + boff + n * 2048 + k * 1024); } while (0)
#define PG8_MMA(ai, bj, At, Bt) do { __builtin_amdgcn_s_setprio(1); _Pragma("unroll") for (int m = 0; m < 4; ++m) _Pragma("unroll") for (int n = 0; n < 2; ++n) _Pragma("unroll") for (int k = 0; k < 2; ++k) \
        acc[ai][bj][m][n] = __builtin_amdgcn_mfma_f32_16x16x32_bf16(Bt[n][k], At[m][k], acc[ai][bj][m][n], 0, 0, 0); __builtin_amdgcn_s_setprio(0); } while (0)
#define PG8_WAIT_V(n) asm volatile("s_waitcnt vmcnt(" #n ")" ::: "memory")
#define PG8_WAIT_L(n) asm volatile("s_waitcnt lgkmcnt(" #n ")" ::: "memory")
#define PG8_BAR __builtin_amdgcn_s_barrier()
#define PG8_SCHED __builtin_amdgcn_sched_barrier(0)
    Unit cur, nxt; int ui = 0;
    if (!S.next(0, cur)) return;
    f32x4 acc[2][2][4][2];
#pragma unroll
    for (int a = 0; a < 2; ++a)
#pragma unroll
        for (int b = 0; b < 2; ++b)
#pragma unroll
            for (int m = 0; m < 4; ++m)
#pragma unroll
                for (int n = 0; n < 2; ++n) acc[a][b][m][n] = (f32x4){0.f, 0.f, 0.f, 0.f};
    bf16x8 At[4][2], B0[2][2], B1[2][2];
    const char* cA = S.a_ptr(g, cur); const char* cB = S.b_ptr(g, cur);
    S.a_ready(cur);
    if constexpr (SP2) {
        PG8_STAGE(PG8_SB(0, 0), cB, voffB); PG8_STAGE(PG8_SB(0, 1), cB + hstep, voffB); PG8_STAGE(PG8_SA(0, 0), cA, voffA); PG8_STAGE(PG8_SA(0, 1), cA + hstep, voffA);
        if (wr == 1) PG8_BAR;
        PG8_WAIT_V(2); PG8_BAR;
        PG8_STAGE(PG8_SB(1, 0), cB + kstep, voffB); PG8_STAGE(PG8_SA(1, 0), cA + kstep, voffA); PG8_STAGE(PG8_SB(1, 1), cB + hstep + kstep, voffB);
        PG8_WAIT_V(6); PG8_BAR;
    } else {
        PG8_STAGE(PG8_SB(0, 0), cB, voffB); PG8_STAGE(PG8_SA(0, 0), cA, voffA); PG8_STAGE(PG8_SB(0, 1), cB + hstep, voffB); PG8_STAGE(PG8_SA(0, 1), cA + hstep, voffA);
        if (wr == 1) PG8_BAR;
        PG8_WAIT_V(4); PG8_BAR;
        PG8_STAGE(PG8_SB(1, 0), cB + kstep, voffB); PG8_STAGE(PG8_SA(1, 0), cA + kstep, voffA); PG8_STAGE(PG8_SB(1, 1), cB + hstep + kstep, voffB);
        PG8_WAIT_V(6); PG8_BAR;
    }
    for (;;) {
        const bool has_next = S.next(ui + 1, nxt);
        const char* nA = has_next ? S.a_ptr(g, nxt) : cA; const char* nB = has_next ? S.b_ptr(g, nxt) : cB;
        const int nt = S.nt(g, cur);
        for (int t = 0; t < nt; t += 2) {
            const bool last = (t == nt - 2);
            const char* a1 = cA + (size_t)(t + 1) * kstep;
            const char* a2 = last ? nA : cA + (size_t)(t + 2) * kstep; const char* b2 = last ? nB : cB + (size_t)(t + 2) * kstep;
            const char* a3 = a2 + kstep; const char* b3 = b2 + kstep;
            if (last && has_next) S.a_ready(nxt);
            if constexpr (Epi::DMA_PRE) { if (last) E.dma_prefetch(cur, lds, wid, lane); }
            if constexpr (SP2) {
            PG8_LDB(B0, 0, 0); PG8_LDB(B1, 0, 1); PG8_SCHED; PG8_LDA(At, 0, 0); PG8_STAGE(PG8_SA(1, 1), a1 + hstep, voffA);
            PG8_WAIT_V(8); PG8_WAIT_L(0); PG8_BAR; PG8_MMA(0, 0, At, B0); PG8_MMA(0, 1, At, B1); PG8_BAR; PG8_SCHED;
            PG8_LDA(At, 0, 1); PG8_STAGE(PG8_SB(0, 0), b2, voffB); PG8_STAGE(PG8_SB(0, 1), b2 + hstep, voffB); PG8_STAGE(PG8_SA(0, 0), a2, voffA);
            PG8_WAIT_V(8); PG8_WAIT_L(0); PG8_BAR; PG8_MMA(1, 0, At, B0); PG8_MMA(1, 1, At, B1); PG8_BAR; PG8_SCHED;
            PG8_LDB(B0, 1, 0); PG8_LDB(B1, 1, 1); PG8_SCHED; PG8_LDA(At, 1, 0); PG8_STAGE(PG8_SA(0, 1), a2 + hstep, voffA);
            PG8_WAIT_V(8); PG8_WAIT_L(0); PG8_BAR; PG8_MMA(0, 0, At, B0); PG8_MMA(0, 1, At, B1); PG8_BAR; PG8_SCHED;
            PG8_LDA(At, 1, 1); PG8_STAGE(PG8_SB(1, 0), b3, voffB); PG8_STAGE(PG8_SB(1, 1), b3 + hstep, voffB); PG8_STAGE(PG8_SA(1, 0), a3, voffA);
            PG8_WAIT_V(8); PG8_WAIT_L(0); PG8_BAR; PG8_MMA(1, 0, At, B0); PG8_MMA(1, 1, At, B1); PG8_BAR; PG8_SCHED;
            } else {
            PG8_LDB(B0, 0, 0); PG8_SCHED; PG8_LDA(At, 0, 0); PG8_STAGE(PG8_SA(1, 1), a1 + hstep, voffA);
            PG8_WAIT_L(8); PG8_BAR; PG8_WAIT_L(0); PG8_MMA(0, 0, At, B0); PG8_BAR; PG8_SCHED;
            PG8_LDB(B1, 0, 1); PG8_STAGE(PG8_SB(0, 0), b2, voffB);
            PG8_BAR; PG8_WAIT_L(0); PG8_MMA(0, 1, At, B1); PG8_BAR;
            PG8_LDA(At, 0, 1); PG8_STAGE(PG8_SA(0, 0), a2, voffA);
            PG8_BAR; PG8_WAIT_L(0); PG8_MMA(1, 0, At, B0); PG8_BAR; PG8_SCHED;
            PG8_STAGE(PG8_SB(0, 1), b2 + hstep, voffB);
            PG8_WAIT_V(6); PG8_BAR; PG8_MMA(1, 1, At, B1); PG8_BAR;
            PG8_LDB(B0, 1, 0); PG8_SCHED; PG8_LDA(At, 1, 0); PG8_STAGE(PG8_SA(0, 1), a2 + hstep, voffA);
            PG8_WAIT_L(8); PG8_BAR; PG8_WAIT_L(0); PG8_MMA(0, 0, At, B0); PG8_BAR; PG8_SCHED;
            PG8_LDB(B1, 1, 1); PG8_STAGE(PG8_SB(1, 0), b3, voffB);
            PG8_BAR; PG8_WAIT_L(0); PG8_MMA(0, 1, At, B1); PG8_BAR;
            PG8_LDA(At, 1, 1); PG8_STAGE(PG8_SA(1, 0), a3, voffA);
            PG8_BAR; PG8_WAIT_L(0); PG8_MMA(1, 0, At, B0); PG8_BAR; PG8_SCHED;
            PG8_STAGE(PG8_SB(1, 1), b3 + hstep, voffB);
            PG8_WAIT_V(6); PG8_BAR; PG8_MMA(1, 1, At, B1); PG8_BAR;
            }
        }
        if constexpr (ALIGN_EPI) { if (wr == 0) PG8_BAR; }
        E(acc, cur, wr, wc, fr, fq, lds); S.done(cur);
        if (!has_next) break;
        if (!S.keep(cur)) {
#pragma unroll
        for (int a = 0; a < 2; ++a)
#pragma unroll
            for (int b = 0; b < 2; ++b)
#pragma unroll
                for (int m = 0; m < 4; ++m)
#pragma unroll
                    for (int n = 0; n < 2; ++n) acc[a][b][m][n] = (f32x4){0.f, 0.f, 0.f, 0.f};
        }
        cur = nxt; cA = nA; cB = nB; ++ui;
        if constexpr (ALIGN_EPI) { if (wr == 1) PG8_BAR; }
    }
    PG8_WAIT_V(0);
    if constexpr (!ALIGN_EPI) { if (wr == 0) PG8_BAR; }
    PG8_BAR;
#undef PG8_SA
#undef PG8_SB
#undef PG8_STAGE
#undef PG8_LDA
#undef PG8_LDB
#undef PG8_MMA
#undef PG8_WAIT_V
#undef PG8_WAIT_L
#undef PG8_BAR
#undef PG8_SCHED
}
}

struct Ws {
    float *rstd1, *sumsq2, *sumsq3;
    bf16_t *Wt_in, *Wt_reto, *Wt_atto, *Wt_o, *Wt_up, *Wt_down;
    bf16_t *xb, *proj, *G, *Oatt, *merged, *act, *ub;
    float* kvc; bf16_t* sb; bf16_t* og; float* lse; unsigned char* g8; bf16_t* tmp;
};
__device__ __forceinline__ Ws make_ws(unsigned char* ws) {
    Ws w;
    w.rstd1 = (float*)(ws + WS_CTL); w.sumsq2 = w.rstd1 + MT; w.sumsq3 = w.sumsq2 + MT;
    w.Wt_in = (bf16_t*)(ws + WS_WIN); w.Wt_reto = (bf16_t*)(ws + WS_WRETO); w.Wt_atto = (bf16_t*)(ws + WS_WATTO_P); w.Wt_o = (bf16_t*)(ws + WS_WO);
    w.Wt_up = (bf16_t*)(ws + WS_WUP); w.Wt_down = (bf16_t*)(ws + WS_WDOWN);
    w.xb = (bf16_t*)(ws + WS_XB); w.proj = (bf16_t*)(ws + WS_PROJ); w.ub = (bf16_t*)(ws + WS_PROJ); w.G = (bf16_t*)(ws + WS_G); w.Oatt = (bf16_t*)(ws + WS_OATT);
    w.merged = (bf16_t*)(ws + WS_MERGED); w.act = (bf16_t*)(ws + WS_ACT); w.kvc = (float*)(ws + WS_KVC);
    w.g8 = ws + WS_G8; w.tmp = (bf16_t*)(ws + WS_KVC);
    w.sb = (bf16_t*)(ws + WS_SB); w.og = (bf16_t*)(ws + WS_OG); w.lse = (float*)(ws + WS_LSE);
    return w;
}

struct EpiIn {
    static constexpr bool PERM = true, DMA_PRE = false, APERM = false;
    Ws w; float* out;
    template <int CLS> __device__ __forceinline__ void body(f32x4 (&acc)[2][2][4][2], int row0, int col0, int grp, int kv) const {
#pragma unroll
        for (int ai = 0; ai < 2; ++ai)
#pragma unroll
            for (int m = 0; m < 4; ++m) {
                const int row = row0 + ai * 128 + m * 16;
#pragma unroll
                for (int bj = 0; bj < 2; ++bj) {
                    const int col = col0 + bj * 128;
                    f32x4 v0 = acc[ai][bj][m][0], v1 = acc[ai][bj][m][1];
                    if (CLS == 1) {
#pragma unroll
                        for (int i = 0; i < 4; ++i) { v0[i] = v0[i] * sigmoidf_(v0[i]); v1[i] = v1[i] * sigmoidf_(v1[i]); }
                    }
                    if (CLS == 2) { u32x2 o8; o8.x = sigcode4(v0); o8.y = sigcode4(v1); __builtin_nontemporal_store(o8, (u32x2*)(w.g8 + (unsigned)(row * 4096) + (col - C_GR))); }
                    else { u32x4 o; o.x = pk2(v0[0], v0[1]); o.y = pk2(v0[2], v0[3]); o.z = pk2(v1[0], v1[1]); o.w = pk2(v1[2], v1[3]);
                        *(u32x4*)(w.proj + (unsigned)(((col >> 7) * MT + row) * 128 + (col & 127))) = o; }
                    if (CLS == 3) {
                        const int win = 128 << (2 * grp);
                        const size_t obase_p = grp == 0 ? O_KV128P : (grp == 1 ? O_KV512P : O_KV2048P);
                        const size_t obase_s = grp == 0 ? O_KV128S : (grp == 1 ? O_KV512S : O_KV2048S);
                        const int c512 = (col & 511);
                        float* dst = nullptr;
                        if (row < MP) { const int b = row >> 13, t = row & 8191; if (t >= SEQ - win) dst = out + obase_p + ((size_t)(b * win + (t - (SEQ - win))) * 2 + kv) * 512 + c512; }
                        else { const int b = (row - MP) >> 3, t = (row - MP) & 7; dst = out + obase_s + ((size_t)(b * win + (win - 8 + t)) * 2 + kv) * 512 + c512; }
                        if (dst) { __builtin_nontemporal_store(v0, (f32x4*)dst); __builtin_nontemporal_store(v1, (f32x4*)(dst + 4)); }
                    }
                }
            }
    }
    __device__ __forceinline__ void operator()(f32x4 (&acc)[2][2][4][2], const pg8::Unit& u, int wr, int wc, int fr_, int fq_, LAS unsigned char*) const {
        int fr = fr_, fq = fq_; asm volatile("" : "+v"(fr), "+v"(fq));
        const int row0 = u.pm * 256 + wr * 64 + fr, col0 = u.pn * 256 + wc * 32 + 8 * fq;
        const int pn = u.pn;
        if (pn >= 34) body<2>(acc, row0, col0, 0, 0);
        else if (pn >= 12 && pn < 16) body<1>(acc, row0, col0, 0, 0);
        else if (pn >= 16) { const int q = (pn - 16) % 6, grp = (pn - 16) / 6;
            const int win = 128 << (2 * grp); const int t_hi = ((u.pm & 31) + 1) * 256;
            if (q >= 2 && (u.pm >= 64 || t_hi > SEQ - win)) body<3>(acc, row0, col0, grp, q >= 4 ? 1 : 0); else body<0>(acc, row0, col0, 0, 0); }
        else body<0>(acc, row0, col0, 0, 0);
    }
};
struct EpiWo {
    static constexpr bool PERM = true, DMA_PRE = false, APERM = false;
    Ws w;
    __device__ __forceinline__ void operator()(f32x4 (&acc)[2][2][4][2], const pg8::Unit& u, int wr, int wc, int fr_, int fq_, LAS unsigned char*) const {
        int fr = fr_, fq = fq_; asm volatile("" : "+v"(fr), "+v"(fq));
        const int row0 = u.pm * 256 + wr * 64 + fr;
        const int col0 = u.pn * 256 + wc * 32 + 8 * fq;
        float ssv[8];
#pragma unroll
        for (int ai = 0; ai < 2; ++ai)
#pragma unroll
            for (int m = 0; m < 4; ++m) {
                const int row = row0 + ai * 128 + m * 16;
                const float rs = w.rstd1[row];
                float ssq = 0.f;
#pragma unroll
                for (int bj = 0; bj < 2; ++bj) {
                    const int col = col0 + bj * 128;
                    f32x4 v0 = acc[ai][bj][m][0], v1 = acc[ai][bj][m][1];
                    { const u32x4 xv = *(const u32x4*)(w.xb + (unsigned)(row * DM) + col);
                      v0[0] += bflo(xv.x) * rs; v0[1] += bfhi(xv.x) * rs; v0[2] += bflo(xv.y) * rs; v0[3] += bfhi(xv.y) * rs;
                      v1[0] += bflo(xv.z) * rs; v1[1] += bfhi(xv.z) * rs; v1[2] += bflo(xv.w) * rs; v1[3] += bfhi(xv.w) * rs; }
                    u32x4 o; o.x = pk2(v0[0], v0[1]); o.y = pk2(v0[2], v0[3]); o.z = pk2(v1[0], v1[1]); o.w = pk2(v1[2], v1[3]);
                    *(u32x4*)(w.xb + (unsigned)(row * DM) + col) = o;
#pragma unroll
                    for (int i = 0; i < 4; ++i) ssq += v0[i] * v0[i] + v1[i] * v1[i];
                }
                ssq += __shfl_xor(ssq, 16); ssq += __shfl_xor(ssq, 32);
                ssv[ai * 4 + m] = ssq;
            }
        if (fq == 0) {
#pragma unroll
            for (int k = 0; k < 8; ++k) atomicAdd(w.sumsq2 + row0 + (k >> 2) * 128 + (k & 3) * 16, ssv[k]);
        }
    }
};

struct EpiP5 {
    static constexpr bool PERM = true, DMA_PRE = false, APERM = false;
    Ws w;
    __device__ __forceinline__ void operator()(f32x4 (&acc)[2][2][4][2], const pg8::Unit& u, int wr, int wc, int fr_, int fq_, LAS unsigned char*) const {
        int fr = fr_, fq = fq_; asm volatile("" : "+v"(fr), "+v"(fq));
        const int row0 = u.pm * 256 + wr * 64 + fr, col0 = u.pn * 256 + wc * 32 + 8 * fq;
        if (u.seg == 0) {
#pragma unroll
            for (int ai = 0; ai < 2; ++ai)
#pragma unroll
                for (int m = 0; m < 4; ++m) {
                    const int row = row0 + ai * 128 + m * 16;
#pragma unroll
                    for (int bj = 0; bj < 2; ++bj) { const unsigned char* gp = w.g8 + (unsigned)(row * 4096) + col0 + bj * 128;
                        const u32x2 gr = __builtin_nontemporal_load((const u32x2*)gp), ga = *(const u32x2*)(gp + 2048);
                        const f32x4 a0 = dec8x4(ga.x), a1 = dec8x4(ga.y);
                        f32x4 q0 = dec8x4(gr.x), q1 = dec8x4(gr.y);
#pragma unroll
                        for (int i = 0; i < 4; ++i) { q0[i] *= __builtin_amdgcn_rcpf(a0[i]); q1[i] *= __builtin_amdgcn_rcpf(a1[i]); }
                        acc[ai][bj][m][0] *= q0; acc[ai][bj][m][1] *= q1; }
                }
        } else {
#pragma unroll
            for (int ai = 0; ai < 2; ++ai)
#pragma unroll
                for (int m = 0; m < 4; ++m) {
                    const int row = row0 + ai * 128 + m * 16;
#pragma unroll
                    for (int bj = 0; bj < 2; ++bj) { const int col = col0 + bj * 128;
                        const u32x2 ga = __builtin_nontemporal_load((const u32x2*)(w.g8 + (unsigned)(row * 4096) + 2048 + col));
                        const f32x4 v0 = acc[ai][bj][m][0] * dec8x4(ga.x), v1 = acc[ai][bj][m][1] * dec8x4(ga.y);
                        u32x4 o; o.x = pk2(v0[0], v0[1]); o.y = pk2(v0[2], v0[3]); o.z = pk2(v1[0], v1[1]); o.w = pk2(v1[2], v1[3]);
                        *(u32x4*)(w.merged + (unsigned)(row * DM) + col) = o; }
                }
        }
    }
};

__device__ __forceinline__ float dpp_ror1(float v) { return __int_as_float(__builtin_amdgcn_mov_dpp(__float_as_int(v), 0x121, 0xf, 0xf, false)); }
__device__ __forceinline__ float dpp_keep(float v) { float d = dpp_ror1(v); asm volatile("" : "+v"(d)); return d; }
__device__ __forceinline__ float dpp_ror2(float v) { return __int_as_float(__builtin_amdgcn_mov_dpp(__float_as_int(v), 0x122, 0xf, 0xf, false)); }
typedef float f32x2 __attribute__((ext_vector_type(2)));
__device__ __forceinline__ f32x2 gelu_gate2(f32x2 v, f32x2 b) {
    f32x2 a; a.x = __builtin_amdgcn_fmed3f(fabsf(v.x), 0.f, 6.5f); a.y = __builtin_amdgcn_fmed3f(fabsf(v.y), 0.f, 6.5f);
    const f32x2 c9 = {3.819134520e-07f, 3.819134520e-07f}, c8 = {-7.616652965e-06f, -7.616652965e-06f}, c7 = {6.311968900e-05f, 6.311968900e-05f}, c6 = {-2.457886876e-04f, -2.457886876e-04f},
                c5 = {-5.764040543e-05f, -5.764040543e-05f}, c4 = {7.011611480e-03f, 7.011611480e-03f}, c3 = {-5.248568207e-02f, -5.248568207e-02f}, c2 = {-4.592045844e-01f, -4.592045844e-01f},
                c1 = {-1.151106715e+00f, -1.151106715e+00f}, c0 = {-9.999999404e-01f, -9.999999404e-01f};
    f32x2 p = c9 * a + c8; p = p * a + c7; p = p * a + c6; p = p * a + c5; p = p * a + c4; p = p * a + c3; p = p * a + c2; p = p * a + c1; p = p * a + c0;
    f32x2 e; e.x = __builtin_amdgcn_exp2f(p.x); e.y = __builtin_amdgcn_exp2f(p.y);
    f32x2 r; asm("v_max_f32 %0, 0, %1" : "=v"(r.x) : "v"(v.x)); asm("v_max_f32 %0, 0, %1" : "=v"(r.y) : "v"(v.y));
    return (r - a * e) * b;
}
#define CONV_SHR1(v, c, w) asm("v_fmac_f32_dpp %0, %1, %2 row_shr:1 row_mask:0xf bank_mask:0xf" : "+v"(v) : "v"(c), "v"(w))
constexpr int HALO_OFF = 131072;
constexpr int PRE_SS = HALO_OFF + 6144, PRE_CW = HALO_OFF + 7168;
struct EpiUp {
    static constexpr bool PERM = true, DMA_PRE = true, APERM = true;
    Ws w; float* out; const float* cw; const float* cb; const float* sconv;
    __device__ __forceinline__ void dma_prefetch(const pg8::Unit& u, LAS unsigned char* lds, int wid, int lane) const {
        if (wid == 0) {
            const bool samp = u.pm >= 66;
            const int rowbase = samp ? MP : (u.pm / 33) * SEQ + 254 * (u.pm % 33) - 2;
#pragma unroll
            for (int i = 0; i < 4; ++i) __builtin_amdgcn_global_load_lds((const unsigned*)(w.sumsq2 + rowbase + 64 * i + lane), (LAS unsigned*)(lds + PRE_SS + 256 * i), 4, 0, 0);
        } else if (wid == 1) {
            const int f0 = u.pn * 128 + 4 * (lane & 31), hb = (lane >> 5) * FF;
#pragma unroll
            for (int k = 0; k < 3; ++k) __builtin_amdgcn_global_load_lds((const unsigned*)(cw + (size_t)k * F2 + hb + f0), (LAS unsigned*)(lds + PRE_CW + 1024 * k), 16, 0, 0);
            __builtin_amdgcn_global_load_lds((const unsigned*)(cb + hb + f0), (LAS unsigned*)(lds + PRE_CW + 3072), 16, 0, 0);
        }
    }
    __device__ __forceinline__ void operator()(f32x4 (&acc)[2][2][4][2], const pg8::Unit& u, int wr, int wc, int fr_, int fq_, LAS unsigned char* lds) const {
        int fr = fr_, fq = fq_; asm volatile("" : "+v"(fr), "+v"(fq));
        const bool samp = u.pm >= 66;
        const int bb = samp ? 0 : u.pm / 33, jj = samp ? 0 : u.pm % 33;
        const int t0 = samp ? 0 : 254 * jj - 2;
        const int rowbase = samp ? MP : bb * SEQ + t0;
#pragma unroll
        for (int ai = 0; ai < 2; ++ai)
#pragma unroll
            for (int m = 0; m < 4; ++m) {
                const int rl = ai * 128 + wr * 64 + 4 * fr + m, t = t0 + rl;
                const bool ok = samp || (t >= 0 && t < SEQ);
                const float ss = *(const LAS float*)(lds + PRE_SS + 4 * rl);
                const float rs = ok ? __builtin_amdgcn_rsqf(ss * (1.0f / DM) + EPS) : 0.f;
#pragma unroll
                for (int bj = 0; bj < 2; ++bj) { acc[ai][bj][m][0] *= rs; acc[ai][bj][m][1] *= rs; }
            }
        asm volatile("" ::: "memory");
        LAS float* halo = (LAS float*)(lds + HALO_OFF);
        const int fcol = u.pn * 128 + wc * 32 + 8 * fq;
        if (!samp) {
            if (fr == 15) {
#pragma unroll
                for (int ai = 0; ai < 2; ++ai) { const int bd = 2 * ai + wr;
                    if (bd < 3) {
#pragma unroll
                        for (int m = 2; m < 4; ++m) { LAS f32x4* hp = (LAS f32x4*)(halo + (((bd * 4 + wc) * 8 + (m - 2) * 4 + fq) * 16));
                            hp[0] = acc[ai][0][m][0]; hp[1] = acc[ai][0][m][1]; hp[2] = acc[ai][1][m][0]; hp[3] = acc[ai][1][m][1]; } } }
            }
            asm volatile("s_waitcnt lgkmcnt(0)" ::: "memory"); __builtin_amdgcn_s_barrier(); asm volatile("" ::: "memory");
            u32x2 olo[2][4];
            const float zm = fr == 0 ? 1.0f : 0.0f;
            bf16_t* const dump = w.merged;
#pragma unroll
            for (int n = 0; n < 2; ++n) {
                const int f0 = fcol + 4 * n;
                f32x4 wa[3], wb[3];
                const LAS unsigned char* wl = lds + PRE_CW + 4 * (f0 - u.pn * 128);
#pragma unroll
                for (int k = 0; k < 3; ++k) { wa[k] = *(const LAS f32x4*)(wl + 1024 * k); wb[k] = *(const LAS f32x4*)(wl + 1024 * k + 512); }
                const f32x4 ba = *(const LAS f32x4*)(wl + 3072), bbv = *(const LAS f32x4*)(wl + 3072 + 512);
#pragma unroll
                for (int ai = 0; ai < 2; ++ai) {
                    const int gi = 2 * ai + wr;
                    const LAS f32x4* hp = (const LAS f32x4*)(halo + ((((gi > 0 ? gi - 1 : 0) * 4 + wc) * 8 + fq) * 16));
                    const f32x4 h62a = hp[n] * zm, h62b = hp[2 + n] * zm, h63a = hp[16 + n] * zm, h63b = hp[16 + 2 + n] * zm;
#pragma unroll
                    for (int m = 0; m < 4; ++m) {
                        const int rl = ai * 128 + wr * 64 + 4 * fr + m, t = t0 + rl;
                        const f32x4 ca = acc[ai][0][m][n], cbv = acc[ai][1][m][n];
                        f32x4 va = ba + wa[2] * ca, vb = bbv + wb[2] * cbv;
                        if (m >= 1) { va += wa[1] * acc[ai][0][m - 1][n]; vb += wb[1] * acc[ai][1][m - 1][n]; }
                        else { va += wa[1] * h63a; vb += wb[1] * h63b; }
                        if (m >= 2) { va += wa[0] * acc[ai][0][m - 2][n]; vb += wb[0] * acc[ai][1][m - 2][n]; }
                        else if (m == 1) { va += wa[0] * h63a; vb += wb[0] * h63b; }
                        else { va += wa[0] * h62a; vb += wb[0] * h62b; }
                        if (m < 2) {
#pragma unroll
                            for (int i = 0; i < 4; ++i) {
                                float ta = va[i], tb = vb[i];
                                if (m == 0) { CONV_SHR1(ta, acc[ai][0][3][n][i], wa[1][i]); CONV_SHR1(tb, acc[ai][1][3][n][i], wb[1][i]);
                                              CONV_SHR1(ta, acc[ai][0][2][n][i], wa[0][i]); CONV_SHR1(tb, acc[ai][1][2][n][i], wb[0][i]); }
                                else { CONV_SHR1(ta, acc[ai][0][3][n][i], wa[0][i]); CONV_SHR1(tb, acc[ai][1][3][n][i], wb[0][i]); }
                                va[i] = ta; vb[i] = tb;
                            }
                        }
                        const f32x2 g01 = gelu_gate2((f32x2){va[0], va[1]}, (f32x2){vb[0], vb[1]}), g23 = gelu_gate2((f32x2){va[2], va[3]}, (f32x2){vb[2], vb[3]});
                        u32x2 o; o.x = pk2(g01.x, g01.y); o.y = pk2(g23.x, g23.y);
                        if (n == 0) olo[ai][m] = o;
                        else { u32x4 o4; o4.x = olo[ai][m].x; o4.y = olo[ai][m].y; o4.z = o.x; o4.w = o.y;
                            const bool ok = rl >= 2 && t < SEQ;
                            bf16_t* dst = ok ? w.act + (unsigned)((rowbase + rl) * FF + fcol) : dump + (unsigned)(threadIdx.x * 8);
                            *(u32x4*)dst = o4; }
                        asm volatile("" ::: "memory");
                    }
                }
            }
            if (jj == 32) {
#pragma unroll
                for (int ai = 0; ai < 2; ++ai)
#pragma unroll
                    for (int m = 0; m < 4; ++m) { const int rl = ai * 128 + wr * 64 + 4 * fr + m, t = t0 + rl;
                        if (t >= SEQ - 2 && t < SEQ) {
#pragma unroll
                            for (int n = 0; n < 2; ++n) { float* d = out + O_CONVP + ((size_t)bb * 2 + (t - (SEQ - 2))) * F2 + fcol + 4 * n; *(f32x4*)d = acc[ai][0][m][n]; *(f32x4*)(d + FF) = acc[ai][1][m][n]; } } }
            }
        } else {
            const bool ev = !(fr & 1);
#pragma unroll
            for (int n = 0; n < 2; ++n) {
                const int f0 = fcol + 4 * n;
                f32x4 wa[3], wb[3];
                const LAS unsigned char* wl = lds + PRE_CW + 4 * (f0 - u.pn * 128);
#pragma unroll
                for (int k = 0; k < 3; ++k) { wa[k] = *(const LAS f32x4*)(wl + 1024 * k); wb[k] = *(const LAS f32x4*)(wl + 1024 * k + 512); }
                const f32x4 ba = *(const LAS f32x4*)(wl + 3072), bbv = *(const LAS f32x4*)(wl + 3072 + 512);
#pragma unroll
                for (int ai = 0; ai < 2; ++ai) {
                    const int bs = ai * 16 + wr * 8 + (fr >> 1);
                    f32x4 s1a = ba, s1b = ba, s0a = ba, s0b = ba;
                    if (ev) { const float* s1 = sconv + ((size_t)bs * 2 + 1) * F2 + f0; const float* s0 = sconv + ((size_t)bs * 2) * F2 + f0;
                        s1a = *(const f32x4*)s1; s1b = *(const f32x4*)(s1 + FF); s0a = *(const f32x4*)s0; s0b = *(const f32x4*)(s0 + FF); }
#pragma unroll
                    for (int m = 0; m < 4; ++m) {
                        const int rl = ai * 128 + wr * 64 + 4 * fr + m, ts = 4 * (fr & 1) + m;
                        const f32x4 ca = acc[ai][0][m][n], cbv = acc[ai][1][m][n];
                        f32x4 a1, a2, b1, b2;
                        if (m >= 1) { a1 = acc[ai][0][m - 1][n]; b1 = acc[ai][1][m - 1][n]; }
                        else {
#pragma unroll
                            for (int i = 0; i < 4; ++i) { const float da = dpp_keep(acc[ai][0][3][n][i]), db = dpp_keep(acc[ai][1][3][n][i]); a1[i] = ev ? s1a[i] : da; b1[i] = ev ? s1b[i] : db; } }
                        if (m >= 2) { a2 = acc[ai][0][m - 2][n]; b2 = acc[ai][1][m - 2][n]; }
                        else if (m == 1) {
#pragma unroll
                            for (int i = 0; i < 4; ++i) { const float da = dpp_keep(acc[ai][0][3][n][i]), db = dpp_keep(acc[ai][1][3][n][i]); a2[i] = ev ? s1a[i] : da; b2[i] = ev ? s1b[i] : db; } }
                        else {
#pragma unroll
                            for (int i = 0; i < 4; ++i) { const float da = dpp_keep(acc[ai][0][2][n][i]), db = dpp_keep(acc[ai][1][2][n][i]); a2[i] = ev ? s0a[i] : da; b2[i] = ev ? s0b[i] : db; } }
                        const f32x4 va = ba + wa[0] * a2 + wa[1] * a1 + wa[2] * ca;
                        const f32x4 vb = bbv + wb[0] * b2 + wb[1] * b1 + wb[2] * cbv;
                        const f32x2 g01 = gelu_gate2((f32x2){va[0], va[1]}, (f32x2){vb[0], vb[1]}), g23 = gelu_gate2((f32x2){va[2], va[3]}, (f32x2){vb[2], vb[3]});
                        u32x2 o; o.x = pk2(g01.x, g01.y); o.y = pk2(g23.x, g23.y);
                        *(u32x2*)(w.act + (unsigned)((MP + rl) * FF + f0)) = o;
                        if (ts >= 6) { float* d = out + O_CONVS + ((size_t)bs * 2 + (ts - 6)) * F2 + f0; *(f32x4*)d = ca; *(f32x4*)(d + FF) = cbv; }
                        asm volatile("" ::: "memory");
                    }
                }
            }
        }
    }
};


__device__ __forceinline__ void panel_arrive_wait(unsigned* cnt, unsigned want) {
    asm volatile("s_waitcnt vmcnt(0)" ::: "memory");
    __hip_atomic_fetch_add(cnt, 1u, __ATOMIC_RELAXED, __HIP_MEMORY_SCOPE_AGENT);
    unsigned sp = 0;
    while (__hip_atomic_load(cnt, __ATOMIC_RELAXED, __HIP_MEMORY_SCOPE_AGENT) < want) { __builtin_amdgcn_s_sleep(2); if (++sp > (1u << 22)) break; }
    asm volatile("s_waitcnt vmcnt(0)" ::: "memory");
}
struct EpiFin {
    static constexpr bool PERM = true, DMA_PRE = false, APERM = false;
    Ws w; float* out; const float* gfin; unsigned* pcnt;
    __device__ __forceinline__ void operator()(f32x4 (&acc)[2][2][4][2], const pg8::Unit& u, int wr, int wc, int fr_, int fq_, LAS unsigned char*) const {
        int fr = fr_, fq = fq_; asm volatile("" : "+v"(fr), "+v"(fq));
        const int row0 = u.pm * 256 + wr * 64 + fr;
        const int col0 = u.pn * 256 + wc * 32 + 8 * fq;
        float ssv[8];
#pragma unroll
        for (int ai = 0; ai < 2; ++ai)
#pragma unroll
            for (int m = 0; m < 4; ++m) {
                const int row = row0 + ai * 128 + m * 16;
                float ssq = 0.f;
#pragma unroll
                for (int bj = 0; bj < 2; ++bj) {
                    const int col = col0 + bj * 128;
                    const u32x4 xv = __builtin_nontemporal_load((const u32x4*)(w.xb + (unsigned)(row * DM) + col));
                    f32x4 v0 = acc[ai][bj][m][0], v1 = acc[ai][bj][m][1];
                    v0[0] += bflo(xv.x); v0[1] += bfhi(xv.x); v0[2] += bflo(xv.y); v0[3] += bfhi(xv.y);
                    v1[0] += bflo(xv.z); v1[1] += bfhi(xv.z); v1[2] += bflo(xv.w); v1[3] += bfhi(xv.w);
                    acc[ai][bj][m][0] = v0; acc[ai][bj][m][1] = v1;
#pragma unroll
                    for (int i = 0; i < 4; ++i) ssq += v0[i] * v0[i] + v1[i] * v1[i];
                }
                ssq += __shfl_xor(ssq, 16); ssq += __shfl_xor(ssq, 32);
                ssv[ai * 4 + m] = ssq;
            }
        if (fq == 0) {
#pragma unroll
            for (int k = 0; k < 8; ++k) atomicAdd(w.sumsq3 + row0 + (k >> 2) * 128 + (k & 3) * 16, ssv[k]);
        }
        asm volatile("s_waitcnt vmcnt(0)" ::: "memory"); __builtin_amdgcn_s_barrier(); asm volatile("" ::: "memory");
        if (threadIdx.x == 0) panel_arrive_wait(pcnt + 16 * u.pm, 8u);
        asm volatile("s_waitcnt vmcnt(0) lgkmcnt(0)" ::: "memory"); __builtin_amdgcn_s_barrier(); asm volatile("" ::: "memory");
        f32x4 g[2][2];
#pragma unroll
        for (int bj = 0; bj < 2; ++bj) { g[bj][0] = *(const f32x4*)(gfin + col0 + bj * 128); g[bj][1] = *(const f32x4*)(gfin + col0 + bj * 128 + 4); }
#pragma unroll
        for (int ai = 0; ai < 2; ++ai)
#pragma unroll
            for (int m = 0; m < 4; ++m) {
                const int row = row0 + ai * 128 + m * 16;
                const float rs = rsqrtf(__hip_atomic_load(w.sumsq3 + row, __ATOMIC_RELAXED, __HIP_MEMORY_SCOPE_AGENT) * (1.0f / DM) + EPS);
#pragma unroll
                for (int bj = 0; bj < 2; ++bj) { float* dst = out + O_Y + (unsigned)(row * DM) + col0 + bj * 128;
                    __builtin_nontemporal_store(acc[ai][bj][m][0] * rs * g[bj][0], (f32x4*)dst); __builtin_nontemporal_store(acc[ai][bj][m][1] * rs * g[bj][1], (f32x4*)(dst + 4)); }
            }
    }
};

__device__ __forceinline__ int up_rowmap(int n) { return n < FF ? ((n >> 7) * 256 + (n & 127)) : (((n - FF) >> 7) * 256 + 128 + ((n - FF) & 127)); }
__device__ __forceinline__ void p0_transpose_item(const float* W, int K, int N, bf16_t* WT, const float* g, bool upmap, LAS float* scr, int item, int lane, int ldt = 0) {
    if (ldt == 0) ldt = K;
    const int nblk = N / 32, kb = item / nblk, nb = item % nblk, k0 = 64 * kb, n0 = 32 * nb;
    float tv[32];
#pragma unroll
    for (int i = 0; i < 32; ++i) { const int kk = 2 * i + (lane >> 5); tv[i] = __builtin_nontemporal_load(W + (size_t)(k0 + kk) * N + n0 + (lane & 31)); }
    if (g) {
#pragma unroll
        for (int i = 0; i < 32; ++i) tv[i] *= g[k0 + 2 * i + (lane >> 5)];
    }
#pragma unroll
    for (int i = 0; i < 32; ++i) { const int kk = 2 * i + (lane >> 5); scr[kk * 33 + (lane & 31)] = tv[i]; }
    LDS_WAIT();
    const int c = lane & 7;
    const int nbase = upmap ? up_rowmap(n0) : n0;
#pragma unroll
    for (int j = 0; j < 4; ++j) { const int n = (lane >> 3) + 8 * j; const LAS float* s = scr + (8 * c) * 33 + n;
        u32x4 o; o.x = pk2(s[0 * 33], s[1 * 33]); o.y = pk2(s[2 * 33], s[3 * 33]); o.z = pk2(s[4 * 33], s[5 * 33]); o.w = pk2(s[6 * 33], s[7 * 33]);
        *(u32x4*)(WT + (size_t)(nbase + n) * ldt + k0 + 8 * c) = o; }
    LDS_WAIT();
}
#ifndef KVSLACK
#define KVSLACK 100
#endif
#define KV_SPLIT ((KVSLACK) >= 100 ? KV_TOTAL : KV_TOTAL / 100 * (KVSLACK))
template <int SET> __device__ __forceinline__ void weight_transposes(const Params& p, const Ws& w, LAS unsigned char* lds, int rk, int n) {
    const int tid = opaque_tid(), lane = tid & 63, wave = tid >> 6;
    LAS float* scr = (LAS float*)(lds + wave * 16384);
    const int gw = rk * 8 + wave, NGW = n * 8;
    constexpr int I_IN = (DM / 64) * (INC / 32), I_RO = (1024 / 64) * (DM / 32), I_AO = (512 / 64) * (DM / 32), I_O = (DM / 64) * (DM / 32), I_UP = (DM / 64) * (F2 / 32), I_DN = (FF / 64) * (DM / 32);
    constexpr int NITEMS = SET == 0 ? I_IN + I_UP : (SET == 1 ? I_RO + I_AO + I_O : I_DN);
    for (int it = gw; it < NITEMS; it += NGW) {
        int r = it;
        if (SET == 0) {
            if (r < I_IN) { p0_transpose_item(p.in[8], DM, INC, w.Wt_in, p.in[7], false, scr, r, lane); continue; } r -= I_IN;
            p0_transpose_item(p.in[14], DM, F2, w.Wt_up, p.in[13], true, scr, r, lane);
        } else if (SET == 1) {
            if (r < I_RO) { p0_transpose_item(p.in[10], 1024, DM, w.Wt_reto, nullptr, false, scr, r, lane); continue; } r -= I_RO;
            if (r < I_AO) { p0_transpose_item(p.in[11], 512, DM, w.Wt_atto, nullptr, false, scr, r, lane, 1024); continue; } r -= I_AO;
            p0_transpose_item(p.in[12], DM, DM, w.Wt_o, nullptr, false, scr, r, lane);
        } else p0_transpose_item(p.in[17], FF, DM, w.Wt_down, nullptr, false, scr, r, lane);
    }
}
__device__ __forceinline__ void p0_xconv(const Params& p, const Ws& w, LAS unsigned char* lds, int vcu, int G) {
    const int tid = opaque_tid(), lane = tid & 63, wave = tid >> 6;
    const int gw = vcu * 8 + wave, NGW = G * 8;
    for (int m = gw; m < MT; m += NGW) {
        const float* xr = (m < MP) ? p.in[0] + (size_t)m * DM : p.in[1] + (size_t)(m - MP) * DM;
        const f32x4* x4 = (const f32x4*)xr + lane;
        f32x4 v[8]; float s = 0.f;
#pragma unroll
        for (int j = 0; j < 8; ++j) { v[j] = __builtin_nontemporal_load(x4 + 64 * j); s += (v[j].x * v[j].x + v[j].y * v[j].y) + (v[j].z * v[j].z + v[j].w * v[j].w); }
        s = wave_sum(s);
        const float rs = rsqrtf(s * (1.0f / DM) + EPS);
        if (lane == 0) w.rstd1[m] = sqrtf(s * (1.0f / DM) + EPS);
        u32x2* o8 = (u32x2*)(w.xb + (size_t)m * DM) + lane;
#pragma unroll
        for (int j = 0; j < 8; ++j) { u32x2 o; o.x = pk2(v[j].x * rs, v[j].y * rs); o.y = pk2(v[j].z * rs, v[j].w * rs); o8[64 * j] = o; }
    }
    for (int i = vcu * 512 + tid; i < 2 * MT; i += G * 512) w.sumsq2[i] = 0.f;
}
constexpr size_t KV_TOTAL = (size_t)32 * 1024 * 256;
__device__ __forceinline__ void kv_resolve(const Params& p, size_t i, const f32x4*& src, f32x4*& dst) {
    const unsigned li = (unsigned)i, b = li >> 18, rr = (li >> 8) & 1023u, c4 = li & 255u, row = (rr >> 3) * 16 + 8 + (rr & 7);
    const size_t o = ((size_t)b * 2048 + row) * 256 + c4;
    src = (const f32x4*)p.in[5] + o; dst = (f32x4*)(p.out + O_KV2048S) + o - 2048;
}
__device__ __forceinline__ void kv_copy_range(const Params& p, size_t c0, size_t c1, int rk, int ncu) {
    const size_t step = (size_t)ncu * 512;
    for (size_t i0 = c0 + (size_t)rk * 512 + opaque_tid(); i0 < c1; i0 += 16 * step) {
        f32x4 v[16]; f32x4* dp[16];
#pragma unroll
        for (int k = 0; k < 16; ++k) { const size_t i = i0 + k * step; if (i < c1) { const f32x4* sp; kv_resolve(p, i, sp, dp[k]); v[k] = __builtin_nontemporal_load(sp); } }
#pragma unroll
        for (int k = 0; k < 16; ++k) { const size_t i = i0 + k * step; if (i < c1) __builtin_nontemporal_store(v[k], dp[k]); }
    }
}

__device__ __forceinline__ float lgamma_h(int h) { return logf(1.0f - exp2f(-5.0f - (float)h)); }
__device__ __forceinline__ void ret_sample(const Params& p, const Ws& w, LAS unsigned char* lds, int vcu, int G) {
    const int tid = opaque_tid(), lane = tid & 63, wave = tid >> 6;
    LAS float* qf = (LAS float*)lds;
    LAS float* kf = qf + 1024;
    LAS float* vf = kf + 1024;
    LAS float* part = vf + 1024;
    LAS float* sc = part + 4096;
    LAS float* yb = sc + 64;
    const float* gn = p.in[9];
    for (int item = vcu; item < 256; item += G) {
        const int bs = item >> 3, h = item & 7;
        const size_t m0 = MP + (size_t)bs * 8;
        const float lg = lgamma_h(h);
        __syncthreads();
        for (int i = tid; i < 1024; i += 512) { const int r = i >> 7, d = i & 127; const bf16_t* row = w.proj + pofs(m0 + r, h * 128 + d);
            qf[i] = bf2f(row[(C_RQ / 128) * PSLAB]); kf[i] = bf2f(row[(C_RK / 128) * PSLAB]) * QK_SCALE; vf[i] = bf2f(row[(C_RV / 128) * PSLAB]); }
        __syncthreads();
        if (tid < 64) { const int i = tid >> 3, j = tid & 7; float s = 0.f; for (int d = 0; d < 128; ++d) s += qf[i * 128 + d] * kf[j * 128 + d]; sc[tid] = (i >= j) ? s * __expf((float)(i - j) * lg) : 0.f; }
        const int e = tid & 127, dq = tid >> 7;
        const float* st = p.in[2] + (size_t)item * 16384;
        float* nst = p.out + O_RETS + (size_t)item * 16384;
        const float g8 = __expf(8.0f * lg);
        float kdec[8];
#pragma unroll
        for (int j = 0; j < 8; ++j) kdec[j] = __expf((float)(7 - j) * lg);
        float cr[8];
#pragma unroll
        for (int i = 0; i < 8; ++i) cr[i] = 0.f;
        float sv[32];
#pragma unroll
        for (int dd = 0; dd < 32; ++dd) sv[dd] = __builtin_nontemporal_load(st + (dq * 32 + dd) * 128 + e);
#pragma unroll
        for (int dd = 0; dd < 32; ++dd) {
            const int d = dq * 32 + dd;
            const float s = sv[dd];
            float ns = s * g8;
#pragma unroll
            for (int j = 0; j < 8; ++j) ns += kf[j * 128 + d] * kdec[j] * vf[j * 128 + e];
            __builtin_nontemporal_store(ns, nst + d * 128 + e);
#pragma unroll
            for (int i = 0; i < 8; ++i) cr[i] += qf[i * 128 + d] * s;
        }
#pragma unroll
        for (int i = 0; i < 8; ++i) part[(dq * 8 + i) * 128 + e] = cr[i];
        __syncthreads();
        for (int idx = tid; idx < 1024; idx += 512) { const int i = idx >> 7, ee = idx & 127;
            float y = (part[(0 * 8 + i) * 128 + ee] + part[(1 * 8 + i) * 128 + ee] + part[(2 * 8 + i) * 128 + ee] + part[(3 * 8 + i) * 128 + ee]) * __expf((float)(i + 1) * lg);
            for (int j = 0; j <= i; ++j) y += sc[i * 8 + j] * vf[j * 128 + ee];
            yb[idx] = y; }
        __syncthreads();
        {
            const int il = wave; const size_t m = m0 + il;
            const float a0 = yb[il * 128 + lane], a1 = yb[il * 128 + 64 + lane];
            const float mean = wave_sum(a0 + a1) * (1.0f / 128.0f);
            const float d0 = a0 - mean, d1 = a1 - mean;
            const float var = wave_sum(d0 * d0 + d1 * d1) * (1.0f / 128.0f);
            const float rstd = rsqrtf(var + EPS);
            const float g0 = bf2f(w.proj[pofs(m, C_RG + h * 128 + lane)]), g1 = bf2f(w.proj[pofs(m, C_RG + h * 128 + 64 + lane)]);
            w.G[m * 1024 + h * 128 + lane] = (bf16_t)f2bf(d0 * rstd * gn[h * 128 + lane] * g0);
            w.G[m * 1024 + h * 128 + 64 + lane] = (bf16_t)f2bf(d1 * rstd * gn[h * 128 + 64 + lane] * g1);
        }
    }
}
typedef short v4s __attribute__((ext_vector_type(4)));
__device__ __forceinline__ v4s tr16(const LAS unsigned char* p) { return __builtin_amdgcn_ds_read_tr16_b64_v4i16((LAS v4s*)p); }
__device__ __forceinline__ bf16x8 cat8(v4s a, v4s b) { return (bf16x8){a[0], a[1], a[2], a[3], b[0], b[1], b[2], b[3]}; }
#define MFMA16(a, b, c) __builtin_amdgcn_mfma_f32_16x16x32_bf16(a, b, c, 0, 0, 0)
constexpr float LOG2E = 1.4426950408889634f, LN2 = 0.6931471805599453f;
__device__ __forceinline__ float lg2gamma(int h) { return log2f(1.0f - exp2f(-5.0f - (float)h)); }
__device__ __forceinline__ bf16x8 pack8(const f32x4 a, const f32x4 b) {
    u32x4 o; o.x = pk2(a[0], a[1]); o.y = pk2(a[2], a[3]); o.z = pk2(b[0], b[1]); o.w = pk2(b[2], b[3]);
    return __builtin_bit_cast(bf16x8, o);
}
constexpr int KP = 272, VP = 288;

struct AttnDesc { int g, h, dil, qb, qcol; size_t rowbase; };
__device__ __forceinline__ AttnDesc attn_desc(int item) {
    AttnDesc d; const int rq = item & 63; d.h = (item >> 6) & 3; const int b = (item >> 8) & 1; d.g = item >> 9;
    d.dil = 1 << (2 * d.g); const int sh = 6 - 2 * d.g, r = rq >> sh; d.qb = rq & ((1 << sh) - 1);
    d.qcol = C_ATT + d.g * 1536 + d.h * 128; d.rowbase = (size_t)b * SEQ + r; return d;
}
__device__ __forceinline__ void attn_load(const Ws& w, const AttnDesc& d, int tid, bool fresh, u32x4 (&kreg)[8], u32x4 (&vreg)[8]) {
    const int s0 = 128 * (d.qb - 1);
#pragma unroll
    for (int i = 0; i < 4; ++i) { const int cidx = tid + 512 * i, c = 128 + (cidx >> 4), ch = cidx & 15, s = s0 + c;
        const bf16_t* rp = w.proj + pofs(d.rowbase + (size_t)d.dil * s, d.qcol + ch * 8); kreg[i] = __builtin_nontemporal_load((const u32x4*)(rp + 4 * PSLAB)); vreg[i] = __builtin_nontemporal_load((const u32x4*)(rp + 8 * PSLAB)); }
    if (fresh) {
#pragma unroll
        for (int i = 4; i < 8; ++i) { const int cidx = tid + 512 * (i - 4), c = cidx >> 4, ch = cidx & 15, s = max(s0 + c, 0);
            const bf16_t* rp = w.proj + pofs(d.rowbase + (size_t)d.dil * s, d.qcol + ch * 8); kreg[i] = __builtin_nontemporal_load((const u32x4*)(rp + 4 * PSLAB)); vreg[i] = __builtin_nontemporal_load((const u32x4*)(rp + 8 * PSLAB)); }
    }
}
__device__ __forceinline__ void attn_loadq(const Ws& w, const AttnDesc& d, int wave, int fr, int fg, bf16x8 (&qf)[4]) {
    const size_t mq = d.rowbase + (size_t)d.dil * (128 * d.qb + 16 * wave + fr);
#pragma unroll
    for (int ds = 0; ds < 4; ++ds) qf[ds] = __builtin_nontemporal_load((const bf16x8*)(w.proj + pofs(mq, d.qcol + 32 * ds + 8 * fg)));
}
__device__ __forceinline__ void attn_compute(const Ws& w, LAS unsigned char* lds, const AttnDesc& d, int off, bf16x8 (&qf)[4], int wave, int fr, int fg, bool has_next, const AttnDesc& dn, int tid, u32x4 (&kreg)[8], u32x4 (&vreg)[8]) {
    LAS unsigned char* Kt = lds; LAS unsigned char* Vt = lds + 256 * KP;
    const int g = d.g, h = d.h, qb = d.qb;
    asm volatile("" : "+v"(fr), "+v"(fg));
    const int iq = 16 * wave + fr;
    const size_t mq = d.rowbase + (size_t)d.dil * (128 * qb + iq);
    const int kbmin = (qb == 0) ? 8 : 0;
    const float c1 = QK_SCALE * LOG2E, c2 = exp2f(-8.0f * (float)(g * 4 + h + 1) / 12.0f) * (float)d.dil * LOG2E;
    f32x4 sc[9];
    float mx = -1e30f;
#pragma unroll
    for (int kk = 0; kk < 9; ++kk) {
        const int kb = wave + kk;
        if (kb >= kbmin) {
            f32x4 a = (f32x4){0.f, 0.f, 0.f, 0.f};
#pragma unroll
            for (int ds = 0; ds < 4; ++ds) { const bf16x8 kf = *(const LAS bf16x8*)(Kt + (((16 * kb + off) & 255) + fr) * KP + (32 * ds + 8 * fg) * 2); a = MFMA16(kf, qf[ds], a); }
#pragma unroll
            for (int r_ = 0; r_ < 4; ++r_) { const int dist = 128 + iq - (16 * kb + 4 * fg + r_); const float s = a[r_] * c1 - c2 * (float)dist; a[r_] = (dist >= 0 && dist <= 128) ? s : -1e30f; mx = fmaxf(mx, a[r_]); }
            sc[kk] = a;
        } else sc[kk] = (f32x4){-1e30f, -1e30f, -1e30f, -1e30f};
    }
    mx = fmaxf(mx, __shfl_xor(mx, 16)); mx = fmaxf(mx, __shfl_xor(mx, 32));
    float sum = 0.f;
#pragma unroll
    for (int kk = 0; kk < 9; ++kk)
#pragma unroll
        for (int r_ = 0; r_ < 4; ++r_) { const float e = __builtin_amdgcn_exp2f(sc[kk][r_] - mx); sc[kk][r_] = e; sum += e; }
    sum += __shfl_xor(sum, 16); sum += __shfl_xor(sum, 32);
    if (has_next) { attn_load(w, dn, tid, dn.qb == 0, kreg, vreg); attn_loadq(w, dn, wave, fr, fg, qf); }
    f32x4 o[8];
#pragma unroll
    for (int eb = 0; eb < 8; ++eb) o[eb] = (f32x4){0.f, 0.f, 0.f, 0.f};
    const int q4 = fr >> 2, p4 = fr & 3;
#pragma unroll
    for (int st = 0; st < 5; ++st) {
        const int kb0 = wave + 2 * st;
        const bf16x8 pf = (st < 4) ? pack8(sc[2 * st], sc[2 * st + 1]) : pack8(sc[8], (f32x4){0.f, 0.f, 0.f, 0.f});
        const LAS unsigned char* v0 = Vt + (((16 * kb0 + off) & 255) + 4 * fg + q4) * VP + 8 * p4;
        const LAS unsigned char* v1 = Vt + (((16 * kb0 + 16 + off) & 255) + 4 * fg + q4) * VP + 8 * p4;
#pragma unroll
        for (int eb = 0; eb < 8; ++eb) {
            const v4s a0 = tr16(v0 + 32 * eb);
            const v4s a1 = (st < 4) ? tr16(v1 + 32 * eb) : (v4s){0, 0, 0, 0};
            o[eb] = MFMA16(cat8(a0, a1), pf, o[eb]);
        }
    }
    const float inv = 1.0f / sum;
    bf16_t* orow = w.og + ((size_t)g * MT + mq) * 512 + h * 128 + 4 * fg;
#pragma unroll
    for (int eb = 0; eb < 8; ++eb) { u32x2 ov; ov.x = pk2(o[eb][0] * inv, o[eb][1] * inv); ov.y = pk2(o[eb][2] * inv, o[eb][3] * inv); *(u32x2*)(orow + 16 * eb) = ov; }
    if (fg == 0) w.lse[((size_t)g * MT + mq) * 4 + h] = mx * LN2 + __logf(sum);
}
__device__ __forceinline__ void attn_phase(const Ws& w, LAS unsigned char* lds, int first, int count) {
    const int tid = opaque_tid(), lane = tid & 63, wave = __builtin_amdgcn_readfirstlane(tid >> 6), fr = lane & 15, fg = lane >> 4;
    if (count <= 0) return;
    LAS unsigned char* Kt = lds; LAS unsigned char* Vt = lds + 256 * KP;
    u32x4 kreg[8], vreg[8]; bf16x8 qf[4];
    AttnDesc d = attn_desc(first);
    attn_load(w, d, tid, true, kreg, vreg); attn_loadq(w, d, wave, fr, fg, qf);
    int off = 0; bool fresh = true;
    for (int n = 0; n < count; ++n) {
        __syncthreads();
        if (fresh) off = 0; else off = (off + 128) & 255;
#pragma unroll
        for (int i = 0; i < 4; ++i) { const int cidx = tid + 512 * i, c = (128 + (cidx >> 4) + off) & 255, ch = cidx & 15;
            *(LAS u32x4*)(Kt + c * KP + ch * 16) = kreg[i]; *(LAS u32x4*)(Vt + c * VP + ch * 16) = vreg[i]; }
        if (fresh) {
#pragma unroll
            for (int i = 4; i < 8; ++i) { const int cidx = tid + 512 * (i - 4), c = ((cidx >> 4) + off) & 255, ch = cidx & 15;
                *(LAS u32x4*)(Kt + c * KP + ch * 16) = kreg[i]; *(LAS u32x4*)(Vt + c * VP + ch * 16) = vreg[i]; }
        }
        __syncthreads();
        const AttnDesc dc = d;
        const bool has_next = n + 1 < count;
        if (has_next) { d = attn_desc(first + n + 1); fresh = (d.qb == 0); }
        attn_compute(w, lds, dc, off, qf, wave, fr, fg, has_next, d, tid, kreg, vreg);
    }
    __syncthreads();
}

__device__ __forceinline__ float half_sum(float v) {
#pragma unroll
    for (int o = 1; o < 32; o <<= 1) v += __shfl_xor(v, o);
    return v;
}
__device__ __forceinline__ void attn_sample(const Params& p, const Ws& w, LAS unsigned char* lds, int vcu, int G) {
    const int tid = opaque_tid(), lane = tid & 63, wave = tid >> 6, half = lane >> 5, c = lane & 31;
    const int gw = vcu * 8 + wave, NGW = G * 8;
    for (int it = gw; it < MS * 12; it += NGW) {
        const int g = it % 3, mh = it / 3, ms = mh >> 2, h = mh & 3, m = MP + ms, b = ms >> 3, t = ms & 7;
        const int dil = 1 << (2 * g), Wb = 128 << (2 * g);
        const int qcol = C_ATT + g * 1536 + h * 128, kcol = qcol + 512, vcol = qcol + 1024;
        f32x4 q; { const u32x2 v = *(const u32x2*)(w.proj + pofs(m, qcol + 4 * c)); q = (f32x4){bflo(v.x), bfhi(v.x), bflo(v.y), bfhi(v.y)}; }
        const float slope = exp2f(-8.0f * (float)(g * 4 + h + 1) / 12.0f) * (float)dil;
        const float* cache = p.in[3 + g];
        const int jn = t >> (2 * g);
        const int ncache = 128 - jn, npair = (ncache + 1) >> 1;
        const float* kb0 = cache + ((size_t)(b * Wb + Wb + t) * 2 + 0) * 512 + h * 128 + 4 * c;
        float* kvout = p.out + (g == 0 ? O_KV128S : (g == 1 ? O_KV512S : O_KV2048S));
        const bool owner = (g == 0) ? (t == 0) : (g == 1 ? (t < 4) : true);
        float mrun = -1e30f, sum = 0.f; f32x4 o = (f32x4){0.f, 0.f, 0.f, 0.f};
#pragma unroll
        for (int j = 0; j < 8; ++j) if (j <= jn) {
            const u32x2 kk2 = *(const u32x2*)(w.proj + pofs(m - dil * j, kcol + 4 * c)), vv = *(const u32x2*)(w.proj + pofs(m - dil * j, vcol + 4 * c));
            const float s = half_sum((bflo(kk2.x) * q[0] + bfhi(kk2.x) * q[1]) + (bflo(kk2.y) * q[2] + bfhi(kk2.y) * q[3])) * QK_SCALE - slope * (float)j;
            if (half == 0) { const float mn = fmaxf(mrun, s), al = __expf(mrun - mn), e = __expf(s - mn); mrun = mn; sum = sum * al + e;
                o = o * al; o[0] += e * bflo(vv.x); o[1] += e * bfhi(vv.x); o[2] += e * bflo(vv.y); o[3] += e * bfhi(vv.y); }
        }
        for (int k0 = 0; k0 < npair; k0 += 16) {
            f32x4 kv[16], vv[16];
#pragma unroll
            for (int u = 0; u < 16; ++u) { const int j = jn + 1 + 2 * (k0 + u) + half;
                if (k0 + u < npair && j <= 128) { const float* rp = kb0 - (size_t)(dil * j) * 1024; kv[u] = __builtin_nontemporal_load((const f32x4*)rp); vv[u] = __builtin_nontemporal_load((const f32x4*)(rp + 512));
                    const int idx = Wb + t - dil * j;
                    if (owner && idx >= 8) { float* wp = kvout + ((size_t)(b * Wb + idx - 8) * 2) * 512 + h * 128 + 4 * c; __builtin_nontemporal_store(kv[u], (f32x4*)wp); __builtin_nontemporal_store(vv[u], (f32x4*)(wp + 512)); } }
                else { kv[u] = (f32x4){0.f, 0.f, 0.f, 0.f}; vv[u] = kv[u]; } }
            float s[16]; float bm = -1e30f;
#pragma unroll
            for (int u = 0; u < 16; ++u) { const int j = jn + 1 + 2 * (k0 + u) + half;
                const float d = half_sum((kv[u][0] * q[0] + kv[u][1] * q[1]) + (kv[u][2] * q[2] + kv[u][3] * q[3]));
                s[u] = (k0 + u < npair && j <= 128) ? d * QK_SCALE - slope * (float)j : -1e30f; bm = fmaxf(bm, s[u]); }
            const float mn = fmaxf(mrun, bm), al = __expf(mrun - mn); mrun = mn; sum *= al; o = o * al;
#pragma unroll
            for (int u = 0; u < 16; ++u) { const float e = __expf(s[u] - mn); sum += e; o += vv[u] * e; }
        }
        const float mo = __shfl_xor(mrun, 32), so = __shfl_xor(sum, 32);
        const float mt = fmaxf(mrun, mo), a0 = __expf(mrun - mt), a1 = __expf(mo - mt);
        const float st = sum * a0 + so * a1;
#pragma unroll
        for (int i = 0; i < 4; ++i) o[i] = o[i] * a0 + __shfl_xor(o[i], 32) * a1;
        const float inv = 1.0f / st;
        if (half == 0) { u32x2 ov; ov.x = pk2(o[0] * inv, o[1] * inv); ov.y = pk2(o[2] * inv, o[3] * inv); *(u32x2*)(w.og + ((size_t)g * MT + m) * 512 + h * 128 + 4 * c) = ov; }
        if (lane == 0) w.lse[((size_t)g * MT + m) * 4 + h] = mt + __logf(st);
    }
}

__device__ __forceinline__ void retA_item(const Ws& w, LAS unsigned char* lds, int item) {
    const int tid = opaque_tid(), lane = tid & 63, wave = __builtin_amdgcn_readfirstlane(tid >> 6), fr = lane & 15, fg = lane >> 4;
    const int c = item & 63, bh = item >> 6, h = bh & 7, b = bh >> 3;
    const size_t m0 = (size_t)b * SEQ + c * 128;
    const float lg2 = lg2gamma(h);
    LAS unsigned char* Kt = lds; LAS unsigned char* Vt = lds + 128 * VP;
#pragma unroll
    for (int i = 0; i < 4; ++i) { const int cidx = tid + 512 * i, j = cidx >> 4, ch = cidx & 15;
        const bf16_t* rp = w.proj + pofs(m0 + j, h * 128 + ch * 8);
        const u32x4 kr = *(const u32x4*)(rp + (C_RK / 128) * PSLAB), vr = *(const u32x4*)(rp + (C_RV / 128) * PSLAB);
        const float kd = exp2f((float)(127 - j) * lg2) * QK_SCALE;
        u32x4 ks; ks.x = pk2(bflo(kr.x) * kd, bfhi(kr.x) * kd); ks.y = pk2(bflo(kr.y) * kd, bfhi(kr.y) * kd); ks.z = pk2(bflo(kr.z) * kd, bfhi(kr.z) * kd); ks.w = pk2(bflo(kr.w) * kd, bfhi(kr.w) * kd);
        *(LAS u32x4*)(Kt + j * VP + ch * 16) = ks; *(LAS u32x4*)(Vt + j * VP + ch * 16) = vr; }
    __syncthreads();
    f32x4 acc[8];
#pragma unroll
    for (int db = 0; db < 8; ++db) acc[db] = (f32x4){0.f, 0.f, 0.f, 0.f};
    const int q4 = fr >> 2, p4 = fr & 3;
#pragma unroll
    for (int st = 0; st < 4; ++st) {
        const int rowoff = (32 * st + 4 * fg + q4) * VP + 8 * p4;
        const bf16x8 af = cat8(tr16(Vt + rowoff + 32 * wave), tr16(Vt + rowoff + 16 * VP + 32 * wave));
#pragma unroll
        for (int db = 0; db < 8; ++db) { const bf16x8 bfr = cat8(tr16(Kt + rowoff + 32 * db), tr16(Kt + rowoff + 16 * VP + 32 * db)); acc[db] = MFMA16(af, bfr, acc[db]); }
    }
    __syncthreads();
    {
        LAS bf16_t* stg = (LAS bf16_t*)(lds + wave * 4096);
#pragma unroll
        for (int db = 0; db < 8; ++db)
#pragma unroll
            for (int r_ = 0; r_ < 4; ++r_) stg[(4 * fg + r_) * 128 + 16 * db + fr] = (bf16_t)f2bf(acc[db][r_]);
        LDS_WAIT();
        bf16_t* dst = (bf16_t*)w.kvc + (size_t)item * 16384 + (size_t)(16 * wave) * 128;
#pragma unroll
        for (int i = 0; i < 4; ++i) { const int row = 4 * i + (lane >> 4), ch = lane & 15; *(u32x4*)(dst + row * 128 + ch * 8) = *(const LAS u32x4*)(stg + row * 128 + ch * 8); }
    }
    __syncthreads();
}
__device__ __forceinline__ void ret_scan2(const Params& p, const Ws& w, int vcu, int G) {
    for (int i = vcu * 512 + opaque_tid(); i < 16 * 8192; i += G * 512) {
        const int bh = i >> 13, idx = (i & 8191) * 2, h = bh & 7;
        const float g128 = exp2f(128.0f * lg2gamma(h));
        const bf16_t* base = (const bf16_t*)w.kvc + (size_t)bh * 64 * 16384 + idx;
        bf16_t* sbase = w.sb + (size_t)bh * 64 * 16384 + idx;
        float s0 = 0.f, s1 = 0.f;
        for (int c0 = 0; c0 < 64; c0 += 16) {
            unsigned kv[16];
#pragma unroll
            for (int k = 0; k < 16; ++k) kv[k] = __builtin_nontemporal_load((const unsigned*)(base + (size_t)(c0 + k) * 16384));
#pragma unroll
            for (int k = 0; k < 16; ++k) { *(unsigned*)(sbase + (size_t)(c0 + k) * 16384) = pk2(s0, s1); s0 = s0 * g128 + bflo(kv[k]); s1 = s1 * g128 + bfhi(kv[k]); }
        }
        const int e = idx >> 7, d = idx & 127;
        __builtin_nontemporal_store(s0, p.out + O_RETP + (size_t)bh * 16384 + d * 128 + e); __builtin_nontemporal_store(s1, p.out + O_RETP + (size_t)bh * 16384 + (d + 1) * 128 + e);
    }
}
struct MergeIn { float l0, l1, l2; u32x4 a, b, c; };
__device__ __forceinline__ MergeIn merge_load(const Ws& w, int i) {
    const int m = i >> 6, c8 = (i & 63) * 8, h = c8 >> 7; MergeIn r;
    r.l0 = w.lse[((size_t)0 * MT + m) * 4 + h]; r.l1 = w.lse[((size_t)1 * MT + m) * 4 + h]; r.l2 = w.lse[((size_t)2 * MT + m) * 4 + h];
    r.a = __builtin_nontemporal_load((const u32x4*)(w.og + ((size_t)0 * MT + m) * 512 + c8)); r.b = __builtin_nontemporal_load((const u32x4*)(w.og + ((size_t)1 * MT + m) * 512 + c8));
    r.c = __builtin_nontemporal_load((const u32x4*)(w.og + ((size_t)2 * MT + m) * 512 + c8));
    return r;
}
__device__ __forceinline__ void merge_store(const Ws& w, int i, const MergeIn& r) {
    const int m = i >> 6, c8 = (i & 63) * 8;
    const float mx = fmaxf(r.l0, fmaxf(r.l1, r.l2));
    float w0 = __expf(r.l0 - mx), w1 = __expf(r.l1 - mx), w2 = __expf(r.l2 - mx);
    const float inv = 1.0f / (w0 + w1 + w2); w0 *= inv; w1 *= inv; w2 *= inv;
    const u32x4 a = r.a, b = r.b, c = r.c;
    u32x4 o;
    o.x = pk2(w0 * bflo(a.x) + w1 * bflo(b.x) + w2 * bflo(c.x), w0 * bfhi(a.x) + w1 * bfhi(b.x) + w2 * bfhi(c.x));
    o.y = pk2(w0 * bflo(a.y) + w1 * bflo(b.y) + w2 * bflo(c.y), w0 * bfhi(a.y) + w1 * bfhi(b.y) + w2 * bfhi(c.y));
    o.z = pk2(w0 * bflo(a.z) + w1 * bflo(b.z) + w2 * bflo(c.z), w0 * bfhi(a.z) + w1 * bfhi(b.z) + w2 * bfhi(c.z));
    o.w = pk2(w0 * bflo(a.w) + w1 * bflo(b.w) + w2 * bflo(c.w), w0 * bfhi(a.w) + w1 * bfhi(b.w) + w2 * bfhi(c.w));
    *(u32x4*)(w.Oatt + (size_t)m * 1024 + c8) = o;
}
__device__ __forceinline__ void attn_merge(const Ws& w, int vcu, int G) {
    const int step = G * 512, N = MT * 64;
    for (int i = vcu * 512 + opaque_tid(); i < N; i += 3 * step) {
        const int i2 = i + step, i3 = i + 2 * step; const bool t2 = i2 < N, t3 = i3 < N;
        const MergeIn r0 = merge_load(w, i), r1 = merge_load(w, t2 ? i2 : i), r2 = merge_load(w, t3 ? i3 : i);
        merge_store(w, i, r0);
        if (t2) merge_store(w, i2, r1);
        if (t3) merge_store(w, i3, r2);
    }
}
__device__ __forceinline__ void retC_load(const Ws& w, int item, int tid, u32x4 (&kr)[4], u32x4 (&vr)[4], u32x4 (&sr)[4]) {
    const int c = item & 63, bh = item >> 6, h = bh & 7, b = bh >> 3;
    const size_t m0 = (size_t)b * SEQ + c * 128;
    const bf16_t* sbp = w.sb + (size_t)item * 16384;
#pragma unroll
    for (int i = 0; i < 4; ++i) { const int cidx = tid + 512 * i, j = cidx >> 4, ch = cidx & 15;
        const bf16_t* rp = w.proj + pofs(m0 + j, h * 128 + ch * 8);
        kr[i] = __builtin_nontemporal_load((const u32x4*)(rp + (C_RK / 128) * PSLAB)); vr[i] = __builtin_nontemporal_load((const u32x4*)(rp + (C_RV / 128) * PSLAB)); sr[i] = __builtin_nontemporal_load((const u32x4*)(sbp + j * 128 + ch * 8)); }
}
__device__ __forceinline__ void retC_loadq(const Ws& w, int item, int wave, int fr, int fg, bf16x8 (&qf)[4]) {
    const int c = item & 63, bh = item >> 6, h = bh & 7, b = bh >> 3;
    const size_t mq = (size_t)b * SEQ + c * 128 + 16 * wave + fr;
#pragma unroll
    for (int ds = 0; ds < 4; ++ds) qf[ds] = __builtin_nontemporal_load((const bf16x8*)(w.proj + pofs(mq, C_RQ + h * 128 + 32 * ds + 8 * fg)));
}
__device__ __forceinline__ void retC_compute(const Params& p, const Ws& w, LAS unsigned char* lds, int item, bf16x8 (&qf)[4], int wave, int fr, int fg, int next_item, int tid, u32x4 (&kr)[4], u32x4 (&vr)[4], u32x4 (&sr)[4]) {
    const int c = item & 63, bh = item >> 6, h = bh & 7, b = bh >> 3;
    const size_t m0 = (size_t)b * SEQ + c * 128;
    const float lg2 = lg2gamma(h);
    LAS unsigned char* Kt = lds; LAS unsigned char* Vt = lds + 128 * KP; LAS unsigned char* St = Vt + 128 * VP;
    asm volatile("" : "+v"(fr), "+v"(fg));
    const int iq = 16 * wave + fr;
    const size_t mq = m0 + iq;
    f32x4 sc[8];
#pragma unroll
    for (int kb = 0; kb < 8; ++kb) {
        if (kb <= wave) {
            f32x4 a = (f32x4){0.f, 0.f, 0.f, 0.f};
#pragma unroll
            for (int ds = 0; ds < 4; ++ds) { const bf16x8 kf = *(const LAS bf16x8*)(Kt + (16 * kb + fr) * KP + (32 * ds + 8 * fg) * 2); a = MFMA16(kf, qf[ds], a); }
#pragma unroll
            for (int r_ = 0; r_ < 4; ++r_) { const int dj = iq - (16 * kb + 4 * fg + r_); a[r_] = (dj >= 0) ? a[r_] * QK_SCALE * exp2f((float)dj * lg2) : 0.f; }
            sc[kb] = a;
        } else sc[kb] = (f32x4){0.f, 0.f, 0.f, 0.f};
    }
    f32x4 y[8], cr[8];
#pragma unroll
    for (int eb = 0; eb < 8; ++eb) { y[eb] = (f32x4){0.f, 0.f, 0.f, 0.f}; cr[eb] = (f32x4){0.f, 0.f, 0.f, 0.f}; }
    const int q4 = fr >> 2, p4 = fr & 3;
#pragma unroll
    for (int st = 0; st < 4; ++st) {
        if (2 * st <= wave) {
            const bf16x8 pf = pack8(sc[2 * st], sc[2 * st + 1]);
            const LAS unsigned char* v0 = Vt + (32 * st + 4 * fg + q4) * VP + 8 * p4;
#pragma unroll
            for (int eb = 0; eb < 8; ++eb) y[eb] = MFMA16(cat8(tr16(v0 + 32 * eb), tr16(v0 + 16 * VP + 32 * eb)), pf, y[eb]);
        }
    }
#pragma unroll
    for (int eb = 0; eb < 8; ++eb)
#pragma unroll
        for (int ds = 0; ds < 4; ++ds) { const bf16x8 sf = *(const LAS bf16x8*)(St + (16 * eb + fr) * KP + (32 * ds + 8 * fg) * 2); cr[eb] = MFMA16(sf, qf[ds], cr[eb]); }
    if (next_item >= 0) { retC_load(w, next_item, tid, kr, vr, sr); retC_loadq(w, next_item, wave, fr, fg, qf); }
    const float qd = exp2f((float)(iq + 1) * lg2);
    float s = 0.f;
#pragma unroll
    for (int eb = 0; eb < 8; ++eb) { y[eb] = y[eb] + cr[eb] * qd; s += (y[eb][0] + y[eb][1]) + (y[eb][2] + y[eb][3]); }
    s += __shfl_xor(s, 16); s += __shfl_xor(s, 32);
    const float mean = s * (1.0f / 128.0f);
    float v = 0.f;
#pragma unroll
    for (int eb = 0; eb < 8; ++eb) { y[eb] = y[eb] - mean; v += (y[eb][0] * y[eb][0] + y[eb][1] * y[eb][1]) + (y[eb][2] * y[eb][2] + y[eb][3] * y[eb][3]); }
    v += __shfl_xor(v, 16); v += __shfl_xor(v, 32);
    const float rstd = rsqrtf(v * (1.0f / 128.0f) + EPS);
    const float* gn = p.in[9] + h * 128 + 4 * fg;
    const bf16_t* grow = w.proj + pofs(mq, C_RG + h * 128 + 4 * fg);
    bf16_t* orow = w.G + mq * 1024 + h * 128 + 4 * fg;
#pragma unroll
    for (int eb = 0; eb < 8; ++eb) { const f32x4 gv = *(const f32x4*)(gn + 16 * eb); const u32x2 sg = __builtin_nontemporal_load((const u32x2*)(grow + 16 * eb));
        u32x2 ov; ov.x = pk2(y[eb][0] * rstd * gv[0] * bflo(sg.x), y[eb][1] * rstd * gv[1] * bfhi(sg.x)); ov.y = pk2(y[eb][2] * rstd * gv[2] * bflo(sg.y), y[eb][3] * rstd * gv[3] * bfhi(sg.y));
        *(u32x2*)(orow + 16 * eb) = ov; }
}
__device__ __forceinline__ void retC_phase(const Params& p, const Ws& w, LAS unsigned char* lds, int vcu, int G) {
    const int tid = opaque_tid(), lane = tid & 63, wave = __builtin_amdgcn_readfirstlane(tid >> 6), fr = lane & 15, fg = lane >> 4;
    if (vcu >= 1024) return;
    LAS unsigned char* Kt = lds; LAS unsigned char* Vt = lds + 128 * KP; LAS unsigned char* St = Vt + 128 * VP;
    u32x4 kr[4], vr[4], sr[4]; bf16x8 qf[4];
    retC_load(w, vcu, tid, kr, vr, sr); retC_loadq(w, vcu, wave, fr, fg, qf);
    for (int item = vcu; item < 1024; item += G) {
        __syncthreads();
#pragma unroll
        for (int i = 0; i < 4; ++i) { const int cidx = tid + 512 * i, j = cidx >> 4, ch = cidx & 15;
            *(LAS u32x4*)(Kt + j * KP + ch * 16) = kr[i]; *(LAS u32x4*)(Vt + j * VP + ch * 16) = vr[i]; *(LAS u32x4*)(St + j * KP + ch * 16) = sr[i]; }
        __syncthreads();
        retC_compute(p, w, lds, item, qf, wave, fr, fg, (item + G < 1024) ? item + G : -1, tid, kr, vr, sr);
    }
    __syncthreads();
}

__device__ __forceinline__ void panel_arrive_wait(unsigned* cnt, unsigned want);
__device__ __forceinline__ void sg_accum(f32x4 (&acc)[2][4], const bf16_t* A, int lda, const bf16_t* Bt, int K, int r0, int n0, int wave, int fr, int fq, int ldb = 0) {
    if (ldb == 0) ldb = K;
    const int kw = K / 8, k0 = wave * kw;
    const bf16_t* ap = A + (size_t)(r0 + fr) * lda + k0 + 8 * fq;
    const bf16_t* bp = Bt + (size_t)(n0 + fr) * ldb + k0 + 8 * fq;
    int ks = 0;
    for (; ks + 128 <= kw; ks += 128) {
        bf16x8 a[4][2], b[4][4];
#pragma unroll
        for (int s = 0; s < 4; ++s) {
#pragma unroll
            for (int i = 0; i < 2; ++i) a[s][i] = *(const bf16x8*)(ap + (size_t)(16 * i) * lda + ks + 32 * s);
#pragma unroll
            for (int j = 0; j < 4; ++j) b[s][j] = *(const bf16x8*)(bp + (size_t)(16 * j) * ldb + ks + 32 * s);
        }
#pragma unroll
        for (int s = 0; s < 4; ++s)
#pragma unroll
            for (int i = 0; i < 2; ++i)
#pragma unroll
                for (int j = 0; j < 4; ++j) acc[i][j] = MFMA16(b[s][j], a[s][i], acc[i][j]);
    }
    for (; ks < kw; ks += 64) {
        bf16x8 a[2][2], b[2][4];
#pragma unroll
        for (int s = 0; s < 2; ++s) {
#pragma unroll
            for (int i = 0; i < 2; ++i) a[s][i] = *(const bf16x8*)(ap + (size_t)(16 * i) * lda + ks + 32 * s);
#pragma unroll
            for (int j = 0; j < 4; ++j) b[s][j] = *(const bf16x8*)(bp + (size_t)(16 * j) * ldb + ks + 32 * s);
        }
#pragma unroll
        for (int s = 0; s < 2; ++s)
#pragma unroll
            for (int i = 0; i < 2; ++i)
#pragma unroll
                for (int j = 0; j < 4; ++j) acc[i][j] = MFMA16(b[s][j], a[s][i], acc[i][j]);
    }
}
template <int MODE>
__device__ __forceinline__ void sample_gemm(const Params& p, const Ws& w, LAS unsigned char* lds, int vcu, int G) {
    const int tid = opaque_tid(), lane = tid & 63, wave = __builtin_amdgcn_readfirstlane(tid >> 6), fr = lane & 15, fq = lane >> 4;
    LAS f32x4* red = (LAS f32x4*)lds;
    for (int unit = vcu; unit < 256; unit += G) {
        const int rg = (unit & 31) >> 2, r0 = rg * 32, n0 = ((unit >> 5) * 4 + (unit & 3)) * 64;
        f32x4 acc[2][4];
#pragma unroll
        for (int i = 0; i < 2; ++i)
#pragma unroll
            for (int j = 0; j < 4; ++j) acc[i][j] = (f32x4){0.f, 0.f, 0.f, 0.f};
        if (MODE == 5) {
            sg_accum(acc, w.G + (size_t)MP * 1024, 1024, w.Wt_reto, 1024, r0, n0, wave, fr, fq);
            f32x4 acc2[2][4];
#pragma unroll
            for (int i = 0; i < 2; ++i)
#pragma unroll
                for (int j = 0; j < 4; ++j) acc2[i][j] = (f32x4){0.f, 0.f, 0.f, 0.f};
            sg_accum(acc2, w.Oatt + (size_t)MP * 1024, 1024, w.Wt_atto, 512, r0, n0, wave, fr, fq, 1024);
#pragma unroll
            for (int i = 0; i < 2; ++i)
#pragma unroll
                for (int j = 0; j < 4; ++j) { const unsigned char* gp = w.g8 + (size_t)(MP + r0 + 16 * i + fr) * 4096 + n0 + 16 * j + 4 * fq;
                    acc[i][j] = acc[i][j] * dec8x4(*(const unsigned*)gp) + acc2[i][j] * dec8x4(*(const unsigned*)(gp + 2048)); }
        } else if (MODE == 6) sg_accum(acc, w.merged + (size_t)MP * DM, DM, w.Wt_o, DM, r0, n0, wave, fr, fq);
        else sg_accum(acc, w.act + (size_t)MP * FF, FF, w.Wt_down, FF, r0, n0, wave, fr, fq);
        __syncthreads();
#pragma unroll
        for (int i = 0; i < 2; ++i)
#pragma unroll
            for (int j = 0; j < 4; ++j) red[(wave * 8 + i * 4 + j) * 64 + lane] = acc[i][j];
        __syncthreads();
        const int blk = tid >> 6;
        f32x4 v = red[blk * 64 + lane];
#pragma unroll
        for (int ww = 1; ww < 8; ++ww) v += red[(ww * 8 + blk) * 64 + lane];
        const int row = MP + r0 + 16 * (blk >> 2) + fr, col = n0 + 16 * (blk & 3) + 4 * fq;
        if (MODE == 5) { u32x2 o; o.x = pk2(v[0], v[1]); o.y = pk2(v[2], v[3]); *(u32x2*)(w.merged + (size_t)row * DM + col) = o; }
        else if (MODE == 6) {
            { const u32x2 xv = *(const u32x2*)(w.xb + (size_t)row * DM + col); const float xs_ = w.rstd1[row]; v[0] += bflo(xv.x) * xs_; v[1] += bfhi(xv.x) * xs_; v[2] += bflo(xv.y) * xs_; v[3] += bfhi(xv.y) * xs_; }
            u32x2 o; o.x = pk2(v[0], v[1]); o.y = pk2(v[2], v[3]); *(u32x2*)(w.xb + (size_t)row * DM + col) = o;
            atomicAdd(w.sumsq2 + row, (v[0] * v[0] + v[1] * v[1]) + (v[2] * v[2] + v[3] * v[3]));
        } else {
            float* dst = p.out + O_Y + (size_t)row * DM + col;
            { const u32x2 xv = *(const u32x2*)(w.xb + (size_t)row * DM + col); v[0] += bflo(xv.x); v[1] += bfhi(xv.x); v[2] += bflo(xv.y); v[3] += bfhi(xv.y); }
            atomicAdd(w.sumsq3 + row, (v[0] * v[0] + v[1] * v[1]) + (v[2] * v[2] + v[3] * v[3]));
            asm volatile("s_waitcnt vmcnt(0)" ::: "memory"); __syncthreads();
            if (tid == 0) panel_arrive_wait((unsigned*)(p.ws + WS_PCNT) + 16 * (64 + rg), 32u);
            __syncthreads();
            const float rs = rsqrtf(__hip_atomic_load(w.sumsq3 + row, __ATOMIC_RELAXED, __HIP_MEMORY_SCOPE_AGENT) * (1.0f / DM) + EPS);
            __builtin_nontemporal_store(v * rs * *(const f32x4*)(p.in[18] + col), (f32x4*)dst);
        }
        __syncthreads();
    }
}

#define XB_TMO      128
#define XB_XCNT(j)  (256  + 64 * (j))
#define XB_XSUB(j)  (1280 + 64 * (j))
#define XB_XGEN(j)  (2304 + 64 * (j))
#define XB_TOP      3328
#define XB_TOPGEN   3392
#define XCD_BAR_WORDS 3456
#define XB_SPIN_CAP (1u << 18)
__device__ __forceinline__ unsigned xb_ld(unsigned* p)              { return __hip_atomic_load(p, __ATOMIC_RELAXED, __HIP_MEMORY_SCOPE_AGENT); }
__device__ __forceinline__ unsigned xb_add(unsigned* p, unsigned v) { return __hip_atomic_fetch_add(p, v, __ATOMIC_RELAXED, __HIP_MEMORY_SCOPE_AGENT); }
__device__ __forceinline__ unsigned xb_xcc_id() { return (unsigned)__builtin_amdgcn_s_getreg((3 << 11) | 20) & 0xFu; }
#define XB_SPIN(cond, bar) do { unsigned _sp = 0; while (cond) { __builtin_amdgcn_s_sleep(1); \
    if ((++_sp & 255u) == 0u) { if (xb_ld(&(bar)[XB_TMO])) break; if (_sp > XB_SPIN_CAP) { atomicAdd(&(bar)[XB_TMO], 1u); break; } } } } while (0)
struct XcdBarrier { unsigned* bar; unsigned x; volatile LAS unsigned* st; };
__device__ __forceinline__ XcdBarrier xcd_barrier_post(unsigned* bar, volatile LAS unsigned* st) {
    XcdBarrier b; b.bar = bar; b.x = xb_xcc_id(); b.st = st;
    if (threadIdx.x == 0) (void)xb_add(&bar[XB_XCNT(b.x)], 1u);
    return b;
}
__device__ __forceinline__ void xcd_barrier_complete(unsigned* bar, unsigned x, unsigned& nloc, unsigned& nx) {
    const unsigned G = gridDim.x * gridDim.y * gridDim.z;
    unsigned sum, cnt, mine, sp = 0u;
    for (;;) {
        sum = 0u; cnt = 0u; mine = 0u;
#pragma unroll
        for (unsigned j = 0; j < 16; ++j) { const unsigned c = xb_ld(&bar[XB_XCNT(j)]); sum += c; cnt += (c > 0u) ? 1u : 0u; mine = (j == x) ? c : mine; }
        if (sum == G) break;
        __builtin_amdgcn_s_sleep(1);
        if ((++sp & 255u) == 0u) { if (xb_ld(&bar[XB_TMO])) break; if (sp > XB_SPIN_CAP) { atomicAdd(&bar[XB_TMO], 1u); break; } }
    }
    nloc = mine > 0u ? mine : 1u; nx = cnt > 0u ? cnt : 1u;
}
__device__ __forceinline__ void xcd_barrier(const XcdBarrier& b) {
    asm volatile("s_waitcnt vmcnt(0)" ::: "memory");
    __syncthreads();
    if (threadIdx.x == 0) {
        unsigned* bar = b.bar;
        __builtin_amdgcn_s_waitcnt(0);
        unsigned nloc = b.st[0], nx = b.st[1];
        if (nloc == 0u) { xcd_barrier_complete(bar, b.x, nloc, nx); b.st[0] = nloc; b.st[1] = nx; }
        const unsigned old = xb_add(&bar[XB_XSUB(b.x)], 1u);
        const unsigned gen = old / nloc;
        if (old + 1u == (gen + 1u) * nloc) {
            __builtin_amdgcn_fence(__ATOMIC_RELEASE, "agent");
            asm volatile("s_waitcnt vmcnt(0)" ::: "memory");
            const unsigned og = xb_add(&bar[XB_TOP], 1u);
            const unsigned tg = og / nx;
            if (og + 1u == (tg + 1u) * nx) xb_add(&bar[XB_TOPGEN], 1u);
            else XB_SPIN(xb_ld(&bar[XB_TOPGEN]) == tg, bar);
            __builtin_amdgcn_fence(__ATOMIC_ACQUIRE, "agent");
            xb_add(&bar[XB_XGEN(b.x)], 1u);
            asm volatile("s_waitcnt vmcnt(0)" ::: "memory");
        } else {
            XB_SPIN(xb_ld(&bar[XB_XGEN(b.x)]) == gen, bar);
            __builtin_amdgcn_fence(__ATOMIC_ACQUIRE, "agent");
            asm volatile("s_waitcnt vmcnt(0)" ::: "memory");
        }
    }
    __syncthreads();
}

constexpr int LDS_BYTES = 147456;
constexpr int LDS_BARST = 143360;
constexpr int NPHASE = 12;
__global__ void __launch_bounds__(512, 2) fwd_kernel(Params p) {
    extern __shared__ __attribute__((aligned(16))) unsigned char lds_raw[];
    LAS unsigned char* lds = (LAS unsigned char*)lds_raw;
    const Ws w = make_ws(p.ws);
    const int G = gridDim.x; const int bx = blockIdx.x;
    const int vcu = (G % 8 == 0) ? (bx % 8) * (G / 8) + bx / 8 : bx;
    const int lo = p.ph_lo, hi = p.ph_hi;
    volatile LAS unsigned* barst = (volatile LAS unsigned*)(lds + LDS_BARST);
    if (threadIdx.x < 2) barst[threadIdx.x] = 0u;
    __syncthreads();
    XcdBarrier bar = xcd_barrier_post((unsigned*)(p.ws + WS_BAR), barst);
#define IN(k) (lo <= (k) && (k) < hi)
    if (lo < 0) cg::this_grid().sync();
#define SEAM(k) do { if (IN(k) && IN((k) + 1)) xcd_barrier(bar); } while (0)
    if (IN(0)) { weight_transposes<0>(p, w, lds, vcu, G); p0_xconv(p, w, lds, vcu, G);
        if (KVSLACK < 100) kv_copy_range(p, KV_SPLIT, KV_TOTAL, vcu, G); } SEAM(0);
    const size_t kv_s1 = KV_SPLIT / 100 * 20;
    const int n1 = (65 * 50) % G, n7 = (67 * 44) % G;
    if (IN(1)) {
        pg8::Gemm g{w.xb, w.Wt_in, MT, INC, DM}; pg8::StaticOrder S; S.init(MT, INC, G, bx); EpiIn E{w, p.out};
        pg8::gemm_phase<EpiIn, pg8::StaticOrder, true, true>(lds, g, S, E);
        if (n1 == 0) { weight_transposes<1>(p, w, lds, vcu, G); kv_copy_range(p, 0, kv_s1, vcu, G); } else if (bx >= n1) { weight_transposes<1>(p, w, lds, bx - n1, G - n1); kv_copy_range(p, 0, kv_s1, bx - n1, G - n1); } } SEAM(1);
    if (vcu & 1) { if (IN(5)) { attn_sample(p, w, lds, vcu, G); __syncthreads(); } if (IN(4)) { ret_sample(p, w, lds, vcu, G); __syncthreads(); } }
    { const int per = (1536 + G - 1) / G;
      if (IN(2)) attn_phase(w, lds, vcu * per, min(per, 1536 - vcu * per)); }
    if (IN(3)) { for (int it = vcu; it < 1024; it += G) retA_item(w, lds, it); }
    if (!(vcu & 1)) { if (IN(4)) { ret_sample(p, w, lds, vcu, G); __syncthreads(); } if (IN(5)) { attn_sample(p, w, lds, vcu, G); } } SEAM(5);
    if (IN(6)) { ret_scan2(p, w, vcu, G); attn_merge(w, vcu, G); } SEAM(6);
    if (IN(7)) { retC_phase(p, w, lds, vcu, G); } SEAM(7);
    if (IN(8)) {
        { pg8::Gemm g{w.G, w.Wt_reto, MP, DM, 1024}; pg8::SegOrder S; S.base.init(MP, DM, G, bx); S.A1 = w.Oatt; S.B1t = w.Wt_atto; S.nt0 = 16; S.nt1 = 8; EpiP5 E{w};
          pg8::gemm_phase<EpiP5, pg8::SegOrder, true, true>(lds, g, S, E); }
        sample_gemm<5>(p, w, lds, vcu, G); } SEAM(8);
    if (IN(9)) { pg8::Gemm g{w.merged, w.Wt_o, MP, DM, DM}; pg8::StaticOrder S; S.init(MP, DM, G, bx); EpiWo E{w};
        pg8::gemm_phase<EpiWo, pg8::StaticOrder, true, true>(lds, g, S, E);
        sample_gemm<6>(p, w, lds, vcu, G); } SEAM(9);
    if (IN(10)) {
        pg8::Gemm g{w.xb, w.Wt_up, MT, F2, DM}; pg8::UpOrder S; S.init_up(G, bx); EpiUp E{w, p.out, p.in[15], p.in[16], p.in[6]};
        pg8::gemm_phase<EpiUp, pg8::UpOrder, true, true>(lds, g, S, E);
        if (n7 == 0) { weight_transposes<2>(p, w, lds, vcu, G); kv_copy_range(p, kv_s1, KV_SPLIT, vcu, G); } else if (bx >= n7) { weight_transposes<2>(p, w, lds, bx - n7, G - n7); kv_copy_range(p, kv_s1, KV_SPLIT, bx - n7, G - n7); } } SEAM(10);
    if (IN(11)) { pg8::Gemm g{w.act, w.Wt_down, MP, DM, FF}; pg8::PanelOrder S{vcu}; EpiFin E{w, p.out, p.in[18], (unsigned*)(p.ws + WS_PCNT)};
        pg8::gemm_phase<EpiFin, pg8::PanelOrder, true, true>(lds, g, S, E);
        sample_gemm<8>(p, w, lds, vcu, G); }
#undef IN
#undef SEAM
}

extern "C" void kernel_launch(void* const* d_in, const int* in_sizes, int n_in, void* d_out, int out_size, void* d_ws, size_t ws_size, hipStream_t stream) {
    static int grid = 0;
    if (grid == 0) {
        if (n_in != 19 || (size_t)out_size != O_END || ws_size < WS_END) { fprintf(stderr, "kernel_launch: unexpected shapes: n_in %d out %d ws %zu\n", n_in, out_size, ws_size); grid = -1; return; }
        int dev = 0, cus = 0;
        if (hipGetDevice(&dev) != hipSuccess || hipDeviceGetAttribute(&cus, hipDeviceAttributeMultiprocessorCount, dev) != hipSuccess) { fprintf(stderr, "kernel_launch: device query failed\n"); grid = -1; return; }
        if (hipFuncSetAttribute((const void*)fwd_kernel, hipFuncAttributeMaxDynamicSharedMemorySize, LDS_BYTES) != hipSuccess) { fprintf(stderr, "kernel_launch: cannot get %d bytes of LDS\n", LDS_BYTES); grid = -1; return; }
        int per_cu = 0;
        if (hipOccupancyMaxActiveBlocksPerMultiprocessor(&per_cu, (const void*)fwd_kernel, 512, LDS_BYTES) != hipSuccess || per_cu < 1) fprintf(stderr, "kernel_launch: occupancy query says %d blocks/CU\n", per_cu);
        (void)hipGetLastError();
        grid = cus;
        if (grid != 256) { fprintf(stderr, "kernel_launch: this kernel is laid out for 256 CUs, device has %d\n", cus); grid = -1; return; }
    }
    if (grid < 0) return;
    if (hipMemsetAsync((char*)d_ws + WS_BAR, 0, 32768, stream) != hipSuccess) { fprintf(stderr, "kernel_launch: memset failed\n"); return; }
    Params p{};
    for (int i = 0; i < 19; ++i) p.in[i] = (const float*)d_in[i];
    p.out = (float*)d_out; p.ws = (unsigned char*)d_ws;
    p.ph_lo = 0; p.ph_hi = NPHASE;
    void* args[] = {&p};
    hipError_t e = hipLaunchCooperativeKernel((const void*)fwd_kernel, dim3(grid), dim3(512), args, LDS_BYTES, stream);
    if (e != hipSuccess) fprintf(stderr, "cooperative launch failed: %s (grid %d)\n", hipGetErrorString(e), grid);
}
```

```cpp
#include <hip/hip_runtime.h>
#include <hip/hip_cooperative_groups.h>
#include <cstdio>
#include <cstdint>
namespace cg = cooperative_groups;

#define LAS __attribute__((address_space(3)))
typedef unsigned short bf16_t;
typedef short bf16x8 __attribute__((ext_vector_type(8)));
typedef float f32x4 __attribute__((ext_vector_type(4)));
typedef float f32x2 __attribute__((ext_vector_type(2)));
typedef unsigned u32x4 __attribute__((ext_vector_type(4)));
typedef unsigned u32x2 __attribute__((ext_vector_type(2)));

constexpr int DM = 2048, SEQ = 8192, MP = 16384, MS = 256, MT = MP + MS;
constexpr int INC = 12800, FF = 5632, F2 = 11264;
constexpr int C_RQ = 0, C_RK = 1024, C_RV = 2048, C_RG = 3072, C_ATT = 4096, C_GR = 8704, C_GA = 10752;
constexpr float EPS = 1e-6f;
constexpr float QK_SCALE = 0.08838834764831845f;
constexpr size_t O_Y = 0;
constexpr size_t O_RETP = 34078720, O_RETS = 34340864;
constexpr size_t O_KV128P = 38535168, O_KV128S = 38797312, O_KV512P = 42991616, O_KV512S = 44040192, O_KV2048P = 60817408, O_KV2048S = 65011712;
constexpr size_t O_CONVP = 132120576, O_CONVS = 132165632, O_END = 132886528;
constexpr size_t MiB = 1u << 20;
constexpr size_t WS_CTL = 0;
constexpr size_t WS_WIN = 1 * MiB, WS_WRETO = 51 * MiB, WS_WATTO = 55 * MiB, WS_WO = 57 * MiB, WS_WUP = 65 * MiB, WS_WDOWN = 109 * MiB;
constexpr size_t WS_XB = 131 * MiB;
constexpr size_t WS_PROJ = 196 * MiB;
constexpr size_t WS_KVC = 603 * MiB;
constexpr size_t WS_SB = 667 * MiB;
constexpr size_t WS_G = 699 * MiB;
constexpr size_t WS_OG = 732 * MiB;
constexpr size_t WS_LSE = 781 * MiB;
constexpr size_t WS_OATT = 930 * MiB;
constexpr size_t WS_MERGED = 799 * MiB;
constexpr size_t WS_ACT = 603 * MiB;
constexpr size_t WS_G8 = 864 * MiB;
constexpr size_t WS_WATTO_P = 964 * MiB;
constexpr size_t WS_END = 968 * MiB;
constexpr size_t WS_BAR = 512 * 1024;
constexpr size_t WS_PCNT = WS_BAR + 16384;

struct Params {
    const float* in[19];
    float* out;
    unsigned char* ws;
    int ph_lo, ph_hi, dummy, pad;
};

constexpr size_t PSLAB = (size_t)MT * 128;
__device__ __forceinline__ size_t pofs(size_t row, int col) { return ((size_t)(col >> 7) * MT + row) * 128 + (col & 127); }
__device__ __forceinline__ float bflo(unsigned w) { return __uint_as_float(w << 16); }
__device__ __forceinline__ float bfhi(unsigned w) { return __uint_as_float(w & 0xffff0000u); }
__device__ __forceinline__ float bf2f(bf16_t b) { return __uint_as_float((unsigned)b << 16); }
__device__ __forceinline__ unsigned f2bf(float f) { unsigned u = __float_as_uint(f); return (u + 0x7fffu + ((u >> 16) & 1u)) >> 16; }
typedef __bf16 bf16x2_t __attribute__((ext_vector_type(2)));
__device__ __forceinline__ unsigned pk2(float lo, float hi) { f32x2 v = {lo, hi}; bf16x2_t b = __builtin_convertvector(v, bf16x2_t); return __builtin_bit_cast(unsigned, b); }
__device__ __forceinline__ unsigned enc8(float s) { const unsigned c = (unsigned)(s * 256.0f); return c > 255u ? 255u : c; }
__device__ __forceinline__ unsigned enc8x4(f32x4 s) {
    return enc8(s[0]) | (enc8(s[1]) << 8) | (enc8(s[2]) << 16) | (enc8(s[3]) << 24);
}
__device__ __forceinline__ f32x4 dec8x4(unsigned c) { return ((f32x4){(float)(c & 255u), (float)((c >> 8) & 255u), (float)((c >> 16) & 255u), (float)(c >> 24)} + 0.5f) * (1.0f / 256.0f); }
__device__ __forceinline__ float wave_sum(float v) {
#pragma unroll
    for (int o = 1; o < 64; o <<= 1) v += __shfl_xor(v, o);
    return v;
}
__device__ __forceinline__ float wave_max(float v) {
#pragma unroll
    for (int o = 1; o < 64; o <<= 1) v = fmaxf(v, __shfl_xor(v, o));
    return v;
}
__device__ __forceinline__ unsigned sigcode(float v) { return (unsigned)__builtin_amdgcn_rcpf(__builtin_amdgcn_exp2f(fmaf(v, -1.4426950408889634f, -7.99994364f)) + (1.0f / 255.99f)); }
__device__ __forceinline__ unsigned sigcode4(f32x4 s) { return sigcode(s[0]) | (sigcode(s[1]) << 8) | (sigcode(s[2]) << 16) | (sigcode(s[3]) << 24); }
__device__ __forceinline__ float sigmoidf_(float v) { return __builtin_amdgcn_rcpf(1.0f + __builtin_amdgcn_exp2f(v * -1.4426950408889634f)); }
#define LDS_WAIT() asm volatile("s_waitcnt lgkmcnt(0)" ::: "memory")
__device__ __forceinline__ int opaque_tid() { int t = threadIdx.x; asm volatile("" : "+v"(t)); return t; }

namespace pg8 {
#define PG8_LAS __attribute__((address_space(3)))
constexpr int BM = 256, BK = 64, HALF = 128, HTB = HALF * BK * 2, STAGE_BYTES = 8 * HTB, NXCD = 8, WGM = 4;
__host__ __device__ __forceinline__ int lds_byte(int r, int c) { const int st = (r >> 4) * 2 + (c >> 5), rr = r & 15, cc = c & 31, ob = rr * 64 + cc * 2; return st * 1024 + (ob ^ (((ob >> 9) & 1) << 5)); }
__host__ __device__ __forceinline__ void stage_rc(int b, int& R, int& C) { const int st = b / 1024, sb = b % 1024, swz = sb ^ (((sb >> 9) & 1) << 5); R = (st >> 1) * 16 + swz / 64; C = (st & 1) * 32 + (swz % 64) / 2; }
__host__ __device__ __forceinline__ int perm32(int rho) { const int n = rho >> 4, i = rho & 15; return 8 * (i >> 2) + 4 * n + (i & 3); }
struct Unit { int pm, pn, seg; };
struct Gemm { const bf16_t* A; const bf16_t* Bt; int M, N, K; };
struct StaticOrder {
    int nM, nN, nwg, G, c;
    __host__ __device__ void init(int M, int N, int G_, int c_) { nM = M / BM; nN = N / BM; nwg = nM * nN; G = G_; c = c_; }
    __host__ __device__ bool next(int i, Unit& u) const {
        const long L = (long)i * G + c; if (L >= nwg) return false;
        int wgid = (int)L; { const int q = nwg / NXCD, r = nwg % NXCD, xcd = wgid % NXCD, off = wgid / NXCD; wgid = (xcd < r ? xcd * (q + 1) : r * (q + 1) + (xcd - r) * q) + off; }
        const int nig = WGM * nN, gid = wgid / nig, fm = gid * WGM, gsz = (nM - fm) < WGM ? (nM - fm) : WGM;
        u.pm = fm + ((wgid % nig) % gsz); u.pn = (wgid % nig) / gsz; u.seg = 0; return true;
    }
    __device__ __forceinline__ void a_ready(const Unit&) const {}
    __device__ __forceinline__ void done(const Unit&) const {}
    __device__ __forceinline__ long a_off(const Unit& u, int K) const { return (long)u.pm * 256 * K * 2; }
    __device__ __forceinline__ const char* a_ptr(const Gemm& g, const Unit& u) const { return (const char*)g.A + a_off(u, g.K); }
    __device__ __forceinline__ const char* b_ptr(const Gemm& g, const Unit& u) const { return (const char*)g.Bt + (size_t)u.pn * 256 * g.K * 2; }
    __device__ __forceinline__ int nt(const Gemm& g, const Unit&) const { return g.K / BK; }
    __device__ __forceinline__ bool keep(const Unit&) const { return false; }
};
struct SegOrder {
    StaticOrder base; const bf16_t* A1; const bf16_t* B1t; int nt0, nt1;
    __device__ __forceinline__ bool next(int i, Unit& u) const { if (!base.next(i >> 1, u)) return false; u.seg = i & 1; return true; }
    __device__ __forceinline__ void a_ready(const Unit&) const {}
    __device__ __forceinline__ void done(const Unit&) const {}
    __device__ __forceinline__ const char* a_ptr(const Gemm& g, const Unit& u) const { return (const char*)(u.seg ? A1 : g.A) + (size_t)u.pm * 256 * g.K * 2; }
    __device__ __forceinline__ const char* b_ptr(const Gemm& g, const Unit& u) const { return (const char*)(u.seg ? B1t : g.Bt) + (size_t)u.pn * 256 * g.K * 2; }
    __device__ __forceinline__ int nt(const Gemm&, const Unit& u) const { return u.seg ? nt1 : nt0; }
    __device__ __forceinline__ bool keep(const Unit& u) const { return u.seg == 0; }
};
struct PanelOrder {
    int v;
    __device__ __forceinline__ bool next(int i, Unit& u) const { if (i >= 2) return false; u.pm = i * 32 + (v >> 3); u.pn = v & 7; u.seg = 0; return true; }
    __device__ __forceinline__ void a_ready(const Unit&) const {}
    __device__ __forceinline__ void done(const Unit&) const {}
    __device__ __forceinline__ const char* a_ptr(const Gemm& g, const Unit& u) const { return (const char*)g.A + (size_t)u.pm * 256 * g.K * 2; }
    __device__ __forceinline__ const char* b_ptr(const Gemm& g, const Unit& u) const { return (const char*)g.Bt + (size_t)u.pn * 256 * g.K * 2; }
    __device__ __forceinline__ int nt(const Gemm& g, const Unit&) const { return g.K / BK; }
    __device__ __forceinline__ bool keep(const Unit&) const { return false; }
};
struct UpOrder : StaticOrder {
    __host__ __device__ void init_up(int G_, int c_) { nM = 67; nN = 44; nwg = nM * nN; G = G_; c = c_; }
    __device__ __forceinline__ long a_off(const Unit& u, int K) const { const int row0 = (u.pm < 66) ? (u.pm / 33) * 8192 + 254 * (u.pm % 33) - 2 : 16384; return (long)row0 * K * 2; }
    __device__ __forceinline__ const char* a_ptr(const Gemm& g, const Unit& u) const { return (const char*)g.A + a_off(u, g.K); }
};

template <class Epi, class Sched, bool ALIGN_EPI = false, bool SP2 = false>
__device__ __forceinline__ void gemm_phase(PG8_LAS unsigned char* lds, const Gemm g, const Sched& S, const Epi& E) {
    const int tid = opaque_tid(), wid = __builtin_amdgcn_readfirstlane(tid >> 6), lane = tid & 63, wr = wid >> 2, wc = wid & 3, fr = lane & 15, fq = lane >> 4;
    const int K = g.K;
    unsigned voffA[2], voffB[2];
#pragma unroll
    for (int i = 0; i < 2; ++i) { int R, C; stage_rc(tid * 16 + i * 8192, R, C); const int Rb = Epi::PERM ? ((R & ~31) + perm32(R & 31)) : R;
        const int Ra = Epi::APERM ? ((R & ~63) + 4 * (R & 15) + ((R >> 4) & 3)) : R;
        voffA[i] = (unsigned)(Ra * K + C) * 2u; voffB[i] = (unsigned)(Rb * K + C) * 2u; }
    const size_t kstep = (size_t)(BK * 2);
    const size_t hstep = (size_t)HALF * K * 2;
    const unsigned ldsw = (unsigned)wid * 1024u;
    const int aoff = lds_byte(wr * 64 + fr, fq * 8), boff = lds_byte(wc * 32 + fr, fq * 8);
#define PG8_SA(b, h) (((b) * 2 + (h)) * HTB)
#define PG8_SB(b, h) ((4 + (b) * 2 + (h)) * HTB)
#define PG8_STAGE(bufoff, gbase, voff) do { _Pragma("unroll") for (int _i = 0; _i < 2; ++_i) \
        __builtin_amdgcn_global_load_lds((const unsigned*)((const char*)(gbase) + (voff)[_i]), (PG8_LAS unsigned*)(lds + (bufoff) + ldsw + _i * 8192), 16, 0, 0); } while (0)
#define PG8_LDA(dst, b, h) do { _Pragma("unroll") for (int m = 0; m < 4; ++m) _Pragma("unroll") for (int k = 0; k < 2; ++k) dst[m][k] = *(const PG8_LAS bf16x8*)(lds + PG8_SA(b, h) + aoff + m * 2048 + k * 1024); } while (0)
#define PG8_LDB(dst, b, h) do { _Pragma("unroll") for (int n = 0; n < 2; ++n) _Pragma("unroll") for (int k = 0; k < 2; ++k) dst[n][k] = *(const PG8_LAS bf16x8*)(lds + PG8_SB(b, h) + boff + n * 2048 + k * 1024); } while (0)
#define PG8_MMA(ai, bj, At, Bt) do { __builtin_amdgcn_s_setprio(1); _Pragma("unroll") for (int m = 0; m < 4; ++m) _Pragma("unroll") for (int n = 0; n < 2; ++n) _Pragma("unroll") for (int k = 0; k < 2; ++k) \
        acc[ai][bj][m][n] = __builtin_amdgcn_mfma_f32_16x16x32_bf16(Bt[n][k], At[m][k], acc[ai][bj][m][n], 0, 0, 0); __builtin_amdgcn_s_setprio(0); } while (0)
#define PG8_WAIT_V(n) asm volatile("s_waitcnt vmcnt(" #n ")" ::: "memory")
#define PG8_WAIT_L(n) asm volatile("s_waitcnt lgkmcnt(" #n ")" ::: "memory")
#define PG8_BAR __builtin_amdgcn_s_barrier()
#define PG8_SCHED __builtin_amdgcn_sched_barrier(0)
    Unit cur, nxt; int ui = 0;
    if (!S.next(0, cur)) return;
    f32x4 acc[2][2][4][2];
#pragma unroll
    for (int a = 0; a < 2; ++a)
#pragma unroll
        for (int b = 0; b < 2; ++b)
#pragma unroll
            for (int m = 0; m < 4; ++m)
#pragma unroll
                for (int n = 0; n < 2; ++n) acc[a][b][m][n] = (f32x4){0.f, 0.f, 0.f, 0.f};
    bf16x8 At[4][2], B0[2][2], B1[2][2];
    const char* cA = S.a_ptr(g, cur); const char* cB = S.b_ptr(g, cur);
    S.a_ready(cur);
    if constexpr (SP2) {
        PG8_STAGE(PG8_SB(0, 0), cB, voffB); PG8_STAGE(PG8_SB(0, 1), cB + hstep, voffB); PG8_STAGE(PG8_SA(0, 0), cA, voffA); PG8_STAGE(PG8_SA(0, 1), cA + hstep, voffA);
        if (wr == 1) PG8_BAR;
        PG8_WAIT_V(2); PG8_BAR;
        PG8_STAGE(PG8_SB(1, 0), cB + kstep, voffB); PG8_STAGE(PG8_SA(1, 0), cA + kstep, voffA); PG8_STAGE(PG8_SB(1, 1), cB + hstep + kstep, voffB);
        PG8_WAIT_V(6); PG8_BAR;
    } else {
        PG8_STAGE(PG8_SB(0, 0), cB, voffB); PG8_STAGE(PG8_SA(0, 0), cA, voffA); PG8_STAGE(PG8_SB(0, 1), cB + hstep, voffB); PG8_STAGE(PG8_SA(0, 1), cA + hstep, voffA);
        if (wr == 1) PG8_BAR;
        PG8_WAIT_V(4); PG8_BAR;
        PG8_STAGE(PG8_SB(1, 0), cB + kstep, voffB); PG8_STAGE(PG8_SA(1, 0), cA + kstep, voffA); PG8_STAGE(PG8_SB(1, 1), cB + hstep + kstep, voffB);
        PG8_WAIT_V(6); PG8_BAR;
    }
    for (;;) {
        const bool has_next = S.next(ui + 1, nxt);
        const char* nA = has_next ? S.a_ptr(g, nxt) : cA; const char* nB = has_next ? S.b_ptr(g, nxt) : cB;
        const int nt = S.nt(g, cur);
        for (int t = 0; t < nt; t += 2) {
            const bool last = (t == nt - 2);
            const char* a1 = cA + (size_t)(t + 1) * kstep;
            const char* a2 = last ? nA : cA + (size_t)(t + 2) * kstep; const char* b2 = last ? nB : cB + (size_t)(t + 2) * kstep;
            const char* a3 = a2 + kstep; const char* b3 = b2 + kstep;
            if (last && has_next) S.a_ready(nxt);
            if constexpr (Epi::DMA_PRE) { if (last) E.dma_prefetch(cur, lds, wid, lane); }
            if constexpr (SP2) {
            PG8_LDB(B0, 0, 0); PG8_LDB(B1, 0, 1); PG8_SCHED; PG8_LDA(At, 0, 0); PG8_STAGE(PG8_SA(1, 1), a1 + hstep, voffA);
            PG8_WAIT_V(8); PG8_WAIT_L(0); PG8_BAR; PG8_MMA(0, 0, At, B0); PG8_MMA(0, 1, At, B1); PG8_BAR; PG8_SCHED;
            PG8_LDA(At, 0, 1); PG8_STAGE(PG8_SB(0, 0), b2, voffB); PG8_STAGE(PG8_SB(0, 1), b2 + hstep, voffB); PG8_STAGE(PG8_SA(0, 0), a2, voffA);
            PG8_WAIT_V(8); PG8_WAIT_L(0); PG8_BAR; PG8_MMA(1, 0, At, B0); PG8_MMA(1, 1, At, B1); PG8_BAR; PG8_SCHED;
            PG8_LDB(B0, 1, 0); PG8_LDB(B1, 1, 1); PG8_SCHED; PG8_LDA(At, 1, 0); PG8_STAGE(PG8_SA(0, 1), a2 + hstep, voffA);
            PG8_WAIT_V(8); PG8_WAIT_L(0); PG8_BAR; PG8_MMA(0, 0, At, B0); PG8_MMA(0, 1, At, B1); PG8_BAR; PG8_SCHED;
            PG8_LDA(At, 1, 1); PG8_STAGE(PG8_SB(1, 0), b3, voffB); PG8_STAGE(PG8_SB(1, 1), b3 + hstep, voffB); PG8_STAGE(PG8_SA(1, 0), a3, voffA);
            PG8_WAIT_V(8); PG8_WAIT_L(0); PG8_BAR; PG8_MMA(1, 0, At, B0); PG8_MMA(1, 1, At, B1); PG8_BAR; PG8_SCHED;
            } else {
            PG8_LDB(B0, 0, 0); PG8_SCHED; PG8_LDA(At, 0, 0); PG8_STAGE(PG8_SA(1, 1), a1 + hstep, voffA);
            PG8_WAIT_L(8); PG8_BAR; PG8_WAIT_L(0); PG8_MMA(0, 0, At, B0); PG8_BAR; PG8_SCHED;
            PG8_LDB(B1, 0, 1); PG8_STAGE(PG8_SB(0, 0), b2, voffB);
            PG8_BAR; PG8_WAIT_L(0); PG8_MMA(0, 1, At, B1); PG8_BAR;
            PG8_LDA(At, 0, 1); PG8_STAGE(PG8_SA(0, 0), a2, voffA);
            PG8_BAR; PG8_WAIT_L(0); PG8_MMA(1, 0, At, B0); PG8_BAR; PG8_SCHED;
            PG8_STAGE(PG8_SB(0, 1), b2 + hstep, voffB);
            PG8_WAIT_V(6); PG8_BAR; PG8_MMA(1, 1, At, B1); PG8_BAR;
            PG8_LDB(B0, 1, 0); PG8_SCHED; PG8_LDA(At, 1, 0); PG8_STAGE(PG8_SA(0, 1), a2 + hstep, voffA);
            PG8_WAIT_L(8); PG8_BAR; PG8_WAIT_L(0); PG8_MMA(0, 0, At, B0); PG8_BAR; PG8_SCHED;
            PG8_LDB(B1, 1, 1); PG8_STAGE(PG8_SB(1, 0), b3, voffB);
            PG8_BAR; PG8_WAIT_L(0); PG8_MMA(0, 1, At, B1); PG8_BAR;
            PG8_LDA(At, 1, 1); PG8_STAGE(PG8_SA(1, 0), a3, voffA);
            PG8_BAR; PG8_WAIT_L(0); PG8_MMA(1, 0, At, B0); PG8_BAR; PG8_SCHED;
            PG8_STAGE(PG8_SB(1, 1), b3 + hstep, voffB);
            PG8_WAIT_V(6); PG8_BAR; PG8_MMA(1, 1, At, B1); PG8_BAR;
            }
        }
        if constexpr (ALIGN_EPI) { if (wr == 0) PG8_BAR; }
        E(acc, cur, wr, wc, fr, fq, lds); S.done(cur);
        if (!has_next) break;
        if (!S.keep(cur)) {
#pragma unroll
        for (int a = 0; a < 2; ++a)
#pragma unroll
            for (int b = 0; b < 2; ++b)
#pragma unroll
                for (int m = 0; m < 4; ++m)
#pragma unroll
                    for (int n = 0; n < 2; ++n) acc[a][b][m][n] = (f32x4){0.f, 0.f, 0.f, 0.f};
        }
        cur = nxt; cA = nA; cB = nB; ++ui;
        if constexpr (ALIGN_EPI) { if (wr == 1) PG8_BAR; }
    }
    PG8_WAIT_V(0);
    if constexpr (!ALIGN_EPI) { if (wr == 0) PG8_BAR; }
    PG8_BAR;
#undef PG8_SA
#undef PG8_SB
#undef PG8_STAGE
#undef PG8_LDA
#undef PG8_LDB
#undef PG8_MMA
#undef PG8_WAIT_V
#undef PG8_WAIT_L
#undef PG8_BAR
#undef PG8_SCHED
}
}

struct Ws {
    float *rstd1, *sumsq2, *sumsq3;
    bf16_t *Wt_in, *Wt_reto, *Wt_atto, *Wt_o, *Wt_up, *Wt_down;
    bf16_t *xb, *proj, *G, *Oatt, *merged, *act, *ub;
    float* kvc; bf16_t* sb; bf16_t* og; float* lse; unsigned char* g8; bf16_t* tmp;
};
__device__ __forceinline__ Ws make_ws(unsigned char* ws) {
    Ws w;
    w.rstd1 = (float*)(ws + WS_CTL); w.sumsq2 = w.rstd1 + MT; w.sumsq3 = w.sumsq2 + MT;
    w.Wt_in = (bf16_t*)(ws + WS_WIN); w.Wt_reto = (bf16_t*)(ws + WS_WRETO); w.Wt_atto = (bf16_t*)(ws + WS_WATTO_P); w.Wt_o = (bf16_t*)(ws + WS_WO);
    w.Wt_up = (bf16_t*)(ws + WS_WUP); w.Wt_down = (bf16_t*)(ws + WS_WDOWN);
    w.xb = (bf16_t*)(ws + WS_XB); w.proj = (bf16_t*)(ws + WS_PROJ); w.ub = (bf16_t*)(ws + WS_PROJ); w.G = (bf16_t*)(ws + WS_G); w.Oatt = (bf16_t*)(ws + WS_OATT);
    w.merged = (bf16_t*)(ws + WS_MERGED); w.act = (bf16_t*)(ws + WS_ACT); w.kvc = (float*)(ws + WS_KVC);
    w.g8 = ws + WS_G8; w.tmp = (bf16_t*)(ws + WS_KVC);
    w.sb = (bf16_t*)(ws + WS_SB); w.og = (bf16_t*)(ws + WS_OG); w.lse = (float*)(ws + WS_LSE);
    return w;
}

struct EpiIn {
    static constexpr bool PERM = true, DMA_PRE = false, APERM = false;
    Ws w; float* out;
    template <int CLS> __device__ __forceinline__ void body(f32x4 (&acc)[2][2][4][2], int row0, int col0, int grp, int kv) const {
#pragma unroll
        for (int ai = 0; ai < 2; ++ai)
#pragma unroll
            for (int m = 0; m < 4; ++m) {
                const int row = row0 + ai * 128 + m * 16;
#pragma unroll
                for (int bj = 0; bj < 2; ++bj) {
                    const int col = col0 + bj * 128;
                    f32x4 v0 = acc[ai][bj][m][0], v1 = acc[ai][bj][m][1];
                    if (CLS == 1) {
#pragma unroll
                        for (int i = 0; i < 4; ++i) { v0[i] = v0[i] * sigmoidf_(v0[i]); v1[i] = v1[i] * sigmoidf_(v1[i]); }
                    }
                    if (CLS == 2) { u32x2 o8; o8.x = sigcode4(v0); o8.y = sigcode4(v1); __builtin_nontemporal_store(o8, (u32x2*)(w.g8 + (unsigned)(row * 4096) + (col - C_GR))); }
                    else { u32x4 o; o.x = pk2(v0[0], v0[1]); o.y = pk2(v0[2], v0[3]); o.z = pk2(v1[0], v1[1]); o.w = pk2(v1[2], v1[3]);
                        *(u32x4*)(w.proj + (unsigned)(((col >> 7) * MT + row) * 128 + (col & 127))) = o; }
                    if (CLS == 3) {
                        const int win = 128 << (2 * grp);
                        const size_t obase_p = grp == 0 ? O_KV128P : (grp == 1 ? O_KV512P : O_KV2048P);
                        const size_t obase_s = grp == 0 ? O_KV128S : (grp == 1 ? O_KV512S : O_KV2048S);
                        const int c512 = (col & 511);
                        float* dst = nullptr;
                        if (row < MP) { const int b = row >> 13, t = row & 8191; if (t >= SEQ - win) dst = out + obase_p + ((size_t)(b * win + (t - (SEQ - win))) * 2 + kv) * 512 + c512; }
                        else { const int b = (row - MP) >> 3, t = (row - MP) & 7; dst = out + obase_s + ((size_t)(b * win + (win - 8 + t)) * 2 + kv) * 512 + c512; }
                        if (dst) { __builtin_nontemporal_store(v0, (f32x4*)dst); __builtin_nontemporal_store(v1, (f32x4*)(dst + 4)); }
                    }
                }
            }
    }
    __device__ __forceinline__ void operator()(f32x4 (&acc)[2][2][4][2], const pg8::Unit& u, int wr, int wc, int fr_, int fq_, LAS unsigned char*) const {
        int fr = fr_, fq = fq_; asm volatile("" : "+v"(fr), "+v"(fq));
        const int row0 = u.pm * 256 + wr * 64 + fr, col0 = u.pn * 256 + wc * 32 + 8 * fq;
        const int pn = u.pn;
        if (pn >= 34) body<2>(acc, row0, col0, 0, 0);
        else if (pn >= 12 && pn < 16) body<1>(acc, row0, col0, 0, 0);
        else if (pn >= 16) { const int q = (pn - 16) % 6, grp = (pn - 16) / 6;
            const int win = 128 << (2 * grp); const int t_hi = ((u.pm & 31) + 1) * 256;
            if (q >= 2 && (u.pm >= 64 || t_hi > SEQ - win)) body<3>(acc, row0, col0, grp, q >= 4 ? 1 : 0); else body<0>(acc, row0, col0, 0, 0); }
        else body<0>(acc, row0, col0, 0, 0);
    }
};
struct EpiWo {
    static constexpr bool PERM = true, DMA_PRE = false, APERM = false;
    Ws w;
    __device__ __forceinline__ void operator()(f32x4 (&acc)[2][2][4][2], const pg8::Unit& u, int wr, int wc, int fr_, int fq_, LAS unsigned char*) const {
        int fr = fr_, fq = fq_; asm volatile("" : "+v"(fr), "+v"(fq));
        const int row0 = u.pm * 256 + wr * 64 + fr;
        const int col0 = u.pn * 256 + wc * 32 + 8 * fq;
        float ssv[8];
#pragma unroll
        for (int ai = 0; ai < 2; ++ai)
#pragma unroll
            for (int m = 0; m < 4; ++m) {
                const int row = row0 + ai * 128 + m * 16;
                const float rs = w.rstd1[row];
                float ssq = 0.f;
#pragma unroll
                for (int bj = 0; bj < 2; ++bj) {
                    const int col = col0 + bj * 128;
                    f32x4 v0 = acc[ai][bj][m][0], v1 = acc[ai][bj][m][1];
                    { const u32x4 xv = *(const u32x4*)(w.xb + (unsigned)(row * DM) + col);
                      v0[0] += bflo(xv.x) * rs; v0[1] += bfhi(xv.x) * rs; v0[2] += bflo(xv.y) * rs; v0[3] += bfhi(xv.y) * rs;
                      v1[0] += bflo(xv.z) * rs; v1[1] += bfhi(xv.z) * rs; v1[2] += bflo(xv.w) * rs; v1[3] += bfhi(xv.w) * rs; }
                    u32x4 o; o.x = pk2(v0[0], v0[1]); o.y = pk2(v0[2], v0[3]); o.z = pk2(v1[0], v1[1]); o.w = pk2(v1[2], v1[3]);
                    *(u32x4*)(w.xb + (unsigned)(row * DM) + col) = o;
#pragma unroll
                    for (int i = 0; i < 4; ++i) ssq += v0[i] * v0[i] + v1[i] * v1[i];
                }
                ssq += __shfl_xor(ssq, 16); ssq += __shfl_xor(ssq, 32);
                ssv[ai * 4 + m] = ssq;
            }
        if (fq == 0) {
#pragma unroll
            for (int k = 0; k < 8; ++k) atomicAdd(w.sumsq2 + row0 + (k >> 2) * 128 + (k & 3) * 16, ssv[k]);
        }
    }
};

struct EpiP5 {
    static constexpr bool PERM = true, DMA_PRE = false, APERM = false;
    Ws w;
    __device__ __forceinline__ void operator()(f32x4 (&acc)[2][2][4][2], const pg8::Unit& u, int wr, int wc, int fr_, int fq_, LAS unsigned char*) const {
        int fr = fr_, fq = fq_; asm volatile("" : "+v"(fr), "+v"(fq));
        const int row0 = u.pm * 256 + wr * 64 + fr, col0 = u.pn * 256 + wc * 32 + 8 * fq;
        if (u.seg == 0) {
#pragma unroll
            for (int ai = 0; ai < 2; ++ai)
#pragma unroll
                for (int m = 0; m < 4; ++m) {
                    const int row = row0 + ai * 128 + m * 16;
#pragma unroll
                    for (int bj = 0; bj < 2; ++bj) { const unsigned char* gp = w.g8 + (unsigned)(row * 4096) + col0 + bj * 128;
                        const u32x2 gr = *(const u32x2*)gp, ga = *(const u32x2*)(gp + 2048);
                        const f32x4 a0 = dec8x4(ga.x), a1 = dec8x4(ga.y);
                        f32x4 q0 = dec8x4(gr.x), q1 = dec8x4(gr.y);
#pragma unroll
                        for (int i = 0; i < 4; ++i) { q0[i] *= __builtin_amdgcn_rcpf(a0[i]); q1[i] *= __builtin_amdgcn_rcpf(a1[i]); }
                        acc[ai][bj][m][0] *= q0; acc[ai][bj][m][1] *= q1; }
                }
        } else {
#pragma unroll
            for (int ai = 0; ai < 2; ++ai)
#pragma unroll
                for (int m = 0; m < 4; ++m) {
                    const int row = row0 + ai * 128 + m * 16;
#pragma unroll
                    for (int bj = 0; bj < 2; ++bj) { const int col = col0 + bj * 128;
                        const u32x2 ga = *(const u32x2*)(w.g8 + (unsigned)(row * 4096) + 2048 + col);
                        const f32x4 v0 = acc[ai][bj][m][0] * dec8x4(ga.x), v1 = acc[ai][bj][m][1] * dec8x4(ga.y);
                        u32x4 o; o.x = pk2(v0[0], v0[1]); o.y = pk2(v0[2], v0[3]); o.z = pk2(v1[0], v1[1]); o.w = pk2(v1[2], v1[3]);
                        *(u32x4*)(w.merged + (unsigned)(row * DM) + col) = o; }
                }
        }
    }
};

__device__ __forceinline__ float dpp_ror1(float v) { return __int_as_float(__builtin_amdgcn_mov_dpp(__float_as_int(v), 0x121, 0xf, 0xf, false)); }
__device__ __forceinline__ float dpp_keep(float v) { float d = dpp_ror1(v); asm volatile("" : "+v"(d)); return d; }
__device__ __forceinline__ float dpp_ror2(float v) { return __int_as_float(__builtin_amdgcn_mov_dpp(__float_as_int(v), 0x122, 0xf, 0xf, false)); }
typedef float f32x2 __attribute__((ext_vector_type(2)));
__device__ __forceinline__ f32x2 gelu_gate2(f32x2 v, f32x2 b) {
    f32x2 a; a.x = __builtin_amdgcn_fmed3f(fabsf(v.x), 0.f, 6.5f); a.y = __builtin_amdgcn_fmed3f(fabsf(v.y), 0.f, 6.5f);
    const f32x2 c9 = {3.819134520e-07f, 3.819134520e-07f}, c8 = {-7.616652965e-06f, -7.616652965e-06f}, c7 = {6.311968900e-05f, 6.311968900e-05f}, c6 = {-2.457886876e-04f, -2.457886876e-04f},
                c5 = {-5.764040543e-05f, -5.764040543e-05f}, c4 = {7.011611480e-03f, 7.011611480e-03f}, c3 = {-5.248568207e-02f, -5.248568207e-02f}, c2 = {-4.592045844e-01f, -4.592045844e-01f},
                c1 = {-1.151106715e+00f, -1.151106715e+00f}, c0 = {-9.999999404e-01f, -9.999999404e-01f};
    f32x2 p = c9 * a + c8; p = p * a + c7; p = p * a + c6; p = p * a + c5; p = p * a + c4; p = p * a + c3; p = p * a + c2; p = p * a + c1; p = p * a + c0;
    f32x2 e; e.x = __builtin_amdgcn_exp2f(p.x); e.y = __builtin_amdgcn_exp2f(p.y);
    f32x2 r; asm("v_max_f32 %0, 0, %1" : "=v"(r.x) : "v"(v.x)); asm("v_max_f32 %0, 0, %1" : "=v"(r.y) : "v"(v.y));
    return (r - a * e) * b;
}
#define CONV_SHR1(v, c, w) asm("v_fmac_f32_dpp %0, %1, %2 row_shr:1 row_mask:0xf bank_mask:0xf" : "+v"(v) : "v"(c), "v"(w))
constexpr int HALO_OFF = 131072;
constexpr int PRE_SS = HALO_OFF + 6144, PRE_CW = HALO_OFF + 7168;
struct EpiUp {
    static constexpr bool PERM = true, DMA_PRE = true, APERM = true;
    Ws w; float* out; const float* cw; const float* cb; const float* sconv;
    __device__ __forceinline__ void dma_prefetch(const pg8::Unit& u, LAS unsigned char* lds, int wid, int lane) const {
        if (wid == 0) {
            const bool samp = u.pm >= 66;
            const int rowbase = samp ? MP : (u.pm / 33) * SEQ + 254 * (u.pm % 33) - 2;
#pragma unroll
            for (int i = 0; i < 4; ++i) __builtin_amdgcn_global_load_lds((const unsigned*)(w.sumsq2 + rowbase + 64 * i + lane), (LAS unsigned*)(lds + PRE_SS + 256 * i), 4, 0, 0);
        } else if (wid == 1) {
            const int f0 = u.pn * 128 + 4 * (lane & 31), hb = (lane >> 5) * FF;
#pragma unroll
            for (int k = 0; k < 3; ++k) __builtin_amdgcn_global_load_lds((const unsigned*)(cw + (size_t)k * F2 + hb + f0), (LAS unsigned*)(lds + PRE_CW + 1024 * k), 16, 0, 0);
            __builtin_amdgcn_global_load_lds((const unsigned*)(cb + hb + f0), (LAS unsigned*)(lds + PRE_CW + 3072), 16, 0, 0);
        }
    }
    __device__ __forceinline__ void operator()(f32x4 (&acc)[2][2][4][2], const pg8::Unit& u, int wr, int wc, int fr_, int fq_, LAS unsigned char* lds) const {
        int fr = fr_, fq = fq_; asm volatile("" : "+v"(fr), "+v"(fq));
        const bool samp = u.pm >= 66;
        const int bb = samp ? 0 : u.pm / 33, jj = samp ? 0 : u.pm % 33;
        const int t0 = samp ? 0 : 254 * jj - 2;
        const int rowbase = samp ? MP : bb * SEQ + t0;
#pragma unroll
        for (int ai = 0; ai < 2; ++ai)
#pragma unroll
            for (int m = 0; m < 4; ++m) {
                const int rl = ai * 128 + wr * 64 + 4 * fr + m, t = t0 + rl;
                const bool ok = samp || (t >= 0 && t < SEQ);
                const float ss = *(const LAS float*)(lds + PRE_SS + 4 * rl);
                const float rs = ok ? __builtin_amdgcn_rsqf(ss * (1.0f / DM) + EPS) : 0.f;
#pragma unroll
                for (int bj = 0; bj < 2; ++bj) { acc[ai][bj][m][0] *= rs; acc[ai][bj][m][1] *= rs; }
            }
        asm volatile("" ::: "memory");
        LAS float* halo = (LAS float*)(lds + HALO_OFF);
        const int fcol = u.pn * 128 + wc * 32 + 8 * fq;
        if (!samp) {
            if (fr == 15) {
#pragma unroll
                for (int ai = 0; ai < 2; ++ai) { const int bd = 2 * ai + wr;
                    if (bd < 3) {
#pragma unroll
                        for (int m = 2; m < 4; ++m) { LAS f32x4* hp = (LAS f32x4*)(halo + (((bd * 4 + wc) * 8 + (m - 2) * 4 + fq) * 16));
                            hp[0] = acc[ai][0][m][0]; hp[1] = acc[ai][0][m][1]; hp[2] = acc[ai][1][m][0]; hp[3] = acc[ai][1][m][1]; } } }
            }
            asm volatile("s_waitcnt lgkmcnt(0)" ::: "memory"); __builtin_amdgcn_s_barrier(); asm volatile("" ::: "memory");
            u32x2 olo[2][4];
            const float zm = fr == 0 ? 1.0f : 0.0f;
            bf16_t* const dump = w.merged;
#pragma unroll
            for (int n = 0; n < 2; ++n) {
                const int f0 = fcol + 4 * n;
                f32x4 wa[3], wb[3];
                const LAS unsigned char* wl = lds + PRE_CW + 4 * (f0 - u.pn * 128);
#pragma unroll
                for (int k = 0; k < 3; ++k) { wa[k] = *(const LAS f32x4*)(wl + 1024 * k); wb[k] = *(const LAS f32x4*)(wl + 1024 * k + 512); }
                const f32x4 ba = *(const LAS f32x4*)(wl + 3072), bbv = *(const LAS f32x4*)(wl + 3072 + 512);
#pragma unroll
                for (int ai = 0; ai < 2; ++ai) {
                    const int gi = 2 * ai + wr;
                    const LAS f32x4* hp = (const LAS f32x4*)(halo + ((((gi > 0 ? gi - 1 : 0) * 4 + wc) * 8 + fq) * 16));
                    const f32x4 h62a = hp[n] * zm, h62b = hp[2 + n] * zm, h63a = hp[16 + n] * zm, h63b = hp[16 + 2 + n] * zm;
#pragma unroll
                    for (int m = 0; m < 4; ++m) {
                        const int rl = ai * 128 + wr * 64 + 4 * fr + m, t = t0 + rl;
                        const f32x4 ca = acc[ai][0][m][n], cbv = acc[ai][1][m][n];
                        f32x4 va = ba + wa[2] * ca, vb = bbv + wb[2] * cbv;
                        if (m >= 1) { va += wa[1] * acc[ai][0][m - 1][n]; vb += wb[1] * acc[ai][1][m - 1][n]; }
                        else { va += wa[1] * h63a; vb += wb[1] * h63b; }
                        if (m >= 2) { va += wa[0] * acc[ai][0][m - 2][n]; vb += wb[0] * acc[ai][1][m - 2][n]; }
                        else if (m == 1) { va += wa[0] * h63a; vb += wb[0] * h63b; }
                        else { va += wa[0] * h62a; vb += wb[0] * h62b; }
                        if (m < 2) {
#pragma unroll
                            for (int i = 0; i < 4; ++i) {
                                float ta = va[i], tb = vb[i];
                                if (m == 0) { CONV_SHR1(ta, acc[ai][0][3][n][i], wa[1][i]); CONV_SHR1(tb, acc[ai][1][3][n][i], wb[1][i]);
                                              CONV_SHR1(ta, acc[ai][0][2][n][i], wa[0][i]); CONV_SHR1(tb, acc[ai][1][2][n][i], wb[0][i]); }
                                else { CONV_SHR1(ta, acc[ai][0][3][n][i], wa[0][i]); CONV_SHR1(tb, acc[ai][1][3][n][i], wb[0][i]); }
                                va[i] = ta; vb[i] = tb;
                            }
                        }
                        const f32x2 g01 = gelu_gate2((f32x2){va[0], va[1]}, (f32x2){vb[0], vb[1]}), g23 = gelu_gate2((f32x2){va[2], va[3]}, (f32x2){vb[2], vb[3]});
                        u32x2 o; o.x = pk2(g01.x, g01.y); o.y = pk2(g23.x, g23.y);
                        if (n == 0) olo[ai][m] = o;
                        else { u32x4 o4; o4.x = olo[ai][m].x; o4.y = olo[ai][m].y; o4.z = o.x; o4.w = o.y;
                            const bool ok = rl >= 2 && t < SEQ;
                            bf16_t* dst = ok ? w.act + (unsigned)((rowbase + rl) * FF + fcol) : dump + (unsigned)(threadIdx.x * 8);
                            *(u32x4*)dst = o4; }
                        asm volatile("" ::: "memory");
                    }
                }
            }
            if (jj == 32) {
#pragma unroll
                for (int ai = 0; ai < 2; ++ai)
#pragma unroll
                    for (int m = 0; m < 4; ++m) { const int rl = ai * 128 + wr * 64 + 4 * fr + m, t = t0 + rl;
                        if (t >= SEQ - 2 && t < SEQ) {
#pragma unroll
                            for (int n = 0; n < 2; ++n) { float* d = out + O_CONVP + ((size_t)bb * 2 + (t - (SEQ - 2))) * F2 + fcol + 4 * n; *(f32x4*)d = acc[ai][0][m][n]; *(f32x4*)(d + FF) = acc[ai][1][m][n]; } } }
            }
        } else {
            const bool ev = !(fr & 1);
#pragma unroll
            for (int n = 0; n < 2; ++n) {
                const int f0 = fcol + 4 * n;
                f32x4 wa[3], wb[3];
                const LAS unsigned char* wl = lds + PRE_CW + 4 * (f0 - u.pn * 128);
#pragma unroll
                for (int k = 0; k < 3; ++k) { wa[k] = *(const LAS f32x4*)(wl + 1024 * k); wb[k] = *(const LAS f32x4*)(wl + 1024 * k + 512); }
                const f32x4 ba = *(const LAS f32x4*)(wl + 3072), bbv = *(const LAS f32x4*)(wl + 3072 + 512);
#pragma unroll
                for (int ai = 0; ai < 2; ++ai) {
                    const int bs = ai * 16 + wr * 8 + (fr >> 1);
                    f32x4 s1a = ba, s1b = ba, s0a = ba, s0b = ba;
                    if (ev) { const float* s1 = sconv + ((size_t)bs * 2 + 1) * F2 + f0; const float* s0 = sconv + ((size_t)bs * 2) * F2 + f0;
                        s1a = *(const f32x4*)s1; s1b = *(const f32x4*)(s1 + FF); s0a = *(const f32x4*)s0; s0b = *(const f32x4*)(s0 + FF); }
#pragma unroll
                    for (int m = 0; m < 4; ++m) {
                        const int rl = ai * 128 + wr * 64 + 4 * fr + m, ts = 4 * (fr & 1) + m;
                        const f32x4 ca = acc[ai][0][m][n], cbv = acc[ai][1][m][n];
                        f32x4 a1, a2, b1, b2;
                        if (m >= 1) { a1 = acc[ai][0][m - 1][n]; b1 = acc[ai][1][m - 1][n]; }
                        else {
#pragma unroll
                            for (int i = 0; i < 4; ++i) { const float da = dpp_keep(acc[ai][0][3][n][i]), db = dpp_keep(acc[ai][1][3][n][i]); a1[i] = ev ? s1a[i] : da; b1[i] = ev ? s1b[i] : db; } }
                        if (m >= 2) { a2 = acc[ai][0][m - 2][n]; b2 = acc[ai][1][m - 2][n]; }
                        else if (m == 1) {
#pragma unroll
                            for (int i = 0; i < 4; ++i) { const float da = dpp_keep(acc[ai][0][3][n][i]), db = dpp_keep(acc[ai][1][3][n][i]); a2[i] = ev ? s1a[i] : da; b2[i] = ev ? s1b[i] : db; } }
                        else {
#pragma unroll
                            for (int i = 0; i < 4; ++i) { const float da = dpp_keep(acc[ai][0][2][n][i]), db = dpp_keep(acc[ai][1][2][n][i]); a2[i] = ev ? s0a[i] : da; b2[i] = ev ? s0b[i] : db; } }
                        const f32x4 va = ba + wa[0] * a2 + wa[1] * a1 + wa[2] * ca;
                        const f32x4 vb = bbv + wb[0] * b2 + wb[1] * b1 + wb[2] * cbv;
                        const f32x2 g01 = gelu_gate2((f32x2){va[0], va[1]}, (f32x2){vb[0], vb[1]}), g23 = gelu_gate2((f32x2){va[2], va[3]}, (f32x2){vb[2], vb[3]});
                        u32x2 o; o.x = pk2(g01.x, g01.y); o.y = pk2(g23.x, g23.y);
                        *(u32x2*)(w.act + (unsigned)((MP + rl) * FF + f0)) = o;
                        if (ts >= 6) { float* d = out + O_CONVS + ((size_t)bs * 2 + (ts - 6)) * F2 + f0; *(f32x4*)d = ca; *(f32x4*)(d + FF) = cbv; }
                        asm volatile("" ::: "memory");
                    }
                }
            }
        }
    }
};


__device__ __forceinline__ void panel_arrive_wait(unsigned* cnt, unsigned want) {
    asm volatile("s_waitcnt vmcnt(0)" ::: "memory");
    __hip_atomic_fetch_add(cnt, 1u, __ATOMIC_RELAXED, __HIP_MEMORY_SCOPE_AGENT);
    unsigned sp = 0;
    while (__hip_atomic_load(cnt, __ATOMIC_RELAXED, __HIP_MEMORY_SCOPE_AGENT) < want) { __builtin_amdgcn_s_sleep(2); if (++sp > (1u << 22)) break; }
    asm volatile("s_waitcnt vmcnt(0)" ::: "memory");
}
struct EpiFin {
    static constexpr bool PERM = true, DMA_PRE = false, APERM = false;
    Ws w; float* out; const float* gfin; unsigned* pcnt;
    __device__ __forceinline__ void operator()(f32x4 (&acc)[2][2][4][2], const pg8::Unit& u, int wr, int wc, int fr_, int fq_, LAS unsigned char*) const {
        int fr = fr_, fq = fq_; asm volatile("" : "+v"(fr), "+v"(fq));
        const int row0 = u.pm * 256 + wr * 64 + fr;
        const int col0 = u.pn * 256 + wc * 32 + 8 * fq;
        float ssv[8];
#pragma unroll
        for (int ai = 0; ai < 2; ++ai)
#pragma unroll
            for (int m = 0; m < 4; ++m) {
                const int row = row0 + ai * 128 + m * 16;
                float ssq = 0.f;
#pragma unroll
                for (int bj = 0; bj < 2; ++bj) {
                    const int col = col0 + bj * 128;
                    const u32x4 xv = __builtin_nontemporal_load((const u32x4*)(w.xb + (unsigned)(row * DM) + col));
                    f32x4 v0 = acc[ai][bj][m][0], v1 = acc[ai][bj][m][1];
                    v0[0] += bflo(xv.x); v0[1] += bfhi(xv.x); v0[2] += bflo(xv.y); v0[3] += bfhi(xv.y);
                    v1[0] += bflo(xv.z); v1[1] += bfhi(xv.z); v1[2] += bflo(xv.w); v1[3] += bfhi(xv.w);
                    acc[ai][bj][m][0] = v0; acc[ai][bj][m][1] = v1;
#pragma unroll
                    for (int i = 0; i < 4; ++i) ssq += v0[i] * v0[i] + v1[i] * v1[i];
                }
                ssq += __shfl_xor(ssq, 16); ssq += __shfl_xor(ssq, 32);
                ssv[ai * 4 + m] = ssq;
            }
        if (fq == 0) {
#pragma unroll
            for (int k = 0; k < 8; ++k) atomicAdd(w.sumsq3 + row0 + (k >> 2) * 128 + (k & 3) * 16, ssv[k]);
        }
        asm volatile("s_waitcnt vmcnt(0)" ::: "memory"); __builtin_amdgcn_s_barrier(); asm volatile("" ::: "memory");
        if (threadIdx.x == 0) panel_arrive_wait(pcnt + 16 * u.pm, 8u);
        asm volatile("s_waitcnt vmcnt(0) lgkmcnt(0)" ::: "memory"); __builtin_amdgcn_s_barrier(); asm volatile("" ::: "memory");
        f32x4 g[2][2];
#pragma unroll
        for (int bj = 0; bj < 2; ++bj) { g[bj][0] = *(const f32x4*)(gfin + col0 + bj * 128); g[bj][1] = *(const f32x4*)(gfin + col0 + bj * 128 + 4); }
#pragma unroll
        for (int ai = 0; ai < 2; ++ai)
#pragma unroll
            for (int m = 0; m < 4; ++m) {
                const int row = row0 + ai * 128 + m * 16;
                const float rs = rsqrtf(__hip_atomic_load(w.sumsq3 + row, __ATOMIC_RELAXED, __HIP_MEMORY_SCOPE_AGENT) * (1.0f / DM) + EPS);
#pragma unroll
                for (int bj = 0; bj < 2; ++bj) { float* dst = out + O_Y + (unsigned)(row * DM) + col0 + bj * 128;
                    __builtin_nontemporal_store(acc[ai][bj][m][0] * rs * g[bj][0], (f32x4*)dst); __builtin_nontemporal_store(acc[ai][bj][m][1] * rs * g[bj][1], (f32x4*)(dst + 4)); }
            }
    }
};

__device__ __forceinline__ int up_rowmap(int n) { return n < FF ? ((n >> 7) * 256 + (n & 127)) : (((n - FF) >> 7) * 256 + 128 + ((n - FF) & 127)); }
__device__ __forceinline__ void p0_transpose_item(const float* W, int K, int N, bf16_t* WT, const float* g, bool upmap, LAS float* scr, int item, int lane, int ldt = 0) {
    if (ldt == 0) ldt = K;
    const int nblk = N / 32, kb = item / nblk, nb = item % nblk, k0 = 64 * kb, n0 = 32 * nb;
    float tv[32];
#pragma unroll
    for (int i = 0; i < 32; ++i) { const int kk = 2 * i + (lane >> 5); tv[i] = __builtin_nontemporal_load(W + (size_t)(k0 + kk) * N + n0 + (lane & 31)); }
    if (g) {
#pragma unroll
        for (int i = 0; i < 32; ++i) tv[i] *= g[k0 + 2 * i + (lane >> 5)];
    }
#pragma unroll
    for (int i = 0; i < 32; ++i) { const int kk = 2 * i + (lane >> 5); scr[kk * 33 + (lane & 31)] = tv[i]; }
    LDS_WAIT();
    const int c = lane & 7;
    const int nbase = upmap ? up_rowmap(n0) : n0;
#pragma unroll
    for (int j = 0; j < 4; ++j) { const int n = (lane >> 3) + 8 * j; const LAS float* s = scr + (8 * c) * 33 + n;
        u32x4 o; o.x = pk2(s[0 * 33], s[1 * 33]); o.y = pk2(s[2 * 33], s[3 * 33]); o.z = pk2(s[4 * 33], s[5 * 33]); o.w = pk2(s[6 * 33], s[7 * 33]);
        *(u32x4*)(WT + (size_t)(nbase + n) * ldt + k0 + 8 * c) = o; }
    LDS_WAIT();
}
#ifndef KVSLACK
#define KVSLACK 100
#endif
#define KV_SPLIT ((KVSLACK) >= 100 ? KV_TOTAL : KV_TOTAL / 100 * (KVSLACK))
template <int SET> __device__ __forceinline__ void weight_transposes(const Params& p, const Ws& w, LAS unsigned char* lds, int rk, int n) {
    const int tid = opaque_tid(), lane = tid & 63, wave = tid >> 6;
    LAS float* scr = (LAS float*)(lds + wave * 16384);
    const int gw = rk * 8 + wave, NGW = n * 8;
    constexpr int I_IN = (DM / 64) * (INC / 32), I_RO = (1024 / 64) * (DM / 32), I_AO = (512 / 64) * (DM / 32), I_O = (DM / 64) * (DM / 32), I_UP = (DM / 64) * (F2 / 32), I_DN = (FF / 64) * (DM / 32);
    constexpr int NITEMS = SET == 0 ? I_IN + I_UP : (SET == 1 ? I_RO + I_AO + I_O : I_DN);
    for (int it = gw; it < NITEMS; it += NGW) {
        int r = it;
        if (SET == 0) {
            if (r < I_IN) { p0_transpose_item(p.in[8], DM, INC, w.Wt_in, p.in[7], false, scr, r, lane); continue; } r -= I_IN;
            p0_transpose_item(p.in[14], DM, F2, w.Wt_up, p.in[13], true, scr, r, lane);
        } else if (SET == 1) {
            if (r < I_RO) { p0_transpose_item(p.in[10], 1024, DM, w.Wt_reto, nullptr, false, scr, r, lane); continue; } r -= I_RO;
            if (r < I_AO) { p0_transpose_item(p.in[11], 512, DM, w.Wt_atto, nullptr, false, scr, r, lane, 1024); continue; } r -= I_AO;
            p0_transpose_item(p.in[12], DM, DM, w.Wt_o, nullptr, false, scr, r, lane);
        } else p0_transpose_item(p.in[17], FF, DM, w.Wt_down, nullptr, false, scr, r, lane);
    }
}
__device__ __forceinline__ void p0_xconv(const Params& p, const Ws& w, LAS unsigned char* lds, int vcu, int G) {
    const int tid = opaque_tid(), lane = tid & 63, wave = tid >> 6;
    const int gw = vcu * 8 + wave, NGW = G * 8;
    for (int m = gw; m < MT; m += NGW) {
        const float* xr = (m < MP) ? p.in[0] + (size_t)m * DM : p.in[1] + (size_t)(m - MP) * DM;
        const f32x4* x4 = (const f32x4*)xr + lane;
        f32x4 v[8]; float s = 0.f;
#pragma unroll
        for (int j = 0; j < 8; ++j) { v[j] = __builtin_nontemporal_load(x4 + 64 * j); s += (v[j].x * v[j].x + v[j].y * v[j].y) + (v[j].z * v[j].z + v[j].w * v[j].w); }
        s = wave_sum(s);
        const float rs = rsqrtf(s * (1.0f / DM) + EPS);
        if (lane == 0) w.rstd1[m] = sqrtf(s * (1.0f / DM) + EPS);
        u32x2* o8 = (u32x2*)(w.xb + (size_t)m * DM) + lane;
#pragma unroll
        for (int j = 0; j < 8; ++j) { u32x2 o; o.x = pk2(v[j].x * rs, v[j].y * rs); o.y = pk2(v[j].z * rs, v[j].w * rs); o8[64 * j] = o; }
    }
    for (int i = vcu * 512 + tid; i < 2 * MT; i += G * 512) w.sumsq2[i] = 0.f;
}
constexpr size_t KV_TOTAL = (size_t)32 * 1024 * 256;
__device__ __forceinline__ void kv_resolve(const Params& p, size_t i, const f32x4*& src, f32x4*& dst) {
    const unsigned li = (unsigned)i, b = li >> 18, rr = (li >> 8) & 1023u, c4 = li & 255u, row = (rr >> 3) * 16 + 8 + (rr & 7);
    const size_t o = ((size_t)b * 2048 + row) * 256 + c4;
    src = (const f32x4*)p.in[5] + o; dst = (f32x4*)(p.out + O_KV2048S) + o - 2048;
}
__device__ __forceinline__ void kv_copy_range(const Params& p, size_t c0, size_t c1, int rk, int ncu) {
    const size_t step = (size_t)ncu * 512;
    for (size_t i0 = c0 + (size_t)rk * 512 + opaque_tid(); i0 < c1; i0 += 16 * step) {
        f32x4 v[16]; f32x4* dp[16];
#pragma unroll
        for (int k = 0; k < 16; ++k) { const size_t i = i0 + k * step; if (i < c1) { const f32x4* sp; kv_resolve(p, i, sp, dp[k]); v[k] = __builtin_nontemporal_load(sp); } }
#pragma unroll
        for (int k = 0; k < 16; ++k) { const size_t i = i0 + k * step; if (i < c1) __builtin_nontemporal_store(v[k], dp[k]); }
    }
}

__device__ __forceinline__ float lgamma_h(int h) { return logf(1.0f - exp2f(-5.0f - (float)h)); }
__device__ __forceinline__ void ret_sample(const Params& p, const Ws& w, LAS unsigned char* lds, int vcu, int G) {
    const int tid = opaque_tid(), lane = tid & 63, wave = tid >> 6;
    LAS float* qf = (LAS float*)lds;
    LAS float* kf = qf + 1024;
    LAS float* vf = kf + 1024;
    LAS float* part = vf + 1024;
    LAS float* sc = part + 4096;
    LAS float* yb = sc + 64;
    const float* gn = p.in[9];
    for (int item = vcu; item < 256; item += G) {
        const int bs = item >> 3, h = item & 7;
        const size_t m0 = MP + (size_t)bs * 8;
        const float lg = lgamma_h(h);
        __syncthreads();
        for (int i = tid; i < 1024; i += 512) { const int r = i >> 7, d = i & 127; const bf16_t* row = w.proj + pofs(m0 + r, h * 128 + d);
            qf[i] = bf2f(row[(C_RQ / 128) * PSLAB]); kf[i] = bf2f(row[(C_RK / 128) * PSLAB]) * QK_SCALE; vf[i] = bf2f(row[(C_RV / 128) * PSLAB]); }
        __syncthreads();
        if (tid < 64) { const int i = tid >> 3, j = tid & 7; float s = 0.f; for (int d = 0; d < 128; ++d) s += qf[i * 128 + d] * kf[j * 128 + d]; sc[tid] = (i >= j) ? s * __expf((float)(i - j) * lg) : 0.f; }
        const int e = tid & 127, dq = tid >> 7;
        const float* st = p.in[2] + (size_t)item * 16384;
        float* nst = p.out + O_RETS + (size_t)item * 16384;
        const float g8 = __expf(8.0f * lg);
        float kdec[8];
#pragma unroll
        for (int j = 0; j < 8; ++j) kdec[j] = __expf((float)(7 - j) * lg);
        float cr[8];
#pragma unroll
        for (int i = 0; i < 8; ++i) cr[i] = 0.f;
        float sv[32];
#pragma unroll
        for (int dd = 0; dd < 32; ++dd) sv[dd] = __builtin_nontemporal_load(st + (dq * 32 + dd) * 128 + e);
#pragma unroll
        for (int dd = 0; dd < 32; ++dd) {
            const int d = dq * 32 + dd;
            const float s = sv[dd];
            float ns = s * g8;
#pragma unroll
            for (int j = 0; j < 8; ++j) ns += kf[j * 128 + d] * kdec[j] * vf[j * 128 + e];
            __builtin_nontemporal_store(ns, nst + d * 128 + e);
#pragma unroll
            for (int i = 0; i < 8; ++i) cr[i] += qf[i * 128 + d] * s;
        }
#pragma unroll
        for (int i = 0; i < 8; ++i) part[(dq * 8 + i) * 128 + e] = cr[i];
        __syncthreads();
        for (int idx = tid; idx < 1024; idx += 512) { const int i = idx >> 7, ee = idx & 127;
            float y = (part[(0 * 8 + i) * 128 + ee] + part[(1 * 8 + i) * 128 + ee] + part[(2 * 8 + i) * 128 + ee] + part[(3 * 8 + i) * 128 + ee]) * __expf((float)(i + 1) * lg);
            for (int j = 0; j <= i; ++j) y += sc[i * 8 + j] * vf[j * 128 + ee];
            yb[idx] = y; }
        __syncthreads();
        {
            const int il = wave; const size_t m = m0 + il;
            const float a0 = yb[il * 128 + lane], a1 = yb[il * 128 + 64 + lane];
            const float mean = wave_sum(a0 + a1) * (1.0f / 128.0f);
            const float d0 = a0 - mean, d1 = a1 - mean;
            const float var = wave_sum(d0 * d0 + d1 * d1) * (1.0f / 128.0f);
            const float rstd = rsqrtf(var + EPS);
            const float g0 = bf2f(w.proj[pofs(m, C_RG + h * 128 + lane)]), g1 = bf2f(w.proj[pofs(m, C_RG + h * 128 + 64 + lane)]);
            w.G[m * 1024 + h * 128 + lane] = (bf16_t)f2bf(d0 * rstd * gn[h * 128 + lane] * g0);
            w.G[m * 1024 + h * 128 + 64 + lane] = (bf16_t)f2bf(d1 * rstd * gn[h * 128 + 64 + lane] * g1);
        }
    }
}
typedef short v4s __attribute__((ext_vector_type(4)));
__device__ __forceinline__ v4s tr16(const LAS unsigned char* p) { return __builtin_amdgcn_ds_read_tr16_b64_v4i16((LAS v4s*)p); }
__device__ __forceinline__ bf16x8 cat8(v4s a, v4s b) { return (bf16x8){a[0], a[1], a[2], a[3], b[0], b[1], b[2], b[3]}; }
#define MFMA16(a, b, c) __builtin_amdgcn_mfma_f32_16x16x32_bf16(a, b, c, 0, 0, 0)
constexpr float LOG2E = 1.4426950408889634f, LN2 = 0.6931471805599453f;
__device__ __forceinline__ float lg2gamma(int h) { return log2f(1.0f - exp2f(-5.0f - (float)h)); }
__device__ __forceinline__ bf16x8 pack8(const f32x4 a, const f32x4 b) {
    u32x4 o; o.x = pk2(a[0], a[1]); o.y = pk2(a[2], a[3]); o.z = pk2(b[0], b[1]); o.w = pk2(b[2], b[3]);
    return __builtin_bit_cast(bf16x8, o);
}
constexpr int KP = 272, VP = 288;

struct AttnDesc { int g, h, dil, qb, qcol; size_t rowbase; };
__device__ __forceinline__ AttnDesc attn_desc(int item) {
    AttnDesc d; const int rq = item & 63; d.h = (item >> 6) & 3; const int b = (item >> 8) & 1; d.g = item >> 9;
    d.dil = 1 << (2 * d.g); const int sh = 6 - 2 * d.g, r = rq >> sh; d.qb = rq & ((1 << sh) - 1);
    d.qcol = C_ATT + d.g * 1536 + d.h * 128; d.rowbase = (size_t)b * SEQ + r; return d;
}
__device__ __forceinline__ void attn_load(const Ws& w, const AttnDesc& d, int tid, bool fresh, u32x4 (&kreg)[8], u32x4 (&vreg)[8]) {
    const int s0 = 128 * (d.qb - 1);
#pragma unroll
    for (int i = 0; i < 4; ++i) { const int cidx = tid + 512 * i, c = 128 + (cidx >> 4), ch = cidx & 15, s = s0 + c;
        const bf16_t* rp = w.proj + pofs(d.rowbase + (size_t)d.dil * s, d.qcol + ch * 8); kreg[i] = __builtin_nontemporal_load((const u32x4*)(rp + 4 * PSLAB)); vreg[i] = __builtin_nontemporal_load((const u32x4*)(rp + 8 * PSLAB)); }
    if (fresh) {
#pragma unroll
        for (int i = 4; i < 8; ++i) { const int cidx = tid + 512 * (i - 4), c = cidx >> 4, ch = cidx & 15, s = max(s0 + c, 0);
            const bf16_t* rp = w.proj + pofs(d.rowbase + (size_t)d.dil * s, d.qcol + ch * 8); kreg[i] = __builtin_nontemporal_load((const u32x4*)(rp + 4 * PSLAB)); vreg[i] = __builtin_nontemporal_load((const u32x4*)(rp + 8 * PSLAB)); }
    }
}
__device__ __forceinline__ void attn_loadq(const Ws& w, const AttnDesc& d, int wave, int fr, int fg, bf16x8 (&qf)[4]) {
    const size_t mq = d.rowbase + (size_t)d.dil * (128 * d.qb + 16 * wave + fr);
#pragma unroll
    for (int ds = 0; ds < 4; ++ds) qf[ds] = __builtin_nontemporal_load((const bf16x8*)(w.proj + pofs(mq, d.qcol + 32 * ds + 8 * fg)));
}
__device__ __forceinline__ void attn_compute(const Ws& w, LAS unsigned char* lds, const AttnDesc& d, int off, bf16x8 (&qf)[4], int wave, int fr, int fg, bool has_next, const AttnDesc& dn, int tid, u32x4 (&kreg)[8], u32x4 (&vreg)[8]) {
    LAS unsigned char* Kt = lds; LAS unsigned char* Vt = lds + 256 * KP;
    const int g = d.g, h = d.h, qb = d.qb;
    asm volatile("" : "+v"(fr), "+v"(fg));
    const int iq = 16 * wave + fr;
    const size_t mq = d.rowbase + (size_t)d.dil * (128 * qb + iq);
    const int kbmin = (qb == 0) ? 8 : 0;
    const float c1 = QK_SCALE * LOG2E, c2 = exp2f(-8.0f * (float)(g * 4 + h + 1) / 12.0f) * (float)d.dil * LOG2E;
    f32x4 sc[9];
    float mx = -1e30f;
#pragma unroll
    for (int kk = 0; kk < 9; ++kk) {
        const int kb = wave + kk;
        if (kb >= kbmin) {
            f32x4 a = (f32x4){0.f, 0.f, 0.f, 0.f};
#pragma unroll
            for (int ds = 0; ds < 4; ++ds) { const bf16x8 kf = *(const LAS bf16x8*)(Kt + (((16 * kb + off) & 255) + fr) * KP + (32 * ds + 8 * fg) * 2); a = MFMA16(kf, qf[ds], a); }
#pragma unroll
            for (int r_ = 0; r_ < 4; ++r_) { const int dist = 128 + iq - (16 * kb + 4 * fg + r_); const float s = a[r_] * c1 - c2 * (float)dist; a[r_] = (dist >= 0 && dist <= 128) ? s : -1e30f; mx = fmaxf(mx, a[r_]); }
            sc[kk] = a;
        } else sc[kk] = (f32x4){-1e30f, -1e30f, -1e30f, -1e30f};
    }
    mx = fmaxf(mx, __shfl_xor(mx, 16)); mx = fmaxf(mx, __shfl_xor(mx, 32));
    float sum = 0.f;
#pragma unroll
    for (int kk = 0; kk < 9; ++kk)
#pragma unroll
        for (int r_ = 0; r_ < 4; ++r_) { const float e = __builtin_amdgcn_exp2f(sc[kk][r_] - mx); sc[kk][r_] = e; sum += e; }
    sum += __shfl_xor(sum, 16); sum += __shfl_xor(sum, 32);
    if (has_next) { attn_load(w, dn, tid, dn.qb == 0, kreg, vreg); attn_loadq(w, dn, wave, fr, fg, qf); }
    f32x4 o[8];
#pragma unroll
    for (int eb = 0; eb < 8; ++eb) o[eb] = (f32x4){0.f, 0.f, 0.f, 0.f};
    const int q4 = fr >> 2, p4 = fr & 3;
#pragma unroll
    for (int st = 0; st < 5; ++st) {
        const int kb0 = wave + 2 * st;
        const bf16x8 pf = (st < 4) ? pack8(sc[2 * st], sc[2 * st + 1]) : pack8(sc[8], (f32x4){0.f, 0.f, 0.f, 0.f});
        const LAS unsigned char* v0 = Vt + (((16 * kb0 + off) & 255) + 4 * fg + q4) * VP + 8 * p4;
        const LAS unsigned char* v1 = Vt + (((16 * kb0 + 16 + off) & 255) + 4 * fg + q4) * VP + 8 * p4;
#pragma unroll
        for (int eb = 0; eb < 8; ++eb) {
            const v4s a0 = tr16(v0 + 32 * eb);
            const v4s a1 = (st < 4) ? tr16(v1 + 32 * eb) : (v4s){0, 0, 0, 0};
            o[eb] = MFMA16(cat8(a0, a1), pf, o[eb]);
        }
    }
    const float inv = 1.0f / sum;
    bf16_t* orow = w.og + ((size_t)g * MT + mq) * 512 + h * 128 + 4 * fg;
#pragma unroll
    for (int eb = 0; eb < 8; ++eb) { u32x2 ov; ov.x = pk2(o[eb][0] * inv, o[eb][1] * inv); ov.y = pk2(o[eb][2] * inv, o[eb][3] * inv); *(u32x2*)(orow + 16 * eb) = ov; }
    if (fg == 0) w.lse[((size_t)g * MT + mq) * 4 + h] = mx * LN2 + __logf(sum);
}
__device__ __forceinline__ void attn_phase(const Ws& w, LAS unsigned char* lds, int first, int count) {
    const int tid = opaque_tid(), lane = tid & 63, wave = __builtin_amdgcn_readfirstlane(tid >> 6), fr = lane & 15, fg = lane >> 4;
    if (count <= 0) return;
    LAS unsigned char* Kt = lds; LAS unsigned char* Vt = lds + 256 * KP;
    u32x4 kreg[8], vreg[8]; bf16x8 qf[4];
    AttnDesc d = attn_desc(first);
    attn_load(w, d, tid, true, kreg, vreg); attn_loadq(w, d, wave, fr, fg, qf);
    int off = 0; bool fresh = true;
    for (int n = 0; n < count; ++n) {
        __syncthreads();
        if (fresh) off = 0; else off = (off + 128) & 255;
#pragma unroll
        for (int i = 0; i < 4; ++i) { const int cidx = tid + 512 * i, c = (128 + (cidx >> 4) + off) & 255, ch = cidx & 15;
            *(LAS u32x4*)(Kt + c * KP + ch * 16) = kreg[i]; *(LAS u32x4*)(Vt + c * VP + ch * 16) = vreg[i]; }
        if (fresh) {
#pragma unroll
            for (int i = 4; i < 8; ++i) { const int cidx = tid + 512 * (i - 4), c = ((cidx >> 4) + off) & 255, ch = cidx & 15;
                *(LAS u32x4*)(Kt + c * KP + ch * 16) = kreg[i]; *(LAS u32x4*)(Vt + c * VP + ch * 16) = vreg[i]; }
        }
        __syncthreads();
        const AttnDesc dc = d;
        const bool has_next = n + 1 < count;
        if (has_next) { d = attn_desc(first + n + 1); fresh = (d.qb == 0); }
        attn_compute(w, lds, dc, off, qf, wave, fr, fg, has_next, d, tid, kreg, vreg);
    }
    __syncthreads();
}

__device__ __forceinline__ float half_sum(float v) {
#pragma unroll
    for (int o = 1; o < 32; o <<= 1) v += __shfl_xor(v, o);
    return v;
}
__device__ __forceinline__ void attn_sample(const Params& p, const Ws& w, LAS unsigned char* lds, int vcu, int G) {
    const int tid = opaque_tid(), lane = tid & 63, wave = tid >> 6, half = lane >> 5, c = lane & 31;
    const int gw = vcu * 8 + wave, NGW = G * 8;
    for (int it = gw; it < MS * 12; it += NGW) {
        const int g = it % 3, mh = it / 3, ms = mh >> 2, h = mh & 3, m = MP + ms, b = ms >> 3, t = ms & 7;
        const int dil = 1 << (2 * g), Wb = 128 << (2 * g);
        const int qcol = C_ATT + g * 1536 + h * 128, kcol = qcol + 512, vcol = qcol + 1024;
        f32x4 q; { const u32x2 v = *(const u32x2*)(w.proj + pofs(m, qcol + 4 * c)); q = (f32x4){bflo(v.x), bfhi(v.x), bflo(v.y), bfhi(v.y)}; }
        const float slope = exp2f(-8.0f * (float)(g * 4 + h + 1) / 12.0f) * (float)dil;
        const float* cache = p.in[3 + g];
        const int jn = t >> (2 * g);
        const int ncache = 128 - jn, npair = (ncache + 1) >> 1;
        const float* kb0 = cache + ((size_t)(b * Wb + Wb + t) * 2 + 0) * 512 + h * 128 + 4 * c;
        float* kvout = p.out + (g == 0 ? O_KV128S : (g == 1 ? O_KV512S : O_KV2048S));
        const bool owner = (g == 0) ? (t == 0) : (g == 1 ? (t < 4) : true);
        float mrun = -1e30f, sum = 0.f; f32x4 o = (f32x4){0.f, 0.f, 0.f, 0.f};
#pragma unroll
        for (int j = 0; j < 8; ++j) if (j <= jn) {
            const u32x2 kk2 = *(const u32x2*)(w.proj + pofs(m - dil * j, kcol + 4 * c)), vv = *(const u32x2*)(w.proj + pofs(m - dil * j, vcol + 4 * c));
            const float s = half_sum((bflo(kk2.x) * q[0] + bfhi(kk2.x) * q[1]) + (bflo(kk2.y) * q[2] + bfhi(kk2.y) * q[3])) * QK_SCALE - slope * (float)j;
            if (half == 0) { const float mn = fmaxf(mrun, s), al = __expf(mrun - mn), e = __expf(s - mn); mrun = mn; sum = sum * al + e;
                o = o * al; o[0] += e * bflo(vv.x); o[1] += e * bfhi(vv.x); o[2] += e * bflo(vv.y); o[3] += e * bfhi(vv.y); }
        }
        for (int k0 = 0; k0 < npair; k0 += 16) {
            f32x4 kv[16], vv[16];
#pragma unroll
            for (int u = 0; u < 16; ++u) { const int j = jn + 1 + 2 * (k0 + u) + half;
                if (k0 + u < npair && j <= 128) { const float* rp = kb0 - (size_t)(dil * j) * 1024; kv[u] = __builtin_nontemporal_load((const f32x4*)rp); vv[u] = __builtin_nontemporal_load((const f32x4*)(rp + 512));
                    const int idx = Wb + t - dil * j;
                    if (owner && idx >= 8) { float* wp = kvout + ((size_t)(b * Wb + idx - 8) * 2) * 512 + h * 128 + 4 * c; __builtin_nontemporal_store(kv[u], (f32x4*)wp); __builtin_nontemporal_store(vv[u], (f32x4*)(wp + 512)); } }
                else { kv[u] = (f32x4){0.f, 0.f, 0.f, 0.f}; vv[u] = kv[u]; } }
            float s[16]; float bm = -1e30f;
#pragma unroll
            for (int u = 0; u < 16; ++u) { const int j = jn + 1 + 2 * (k0 + u) + half;
                const float d = half_sum((kv[u][0] * q[0] + kv[u][1] * q[1]) + (kv[u][2] * q[2] + kv[u][3] * q[3]));
                s[u] = (k0 + u < npair && j <= 128) ? d * QK_SCALE - slope * (float)j : -1e30f; bm = fmaxf(bm, s[u]); }
            const float mn = fmaxf(mrun, bm), al = __expf(mrun - mn); mrun = mn; sum *= al; o = o * al;
#pragma unroll
            for (int u = 0; u < 16; ++u) { const float e = __expf(s[u] - mn); sum += e; o += vv[u] * e; }
        }
        const float mo = __shfl_xor(mrun, 32), so = __shfl_xor(sum, 32);
        const float mt = fmaxf(mrun, mo), a0 = __expf(mrun - mt), a1 = __expf(mo - mt);
        const float st = sum * a0 + so * a1;
#pragma unroll
        for (int i = 0; i < 4; ++i) o[i] = o[i] * a0 + __shfl_xor(o[i], 32) * a1;
        const float inv = 1.0f / st;
        if (half == 0) { u32x2 ov; ov.x = pk2(o[0] * inv, o[1] * inv); ov.y = pk2(o[2] * inv, o[3] * inv); *(u32x2*)(w.og + ((size_t)g * MT + m) * 512 + h * 128 + 4 * c) = ov; }
        if (lane == 0) w.lse[((size_t)g * MT + m) * 4 + h] = mt + __logf(st);
    }
}

__device__ __forceinline__ void retA_item(const Ws& w, LAS unsigned char* lds, int item) {
    const int tid = opaque_tid(), lane = tid & 63, wave = __builtin_amdgcn_readfirstlane(tid >> 6), fr = lane & 15, fg = lane >> 4;
    const int c = item & 63, bh = item >> 6, h = bh & 7, b = bh >> 3;
    const size_t m0 = (size_t)b * SEQ + c * 128;
    const float lg2 = lg2gamma(h);
    LAS unsigned char* Kt = lds; LAS unsigned char* Vt = lds + 128 * VP;
#pragma unroll
    for (int i = 0; i < 4; ++i) { const int cidx = tid + 512 * i, j = cidx >> 4, ch = cidx & 15;
        const bf16_t* rp = w.proj + pofs(m0 + j, h * 128 + ch * 8);
        const u32x4 kr = *(const u32x4*)(rp + (C_RK / 128) * PSLAB), vr = *(const u32x4*)(rp + (C_RV / 128) * PSLAB);
        const float kd = exp2f((float)(127 - j) * lg2) * QK_SCALE;
        u32x4 ks; ks.x = pk2(bflo(kr.x) * kd, bfhi(kr.x) * kd); ks.y = pk2(bflo(kr.y) * kd, bfhi(kr.y) * kd); ks.z = pk2(bflo(kr.z) * kd, bfhi(kr.z) * kd); ks.w = pk2(bflo(kr.w) * kd, bfhi(kr.w) * kd);
        *(LAS u32x4*)(Kt + j * VP + ch * 16) = ks; *(LAS u32x4*)(Vt + j * VP + ch * 16) = vr; }
    __syncthreads();
    f32x4 acc[8];
#pragma unroll
    for (int db = 0; db < 8; ++db) acc[db] = (f32x4){0.f, 0.f, 0.f, 0.f};
    const int q4 = fr >> 2, p4 = fr & 3;
#pragma unroll
    for (int st = 0; st < 4; ++st) {
        const int rowoff = (32 * st + 4 * fg + q4) * VP + 8 * p4;
        const bf16x8 af = cat8(tr16(Vt + rowoff + 32 * wave), tr16(Vt + rowoff + 16 * VP + 32 * wave));
#pragma unroll
        for (int db = 0; db < 8; ++db) { const bf16x8 bfr = cat8(tr16(Kt + rowoff + 32 * db), tr16(Kt + rowoff + 16 * VP + 32 * db)); acc[db] = MFMA16(af, bfr, acc[db]); }
    }
    __syncthreads();
    {
        LAS bf16_t* stg = (LAS bf16_t*)(lds + wave * 4096);
#pragma unroll
        for (int db = 0; db < 8; ++db)
#pragma unroll
            for (int r_ = 0; r_ < 4; ++r_) stg[(4 * fg + r_) * 128 + 16 * db + fr] = (bf16_t)f2bf(acc[db][r_]);
        LDS_WAIT();
        bf16_t* dst = (bf16_t*)w.kvc + (size_t)item * 16384 + (size_t)(16 * wave) * 128;
#pragma unroll
        for (int i = 0; i < 4; ++i) { const int row = 4 * i + (lane >> 4), ch = lane & 15; *(u32x4*)(dst + row * 128 + ch * 8) = *(const LAS u32x4*)(stg + row * 128 + ch * 8); }
    }
    __syncthreads();
}
__device__ __forceinline__ void ret_scan2(const Params& p, const Ws& w, int vcu, int G) {
    for (int i = vcu * 512 + opaque_tid(); i < 16 * 8192; i += G * 512) {
        const int bh = i >> 13, idx = (i & 8191) * 2, h = bh & 7;
        const float g128 = exp2f(128.0f * lg2gamma(h));
        const bf16_t* base = (const bf16_t*)w.kvc + (size_t)bh * 64 * 16384 + idx;
        bf16_t* sbase = w.sb + (size_t)bh * 64 * 16384 + idx;
        float s0 = 0.f, s1 = 0.f;
        for (int c0 = 0; c0 < 64; c0 += 32) {
            unsigned kv[32];
#pragma unroll
            for (int k = 0; k < 32; ++k) kv[k] = __builtin_nontemporal_load((const unsigned*)(base + (size_t)(c0 + k) * 16384));
#pragma unroll
            for (int k = 0; k < 32; ++k) { *(unsigned*)(sbase + (size_t)(c0 + k) * 16384) = pk2(s0, s1); s0 = s0 * g128 + bflo(kv[k]); s1 = s1 * g128 + bfhi(kv[k]); }
        }
        const int e = idx >> 7, d = idx & 127;
        __builtin_nontemporal_store(s0, p.out + O_RETP + (size_t)bh * 16384 + d * 128 + e); __builtin_nontemporal_store(s1, p.out + O_RETP + (size_t)bh * 16384 + (d + 1) * 128 + e);
    }
}
struct MergeIn { float l0, l1, l2; u32x4 a, b, c; };
__device__ __forceinline__ MergeIn merge_load(const Ws& w, int i) {
    const int m = i >> 6, c8 = (i & 63) * 8, h = c8 >> 7; MergeIn r;
    r.l0 = w.lse[((size_t)0 * MT + m) * 4 + h]; r.l1 = w.lse[((size_t)1 * MT + m) * 4 + h]; r.l2 = w.lse[((size_t)2 * MT + m) * 4 + h];
    r.a = __builtin_nontemporal_load((const u32x4*)(w.og + ((size_t)0 * MT + m) * 512 + c8)); r.b = __builtin_nontemporal_load((const u32x4*)(w.og + ((size_t)1 * MT + m) * 512 + c8));
    r.c = __builtin_nontemporal_load((const u32x4*)(w.og + ((size_t)2 * MT + m) * 512 + c8));
    return r;
}
__device__ __forceinline__ void merge_store(const Ws& w, int i, const MergeIn& r) {
    const int m = i >> 6, c8 = (i & 63) * 8;
    const float mx = fmaxf(r.l0, fmaxf(r.l1, r.l2));
    float w0 = __expf(r.l0 - mx), w1 = __expf(r.l1 - mx), w2 = __expf(r.l2 - mx);
    const float inv = 1.0f / (w0 + w1 + w2); w0 *= inv; w1 *= inv; w2 *= inv;
    const u32x4 a = r.a, b = r.b, c = r.c;
    u32x4 o;
    o.x = pk2(w0 * bflo(a.x) + w1 * bflo(b.x) + w2 * bflo(c.x), w0 * bfhi(a.x) + w1 * bfhi(b.x) + w2 * bfhi(c.x));
    o.y = pk2(w0 * bflo(a.y) + w1 * bflo(b.y) + w2 * bflo(c.y), w0 * bfhi(a.y) + w1 * bfhi(b.y) + w2 * bfhi(c.y));
    o.z = pk2(w0 * bflo(a.z) + w1 * bflo(b.z) + w2 * bflo(c.z), w0 * bfhi(a.z) + w1 * bfhi(b.z) + w2 * bfhi(c.z));
    o.w = pk2(w0 * bflo(a.w) + w1 * bflo(b.w) + w2 * bflo(c.w), w0 * bfhi(a.w) + w1 * bfhi(b.w) + w2 * bfhi(c.w));
    *(u32x4*)(w.Oatt + (size_t)m * 1024 + c8) = o;
}
__device__ __forceinline__ void attn_merge(const Ws& w, int vcu, int G) {
    const int step = G * 512, N = MT * 64;
    for (int i = vcu * 512 + opaque_tid(); i < N; i += 3 * step) {
        const int i2 = i + step, i3 = i + 2 * step; const bool t2 = i2 < N, t3 = i3 < N;
        const MergeIn r0 = merge_load(w, i), r1 = merge_load(w, t2 ? i2 : i), r2 = merge_load(w, t3 ? i3 : i);
        merge_store(w, i, r0);
        if (t2) merge_store(w, i2, r1);
        if (t3) merge_store(w, i3, r2);
    }
}
__device__ __forceinline__ void retC_load(const Ws& w, int item, int tid, u32x4 (&kr)[4], u32x4 (&vr)[4], u32x4 (&sr)[4]) {
    const int c = item & 63, bh = item >> 6, h = bh & 7, b = bh >> 3;
    const size_t m0 = (size_t)b * SEQ + c * 128;
    const bf16_t* sbp = w.sb + (size_t)item * 16384;
#pragma unroll
    for (int i = 0; i < 4; ++i) { const int cidx = tid + 512 * i, j = cidx >> 4, ch = cidx & 15;
        const bf16_t* rp = w.proj + pofs(m0 + j, h * 128 + ch * 8);
        kr[i] = __builtin_nontemporal_load((const u32x4*)(rp + (C_RK / 128) * PSLAB)); vr[i] = __builtin_nontemporal_load((const u32x4*)(rp + (C_RV / 128) * PSLAB)); sr[i] = __builtin_nontemporal_load((const u32x4*)(sbp + j * 128 + ch * 8)); }
}
__device__ __forceinline__ void retC_loadq(const Ws& w, int item, int wave, int fr, int fg, bf16x8 (&qf)[4]) {
    const int c = item & 63, bh = item >> 6, h = bh & 7, b = bh >> 3;
    const size_t mq = (size_t)b * SEQ + c * 128 + 16 * wave + fr;
#pragma unroll
    for (int ds = 0; ds < 4; ++ds) qf[ds] = __builtin_nontemporal_load((const bf16x8*)(w.proj + pofs(mq, C_RQ + h * 128 + 32 * ds + 8 * fg)));
}
__device__ __forceinline__ void retC_compute(const Params& p, const Ws& w, LAS unsigned char* lds, int item, bf16x8 (&qf)[4], int wave, int fr, int fg, int next_item, int tid, u32x4 (&kr)[4], u32x4 (&vr)[4], u32x4 (&sr)[4]) {
    const int c = item & 63, bh = item >> 6, h = bh & 7, b = bh >> 3;
    const size_t m0 = (size_t)b * SEQ + c * 128;
    const float lg2 = lg2gamma(h);
    LAS unsigned char* Kt = lds; LAS unsigned char* Vt = lds + 128 * KP; LAS unsigned char* St = Vt + 128 * VP;
    asm volatile("" : "+v"(fr), "+v"(fg));
    const int iq = 16 * wave + fr;
    const size_t mq = m0 + iq;
    f32x4 sc[8];
#pragma unroll
    for (int kb = 0; kb < 8; ++kb) {
        if (kb <= wave) {
            f32x4 a = (f32x4){0.f, 0.f, 0.f, 0.f};
#pragma unroll
            for (int ds = 0; ds < 4; ++ds) { const bf16x8 kf = *(const LAS bf16x8*)(Kt + (16 * kb + fr) * KP + (32 * ds + 8 * fg) * 2); a = MFMA16(kf, qf[ds], a); }
#pragma unroll
            for (int r_ = 0; r_ < 4; ++r_) { const int dj = iq - (16 * kb + 4 * fg + r_); a[r_] = (dj >= 0) ? a[r_] * QK_SCALE * exp2f((float)dj * lg2) : 0.f; }
            sc[kb] = a;
        } else sc[kb] = (f32x4){0.f, 0.f, 0.f, 0.f};
    }
    f32x4 y[8], cr[8];
#pragma unroll
    for (int eb = 0; eb < 8; ++eb) { y[eb] = (f32x4){0.f, 0.f, 0.f, 0.f}; cr[eb] = (f32x4){0.f, 0.f, 0.f, 0.f}; }
    const int q4 = fr >> 2, p4 = fr & 3;
#pragma unroll
    for (int st = 0; st < 4; ++st) {
        if (2 * st <= wave) {
            const bf16x8 pf = pack8(sc[2 * st], sc[2 * st + 1]);
            const LAS unsigned char* v0 = Vt + (32 * st + 4 * fg + q4) * VP + 8 * p4;
#pragma unroll
            for (int eb = 0; eb < 8; ++eb) y[eb] = MFMA16(cat8(tr16(v0 + 32 * eb), tr16(v0 + 16 * VP + 32 * eb)), pf, y[eb]);
        }
    }
#pragma unroll
    for (int eb = 0; eb < 8; ++eb)
#pragma unroll
        for (int ds = 0; ds < 4; ++ds) { const bf16x8 sf = *(const LAS bf16x8*)(St + (16 * eb + fr) * KP + (32 * ds + 8 * fg) * 2); cr[eb] = MFMA16(sf, qf[ds], cr[eb]); }
    if (next_item >= 0) { retC_load(w, next_item, tid, kr, vr, sr); retC_loadq(w, next_item, wave, fr, fg, qf); }
    const float qd = exp2f((float)(iq + 1) * lg2);
    float s = 0.f;
#pragma unroll
    for (int eb = 0; eb < 8; ++eb) { y[eb] = y[eb] + cr[eb] * qd; s += (y[eb][0] + y[eb][1]) + (y[eb][2] + y[eb][3]); }
    s += __shfl_xor(s, 16); s += __shfl_xor(s, 32);
    const float mean = s * (1.0f / 128.0f);
    float v = 0.f;
#pragma unroll
    for (int eb = 0; eb < 8; ++eb) { y[eb] = y[eb] - mean; v += (y[eb][0] * y[eb][0] + y[eb][1] * y[eb][1]) + (y[eb][2] * y[eb][2] + y[eb][3] * y[eb][3]); }
    v += __shfl_xor(v, 16); v += __shfl_xor(v, 32);
    const float rstd = rsqrtf(v * (1.0f / 128.0f) + EPS);
    const float* gn = p.in[9] + h * 128 + 4 * fg;
    const bf16_t* grow = w.proj + pofs(mq, C_RG + h * 128 + 4 * fg);
    bf16_t* orow = w.G + mq * 1024 + h * 128 + 4 * fg;
#pragma unroll
    for (int eb = 0; eb < 8; ++eb) { const f32x4 gv = *(const f32x4*)(gn + 16 * eb); const u32x2 sg = __builtin_nontemporal_load((const u32x2*)(grow + 16 * eb));
        u32x2 ov; ov.x = pk2(y[eb][0] * rstd * gv[0] * bflo(sg.x), y[eb][1] * rstd * gv[1] * bfhi(sg.x)); ov.y = pk2(y[eb][2] * rstd * gv[2] * bflo(sg.y), y[eb][3] * rstd * gv[3] * bfhi(sg.y));
        *(u32x2*)(orow + 16 * eb) = ov; }
}
__device__ __forceinline__ void retC_phase(const Params& p, const Ws& w, LAS unsigned char* lds, int vcu, int G) {
    const int tid = opaque_tid(), lane = tid & 63, wave = __builtin_amdgcn_readfirstlane(tid >> 6), fr = lane & 15, fg = lane >> 4;
    if (vcu >= 1024) return;
    LAS unsigned char* Kt = lds; LAS unsigned char* Vt = lds + 128 * KP; LAS unsigned char* St = Vt + 128 * VP;
    u32x4 kr[4], vr[4], sr[4]; bf16x8 qf[4];
    retC_load(w, vcu, tid, kr, vr, sr); retC_loadq(w, vcu, wave, fr, fg, qf);
    for (int item = vcu; item < 1024; item += G) {
        __syncthreads();
#pragma unroll
        for (int i = 0; i < 4; ++i) { const int cidx = tid + 512 * i, j = cidx >> 4, ch = cidx & 15;
            *(LAS u32x4*)(Kt + j * KP + ch * 16) = kr[i]; *(LAS u32x4*)(Vt + j * VP + ch * 16) = vr[i]; *(LAS u32x4*)(St + j * KP + ch * 16) = sr[i]; }
        __syncthreads();
        retC_compute(p, w, lds, item, qf, wave, fr, fg, (item + G < 1024) ? item + G : -1, tid, kr, vr, sr);
    }
    __syncthreads();
}

__device__ __forceinline__ void panel_arrive_wait(unsigned* cnt, unsigned want);
__device__ __forceinline__ void sg_accum(f32x4 (&acc)[2][4], const bf16_t* A, int lda, const bf16_t* Bt, int K, int r0, int n0, int wave, int fr, int fq, int ldb = 0) {
    if (ldb == 0) ldb = K;
    const int kw = K / 8, k0 = wave * kw;
    const bf16_t* ap = A + (size_t)(r0 + fr) * lda + k0 + 8 * fq;
    const bf16_t* bp = Bt + (size_t)(n0 + fr) * ldb + k0 + 8 * fq;
    int ks = 0;
    for (; ks + 128 <= kw; ks += 128) {
        bf16x8 a[4][2], b[4][4];
#pragma unroll
        for (int s = 0; s < 4; ++s) {
#pragma unroll
            for (int i = 0; i < 2; ++i) a[s][i] = *(const bf16x8*)(ap + (size_t)(16 * i) * lda + ks + 32 * s);
#pragma unroll
            for (int j = 0; j < 4; ++j) b[s][j] = *(const bf16x8*)(bp + (size_t)(16 * j) * ldb + ks + 32 * s);
        }
#pragma unroll
        for (int s = 0; s < 4; ++s)
#pragma unroll
            for (int i = 0; i < 2; ++i)
#pragma unroll
                for (int j = 0; j < 4; ++j) acc[i][j] = MFMA16(b[s][j], a[s][i], acc[i][j]);
    }
    for (; ks < kw; ks += 64) {
        bf16x8 a[2][2], b[2][4];
#pragma unroll
        for (int s = 0; s < 2; ++s) {
#pragma unroll
            for (int i = 0; i < 2; ++i) a[s][i] = *(const bf16x8*)(ap + (size_t)(16 * i) * lda + ks + 32 * s);
#pragma unroll
            for (int j = 0; j < 4; ++j) b[s][j] = *(const bf16x8*)(bp + (size_t)(16 * j) * ldb + ks + 32 * s);
        }
#pragma unroll
        for (int s = 0; s < 2; ++s)
#pragma unroll
            for (int i = 0; i < 2; ++i)
#pragma unroll
                for (int j = 0; j < 4; ++j) acc[i][j] = MFMA16(b[s][j], a[s][i], acc[i][j]);
    }
}
template <int MODE>
__device__ __forceinline__ void sample_gemm(const Params& p, const Ws& w, LAS unsigned char* lds, int vcu, int G) {
    const int tid = opaque_tid(), lane = tid & 63, wave = __builtin_amdgcn_readfirstlane(tid >> 6), fr = lane & 15, fq = lane >> 4;
    LAS f32x4* red = (LAS f32x4*)lds;
    for (int unit = vcu; unit < 256; unit += G) {
        const int rg = (unit & 31) >> 2, r0 = rg * 32, n0 = ((unit >> 5) * 4 + (unit & 3)) * 64;
        f32x4 acc[2][4];
#pragma unroll
        for (int i = 0; i < 2; ++i)
#pragma unroll
            for (int j = 0; j < 4; ++j) acc[i][j] = (f32x4){0.f, 0.f, 0.f, 0.f};
        if (MODE == 5) {
            sg_accum(acc, w.G + (size_t)MP * 1024, 1024, w.Wt_reto, 1024, r0, n0, wave, fr, fq);
            f32x4 acc2[2][4];
#pragma unroll
            for (int i = 0; i < 2; ++i)
#pragma unroll
                for (int j = 0; j < 4; ++j) acc2[i][j] = (f32x4){0.f, 0.f, 0.f, 0.f};
            sg_accum(acc2, w.Oatt + (size_t)MP * 1024, 1024, w.Wt_atto, 512, r0, n0, wave, fr, fq, 1024);
#pragma unroll
            for (int i = 0; i < 2; ++i)
#pragma unroll
                for (int j = 0; j < 4; ++j) { const unsigned char* gp = w.g8 + (size_t)(MP + r0 + 16 * i + fr) * 4096 + n0 + 16 * j + 4 * fq;
                    acc[i][j] = acc[i][j] * dec8x4(*(const unsigned*)gp) + acc2[i][j] * dec8x4(*(const unsigned*)(gp + 2048)); }
        } else if (MODE == 6) sg_accum(acc, w.merged + (size_t)MP * DM, DM, w.Wt_o, DM, r0, n0, wave, fr, fq);
        else sg_accum(acc, w.act + (size_t)MP * FF, FF, w.Wt_down, FF, r0, n0, wave, fr, fq);
        __syncthreads();
#pragma unroll
        for (int i = 0; i < 2; ++i)
#pragma unroll
            for (int j = 0; j < 4; ++j) red[(wave * 8 + i * 4 + j) * 64 + lane] = acc[i][j];
        __syncthreads();
        const int blk = tid >> 6;
        f32x4 v = red[blk * 64 + lane];
#pragma unroll
        for (int ww = 1; ww < 8; ++ww) v += red[(ww * 8 + blk) * 64 + lane];
        const int row = MP + r0 + 16 * (blk >> 2) + fr, col = n0 + 16 * (blk & 3) + 4 * fq;
        if (MODE == 5) { u32x2 o; o.x = pk2(v[0], v[1]); o.y = pk2(v[2], v[3]); *(u32x2*)(w.merged + (size_t)row * DM + col) = o; }
        else if (MODE == 6) {
            { const u32x2 xv = *(const u32x2*)(w.xb + (size_t)row * DM + col); const float xs_ = w.rstd1[row]; v[0] += bflo(xv.x) * xs_; v[1] += bfhi(xv.x) * xs_; v[2] += bflo(xv.y) * xs_; v[3] += bfhi(xv.y) * xs_; }
            u32x2 o; o.x = pk2(v[0], v[1]); o.y = pk2(v[2], v[3]); *(u32x2*)(w.xb + (size_t)row * DM + col) = o;
            atomicAdd(w.sumsq2 + row, (v[0] * v[0] + v[1] * v[1]) + (v[2] * v[2] + v[3] * v[3]));
        } else {
            float* dst = p.out + O_Y + (size_t)row * DM + col;
            { const u32x2 xv = *(const u32x2*)(w.xb + (size_t)row * DM + col); v[0] += bflo(xv.x); v[1] += bfhi(xv.x); v[2] += bflo(xv.y); v[3] += bfhi(xv.y); }
            atomicAdd(w.sumsq3 + row, (v[0] * v[0] + v[1] * v[1]) + (v[2] * v[2] + v[3] * v[3]));
            asm volatile("s_waitcnt vmcnt(0)" ::: "memory"); __syncthreads();
            if (tid == 0) panel_arrive_wait((unsigned*)(p.ws + WS_PCNT) + 16 * (64 + rg), 32u);
            __syncthreads();
            const float rs = rsqrtf(__hip_atomic_load(w.sumsq3 + row, __ATOMIC_RELAXED, __HIP_MEMORY_SCOPE_AGENT) * (1.0f / DM) + EPS);
            __builtin_nontemporal_store(v * rs * *(const f32x4*)(p.in[18] + col), (f32x4*)dst);
        }
        __syncthreads();
    }
}

#define XB_TMO      128
#define XB_XCNT(j)  (256  + 64 * (j))
#define XB_XSUB(j)  (1280 + 64 * (j))
#define XB_XGEN(j)  (2304 + 64 * (j))
#define XB_TOP      3328
#define XB_TOPGEN   3392
#define XCD_BAR_WORDS 3456
#define XB_SPIN_CAP (1u << 18)
__device__ __forceinline__ unsigned xb_ld(unsigned* p)              { return __hip_atomic_load(p, __ATOMIC_RELAXED, __HIP_MEMORY_SCOPE_AGENT); }
__device__ __forceinline__ unsigned xb_add(unsigned* p, unsigned v) { return __hip_atomic_fetch_add(p, v, __ATOMIC_RELAXED, __HIP_MEMORY_SCOPE_AGENT); }
__device__ __forceinline__ unsigned xb_xcc_id() { return (unsigned)__builtin_amdgcn_s_getreg((3 << 11) | 20) & 0xFu; }
#define XB_SPIN(cond, bar) do { unsigned _sp = 0; while (cond) { __builtin_amdgcn_s_sleep(1); \
    if ((++_sp & 255u) == 0u) { if (xb_ld(&(bar)[XB_TMO])) break; if (_sp > XB_SPIN_CAP) { atomicAdd(&(bar)[XB_TMO], 1u); break; } } } } while (0)
struct XcdBarrier { unsigned* bar; unsigned x; volatile LAS unsigned* st; };
__device__ __forceinline__ XcdBarrier xcd_barrier_post(unsigned* bar, volatile LAS unsigned* st) {
    XcdBarrier b; b.bar = bar; b.x = xb_xcc_id(); b.st = st;
    if (threadIdx.x == 0) (void)xb_add(&bar[XB_XCNT(b.x)], 1u);
    return b;
}
__device__ __forceinline__ void xcd_barrier_complete(unsigned* bar, unsigned x, unsigned& nloc, unsigned& nx) {
    const unsigned G = gridDim.x * gridDim.y * gridDim.z;
    unsigned sum, cnt, mine, sp = 0u;
    for (;;) {
        sum = 0u; cnt = 0u; mine = 0u;
#pragma unroll
        for (unsigned j = 0; j < 16; ++j) { const unsigned c = xb_ld(&bar[XB_XCNT(j)]); sum += c; cnt += (c > 0u) ? 1u : 0u; mine = (j == x) ? c : mine; }
        if (sum == G) break;
        __builtin_amdgcn_s_sleep(1);
        if ((++sp & 255u) == 0u) { if (xb_ld(&bar[XB_TMO])) break; if (sp > XB_SPIN_CAP) { atomicAdd(&bar[XB_TMO], 1u); break; } }
    }
    nloc = mine > 0u ? mine : 1u; nx = cnt > 0u ? cnt : 1u;
}
__device__ __forceinline__ void xcd_barrier(const XcdBarrier& b) {
    asm volatile("s_waitcnt vmcnt(0)" ::: "memory");
    __syncthreads();
    if (threadIdx.x == 0) {
        unsigned* bar = b.bar;
        __builtin_amdgcn_s_waitcnt(0);
        unsigned nloc = b.st[0], nx = b.st[1];
        if (nloc == 0u) { xcd_barrier_complete(bar, b.x, nloc, nx); b.st[0] = nloc; b.st[1] = nx; }
        const unsigned old = xb_add(&bar[XB_XSUB(b.x)], 1u);
        const unsigned gen = old / nloc;
        if (old + 1u == (gen + 1u) * nloc) {
            __builtin_amdgcn_fence(__ATOMIC_RELEASE, "agent");
            asm volatile("s_waitcnt vmcnt(0)" ::: "memory");
            const unsigned og = xb_add(&bar[XB_TOP], 1u);
            const unsigned tg = og / nx;
            if (og + 1u == (tg + 1u) * nx) xb_add(&bar[XB_TOPGEN], 1u);
            else XB_SPIN(xb_ld(&bar[XB_TOPGEN]) == tg, bar);
            __builtin_amdgcn_fence(__ATOMIC_ACQUIRE, "agent");
            xb_add(&bar[XB_XGEN(b.x)], 1u);
            asm volatile("s_waitcnt vmcnt(0)" ::: "memory");
        } else {
            XB_SPIN(xb_ld(&bar[XB_XGEN(b.x)]) == gen, bar);
            __builtin_amdgcn_fence(__ATOMIC_ACQUIRE, "agent");
            asm volatile("s_waitcnt vmcnt(0)" ::: "memory");
        }
    }
    __syncthreads();
}

constexpr int LDS_BYTES = 147456;
constexpr int LDS_BARST = 143360;
constexpr int NPHASE = 12;
__global__ void __launch_bounds__(512, 2) fwd_kernel(Params p) {
    extern __shared__ __attribute__((aligned(16))) unsigned char lds_raw[];
    LAS unsigned char* lds = (LAS unsigned char*)lds_raw;
    const Ws w = make_ws(p.ws);
    const int G = gridDim.x; const int bx = blockIdx.x;
    const int vcu = (G % 8 == 0) ? (bx % 8) * (G / 8) + bx / 8 : bx;
    const int lo = p.ph_lo, hi = p.ph_hi;
    volatile LAS unsigned* barst = (volatile LAS unsigned*)(lds + LDS_BARST);
    if (threadIdx.x < 2) barst[threadIdx.x] = 0u;
    __syncthreads();
    XcdBarrier bar = xcd_barrier_post((unsigned*)(p.ws + WS_BAR), barst);
#define IN(k) (lo <= (k) && (k) < hi)
    if (lo < 0) cg::this_grid().sync();
#define SEAM(k) do { if (IN(k) && IN((k) + 1)) xcd_barrier(bar); } while (0)
    if (IN(0)) { weight_transposes<0>(p, w, lds, vcu, G); p0_xconv(p, w, lds, vcu, G);
        if (KVSLACK < 100) kv_copy_range(p, KV_SPLIT, KV_TOTAL, vcu, G); } SEAM(0);
    const size_t kv_s1 = KV_SPLIT / 100 * 20;
    const int n1 = (65 * 50) % G, n7 = (67 * 44) % G;
    if (IN(1)) {
        pg8::Gemm g{w.xb, w.Wt_in, MT, INC, DM}; pg8::StaticOrder S; S.init(MT, INC, G, bx); EpiIn E{w, p.out};
        pg8::gemm_phase<EpiIn, pg8::StaticOrder, true, true>(lds, g, S, E);
        if (n1 == 0) { weight_transposes<1>(p, w, lds, vcu, G); kv_copy_range(p, 0, kv_s1, vcu, G); } else if (bx >= n1) { weight_transposes<1>(p, w, lds, bx - n1, G - n1); kv_copy_range(p, 0, kv_s1, bx - n1, G - n1); } } SEAM(1);
    if (vcu & 1) { if (IN(5)) { attn_sample(p, w, lds, vcu, G); __syncthreads(); } if (IN(4)) { ret_sample(p, w, lds, vcu, G); __syncthreads(); } }
    { const int per = (1536 + G - 1) / G;
      if (IN(2)) attn_phase(w, lds, vcu * per, min(per, 1536 - vcu * per)); }
    if (IN(3)) { for (int it = vcu; it < 1024; it += G) retA_item(w, lds, it); }
    if (!(vcu & 1)) { if (IN(4)) { ret_sample(p, w, lds, vcu, G); __syncthreads(); } if (IN(5)) { attn_sample(p, w, lds, vcu, G); } } SEAM(5);
    if (IN(6)) { ret_scan2(p, w, vcu, G); attn_merge(w, vcu, G); } SEAM(6);
    if (IN(7)) { retC_phase(p, w, lds, vcu, G); } SEAM(7);
    if (IN(8)) {
        { pg8::Gemm g{w.G, w.Wt_reto, MP, DM, 1024}; pg8::SegOrder S; S.base.init(MP, DM, G, bx); S.A1 = w.Oatt; S.B1t = w.Wt_atto; S.nt0 = 16; S.nt1 = 8; EpiP5 E{w};
          pg8::gemm_phase<EpiP5, pg8::SegOrder, true, true>(lds, g, S, E); }
        sample_gemm<5>(p, w, lds, vcu, G); } SEAM(8);
    if (IN(9)) { pg8::Gemm g{w.merged, w.Wt_o, MP, DM, DM}; pg8::StaticOrder S; S.init(MP, DM, G, bx); EpiWo E{w};
        pg8::gemm_phase<EpiWo, pg8::StaticOrder, true, true>(lds, g, S, E);
        sample_gemm<6>(p, w, lds, vcu, G); } SEAM(9);
    if (IN(10)) {
        pg8::Gemm g{w.xb, w.Wt_up, MT, F2, DM}; pg8::UpOrder S; S.init_up(G, bx); EpiUp E{w, p.out, p.in[15], p.in[16], p.in[6]};
        pg8::gemm_phase<EpiUp, pg8::UpOrder, true, true>(lds, g, S, E);
        if (n7 == 0) { weight_transposes<2>(p, w, lds, vcu, G); kv_copy_range(p, kv_s1, KV_SPLIT, vcu, G); } else if (bx >= n7) { weight_transposes<2>(p, w, lds, bx - n7, G - n7); kv_copy_range(p, kv_s1, KV_SPLIT, bx - n7, G - n7); } } SEAM(10);
    if (IN(11)) { pg8::Gemm g{w.act, w.Wt_down, MP, DM, FF}; pg8::PanelOrder S{vcu}; EpiFin E{w, p.out, p.in[18], (unsigned*)(p.ws + WS_PCNT)};
        pg8::gemm_phase<EpiFin, pg8::PanelOrder, true, true>(lds, g, S, E);
        sample_gemm<8>(p, w, lds, vcu, G); }
#undef IN
#undef SEAM
}

extern "C" void kernel_launch(void* const* d_in, const int* in_sizes, int n_in, void* d_out, int out_size, void* d_ws, size_t ws_size, hipStream_t stream) {
    static int grid = 0;
    if (grid == 0) {
        if (n_in != 19 || (size_t)out_size != O_END || ws_size < WS_END) { fprintf(stderr, "kernel_launch: unexpected shapes: n_in %d out %d ws %zu\n", n_in, out_size, ws_size); grid = -1; return; }
        int dev = 0, cus = 0;
        if (hipGetDevice(&dev) != hipSuccess || hipDeviceGetAttribute(&cus, hipDeviceAttributeMultiprocessorCount, dev) != hipSuccess) { fprintf(stderr, "kernel_launch: device query failed\n"); grid = -1; return; }
        if (hipFuncSetAttribute((const void*)fwd_kernel, hipFuncAttributeMaxDynamicSharedMemorySize, LDS_BYTES) != hipSuccess) { fprintf(stderr, "kernel_launch: cannot get %d bytes of LDS\n", LDS_BYTES); grid = -1; return; }
        int per_cu = 0;
        if (hipOccupancyMaxActiveBlocksPerMultiprocessor(&per_cu, (const void*)fwd_kernel, 512, LDS_BYTES) != hipSuccess || per_cu < 1) fprintf(stderr, "kernel_launch: occupancy query says %d blocks/CU\n", per_cu);
        (void)hipGetLastError();
        grid = cus;
        if (grid != 256) { fprintf(stderr, "kernel_launch: this kernel is laid out for 256 CUs, device has %d\n", cus); grid = -1; return; }
    }
    if (grid < 0) return;
    if (hipMemsetAsync((char*)d_ws + WS_BAR, 0, 32768, stream) != hipSuccess) { fprintf(stderr, "kernel_launch: memset failed\n"); return; }
    Params p{};
    for (int i = 0; i < 19; ++i) p.in[i] = (const float*)d_in[i];
    p.out = (float*)d_out; p.ws = (unsigned char*)d_ws;
    p.ph_lo = 0; p.ph_hi = NPHASE;
    void* args[] = {&p};
    hipError_t e = hipLaunchCooperativeKernel((const void*)fwd_kernel, dim3(grid), dim3(512), args, LDS_BYTES, stream);
    if (e != hipSuccess) fprintf(stderr, "cooperative launch failed: %s (grid %d)\n", hipGetErrorString(e), grid);
}
```
